# Optimizing an MI355X kernel written in HIP

```python
import jax
import jax.numpy as jnp
from jax import lax
import numpy as np

D_MODEL = 1024
BATCH = 16
SEQ = 4096
DEPTH = 2

F32 = jnp.float32
N_EVEN = (DEPTH + 1) // 2
N_ODD = DEPTH // 2
EPS = 1e-6
ROPE_THETA = 500000.0

HG_DIM = 128
HG_WIDTH = D_MODEL // 2
HG_HEADS = HG_WIDTH // HG_DIM
HG_CHUNK = 64

NSA_HD = 64
NSA_WIDTH = D_MODEL // 2
NSA_HEADS = NSA_WIDTH // NSA_HD
NSA_KV = 2
CMP_LEN = 32
CMP_STRIDE = 16
CMP_HIDDEN = 256
SEL_LEN = 64
SEL_TOPN = 8
NSA_WINDOW = 512
NSA_QBLOCK = 64
FORCE_BONUS = 1e4

SWA_HD = 64
SWA_HEADS = D_MODEL // SWA_HD
SWA_KV = 2
SWA_WINDOW = 128
SWA_QBLOCK = 128

N_GROUPS = 4
EXP_PER_GROUP = 8
N_EXPERTS = N_GROUPS * EXP_PER_GROUP
TOP_K = 2
EXPERT_FF = 512
MOE_BLOCK = 256

EV_PROJ = 4 * HG_WIDTH + NSA_WIDTH + 6 * NSA_KV * NSA_HD + 3 * NSA_HEADS
OD_PROJ = SWA_HEADS * SWA_HD + 2 * SWA_KV * SWA_HD

kernel_name = 'hybrid_hgrn2_nsa_swa_hmoe'


def rmsnorm(x, gain):
    xf = x.astype(F32)
    y = xf * lax.rsqrt(jnp.mean(xf * xf, axis=-1, keepdims=True) + EPS)
    return (y * gain.astype(F32)).astype(x.dtype)


def rope_partial(x, pos):
    hd = x.shape[-1]
    rot = hd // 4
    half = rot // 2
    inv = jnp.power(ROPE_THETA, -jnp.arange(half, dtype=F32) * 2.0 / rot)
    ang = pos[:, None] * inv[None, :]
    cos = jnp.cos(ang)[:, None, :]
    sin = jnp.sin(ang)[:, None, :]
    xf = x.astype(F32)
    x1 = xf[..., :half]
    x2 = xf[..., half:rot]
    out = jnp.concatenate([x1 * cos - x2 * sin, x2 * cos + x1 * sin, xf[..., rot:]], axis=-1)
    return out.astype(x.dtype)


def masked_softmax(s, mask):
    s = jnp.where(mask, s.astype(F32), -jnp.inf)
    m = jnp.max(s, axis=-1, keepdims=True)
    m = jnp.where(jnp.isfinite(m), m, 0.0)
    p = jnp.exp(s - m)
    return p / jnp.maximum(jnp.sum(p, axis=-1, keepdims=True), 1e-30)


def hgrn2_mix(q, f_logit, inp, gate, lb, out_gain):
    B, S, W = q.shape
    H, Dh, C = HG_HEADS, HG_DIM, HG_CHUNK
    n_chunks = S // C
    z = f_logit.astype(F32)
    log_f = jnp.log(lb + (1.0 - lb) * jax.nn.sigmoid(z))
    k = (1.0 - lb) * jax.nn.sigmoid(-z)

    def chunks(t):
        return t.astype(F32).reshape(B, n_chunks, C, H, Dh).transpose(1, 0, 3, 2, 4)

    causal = jnp.tril(jnp.ones((C, C), dtype=bool))

    def step(state, xs):
        qc, kc, vc, lfc = xs
        b = jnp.cumsum(lfc, axis=2)
        diff = jnp.where(causal[:, :, None], b[:, :, :, None, :] - b[:, :, None, :, :], -jnp.inf)
        scores = jnp.einsum('bhtd,bhsd,bhtsd->bhts', qc, kc, jnp.exp(diff))
        b_last = b[:, :, -1, :]
        o = (jnp.einsum('bhts,bhsv->bhtv', scores, vc)
             + jnp.einsum('bhtd,bhdv->bhtv', qc * jnp.exp(b), state))
        state = (state * jnp.exp(b_last)[..., None]
                 + jnp.einsum('bhsd,bhsv->bhdv', kc * jnp.exp(b_last[:, :, None, :] - b), vc))
        return state, o

    s0 = jnp.zeros((B, H, Dh, Dh), F32)
    _, o = lax.scan(step, s0, (chunks(q), chunks(k), chunks(inp), chunks(log_f)))
    o = o.transpose(1, 0, 3, 2, 4).reshape(B, S, H, Dh)
    g = gate.astype(F32).reshape(B, S, H, Dh)
    o = rmsnorm(o, out_gain) * jax.nn.silu(g)
    return o.reshape(B, S, W).astype(q.dtype)


def compress_blocks(t, pe, w1, w2):
    B, S, G, d = t.shape
    r = CMP_LEN // CMP_STRIDE
    n_cmp = S // CMP_STRIDE - r + 1
    c = t.reshape(B, S // CMP_STRIDE, CMP_STRIDE, G, d)
    blocks = jnp.concatenate([c[:, j:j + n_cmp] for j in range(r)], axis=2)
    blocks = blocks + pe[:, None, :]
    flat = blocks.transpose(0, 1, 3, 2, 4).reshape(B, n_cmp, G, CMP_LEN * d)
    return jax.nn.gelu(flat @ w1) @ w2


def nsa_mix(q, kc, vc, ks, vs, kw, vw, gate_logits, q_gain, k_gain, cmp_pe, cmp_w1, cmp_w2):
    B, S, H, d = q.shape
    G = kc.shape[2]
    hpg = H // G
    QB = NSA_QBLOCK
    nqb = S // QB
    scale = d ** -0.5
    pos = jnp.arange(S, dtype=F32)
    q = rope_partial(rmsnorm(q, q_gain), pos)
    kc_blk = compress_blocks(kc, cmp_pe[0], cmp_w1[0], cmp_w2[0])
    vc_blk = compress_blocks(vc, cmp_pe[1], cmp_w1[1], cmp_w2[1]).astype(F32)
    n_cmp = kc_blk.shape[1]
    cmp_start = jnp.arange(n_cmp) * CMP_STRIDE
    cmp_end = cmp_start + CMP_LEN - 1
    kc_blk = rope_partial(rmsnorm(kc_blk, k_gain[0]), cmp_end.astype(F32))
    ks = rope_partial(rmsnorm(ks, k_gain[1]), pos)
    kw = rope_partial(rmsnorm(kw, k_gain[2]), pos)
    n_sel = S // SEL_LEN
    n_top = min(SEL_TOPN, n_sel)
    sel_start = jnp.arange(n_sel) * SEL_LEN
    cover = ((cmp_start[:, None] < sel_start[None, :] + SEL_LEN)
             & (cmp_start[:, None] + CMP_LEN > sel_start[None, :])).astype(F32)
    ks_t = ks.transpose(0, 2, 1, 3)
    vs_t = vs.transpose(0, 2, 1, 3)
    bi = jnp.arange(B)[:, None, None]
    gi = jnp.arange(G)[None, :, None]
    kw_pad = jnp.pad(kw, ((0, 0), (NSA_WINDOW, 0), (0, 0), (0, 0)))
    vw_pad = jnp.pad(vw, ((0, 0), (NSA_WINDOW, 0), (0, 0), (0, 0)))
    n_win = NSA_WINDOW + QB
    n_selk = n_top * SEL_LEN
    q_blocks = q.reshape(B, nqb, QB, G, hpg, d).transpose(1, 0, 2, 3, 4, 5)
    g_blocks = jax.nn.sigmoid(gate_logits.astype(F32)).reshape(B, nqb, QB, G, hpg, 3).transpose(1, 0, 2, 3, 4, 5)

    def block(args):
        qg, gb, i = args
        t = i * QB + jnp.arange(QB)
        s_c = jnp.einsum('bqghd,bngd->bqghn', qg, kc_blk).astype(F32) * scale
        p_c = masked_softmax(s_c, (cmp_end[None, :] <= t[:, None])[None, :, None, None, :])
        o_c = jnp.einsum('bqghn,bngd->bqghd', p_c, vc_blk)
        imp = jnp.einsum('bqghn,nj->bqgj', p_c, cover)
        cur = t // SEL_LEN
        jj = jnp.arange(n_sel)[None, :]
        allowed = sel_start[None, :] <= t[:, None]
        forced = (jj == 0) | (jj == cur[:, None]) | (jj == cur[:, None] - 1)
        score = jnp.where(allowed[None, :, None, :], imp + FORCE_BONUS * forced[None, :, None, :], -jnp.inf)
        top_s, top_j = lax.top_k(score, n_top)
        tok = top_j[..., None] * SEL_LEN + jnp.arange(SEL_LEN)
        valid = jnp.isfinite(top_s)[..., None] & (tok <= t[None, :, None, None, None])
        idx = tok.transpose(0, 2, 1, 3, 4).reshape(B, G, QB * n_selk)
        k_sel = ks_t[bi, gi, idx].reshape(B, G, QB, n_selk, d)
        v_sel = vs_t[bi, gi, idx].reshape(B, G, QB, n_selk, d).astype(F32)
        s_s = jnp.einsum('bqghd,bgqkd->bqghk', qg, k_sel).astype(F32) * scale
        p_s = masked_softmax(s_s, valid.reshape(B, QB, G, 1, n_selk))
        o_s = jnp.einsum('bqghk,bgqkd->bqghd', p_s, v_sel)
        kp = i * QB - NSA_WINDOW + jnp.arange(n_win)
        kb = lax.dynamic_slice_in_dim(kw_pad, i * QB, n_win, axis=1)
        vb = lax.dynamic_slice_in_dim(vw_pad, i * QB, n_win, axis=1).astype(F32)
        wmask = (kp[None, :] <= t[:, None]) & (kp[None, :] > t[:, None] - NSA_WINDOW) & (kp[None, :] >= 0)
        s_w = jnp.einsum('bqghd,bkgd->bqghk', qg, kb).astype(F32) * scale
        p_w = masked_softmax(s_w, wmask[None, :, None, None, :])
        o_w = jnp.einsum('bqghk,bkgd->bqghd', p_w, vb)
        o = gb[..., 0:1] * o_c + gb[..., 1:2] * o_s + gb[..., 2:3] * o_w
        return o.reshape(B, QB, H * d).astype(q.dtype)

    out = lax.map(block, (q_blocks, g_blocks, jnp.arange(nqb)))
    return out.transpose(1, 0, 2, 3).reshape(B, S, H * d)


def swa_sink_attention(q, k, v, sinks):
    B, S, H, d = q.shape
    G = k.shape[2]
    hpg = H // G
    QB, W = SWA_QBLOCK, SWA_WINDOW
    nqb = S // QB
    n_keys = W + QB
    scale = d ** -0.5
    kpad = jnp.pad(k, ((0, 0), (W, 0), (0, 0), (0, 0)))
    vpad = jnp.pad(v, ((0, 0), (W, 0), (0, 0), (0, 0)))
    q_blocks = q.reshape(B, nqb, QB, G, hpg, d).transpose(1, 0, 2, 3, 4, 5)
    sink = sinks.astype(F32).reshape(G, hpg)

    def block(args):
        qg, i = args
        t = i * QB + jnp.arange(QB)
        kp = i * QB - W + jnp.arange(n_keys)
        kb = lax.dynamic_slice_in_dim(kpad, i * QB, n_keys, axis=1)
        vb = lax.dynamic_slice_in_dim(vpad, i * QB, n_keys, axis=1).astype(F32)
        mask = (kp[None, :] <= t[:, None]) & (kp[None, :] > t[:, None] - W) & (kp[None, :] >= 0)
        s = jnp.einsum('bqghd,bkgd->bqghk', qg, kb).astype(F32) * scale
        s = jnp.where(mask[None, :, None, None, :], s, -jnp.inf)
        m = jnp.maximum(jnp.max(s, axis=-1), sink[None, None])
        p = jnp.exp(s - m[..., None])
        den = jnp.sum(p, axis=-1) + jnp.exp(sink[None, None] - m)
        o = jnp.einsum('bqghk,bkgd->bqghd', p, vb) / den[..., None]
        return o.reshape(B, QB, H * d).astype(q.dtype)

    out = lax.map(block, (q_blocks, jnp.arange(nqb)))
    return out.transpose(1, 0, 2, 3).reshape(B, S, H * d)


def even_mixer(h, w_in, lb, hg_gain, nsa_q_gain, nsa_k_gain, cmp_pe, cmp_w1, cmp_w2, w_out):
    B, S, _ = h.shape
    proj = h @ w_in
    sizes = [HG_WIDTH] * 4 + [NSA_WIDTH] + [NSA_KV * NSA_HD] * 6 + [3 * NSA_HEADS]
    cuts = [int(c) for c in np.cumsum(sizes)[:-1]]
    a_q, a_f, a_i, a_g, b_q, b_kc, b_vc, b_ks, b_vs, b_kw, b_vw, b_gate = jnp.split(proj, cuts, axis=-1)
    a_out = hgrn2_mix(a_q, a_f, a_i, a_g, lb, hg_gain)
    kv = lambda t: t.reshape(B, S, NSA_KV, NSA_HD)
    b_out = nsa_mix(b_q.reshape(B, S, NSA_HEADS, NSA_HD), kv(b_kc), kv(b_vc), kv(b_ks), kv(b_vs),
                    kv(b_kw), kv(b_vw), b_gate.reshape(B, S, NSA_HEADS, 3),
                    nsa_q_gain, nsa_k_gain, cmp_pe, cmp_w1, cmp_w2)
    return jnp.concatenate([a_out, b_out], axis=-1) @ w_out


def odd_mixer(h, w_in, q_gain, k_gain, sinks, w_out):
    B, S, _ = h.shape
    proj = h @ w_in
    qd = SWA_HEADS * SWA_HD
    kvd = SWA_KV * SWA_HD
    q, k, v = jnp.split(proj, [qd, qd + kvd], axis=-1)
    pos = jnp.arange(S, dtype=F32)
    q = rope_partial(rmsnorm(q.reshape(B, S, SWA_HEADS, SWA_HD), q_gain), pos)
    k = rope_partial(rmsnorm(k.reshape(B, S, SWA_KV, SWA_HD), k_gain), pos)
    v = v.reshape(B, S, SWA_KV, SWA_HD)
    return swa_sink_attention(q, k, v, sinks) @ w_out


def hier_moe(h, w_grp, b_grp, w_exp, b_exp, w_gate, w_up, w_down):
    B, S, D = h.shape
    T = B * S
    xt = h.reshape(T, D)
    tok_ids = jnp.arange(T)
    grp_logits = (xt @ w_grp).astype(F32) + b_grp.astype(F32)
    grp_prob = jax.nn.softmax(grp_logits, axis=-1)
    g_idx = jnp.argmax(grp_logits, axis=-1)
    g_w = grp_prob[tok_ids, g_idx]
    exp_logits = ((xt @ w_exp).astype(F32) + b_exp.astype(F32)).reshape(T, N_GROUPS, EXP_PER_GROUP)
    within = exp_logits[tok_ids, g_idx]
    top_l, top_j = lax.top_k(within, TOP_K)
    wts = jax.nn.softmax(top_l, axis=-1) * g_w[:, None]
    e_idx = g_idx[:, None] * EXP_PER_GROUP + top_j
    A = T * TOP_K
    flat_e = e_idx.reshape(A)
    flat_w = wts.reshape(A)
    flat_tok = jnp.arange(A) // TOP_K
    order = jnp.argsort(flat_e)
    se, stok, sw = flat_e[order], flat_tok[order], flat_w[order]
    counts = jnp.bincount(flat_e, length=N_EXPERTS)
    start = jnp.cumsum(counts) - counts
    pcounts = (counts + MOE_BLOCK - 1) // MOE_BLOCK * MOE_BLOCK
    pend = jnp.cumsum(pcounts)
    pstart = pend - pcounts
    dest = pstart[se] + jnp.arange(A) - start[se]
    n_rows = -(-A // MOE_BLOCK) * MOE_BLOCK + N_EXPERTS * MOE_BLOCK
    n_blocks = n_rows // MOE_BLOCK
    row_tok = jnp.full((n_rows,), T, dtype=jnp.int32).at[dest].set(stok.astype(jnp.int32))
    x_pad = jnp.concatenate([xt, jnp.zeros((1, D), xt.dtype)], axis=0)
    xb = x_pad[row_tok].reshape(n_blocks, MOE_BLOCK, D)
    blk_expert = jnp.minimum(jnp.searchsorted(pend, jnp.arange(n_blocks) * MOE_BLOCK, side='right'), N_EXPERTS - 1)

    def expert_block(args):
        xblk, e = args
        hid = jax.nn.silu(xblk @ w_gate[e]) * (xblk @ w_up[e])
        return hid @ w_down[e]

    yb = lax.map(expert_block, (xb, blk_expert)).reshape(n_rows, D)
    y = jnp.zeros((T, D), yb.dtype).at[stok].add(yb[dest] * sw[:, None].astype(yb.dtype))
    return y.reshape(B, S, D).astype(h.dtype)


def setup_inputs(seed: int = 0) -> dict:
    key = jax.random.key(seed)
    k = jax.random.split(key, 26)

    def normal(kk, shape, scale):
        return jax.random.normal(kk, shape, F32) * scale

    def gain(kk, shape):
        return 1.0 + 0.02 * jax.random.normal(kk, shape, F32)

    return {
        'x': normal(k[0], (BATCH, SEQ, D_MODEL), 1.0),
        'ev_norm': gain(k[1], (N_EVEN, D_MODEL)),
        'ev_w_in': normal(k[2], (N_EVEN, D_MODEL, EV_PROJ), D_MODEL ** -0.5),
        'hg_lb_logits': normal(k[3], (N_EVEN + 1, HG_WIDTH), 1.0),
        'hg_out_gain': gain(k[4], (N_EVEN, HG_DIM)),
        'nsa_q_gain': gain(k[5], (N_EVEN, NSA_HD)),
        'nsa_k_gain': gain(k[6], (N_EVEN, 3, NSA_HD)),
        'nsa_cmp_pe': normal(k[7], (N_EVEN, 2, CMP_LEN, NSA_HD), 0.1),
        'nsa_cmp_w1': normal(k[8], (N_EVEN, 2, CMP_LEN * NSA_HD, CMP_HIDDEN), (CMP_LEN * NSA_HD) ** -0.5),
        'nsa_cmp_w2': normal(k[9], (N_EVEN, 2, CMP_HIDDEN, NSA_HD), CMP_HIDDEN ** -0.5),
        'ev_w_out': normal(k[10], (N_EVEN, HG_WIDTH + NSA_WIDTH, D_MODEL), (HG_WIDTH + NSA_WIDTH) ** -0.5),
        'od_norm': gain(k[11], (N_ODD, D_MODEL)),
        'od_w_in': normal(k[12], (N_ODD, D_MODEL, OD_PROJ), D_MODEL ** -0.5),
        'swa_q_gain': gain(k[13], (N_ODD, SWA_HD)),
        'swa_k_gain': gain(k[14], (N_ODD, SWA_HD)),
        'swa_sinks': normal(k[15], (N_ODD, SWA_HEADS), 0.5),
        'od_w_out': normal(k[16], (N_ODD, SWA_HEADS * SWA_HD, D_MODEL), (SWA_HEADS * SWA_HD) ** -0.5),
        'moe_norm': gain(k[17], (DEPTH, D_MODEL)),
        'moe_w_grp': normal(k[18], (DEPTH, D_MODEL, N_GROUPS), D_MODEL ** -0.5),
        'moe_b_grp': normal(k[19], (DEPTH, N_GROUPS), 0.01),
        'moe_w_exp': normal(k[20], (DEPTH, D_MODEL, N_EXPERTS), D_MODEL ** -0.5),
        'moe_b_exp': normal(k[21], (DEPTH, N_EXPERTS), 0.01),
        'moe_w_gate': normal(k[22], (DEPTH, N_EXPERTS, D_MODEL, EXPERT_FF), D_MODEL ** -0.5),
        'moe_w_up': normal(k[23], (DEPTH, N_EXPERTS, D_MODEL, EXPERT_FF), D_MODEL ** -0.5),
        'moe_w_down': normal(k[24], (DEPTH, N_EXPERTS, EXPERT_FF, D_MODEL), EXPERT_FF ** -0.5),
    }


def reference(x, ev_norm, ev_w_in, hg_lb_logits, hg_out_gain, nsa_q_gain, nsa_k_gain, nsa_cmp_pe,
              nsa_cmp_w1, nsa_cmp_w2, ev_w_out, od_norm, od_w_in, swa_q_gain, swa_k_gain, swa_sinks,
              od_w_out, moe_norm, moe_w_grp, moe_b_grp, moe_w_exp, moe_b_exp, moe_w_gate, moe_w_up,
              moe_w_down):
    lower_bounds = jnp.cumsum(jax.nn.softmax(hg_lb_logits.astype(F32), axis=0), axis=0)
    for layer in range(DEPTH):
        j = layer // 2
        if layer % 2 == 0:
            x = x + even_mixer(rmsnorm(x, ev_norm[j]), ev_w_in[j], lower_bounds[j], hg_out_gain[j],
                               nsa_q_gain[j], nsa_k_gain[j], nsa_cmp_pe[j], nsa_cmp_w1[j],
                               nsa_cmp_w2[j], ev_w_out[j])
        else:
            x = x + odd_mixer(rmsnorm(x, od_norm[j]), od_w_in[j], swa_q_gain[j], swa_k_gain[j],
                              swa_sinks[j], od_w_out[j])
        x = x + hier_moe(rmsnorm(x, moe_norm[layer]), moe_w_grp[layer], moe_b_grp[layer],
                         moe_w_exp[layer], moe_b_exp[layer], moe_w_gate[layer], moe_w_up[layer],
                         moe_w_down[layer])
    return x
```

```cpp
#include <hip/hip_runtime.h>
#include <hip/hip_cooperative_groups.h>
#include <cstdio>
#include <cstdint>
namespace cg = cooperative_groups;

constexpr int D = 1024, BATCH = 16, SEQ = 4096, M = BATCH * SEQ;
constexpr int EVP = 3352, EVPP = 3584, ODP = 1280;
constexpr int NEXP = 32, FF = 512;
constexpr int NTHREADS = 512, NWAVES = 8;
constexpr int MAXTILES = 544;
constexpr int NSLOTS = MAXTILES * 256;
constexpr float EPS = 1e-6f;

typedef unsigned short bf16_t;
typedef unsigned int u32;

constexpr size_t MiB = 1u << 20;
constexpr size_t WS_CTL = 0;
constexpr size_t CTL_BYTES = 64 * 1024;
constexpr size_t WS_LB = 1 * MiB;
constexpr size_t WS_CBIAS = WS_LB + 4096;
constexpr size_t WS_ROPE = WS_LB + 8192;
constexpr size_t WS_KCB = 2 * MiB;
constexpr size_t WS_VCB = 3 * MiB;
constexpr size_t WS_TE = 4 * MiB;
constexpr size_t WS_TR = 4 * MiB + 512 * 1024;
constexpr size_t WS_TW = 5 * MiB;
constexpr size_t WS_TSLOT = 5 * MiB + 512 * 1024;
constexpr size_t WS_ROWTOK = 6 * MiB;
constexpr size_t WS_ROWW = 7 * MiB;
constexpr size_t WS_TILEE = 8 * MiB;
constexpr size_t WS_W0T = 16 * MiB;
constexpr size_t WS_WO0T = 23 * MiB;
constexpr size_t WS_W1T = 25 * MiB;
constexpr size_t WS_WO1T = 28 * MiB;
constexpr size_t WS_CW1T = 30 * MiB;
constexpr size_t WS_CW2T = 32 * MiB;
constexpr size_t WS_RW = 33 * MiB;
constexpr size_t WS_WGU = 40 * MiB;
constexpr size_t WS_WD = 168 * MiB;
constexpr size_t WS_H = 232 * MiB;
constexpr size_t WS_PROJ = 360 * MiB;
constexpr size_t WS_HID = WS_PROJ;
constexpr size_t WS_YS = WS_PROJ + 136 * MiB;
constexpr size_t WS_LOGF = 808 * MiB;
constexpr size_t WS_XB = WS_LOGF;
constexpr size_t WS_LIST = 936 * MiB;
constexpr size_t WS_END = 944 * MiB;

constexpr int LDS_BYTES = 160 * 1024;
constexpr int LDS_BARST = LDS_BYTES - 16;
constexpr size_t CTL_BAR = 16 * 1024;

__device__ __forceinline__ float bf2f(bf16_t v) { return __uint_as_float(((u32)v) << 16); }
typedef float f32x2_t __attribute__((ext_vector_type(2))); typedef __bf16 bf16x2_t __attribute__((ext_vector_type(2)));
__device__ __forceinline__ u32 pk2(float lo, float hi) { f32x2_t v = {lo, hi}; bf16x2_t b = __builtin_convertvector(v, bf16x2_t); return __builtin_bit_cast(u32, b); }
__device__ __forceinline__ bf16_t f2bf(float f) { return (bf16_t)(pk2(f, 0.f) & 0xffffu); }
__device__ __forceinline__ float wsum(float v) {
#pragma unroll
    for (int o = 32; o; o >>= 1) v += __shfl_xor(v, o);
    return v;
}
__device__ __forceinline__ float wmax(float v) {
#pragma unroll
    for (int o = 32; o; o >>= 1) v = fmaxf(v, __shfl_xor(v, o));
    return v;
}
__device__ __forceinline__ void unpack8(const uint4& w, float* f) {
    f[0] = __uint_as_float(w.x << 16); f[1] = __uint_as_float(w.x & 0xffff0000u);
    f[2] = __uint_as_float(w.y << 16); f[3] = __uint_as_float(w.y & 0xffff0000u);
    f[4] = __uint_as_float(w.z << 16); f[5] = __uint_as_float(w.z & 0xffff0000u);
    f[6] = __uint_as_float(w.w << 16); f[7] = __uint_as_float(w.w & 0xffff0000u);
}
#define LDS_FENCE() asm volatile("s_waitcnt lgkmcnt(0)" ::: "memory")

#define XB_TMO      128
#define XB_XCNT(j)  (256  + 64 * (j))
#define XB_XSUB(j)  (1280 + 64 * (j))
#define XB_XGEN(j)  (2304 + 64 * (j))
#define XB_TOP      3328
#define XB_TOPGEN   3392
#define XCD_BAR_WORDS 3456
#define XB_SPIN_CAP (1u << 18)
#define XLAS __attribute__((address_space(3)))
__device__ __forceinline__ unsigned xb_ld(unsigned* p)              { return __hip_atomic_load(p, __ATOMIC_RELAXED, __HIP_MEMORY_SCOPE_AGENT); }
__device__ __forceinline__ unsigned xb_add(unsigned* p, unsigned v) { return __hip_atomic_fetch_add(p, v, __ATOMIC_RELAXED, __HIP_MEMORY_SCOPE_AGENT); }
__device__ __forceinline__ unsigned xb_xcc_id() { return (unsigned)__builtin_amdgcn_s_getreg((3 << 11) | 20) & 0xFu; }
#define XB_SPIN(cond, bar) do { unsigned _sp = 0; while (cond) { __builtin_amdgcn_s_sleep(1); \
    if ((++_sp & 255u) == 0u) { if (xb_ld(&(bar)[XB_TMO])) break; if (_sp > XB_SPIN_CAP) { atomicAdd(&(bar)[XB_TMO], 1u); break; } } } } while (0)
struct XcdBarrier { unsigned* bar; unsigned x; volatile XLAS unsigned* st; };
__device__ __forceinline__ XcdBarrier xcd_barrier_post(unsigned* bar, volatile XLAS unsigned* st) {
    XcdBarrier b; b.bar = bar; b.x = xb_xcc_id(); b.st = st;
    if (threadIdx.x == 0) (void)xb_add(&bar[XB_XCNT(b.x)], 1u);
    return b;
}
__device__ __forceinline__ void xcd_barrier_complete(unsigned* bar, unsigned x, unsigned& nloc, unsigned& nx) {
    const unsigned G = gridDim.x * gridDim.y * gridDim.z;
    unsigned sum, cnt, mine, sp = 0u;
    for (;;) {
        sum = 0u; cnt = 0u; mine = 0u;
#pragma unroll
        for (unsigned j = 0; j < 16; ++j) { const unsigned c = xb_ld(&bar[XB_XCNT(j)]); sum += c; cnt += (c > 0u) ? 1u : 0u; mine = (j == x) ? c : mine; }
        if (sum == G) break;
        __builtin_amdgcn_s_sleep(1);
        if ((++sp & 255u) == 0u) { if (xb_ld(&bar[XB_TMO])) break; if (sp > XB_SPIN_CAP) { atomicAdd(&bar[XB_TMO], 1u); break; } }
    }
    nloc = mine > 0u ? mine : 1u; nx = cnt > 0u ? cnt : 1u;
}
__device__ __forceinline__ void xcd_barrier(const XcdBarrier& b) {
    asm volatile("s_waitcnt vmcnt(0)" ::: "memory");
    __syncthreads();
    if (threadIdx.x == 0) {
        unsigned* bar = b.bar;
        __builtin_amdgcn_s_waitcnt(0);
        unsigned nloc = b.st[0], nx = b.st[1];
        if (nloc == 0u) { xcd_barrier_complete(bar, b.x, nloc, nx); b.st[0] = nloc; b.st[1] = nx; }
        const unsigned old = xb_add(&bar[XB_XSUB(b.x)], 1u);
        const unsigned gen = old / nloc;
        if (old + 1u == (gen + 1u) * nloc) {
            __builtin_amdgcn_fence(__ATOMIC_RELEASE, "agent");
            asm volatile("s_waitcnt vmcnt(0)" ::: "memory");
            const unsigned og = xb_add(&bar[XB_TOP], 1u);
            const unsigned tg = og / nx;
            if (og + 1u == (tg + 1u) * nx) xb_add(&bar[XB_TOPGEN], 1u);
            else XB_SPIN(xb_ld(&bar[XB_TOPGEN]) == tg, bar);
            __builtin_amdgcn_fence(__ATOMIC_ACQUIRE, "agent");
            xb_add(&bar[XB_XGEN(b.x)], 1u);
            asm volatile("s_waitcnt vmcnt(0)" ::: "memory");
        } else {
            XB_SPIN(xb_ld(&bar[XB_XGEN(b.x)]) == gen, bar);
            __builtin_amdgcn_fence(__ATOMIC_ACQUIRE, "agent");
            asm volatile("s_waitcnt vmcnt(0)" ::: "memory");
        }
    }
    __syncthreads();
}

struct Args {
    const float* in[25];
    float* out;
    unsigned char* ws;
};

struct Ctx {
    const float *x, *ev_norm, *ev_w_in, *hg_lb, *hg_gain, *nsa_qg, *nsa_kg, *cmp_pe, *cmp_w1, *cmp_w2, *ev_w_out;
    const float *od_norm, *od_w_in, *swa_qg, *swa_kg, *swa_sinks, *od_w_out;
    const float *moe_norm, *moe_w_grp, *moe_b_grp, *moe_w_exp, *moe_b_exp, *moe_w_gate, *moe_w_up, *moe_w_down;
    float* xr;
    unsigned char* ws;
    int tid, lane, wave, gw, ngw;
};

__device__ __forceinline__ void transpose_item(const float* W, int K, int Nsrc, bf16_t* WT, int drow0, int k0, int n0, float* scr, int lane) {
    const int rk = lane >> 3, c4 = 4 * (lane & 7);
    float4 v[8];
#pragma unroll
    for (int i = 0; i < 8; ++i) v[i] = (n0 + c4 < Nsrc) ? *(const float4*)(W + (size_t)(k0 + 8 * i + rk) * Nsrc + n0 + c4) : make_float4(0.f, 0.f, 0.f, 0.f);
#pragma unroll
    for (int i = 0; i < 8; ++i) { float* d = scr + (8 * i + rk) * 33 + c4; d[0] = v[i].x; d[1] = v[i].y; d[2] = v[i].z; d[3] = v[i].w; }
    LDS_FENCE();
    const int c = lane & 7;
#pragma unroll
    for (int j = 0; j < 4; ++j) {
        const int n = (lane >> 3) + 8 * j;
        const float* s = scr + (8 * c) * 33 + n;
        uint4 o;
        o.x = pk2(s[0 * 33], s[1 * 33]); o.y = pk2(s[2 * 33], s[3 * 33]); o.z = pk2(s[4 * 33], s[5 * 33]); o.w = pk2(s[6 * 33], s[7 * 33]);
        *(uint4*)(WT + (size_t)(drow0 + n0 + n) * K + k0 + 8 * c) = o;
    }
    LDS_FENCE();
}

struct MoeItem { const float* W; bf16_t* WT; int K, N, drow0, k0, n0; };
constexpr int MOE_ITEMS = 3 * 64 * 512;
static_assert(MOE_ITEMS == 64 * 256 * 6, "one MoE conversion item per (chunk, scan unit, wave < 6) slot");
__device__ __forceinline__ void moe_item_decode(const Ctx& c, int r, MoeItem& it) {
    constexpr int IG = 64 * 512;
    bf16_t* WGU = (bf16_t*)(c.ws + WS_WGU); bf16_t* WDt = (bf16_t*)(c.ws + WS_WD);
    if (r < 2 * IG) {
        const bool up = r >= IG; if (up) r -= IG;
        const int le = r >> 9, q = r & 511, kb = q >> 4, nb = q & 15, n0 = 32 * nb;
        it.W = (up ? c.moe_w_up : c.moe_w_gate) + (size_t)le * 1024 * 512; it.WT = WGU + (size_t)le * 1024 * 1024; it.K = 1024; it.N = 512;
        it.drow0 = (n0 >> 7) * 256 + (up ? 128 : 0) + (n0 & 127) - n0; it.k0 = 32 * kb; it.n0 = n0;
    } else {
        r -= 2 * IG; const int le = r >> 9, q = r & 511;
        it.W = c.moe_w_down + (size_t)le * 512 * 1024; it.WT = WDt + (size_t)le * 1024 * 512; it.K = 512; it.N = 1024; it.drow0 = 0; it.k0 = 32 * (q >> 5); it.n0 = 32 * (q & 31);
    }
}
struct MoeRegs { float4 a, b, c, d; };
__device__ __forceinline__ void moe_item_issue(const MoeItem& it, MoeRegs& v, int lane) {
    const float* p = it.W + (size_t)(it.k0 + 4 * (lane >> 3)) * it.N + it.n0 + 4 * (lane & 7); const size_t N = it.N;
    v.a = *(const float4*)(p); v.b = *(const float4*)(p + N); v.c = *(const float4*)(p + 2 * N); v.d = *(const float4*)(p + 3 * N);
}
__device__ __forceinline__ void moe_item_finish(const MoeItem& it, const MoeRegs& v, int lane) {
    bf16_t* o = it.WT + (size_t)(it.drow0 + it.n0 + 4 * (lane & 7)) * it.K + it.k0 + 4 * (lane >> 3);
    uint2 w;
    w.x = pk2(v.a.x, v.b.x); w.y = pk2(v.c.x, v.d.x); *(uint2*)(o) = w;
    w.x = pk2(v.a.y, v.b.y); w.y = pk2(v.c.y, v.d.y); *(uint2*)(o + it.K) = w;
    w.x = pk2(v.a.z, v.b.z); w.y = pk2(v.c.z, v.d.z); *(uint2*)(o + 2 * (size_t)it.K) = w;
    w.x = pk2(v.a.w, v.b.w); w.y = pk2(v.c.w, v.d.w); *(uint2*)(o + 3 * (size_t)it.K) = w;
}

__device__ __forceinline__ void phase_prologue(const Ctx& c, float* lds) {
    float* scr = lds + c.wave * (64 * 33);
    unsigned char* ws = c.ws;
    bf16_t* W0T = (bf16_t*)(ws + WS_W0T); bf16_t* WO0T = (bf16_t*)(ws + WS_WO0T); bf16_t* W1T = (bf16_t*)(ws + WS_W1T); bf16_t* WO1T = (bf16_t*)(ws + WS_WO1T);
    bf16_t* CW1T = (bf16_t*)(ws + WS_CW1T); bf16_t* CW2T = (bf16_t*)(ws + WS_CW2T);
    constexpr int I0 = 16 * 112, I1 = 16 * 32, I2 = 16 * 40, I3 = 16 * 32, I4 = 2 * 32 * 8, I5 = 2 * 4 * 2;
    constexpr int NITEMS = I0 + I1 + I2 + I3 + I4 + I5;
    for (int it = c.gw; it < NITEMS; it += c.ngw) {
        int r = it;
        if (r < I0) { transpose_item(c.ev_w_in, 1024, EVP, W0T, 0, 64 * (r / 112), 32 * (r % 112), scr, c.lane); continue; } r -= I0;
        if (r < I1) { transpose_item(c.ev_w_out, 1024, 1024, WO0T, 0, 64 * (r / 32), 32 * (r % 32), scr, c.lane); continue; } r -= I1;
        if (r < I2) { transpose_item(c.od_w_in, 1024, ODP, W1T, 0, 64 * (r / 40), 32 * (r % 40), scr, c.lane); continue; } r -= I2;
        if (r < I3) { transpose_item(c.od_w_out, 1024, 1024, WO1T, 0, 64 * (r / 32), 32 * (r % 32), scr, c.lane); continue; } r -= I3;
        if (r < I4) { const int kind = r / 256, q = r % 256; transpose_item(c.cmp_w1 + (size_t)kind * 2048 * 256, 2048, 256, CW1T + (size_t)kind * 256 * 2048, 0, 64 * (q / 8), 32 * (q % 8), scr, c.lane); continue; } r -= I4;
        if (r < I5) { const int kind = r / 8, q = r % 8; transpose_item(c.cmp_w2 + (size_t)kind * 256 * 64, 256, 64, CW2T + (size_t)kind * 64 * 256, 0, 64 * (q / 2), 32 * (q % 2), scr, c.lane); continue; }
    }
    const int gt = blockIdx.x * NTHREADS + c.tid, ngt = gridDim.x * NTHREADS;
    float* LB = (float*)(ws + WS_LB);
    for (int i = gt; i < 512; i += ngt) { const float l0 = c.hg_lb[i], l1 = c.hg_lb[512 + i]; LB[i] = 1.f / (1.f + expf(l1 - l0)); }
    float* CB = (float*)(ws + WS_CBIAS);
    for (int i = c.gw; i < 512; i += c.ngw) {
        const int kind = i >> 8, cc = i & 255; float sacc = 0.f;
        for (int k = c.lane; k < 2048; k += 64) sacc += c.cmp_pe[kind * 2048 + k] * c.cmp_w1[((size_t)kind * 2048 + k) * 256 + cc];
        sacc = wsum(sacc);
        if (c.lane == 0) CB[i] = sacc;
    }
    bf16_t* RW = (bf16_t*)(ws + WS_RW);
    for (int i = gt; i < 2 * 48 * 1024; i += ngt) {
        const int k = i & 1023, o = (i >> 10) % 48, layer = i / (48 * 1024);
        float wv = 0.f;
        if (o < 36) wv = c.moe_norm[layer * D + k] * (o < 4 ? c.moe_w_grp[(size_t)layer * 1024 * 4 + k * 4 + o] : c.moe_w_exp[(size_t)layer * 1024 * 32 + k * 32 + (o - 4)]);
        const bf16_t hi = f2bf(wv); const bf16_t lo = f2bf(wv - bf2f(hi));
        RW[((size_t)layer * 48 + o) * 2048 + k] = hi; RW[((size_t)layer * 48 + o) * 2048 + 1024 + k] = lo;
    }
    float2* RT = (float2*)(ws + WS_ROPE);
    for (int i = gt; i < 4096 * 8; i += ngt) {
        const int pos = i >> 3, f = i & 7;
        const double inv = exp(-(double)f * 0.125 * 13.122363377404328);
        const double a = (double)pos * inv;
        const double r = a - 6.283185307179586476925 * rint(a / 6.283185307179586476925);
        const float rf = (float)r;
        RT[i] = make_float2(cosf(rf), sinf(rf));
    }
}

__device__ __forceinline__ void phase_norm_x(const Ctx& c, const float* src, const float* gain, bf16_t* H) {
    for (int m0 = 2 * c.gw; m0 < M; m0 += 2 * c.ngw) {
        float4 v[2][4];
#pragma unroll
        for (int u = 0; u < 2; ++u) { const float4* xr = (const float4*)(src + (size_t)(m0 + u) * D) + c.lane;
#pragma unroll
            for (int j = 0; j < 4; ++j) v[u][j] = xr[64 * j]; }
#pragma unroll
        for (int u = 0; u < 2; ++u) {
            float s = 0.f;
#pragma unroll
            for (int j = 0; j < 4; ++j) s += v[u][j].x * v[u][j].x + v[u][j].y * v[u][j].y + v[u][j].z * v[u][j].z + v[u][j].w * v[u][j].w;
            const float rstd = rsqrtf(wsum(s) * (1.f / D) + EPS);
            uint2* o = (uint2*)(H + (size_t)(m0 + u) * D) + c.lane;
#pragma unroll
            for (int j = 0; j < 4; ++j) {
                const float4 g = ((const float4*)gain)[c.lane + 64 * j];
                uint2 w; w.x = pk2(v[u][j].x * rstd * g.x, v[u][j].y * rstd * g.y); w.y = pk2(v[u][j].z * rstd * g.z, v[u][j].w * rstd * g.w);
                o[64 * j] = w;
            }
        }
    }
}
template <bool FINAL>
__device__ __forceinline__ void phase_combine(const Ctx& c, bf16_t* XB, float* out, const float* gain, bf16_t* H, const bf16_t* YS, int layer) {
    const float* TWp = (const float*)(c.ws + WS_TW); const int* TEp = (const int*)(c.ws + WS_TE); const int* TRp = (const int*)(c.ws + WS_TR);
    int psrow;
    { const int cnt = ((const int*)(c.ws + WS_CTL))[layer * 32 + (c.lane & 31)]; const int pc = (cnt + 255) & ~255; int incl = pc;
#pragma unroll
      for (int o = 1; o < 32; o <<= 1) { const int t_ = __shfl_up(incl, o, 32); if ((c.lane & 31) >= o) incl += t_; }
      psrow = incl - pc; }
    for (int m0 = 2 * c.gw; m0 < M; m0 += 2 * c.ngw) {
        uint2 xw[2][4], ya[2][4], yb[2][4]; float wa[2], wb[2];
#pragma unroll
        for (int u = 0; u < 2; ++u) {
            const int m = m0 + u; const int s0 = __shfl(psrow, TEp[2 * m]) + TRp[2 * m], s1 = __shfl(psrow, TEp[2 * m + 1]) + TRp[2 * m + 1]; wa[u] = TWp[2 * m]; wb[u] = TWp[2 * m + 1];
            const uint2* xr = (const uint2*)(XB + (size_t)m * D) + c.lane; const uint2* y0 = (const uint2*)(YS + (size_t)s0 * D) + c.lane; const uint2* y1 = (const uint2*)(YS + (size_t)s1 * D) + c.lane;
#pragma unroll
            for (int j = 0; j < 4; ++j) { xw[u][j] = xr[64 * j]; ya[u][j] = y0[64 * j]; yb[u][j] = y1[64 * j]; }
        }
#pragma unroll
        for (int u = 0; u < 2; ++u) {
            const int m = m0 + u;
            float4 v[4]; float s = 0.f;
#pragma unroll
            for (int j = 0; j < 4; ++j) {
                v[j].x = __uint_as_float(xw[u][j].x << 16) + wa[u] * __uint_as_float(ya[u][j].x << 16) + wb[u] * __uint_as_float(yb[u][j].x << 16);
                v[j].y = __uint_as_float(xw[u][j].x & 0xffff0000u) + wa[u] * __uint_as_float(ya[u][j].x & 0xffff0000u) + wb[u] * __uint_as_float(yb[u][j].x & 0xffff0000u);
                v[j].z = __uint_as_float(xw[u][j].y << 16) + wa[u] * __uint_as_float(ya[u][j].y << 16) + wb[u] * __uint_as_float(yb[u][j].y << 16);
                v[j].w = __uint_as_float(xw[u][j].y & 0xffff0000u) + wa[u] * __uint_as_float(ya[u][j].y & 0xffff0000u) + wb[u] * __uint_as_float(yb[u][j].y & 0xffff0000u);
                s += v[j].x * v[j].x + v[j].y * v[j].y + v[j].z * v[j].z + v[j].w * v[j].w;
            }
            if (FINAL) {
                float4* xo = (float4*)(out + (size_t)m * D) + c.lane;
#pragma unroll
                for (int j = 0; j < 4; ++j) xo[64 * j] = v[j];
            } else {
                uint2* xo = (uint2*)(XB + (size_t)m * D) + c.lane;
#pragma unroll
                for (int j = 0; j < 4; ++j) { uint2 w; w.x = pk2(v[j].x, v[j].y); w.y = pk2(v[j].z, v[j].w); xo[64 * j] = w; }
                const float rstd = rsqrtf(wsum(s) * (1.f / D) + EPS);
                uint2* o = (uint2*)(H + (size_t)m * D) + c.lane;
#pragma unroll
                for (int j = 0; j < 4; ++j) {
                    const float4 g = ((const float4*)gain)[c.lane + 64 * j];
                    uint2 w; w.x = pk2(v[j].x * rstd * g.x, v[j].y * rstd * g.y); w.y = pk2(v[j].z * rstd * g.z, v[j].w * rstd * g.w);
                    o[64 * j] = w;
                }
            }
        }
    }
}

struct ARowPlain { const bf16_t* A; int K; __device__ __forceinline__ const bf16_t* operator()(int m) const { return A + (size_t)m * K; } };
struct ARowGather { const bf16_t* A; int K; const int* idx; __device__ __forceinline__ const bf16_t* operator()(int m) const { return A + (size_t)idx[m] * K; } };
struct BRowPlain { const bf16_t* B; int K; __device__ __forceinline__ const bf16_t* operator()(int n) const { return B + (size_t)n * K; } };
struct BRowGU { const bf16_t* B; int K;
    __device__ __forceinline__ const bf16_t* operator()(int nv) const {
        const int cc = (nv >> 6) * 32 + 2 * ((nv & 63) >> 2) + (nv & 1), up = (nv >> 1) & 1;
        return B + (size_t)((cc >> 7) * 256 + (cc & 127) + up * 128) * K; } };

template <class AR, class BR, class Epi>
__device__ __forceinline__ void gemm_naive_tile(float* lds, int m0, int nv0, int K, const AR& arow, const BR& brow, const Epi& epi) {
    const int tid = threadIdx.x, ty = tid >> 4, tx = tid & 15;
    float acc[4][4];
#pragma unroll
    for (int i = 0; i < 4; ++i)
#pragma unroll
        for (int j = 0; j < 4; ++j) acc[i][j] = 0.f;
    float* As = lds; float* Bs = lds + 32 * 132;
    const int lr = tid >> 2, kq = (tid & 3) * 8;
    const bf16_t* ap = arow(m0 + lr) + kq;
    const bf16_t* bp = brow(nv0 + (lr & 63)) + kq;
    for (int k0 = 0; k0 < K; k0 += 32) {
        __syncthreads();
        { const uint4 w = *(const uint4*)(ap + k0); float f[8]; unpack8(w, f);
#pragma unroll
          for (int i = 0; i < 8; ++i) As[(kq + i) * 132 + lr] = f[i]; }
        if (tid < 256) { const uint4 w = *(const uint4*)(bp + k0); float f[8]; unpack8(w, f);
#pragma unroll
          for (int i = 0; i < 8; ++i) Bs[(kq + i) * 68 + lr] = f[i]; }
        __syncthreads();
#pragma unroll 8
        for (int k = 0; k < 32; ++k) {
            const float4 a = *(const float4*)&As[k * 132 + 4 * ty]; const float4 b = *(const float4*)&Bs[k * 68 + 4 * tx];
            acc[0][0] += a.x * b.x; acc[0][1] += a.x * b.y; acc[0][2] += a.x * b.z; acc[0][3] += a.x * b.w;
            acc[1][0] += a.y * b.x; acc[1][1] += a.y * b.y; acc[1][2] += a.y * b.z; acc[1][3] += a.y * b.w;
            acc[2][0] += a.z * b.x; acc[2][1] += a.z * b.y; acc[2][2] += a.z * b.z; acc[2][3] += a.z * b.w;
            acc[3][0] += a.w * b.x; acc[3][1] += a.w * b.y; acc[3][2] += a.w * b.z; acc[3][3] += a.w * b.w;
        }
    }
    epi.tile(m0 + 4 * ty, nv0 + 4 * tx, acc);
}

struct EpiProj0 { bf16_t* P; float* LOGF; const float* LB;
    __device__ __forceinline__ void tile(int m, int n, const float (&acc)[4][4]) const {
#pragma unroll
        for (int i = 0; i < 4; ++i)
#pragma unroll
            for (int j = 0; j < 4; ++j) {
                const int nn = n + j; const float v = acc[i][j]; const size_t mm = m + i;
                if (nn >= 512 && nn < 1024) {
                    const int cc = nn - 512; const float lb = LB[cc];
                    const float sg = 1.f / (1.f + expf(-v)), sn = 1.f / (1.f + expf(v));
                    LOGF[mm * 512 + cc] = logf(lb + (1.f - lb) * sg);
                    P[mm * EVPP + nn] = f2bf((1.f - lb) * sn);
                } else P[mm * EVPP + nn] = f2bf(v);
            }
    } };
struct EpiRaw { bf16_t* P; int ld;
    __device__ __forceinline__ void tile(int m, int n, const float (&acc)[4][4]) const {
#pragma unroll
        for (int i = 0; i < 4; ++i)
#pragma unroll
            for (int j = 0; j < 4; ++j) P[(size_t)(m + i) * ld + n + j] = f2bf(acc[i][j]);
    } };
struct EpiResid { const float* X; float* O;
    __device__ __forceinline__ void tile(int m, int n, const float (&acc)[4][4]) const {
#pragma unroll
        for (int i = 0; i < 4; ++i) { const size_t o = (size_t)(m + i) * D + n; const float4 xv = *(const float4*)(X + o);
            *(float4*)(O + o) = make_float4(xv.x + acc[i][0], xv.y + acc[i][1], xv.z + acc[i][2], xv.w + acc[i][3]); }
    } };
struct EpiGU { bf16_t* HID;
    __device__ __forceinline__ void tile(int m, int nv, const float (&acc)[4][4]) const {
        const int c0 = (nv >> 6) * 32 + 2 * ((nv & 63) >> 2);
#pragma unroll
        for (int i = 0; i < 4; ++i) {
            const float g0 = acc[i][0], g1 = acc[i][1], u0 = acc[i][2], u1 = acc[i][3];
            const float h0 = g0 / (1.f + expf(-g0)) * u0, h1 = g1 / (1.f + expf(-g1)) * u1;
            *(u32*)(HID + (size_t)(m + i) * FF + c0) = pk2(h0, h1);
        }
    } };
struct EpiDown { bf16_t* YS; const float* ROWW;
    __device__ __forceinline__ void tile(int m, int n, const float (&acc)[4][4]) const {
#pragma unroll
        for (int i = 0; i < 4; ++i) { const float w = ROWW[m + i]; uint2 o; o.x = pk2(acc[i][0] * w, acc[i][1] * w); o.y = pk2(acc[i][2] * w, acc[i][3] * w);
            *(uint2*)(YS + (size_t)(m + i) * D + n) = o; }
    } };

template <class Epi>
__device__ __forceinline__ void phase_gemm_naive(float* lds, const bf16_t* A, const bf16_t* Bt, int Npad, int K, const Epi& epi) {
    const int ntn = Npad / 64, ntiles = (M / 128) * ntn;
    ARowPlain ar{A, K}; BRowPlain br{Bt, K};
    for (int t = blockIdx.x; t < ntiles; t += gridDim.x) gemm_naive_tile(lds, (t / ntn) * 128, (t % ntn) * 64, K, ar, br, epi);
}

namespace pg8 {
#define PG8_LAS __attribute__((address_space(3)))
typedef short bf16x8 __attribute__((ext_vector_type(8)));
typedef float f32x4 __attribute__((ext_vector_type(4)));
typedef unsigned u32x4 __attribute__((ext_vector_type(4)));
constexpr int BM = 256, BK = 64, HALF = 128, HTB = HALF * BK * 2, STAGE_BYTES = 8 * HTB, NXCD = 8, WGM = 8;
__device__ __forceinline__ int lds_byte(int r, int c) { const int st = (r >> 4) * 2 + (c >> 5), rr = r & 15, cc = c & 31, ob = rr * 64 + cc * 2; return st * 1024 + (ob ^ (((ob >> 9) & 1) << 5)); }
__device__ __forceinline__ void stage_rc(int b, int& R, int& C) { const int st = b / 1024, sb = b % 1024, swz = sb ^ (((sb >> 9) & 1) << 5); R = (st >> 1) * 16 + swz / 64; C = (st & 1) * 32 + (swz % 64) / 2; }
__device__ __forceinline__ int perm32(int rho) { const int n = rho >> 4, i = rho & 15; return 8 * (i >> 2) + 4 * n + (i & 3); }
struct Unit { int pm, pn, e, nvalid, gbase; };
struct Gemm { const bf16_t* A; const bf16_t* Bt; int K; const int* gather; size_t bstride; };
struct StaticOrder {
    int nM, nN, nwg, G, c;
    __device__ __forceinline__ void init(int Mr, int N, int G_, int c_) { nM = Mr / BM; nN = N / BM; nwg = nM * nN; G = G_; c = c_; }
    __device__ __forceinline__ bool next(int i, Unit& u) const {
        const long L = (long)i * G + c; if (L >= nwg) return false;
        int wgid = (int)L; { const int q = nwg / NXCD, r = nwg % NXCD, xcd = wgid % NXCD, off = wgid / NXCD; wgid = (xcd < r ? xcd * (q + 1) : r * (q + 1) + (xcd - r) * q) + off; }
        const int nig = WGM * nN, gid = wgid / nig, fm = gid * WGM, gsz = (nM - fm) < WGM ? (nM - fm) : WGM;
        u.pm = fm + ((wgid % nig) % gsz); u.pn = (wgid % nig) / gsz; u.e = 0; u.nvalid = BM; u.gbase = 0; return true;
    }
};
struct MoeOrder {
    const int* te; const int* tv; const int* tg; int nwg, G, c;
    __device__ __forceinline__ bool next(int i, Unit& u) const {
        const long L = (long)i * G + c; if (L >= nwg) return false;
        int wgid = (int)L; { const int q = nwg / NXCD, r = nwg % NXCD, xcd = wgid % NXCD, off = wgid / NXCD; wgid = (xcd < r ? xcd * (q + 1) : r * (q + 1) + (xcd - r) * q) + off; }
        u.pm = wgid >> 2; u.pn = wgid & 3; u.e = te[u.pm]; u.nvalid = tv[u.pm]; u.gbase = tg[u.pm]; return true;
    }
};
__device__ __forceinline__ unsigned cvt_pk_bf16(float lo, float hi) { unsigned r; asm volatile("v_cvt_pk_bf16_f32 %0, %1, %2" : "=v"(r) : "v"(lo), "v"(hi)); return r; }

struct EpiRawT { static constexpr bool PERM = true; bf16_t* O; int ldc;
    __device__ __forceinline__ void operator()(const f32x4 (&acc)[2][2][4][2], const Unit& u, int wr, int wc, int fr, int fq) const {
        const int row0 = u.pm * BM + wr * 64 + fr, col0 = u.pn * BM + wc * 32 + 8 * fq;
#pragma unroll
        for (int ai = 0; ai < 2; ++ai)
#pragma unroll
            for (int m = 0; m < 4; ++m) { bf16_t* rowp = O + (size_t)(row0 + ai * HALF + m * 16) * ldc + col0;
#pragma unroll
                for (int bj = 0; bj < 2; ++bj) { const f32x4 v0 = acc[ai][bj][m][0], v1 = acc[ai][bj][m][1]; u32x4 w;
                    w.x = cvt_pk_bf16(v0[0], v0[1]); w.y = cvt_pk_bf16(v0[2], v0[3]); w.z = cvt_pk_bf16(v1[0], v1[1]); w.w = cvt_pk_bf16(v1[2], v1[3]);
                    *(u32x4*)(rowp + bj * HALF) = w; } }
    } };
struct EpiProj0T { static constexpr bool PERM = true; bf16_t* O; float* LOGF; const float* LB;
    __device__ __forceinline__ void operator()(const f32x4 (&acc)[2][2][4][2], const Unit& u, int wr, int wc, int fr, int fq) const {
        const int row0 = u.pm * BM + wr * 64 + fr, col0 = u.pn * BM + wc * 32 + 8 * fq;
        const bool isf = (u.pn == 2 || u.pn == 3);
#pragma unroll
        for (int ai = 0; ai < 2; ++ai)
#pragma unroll
            for (int m = 0; m < 4; ++m) { const size_t r = (size_t)(row0 + ai * HALF + m * 16); bf16_t* rowp = O + r * EVPP + col0;
#pragma unroll
                for (int bj = 0; bj < 2; ++bj) { f32x4 v0 = acc[ai][bj][m][0], v1 = acc[ai][bj][m][1];
                    if (isf) {
                        const int cc = col0 + bj * HALF - 512; const f32x4 lb0 = *(const f32x4*)(LB + cc), lb1 = *(const f32x4*)(LB + cc + 4);
                        f32x4 lf0, lf1;
#pragma unroll
                        for (int j = 0; j < 4; ++j) {
                            { const float z = v0[j], lb = lb0[j], sg = 1.f / (1.f + __expf(-z)), sn = 1.f / (1.f + __expf(z)); lf0[j] = __logf(lb + (1.f - lb) * sg); v0[j] = (1.f - lb) * sn; }
                            { const float z = v1[j], lb = lb1[j], sg = 1.f / (1.f + __expf(-z)), sn = 1.f / (1.f + __expf(z)); lf1[j] = __logf(lb + (1.f - lb) * sg); v1[j] = (1.f - lb) * sn; }
                        }
                        *(f32x4*)(LOGF + r * 512 + cc) = lf0; *(f32x4*)(LOGF + r * 512 + cc + 4) = lf1;
                    }
                    u32x4 w; w.x = cvt_pk_bf16(v0[0], v0[1]); w.y = cvt_pk_bf16(v0[2], v0[3]); w.z = cvt_pk_bf16(v1[0], v1[1]); w.w = cvt_pk_bf16(v1[2], v1[3]);
                    *(u32x4*)(rowp + bj * HALF) = w; } }
    } };
struct EpiResidT { static constexpr bool PERM = false; const float* X; float* O;
    __device__ __forceinline__ void operator()(const f32x4 (&acc)[2][2][4][2], const Unit& u, int wr, int wc, int fr, int fq) const {
        const int row0 = u.pm * BM + wr * 64 + fr, col0 = u.pn * BM + wc * 32 + 4 * fq;
#pragma unroll
        for (int ai = 0; ai < 2; ++ai)
#pragma unroll
            for (int m = 0; m < 4; ++m) { const size_t off = (size_t)(row0 + ai * HALF + m * 16) * D + col0;
#pragma unroll
                for (int bj = 0; bj < 2; ++bj)
#pragma unroll
                    for (int n = 0; n < 2; ++n) { const f32x4 xv = *(const f32x4*)(X + off + bj * HALF + n * 16); *(f32x4*)(O + off + bj * HALF + n * 16) = xv + acc[ai][bj][m][n]; } }
    } };
struct EpiResidF2B { static constexpr bool PERM = true; const float* X; bf16_t* O;
    __device__ __forceinline__ void operator()(const f32x4 (&acc)[2][2][4][2], const Unit& u, int wr, int wc, int fr, int fq) const {
        const int row0 = u.pm * BM + wr * 64 + fr, col0 = u.pn * BM + wc * 32 + 8 * fq;
#pragma unroll
        for (int ai = 0; ai < 2; ++ai)
#pragma unroll
            for (int m = 0; m < 4; ++m) { const size_t off = (size_t)(row0 + ai * HALF + m * 16) * D + col0;
#pragma unroll
                for (int bj = 0; bj < 2; ++bj) { const f32x4 x0 = *(const f32x4*)(X + off + bj * HALF), x1 = *(const f32x4*)(X + off + bj * HALF + 4);
                    const f32x4 v0 = x0 + acc[ai][bj][m][0], v1 = x1 + acc[ai][bj][m][1]; u32x4 w;
                    w.x = cvt_pk_bf16(v0[0], v0[1]); w.y = cvt_pk_bf16(v0[2], v0[3]); w.z = cvt_pk_bf16(v1[0], v1[1]); w.w = cvt_pk_bf16(v1[2], v1[3]);
                    *(u32x4*)(O + off + bj * HALF) = w; } }
    } };
struct EpiResidB2B { static constexpr bool PERM = true; bf16_t* XO;
    __device__ __forceinline__ void operator()(const f32x4 (&acc)[2][2][4][2], const Unit& u, int wr, int wc, int fr, int fq) const {
        const int row0 = u.pm * BM + wr * 64 + fr, col0 = u.pn * BM + wc * 32 + 8 * fq;
#pragma unroll
        for (int ai = 0; ai < 2; ++ai)
#pragma unroll
            for (int m = 0; m < 4; ++m) { const size_t off = (size_t)(row0 + ai * HALF + m * 16) * D + col0;
#pragma unroll
                for (int bj = 0; bj < 2; ++bj) { const u32x4 xw = *(const u32x4*)(XO + off + bj * HALF);
                    const f32x4 a0 = acc[ai][bj][m][0], a1 = acc[ai][bj][m][1]; u32x4 w;
                    w.x = cvt_pk_bf16(__uint_as_float(xw.x << 16) + a0[0], __uint_as_float(xw.x & 0xffff0000u) + a0[1]); w.y = cvt_pk_bf16(__uint_as_float(xw.y << 16) + a0[2], __uint_as_float(xw.y & 0xffff0000u) + a0[3]);
                    w.z = cvt_pk_bf16(__uint_as_float(xw.z << 16) + a1[0], __uint_as_float(xw.z & 0xffff0000u) + a1[1]); w.w = cvt_pk_bf16(__uint_as_float(xw.w << 16) + a1[2], __uint_as_float(xw.w & 0xffff0000u) + a1[3]);
                    *(u32x4*)(XO + off + bj * HALF) = w; } }
    } };
struct EpiGUT { static constexpr bool PERM = true; bf16_t* HID;
    __device__ __forceinline__ void operator()(const f32x4 (&acc)[2][2][4][2], const Unit& u, int wr, int wc, int fr, int fq) const {
        const int row0 = u.pm * BM + wr * 64 + fr, col0 = u.pn * HALF + wc * 32 + 8 * fq;
#pragma unroll
        for (int ai = 0; ai < 2; ++ai)
#pragma unroll
            for (int m = 0; m < 4; ++m) { bf16_t* rowp = HID + (size_t)(row0 + ai * HALF + m * 16) * FF + col0; float h[8];
#pragma unroll
                for (int n = 0; n < 2; ++n)
#pragma unroll
                    for (int j = 0; j < 4; ++j) { const float g = acc[ai][0][m][n][j], uu = acc[ai][1][m][n][j]; h[4 * n + j] = g / (1.f + __expf(-g)) * uu; }
                u32x4 w; w.x = cvt_pk_bf16(h[0], h[1]); w.y = cvt_pk_bf16(h[2], h[3]); w.z = cvt_pk_bf16(h[4], h[5]); w.w = cvt_pk_bf16(h[6], h[7]);
                *(u32x4*)rowp = w; }
    } };
struct EpiDownT { static constexpr bool PERM = true; bf16_t* YS;
    __device__ __forceinline__ void operator()(const f32x4 (&acc)[2][2][4][2], const Unit& u, int wr, int wc, int fr, int fq) const {
        const int row0 = u.pm * BM + wr * 64 + fr, col0 = u.pn * BM + wc * 32 + 8 * fq;
#pragma unroll
        for (int ai = 0; ai < 2; ++ai)
#pragma unroll
            for (int m = 0; m < 4; ++m) { bf16_t* rowp = YS + (size_t)(row0 + ai * HALF + m * 16) * D + col0;
#pragma unroll
                for (int bj = 0; bj < 2; ++bj) { const f32x4 v0 = acc[ai][bj][m][0], v1 = acc[ai][bj][m][1]; u32x4 w;
                    w.x = cvt_pk_bf16(v0[0], v0[1]); w.y = cvt_pk_bf16(v0[2], v0[3]); w.z = cvt_pk_bf16(v1[0], v1[1]); w.w = cvt_pk_bf16(v1[2], v1[3]);
                    *(u32x4*)(rowp + bj * HALF) = w; } }
    } };

template <class Epi, class Sched, bool GATHER>
__device__ __forceinline__ void gemm_phase(PG8_LAS unsigned char* lds, const Gemm g, const Sched& S, const Epi& E) {
    int tid_o = threadIdx.x; asm volatile("" : "+v"(tid_o));
    const int tid = tid_o, wid = __builtin_amdgcn_readfirstlane(tid >> 6), lane = tid & 63, wr = wid >> 2, wc = wid & 3, fr = lane & 15, fq = lane >> 4;
    const int K = g.K, nt = K / BK;
    int stR[2], stC[2]; unsigned voffB[2];
#pragma unroll
    for (int i = 0; i < 2; ++i) { int R, C; stage_rc(tid * 16 + i * 8192, R, C); const int Rb = Epi::PERM ? ((R & ~31) + perm32(R & 31)) : R; stR[i] = R; stC[i] = C; voffB[i] = (unsigned)(Rb * K + C) * 2u; }
    const size_t kstep = (size_t)(BK * 2);
    const size_t hstep = (size_t)HALF * K * 2;
    const size_t tstep = 2 * hstep;
    const unsigned ldsw = (unsigned)wid * 1024u;
    const int aoff = lds_byte(wr * 64 + fr, fq * 8), boff = lds_byte(wc * 32 + fr, fq * 8);
#define PG8_SA(b, h) (((b) * 2 + (h)) * HTB)
#define PG8_SB(b, h) ((4 + (b) * 2 + (h)) * HTB)
#define PG8_STAGE(bufoff, gbase, voff) do { _Pragma("unroll") for (int _i = 0; _i < 2; ++_i) \
        __builtin_amdgcn_global_load_lds((const unsigned*)((const char*)(gbase) + (voff)[_i]), (PG8_LAS unsigned*)(lds + (bufoff) + ldsw + _i * 8192), 16, 0, 0); } while (0)
#define PG8_LDA(dst, b, h) do { _Pragma("unroll") for (int m = 0; m < 4; ++m) _Pragma("unroll") for (int k = 0; k < 2; ++k) dst[m][k] = *(const PG8_LAS bf16x8*)(lds + PG8_SA(b, h) + aoff + m * 2048 + k * 1024); } while (0)
#define PG8_LDB(dst, b, h) do { _Pragma("unroll") for (int n = 0; n < 2; ++n) _Pragma("unroll") for (int k = 0; k < 2; ++k) dst[n][k] = *(const PG8_LAS bf16x8*)(lds + PG8_SB(b, h) + boff + n * 2048 + k * 1024); } while (0)
#define PG8_MMA(ai, bj, At, Bt) do { __builtin_amdgcn_s_setprio(1); _Pragma("unroll") for (int m = 0; m < 4; ++m) _Pragma("unroll") for (int n = 0; n < 2; ++n) _Pragma("unroll") for (int k = 0; k < 2; ++k) \
        acc[ai][bj][m][n] = __builtin_amdgcn_mfma_f32_16x16x32_bf16(Bt[n][k], At[m][k], acc[ai][bj][m][n], 0, 0, 0); __builtin_amdgcn_s_setprio(0); } while (0)
#define PG8_WAIT_V(n) asm volatile("s_waitcnt vmcnt(" #n ")" ::: "memory")
#define PG8_WAIT_L(n) asm volatile("s_waitcnt lgkmcnt(" #n ")" ::: "memory")
#define PG8_BAR __builtin_amdgcn_s_barrier()
#define PG8_SCHED __builtin_amdgcn_sched_barrier(0)
#define PG8_OFFS(dst, u) do { _Pragma("unroll") for (int _h = 0; _h < 2; ++_h) _Pragma("unroll") for (int _i = 0; _i < 2; ++_i) { \
        int _row = (u).pm * BM + _h * HALF + stR[_i]; if (GATHER) { const int _lr = _h * HALF + stR[_i]; _row = _lr < (u).nvalid ? g.gather[(u).gbase + _lr] : 0; } dst[_h][_i] = (unsigned)(_row * K + stC[_i]) * 2u; } } while (0)
    Unit cur, nxt; int ui = 0;
    if (!S.next(0, cur)) return;
    f32x4 acc[2][2][4][2];
#pragma unroll
    for (int a = 0; a < 2; ++a)
#pragma unroll
        for (int b = 0; b < 2; ++b)
#pragma unroll
            for (int m = 0; m < 4; ++m)
#pragma unroll
                for (int n = 0; n < 2; ++n) acc[a][b][m][n] = (f32x4){0.f, 0.f, 0.f, 0.f};
    bf16x8 At[4][2], B0[2][2], B1[2][2];
    unsigned offC[2][2], offN[2][2];
    PG8_OFFS(offC, cur);
    const char* const A0 = (const char*)g.A;
    const char* cB = (const char*)g.Bt + ((size_t)cur.e * g.bstride) * 2 + (size_t)cur.pn * tstep;
    PG8_STAGE(PG8_SB(0, 0), cB, voffB); PG8_STAGE(PG8_SB(0, 1), cB + hstep, voffB); PG8_STAGE(PG8_SA(0, 0), A0, offC[0]); PG8_STAGE(PG8_SA(0, 1), A0, offC[1]);
    if (wr == 1) PG8_BAR;
    PG8_WAIT_V(2); PG8_BAR;
    PG8_STAGE(PG8_SB(1, 0), cB + kstep, voffB); PG8_STAGE(PG8_SA(1, 0), A0 + kstep, offC[0]); PG8_STAGE(PG8_SB(1, 1), cB + hstep + kstep, voffB);
    PG8_WAIT_V(6); PG8_BAR;
    for (;;) {
        const bool has_next = S.next(ui + 1, nxt);
        const char* nB = cB;
        if (has_next) { PG8_OFFS(offN, nxt); nB = (const char*)g.Bt + ((size_t)nxt.e * g.bstride) * 2 + (size_t)nxt.pn * tstep; }
        else {
#pragma unroll
            for (int _h = 0; _h < 2; ++_h)
#pragma unroll
                for (int _i = 0; _i < 2; ++_i) offN[_h][_i] = offC[_h][_i];
        }
        for (int t = 0; t < nt; t += 2) {
            const bool last = (t == nt - 2);
            const char* a1 = A0 + (size_t)(t + 1) * kstep;
            const char* a2 = A0 + (last ? (size_t)0 : (size_t)(t + 2) * kstep); const char* b2 = last ? nB : cB + (size_t)(t + 2) * kstep;
            const char* a3 = a2 + kstep; const char* b3 = b2 + kstep;
            unsigned off2[2][2];
            if (last) {
#pragma unroll
                for (int _h = 0; _h < 2; ++_h)
#pragma unroll
                    for (int _i = 0; _i < 2; ++_i) off2[_h][_i] = offN[_h][_i];
            } else {
#pragma unroll
                for (int _h = 0; _h < 2; ++_h)
#pragma unroll
                    for (int _i = 0; _i < 2; ++_i) off2[_h][_i] = offC[_h][_i];
            }
            PG8_LDB(B0, 0, 0); PG8_LDB(B1, 0, 1); PG8_SCHED; PG8_LDA(At, 0, 0); PG8_STAGE(PG8_SA(1, 1), a1, offC[1]);
            PG8_WAIT_V(8); PG8_WAIT_L(0); PG8_BAR; PG8_MMA(0, 0, At, B0); PG8_MMA(0, 1, At, B1); PG8_BAR; PG8_SCHED;
            PG8_LDA(At, 0, 1); PG8_STAGE(PG8_SB(0, 0), b2, voffB); PG8_STAGE(PG8_SB(0, 1), b2 + hstep, voffB); PG8_STAGE(PG8_SA(0, 0), a2, off2[0]);
            PG8_WAIT_V(8); PG8_WAIT_L(0); PG8_BAR; PG8_MMA(1, 0, At, B0); PG8_MMA(1, 1, At, B1); PG8_BAR; PG8_SCHED;
            PG8_LDB(B0, 1, 0); PG8_LDB(B1, 1, 1); PG8_SCHED; PG8_LDA(At, 1, 0); PG8_STAGE(PG8_SA(0, 1), a2, off2[1]);
            PG8_WAIT_V(8); PG8_WAIT_L(0); PG8_BAR; PG8_MMA(0, 0, At, B0); PG8_MMA(0, 1, At, B1); PG8_BAR; PG8_SCHED;
            PG8_LDA(At, 1, 1); PG8_STAGE(PG8_SB(1, 0), b3, voffB); PG8_STAGE(PG8_SB(1, 1), b3 + hstep, voffB); PG8_STAGE(PG8_SA(1, 0), a3, off2[0]);
            PG8_WAIT_V(8); PG8_WAIT_L(0); PG8_BAR; PG8_MMA(1, 0, At, B0); PG8_MMA(1, 1, At, B1); PG8_BAR; PG8_SCHED;
        }
        if (wr == 0) PG8_BAR;
        E(acc, cur, wr, wc, fr, fq);
        if (!has_next) break;
#pragma unroll
        for (int a = 0; a < 2; ++a)
#pragma unroll
            for (int b = 0; b < 2; ++b)
#pragma unroll
                for (int m = 0; m < 4; ++m)
#pragma unroll
                    for (int n = 0; n < 2; ++n) acc[a][b][m][n] = (f32x4){0.f, 0.f, 0.f, 0.f};
        cur = nxt; cB = nB; ++ui;
#pragma unroll
        for (int _h = 0; _h < 2; ++_h)
#pragma unroll
            for (int _i = 0; _i < 2; ++_i) offC[_h][_i] = offN[_h][_i];
        if (wr == 1) PG8_BAR;
    }
    PG8_WAIT_V(0);
    PG8_BAR;
#undef PG8_SA
#undef PG8_SB
#undef PG8_STAGE
#undef PG8_LDA
#undef PG8_LDB
#undef PG8_MMA
#undef PG8_WAIT_V
#undef PG8_WAIT_L
#undef PG8_BAR
#undef PG8_SCHED
#undef PG8_OFFS
}
}

__device__ __forceinline__ void normrope64(bf16_t* p, const float* gain, const float2* rt  ) {
    uint4 w[8]; float f[64];
#pragma unroll
    for (int i = 0; i < 8; ++i) { w[i] = ((const uint4*)p)[i]; unpack8(w[i], f + 8 * i); }
    float s = 0.f;
#pragma unroll
    for (int i = 0; i < 64; ++i) s += f[i] * f[i];
    const float rstd = rsqrtf(s * (1.f / 64.f) + EPS);
#pragma unroll
    for (int i = 0; i < 64; ++i) f[i] = f[i] * rstd * gain[i];
#pragma unroll
    for (int i = 0; i < 8; ++i) { const float2 cs = rt[i]; const float x1 = f[i], x2 = f[8 + i]; f[i] = x1 * cs.x - x2 * cs.y; f[8 + i] = x2 * cs.x + x1 * cs.y; }
#pragma unroll
    for (int i = 0; i < 8; ++i) { uint4 o; o.x = pk2(f[8 * i], f[8 * i + 1]); o.y = pk2(f[8 * i + 2], f[8 * i + 3]); o.z = pk2(f[8 * i + 4], f[8 * i + 5]); o.w = pk2(f[8 * i + 6], f[8 * i + 7]); ((uint4*)p)[i] = o; }
}

__device__ __forceinline__ void post_even(const Ctx& c, int vb, int nvb) {
    bf16_t* P = (bf16_t*)(c.ws + WS_PROJ); const float2* RT = (const float2*)(c.ws + WS_ROPE);
    const long total = (long)M * 4;
    for (long it = (long)vb * NTHREADS + c.tid; it < total; it += (long)nvb * NTHREADS) {
        const int m = (int)(it >> 2), s = (int)(it & 3); const int pos = m & (SEQ - 1);
        int col; const float* gain;
        if (s < 2) { col = 2816 + 64 * s; gain = c.nsa_kg + 64; }
        else { col = 3072 + 64 * (s - 2); gain = c.nsa_kg + 128; }
        normrope64(P + (size_t)m * EVPP + col, gain, RT + pos * 8);
    }
}
__device__ __forceinline__ void post_odd(const Ctx& c) {
    bf16_t* P = (bf16_t*)(c.ws + WS_PROJ); const float2* RT = (const float2*)(c.ws + WS_ROPE);
    const long total = (long)M * 18;
    for (long it = (long)blockIdx.x * NTHREADS + c.tid; it < total; it += (long)gridDim.x * NTHREADS) {
        const int m = (int)(it / 18), s = (int)(it % 18); const int pos = m & (SEQ - 1);
        normrope64(P + (size_t)m * ODP + 64 * s, s < 16 ? c.swa_qg : c.swa_kg, RT + pos * 8);
    }
}

__device__ __forceinline__ float gelu_tanh(float x) { const float u = 0.7978845608028654f * (x + 0.044715f * x * x * x); return 0.5f * x * (1.f + tanhf(u)); }

__device__ __forceinline__ void compress_naive(const Ctx& c, float* lds, int vb, int nvb) {
    const bf16_t* P = (const bf16_t*)(c.ws + WS_PROJ);
    const bf16_t* CW1T = (const bf16_t*)(c.ws + WS_CW1T); const bf16_t* CW2T = (const bf16_t*)(c.ws + WS_CW2T);
    const float* CB = (const float*)(c.ws + WS_CBIAS); const float2* RT = (const float2*)(c.ws + WS_ROPE);
    bf16_t* KCB = (bf16_t*)(c.ws + WS_KCB); bf16_t* VCB = (bf16_t*)(c.ws + WS_VCB);
    float* Xs = lds; float* hs = lds + 4096; float* os = lds + 4096 + 512;
    const int tid = c.tid, rs = tid >> 8, cc = tid & 255;
    constexpr int NROWS = 2 * 16 * 2 * 255;
    for (int rp = vb; rp < NROWS / 2; rp += nvb) {
        __syncthreads();
        for (int e = tid; e < 4096; e += NTHREADS) {
            const int r2 = e >> 11, k = e & 2047, row = 2 * rp + r2;
            const int n = row % 255, q = row / 255, g = q & 1, b = (q >> 1) & 15, kind = q >> 5;
            Xs[e] = bf2f(P[(size_t)(b * SEQ + 16 * n + (k >> 6)) * EVPP + 2560 + kind * 128 + g * 64 + (k & 63)]);
        }
        __syncthreads();
        const int row = 2 * rp + rs;
        const int n = row % 255, q = row / 255, g = q & 1, b = (q >> 1) & 15, kind = q >> 5;
        {
            float hv = CB[kind * 256 + cc];
            const bf16_t* w = CW1T + ((size_t)kind * 256 + cc) * 2048; const float* xs = Xs + rs * 2048;
            for (int k = 0; k < 2048; k += 8) { const uint4 ww = *(const uint4*)(w + k); float f[8]; unpack8(ww, f);
#pragma unroll
                for (int i = 0; i < 8; ++i) hv += xs[k + i] * f[i]; }
            hs[rs * 256 + cc] = bf2f(f2bf(gelu_tanh(hv)));
        }
        __syncthreads();
        float o = 0.f;
        if (cc < 64) {
            const bf16_t* w = CW2T + ((size_t)kind * 64 + cc) * 256;
            for (int k = 0; k < 256; ++k) o += hs[rs * 256 + k] * bf2f(w[k]);
            os[rs * 64 + cc] = o;
        }
        __syncthreads();
        if (cc < 64) {
            const size_t dst = ((size_t)((b * 2 + g) * 256 + n)) * 64 + cc;
            if (kind == 0) {
                float s = 0.f;
                for (int k = 0; k < 64; ++k) s += os[rs * 64 + k] * os[rs * 64 + k];
                const float rstd = rsqrtf(s * (1.f / 64.f) + EPS);
                const float* gain = c.nsa_kg;
                float y = o * rstd * gain[cc];
                if (cc < 16) {
                    const int pc = cc < 8 ? cc + 8 : cc - 8; const float yp = os[rs * 64 + pc] * rstd * gain[pc];
                    const float2 cs = RT[(16 * n + 31) * 8 + (cc & 7)];
                    y = cc < 8 ? y * cs.x - yp * cs.y : y * cs.x + yp * cs.y;
                }
                KCB[dst] = f2bf(y);
            } else VCB[dst] = f2bf(o);
        }
    }
    for (int i = vb * NTHREADS + tid; i < 32 * 64; i += nvb * NTHREADS) { const size_t dst = ((size_t)((i >> 6) * 256 + 255)) * 64 + (i & 63); KCB[dst] = 0; VCB[dst] = 0; }
}

__device__ __forceinline__ void compress_mfma(const Ctx& c, unsigned char* lds, int unit) {
    typedef short bf16x8 __attribute__((ext_vector_type(8)));
    typedef float f32x4 __attribute__((ext_vector_type(4)));
    const int kind = unit >> 7, b = (unit >> 3) & 15, g = (unit >> 2) & 1, n0 = (unit & 3) * 64;
    const bf16_t* P = (const bf16_t*)(c.ws + WS_PROJ);
    const bf16_t* W1 = (const bf16_t*)(c.ws + WS_CW1T) + (size_t)kind * 256 * 2048; const bf16_t* W2 = (const bf16_t*)(c.ws + WS_CW2T) + (size_t)kind * 64 * 256;
    const float* CB = (const float*)(c.ws + WS_CBIAS) + kind * 256; const float2* RT = (const float2*)(c.ws + WS_ROPE);
    bf16_t* OUTB = (bf16_t*)(c.ws + (kind == 0 ? WS_KCB : WS_VCB)) + (size_t)((b * 2 + g) * 256) * 64;
    const int tid = c.tid, lane = c.lane, w = c.wave, l15 = lane & 15, g4 = lane >> 4;
    constexpr int HP = 264;
    bf16_t* HS = (bf16_t*)lds; float* OS = (float*)(lds + 64 * HP * 2);
    __syncthreads();
    f32x4 acc[4][2];
#pragma unroll
    for (int mt = 0; mt < 4; ++mt) { acc[mt][0] = (f32x4){0.f, 0.f, 0.f, 0.f}; acc[mt][1] = (f32x4){0.f, 0.f, 0.f, 0.f}; }
    const bf16_t* xb[4];
#pragma unroll
    for (int mt = 0; mt < 4; ++mt) { int n = n0 + 16 * mt + l15; if (n > 254) n = 254; xb[mt] = P + ((size_t)b * SEQ + 16 * n) * EVPP + 2560 + kind * 128 + g * 64 + 8 * (g4 & 1); }
    const bf16_t* wb0 = W1 + (size_t)(32 * w + l15) * 2048 + 8 * g4; const bf16_t* wb1 = wb0 + (size_t)16 * 2048;
#pragma unroll 4
    for (int ks = 0; ks < 64; ++ks) {
        const size_t xo = (size_t)(ks >> 1) * EVPP + 32 * (ks & 1) + 16 * (g4 >> 1);
        const bf16x8 b0 = *(const bf16x8*)(wb0 + 32 * ks), b1 = *(const bf16x8*)(wb1 + 32 * ks);
#pragma unroll
        for (int mt = 0; mt < 4; ++mt) {
            const bf16x8 af = *(const bf16x8*)(xb[mt] + xo);
            acc[mt][0] = __builtin_amdgcn_mfma_f32_16x16x32_bf16(af, b0, acc[mt][0], 0, 0, 0);
            acc[mt][1] = __builtin_amdgcn_mfma_f32_16x16x32_bf16(af, b1, acc[mt][1], 0, 0, 0);
        }
    }
#pragma unroll
    for (int mt = 0; mt < 4; ++mt)
#pragma unroll
        for (int nt = 0; nt < 2; ++nt) { const int cc = 32 * w + 16 * nt + l15; const float bias = CB[cc];
#pragma unroll
            for (int r = 0; r < 4; ++r) HS[(16 * mt + 4 * g4 + r) * HP + cc] = f2bf(gelu_tanh(acc[mt][nt][r] + bias)); }
    __syncthreads();
    {
        const int mt = w >> 1, nt0 = 2 * (w & 1);
        f32x4 o0 = {0.f, 0.f, 0.f, 0.f}, o1 = {0.f, 0.f, 0.f, 0.f};
        const bf16_t* ar = HS + (16 * mt + l15) * HP + 8 * g4;
        const bf16_t* br0 = W2 + (size_t)(16 * nt0 + l15) * 256 + 8 * g4; const bf16_t* br1 = br0 + 16 * 256;
#pragma unroll
        for (int ks = 0; ks < 8; ++ks) {
            const bf16x8 af = *(const bf16x8*)(ar + 32 * ks);
            o0 = __builtin_amdgcn_mfma_f32_16x16x32_bf16(af, *(const bf16x8*)(br0 + 32 * ks), o0, 0, 0, 0);
            o1 = __builtin_amdgcn_mfma_f32_16x16x32_bf16(af, *(const bf16x8*)(br1 + 32 * ks), o1, 0, 0, 0);
        }
#pragma unroll
        for (int r = 0; r < 4; ++r) { OS[(16 * mt + 4 * g4 + r) * 68 + 16 * nt0 + l15] = o0[r]; OS[(16 * mt + 4 * g4 + r) * 68 + 16 * nt0 + 16 + l15] = o1[r]; }
    }
    __syncthreads();
    {
        const int row = tid >> 3, sub = tid & 7, n = n0 + row;
        float v[8];
#pragma unroll
        for (int j = 0; j < 8; ++j) v[j] = OS[row * 68 + 8 * sub + j];
        if (kind == 0) {
            float sq = 0.f;
#pragma unroll
            for (int j = 0; j < 8; ++j) sq += v[j] * v[j];
            sq += __shfl_xor(sq, 1); sq += __shfl_xor(sq, 2); sq += __shfl_xor(sq, 4);
            const float rstd = rsqrtf(sq * (1.f / 64.f) + EPS);
#pragma unroll
            for (int j = 0; j < 8; ++j) v[j] = v[j] * rstd * c.nsa_kg[8 * sub + j];
            const int pos = (16 * n + 31) & (SEQ - 1);
#pragma unroll
            for (int j = 0; j < 8; ++j) {
                const float other = __shfl_xor(v[j], 1);
                const float2 cs = RT[pos * 8 + j];
                if (sub == 0) v[j] = v[j] * cs.x - other * cs.y; else if (sub == 1) v[j] = v[j] * cs.x + other * cs.y;
            }
        }
        uint4 o; o.x = pk2(v[0], v[1]); o.y = pk2(v[2], v[3]); o.z = pk2(v[4], v[5]); o.w = pk2(v[6], v[7]);
        if (n > 254) { o.x = 0u; o.y = 0u; o.z = 0u; o.w = 0u; }
        *(uint4*)(OUTB + (size_t)n * 64 + 8 * sub) = o;
    }
}

__device__ __forceinline__ void hgrn2_naive(const Ctx& c, int vb) {
    bf16_t* P = (bf16_t*)(c.ws + WS_PROJ); const float* LOGF = (const float*)(c.ws + WS_LOGF);
    const int id = vb * NTHREADS + c.tid;
    const int half = id & 1, v = (id >> 1) & 127, h = (id >> 8) & 3, b = id >> 10;
    float S[64];
#pragma unroll
    for (int d = 0; d < 64; ++d) S[d] = 0.f;
    for (int t = 0; t < SEQ; ++t) {
        const size_t m = (size_t)b * SEQ + t;
        bf16_t* row = P + m * EVPP; const float* lf = LOGF + m * 512 + h * 128 + half * 64;
        const float vv = bf2f(row[1024 + h * 128 + v]);
        float o = 0.f;
#pragma unroll
        for (int d8 = 0; d8 < 8; ++d8) {
            const uint4 qw = *(const uint4*)(row + h * 128 + half * 64 + 8 * d8); const uint4 kw = *(const uint4*)(row + 512 + h * 128 + half * 64 + 8 * d8);
            const float4 l0 = *(const float4*)(lf + 8 * d8), l1 = *(const float4*)(lf + 8 * d8 + 4);
            float qf[8], kf[8]; unpack8(qw, qf); unpack8(kw, kf);
            const float lfv[8] = {l0.x, l0.y, l0.z, l0.w, l1.x, l1.y, l1.z, l1.w};
#pragma unroll
            for (int i = 0; i < 8; ++i) { const int d = 8 * d8 + i; S[d] = __expf(lfv[i]) * S[d] + kf[i] * vv; o += qf[i] * S[d]; }
        }
        o += __shfl_xor(o, 1);
        asm volatile("" ::: "memory");
        if (half == 0) row[1024 + h * 128 + v] = f2bf(o);
    }
}

namespace hg {
typedef short bf16x8 __attribute__((ext_vector_type(8)));
typedef float f32x4 __attribute__((ext_vector_type(4)));
constexpr int PQ = 136, PS = 72;
constexpr int O_QS = 0, O_QD = O_QS + 64 * PQ * 2, O_KD = O_QD + 64 * PQ * 2, O_KK = O_KD + 64 * PQ * 2, O_QO = O_KK + 48 * PQ * 2, O_KST = O_QO + 96 * PQ * 2,
              O_VT = O_KST + 128 * PS * 2, O_STT = O_VT + 32 * PS * 2, O_TSH = O_STT + 32 * PQ * 2, O_END = O_TSH + 4 * 128 * 4;
static_assert(O_END <= 160 * 1024, "hgrn2 LDS");
__device__ __forceinline__ bf16x8 pack8(float a0, float a1, float a2, float a3, float a4, float a5, float a6, float a7) {
    uint4 w; w.x = pk2(a0, a1); w.y = pk2(a2, a3); w.z = pk2(a4, a5); w.w = pk2(a6, a7); return __builtin_bit_cast(bf16x8, w); }
__device__ __forceinline__ float cexp(float x) { return __expf(fminf(fmaxf(x, -80.f), 80.f)); }
}
__device__ __forceinline__ void hgrn2_chunk(const Ctx& c, unsigned char* lds_raw, int unit) {
    using namespace hg;
    const int vs = unit & 3, h = (unit >> 2) & 3, b = unit >> 4;
    bf16_t* P = (bf16_t*)(c.ws + WS_PROJ); const float* LOGF = (const float*)(c.ws + WS_LOGF);
    bf16_t* QS = (bf16_t*)(lds_raw + O_QS); bf16_t* QD = (bf16_t*)(lds_raw + O_QD); bf16_t* KD = (bf16_t*)(lds_raw + O_KD); bf16_t* KK = (bf16_t*)(lds_raw + O_KK);
    bf16_t* QO = (bf16_t*)(lds_raw + O_QO); bf16_t* KST = (bf16_t*)(lds_raw + O_KST); bf16_t* VT = (bf16_t*)(lds_raw + O_VT); bf16_t* STT = (bf16_t*)(lds_raw + O_STT);
    float* TSH = (float*)(lds_raw + O_TSH);
    const int tid = c.tid, lane = c.lane, w = c.wave;
    const int i = w >> 1, hf = w & 1, d = 2 * lane;
    const int tt = w >> 1, vvt = w & 1, g4 = lane >> 4, l15 = lane & 15;
    const int dt0 = 2 * (w >> 1), dt1 = dt0 + 1;
    __syncthreads();
    for (int x = tid; x < 32 * PQ / 2; x += NTHREADS) ((u32*)STT)[x] = 0u;
    f32x4 st0 = {0.f, 0.f, 0.f, 0.f}, st1 = {0.f, 0.f, 0.f, 0.f};
    const size_t rowbase = (size_t)b * SEQ;
    const bf16_t* qp = P + (rowbase + 16 * i + 8 * hf) * EVPP + h * 128 + d;
    const float* lp = LOGF + (rowbase + 16 * i + 8 * hf) * 512 + h * 128 + d;
    const int vrow = tid >> 3, vc4 = (tid & 7) * 4;
    const bf16_t* vp = P + (rowbase + vrow) * EVPP + 1024 + h * 128 + 32 * vs + vc4;
    u32 qraw[8], kraw[8]; float2 lfr[8], pre[8]; uint2 vraw;
#pragma unroll
    for (int r = 0; r < 8; ++r) { qraw[r] = *(const u32*)(qp + (size_t)r * EVPP); kraw[r] = *(const u32*)(qp + (size_t)r * EVPP + 512); lfr[r] = *(const float2*)(lp + (size_t)r * 512);
        pre[r] = hf ? *(const float2*)(lp + (size_t)r * 512 - 8 * 512) : make_float2(0.f, 0.f); }
    vraw = *(const uint2*)vp;
    for (int ch = 0; ch < 64; ++ch) {
        const int t0 = ch * 64;
        const int mslot = (ch * 256 + unit) * 6 + w; const bool mok = (w < 6) && mslot < MOE_ITEMS;
        MoeItem mit; moe_item_decode(c, mok ? mslot : 0, mit);
        float4 mva, mvb, mvc, mvd;
        { const float* p_ = mit.W + (size_t)(mit.k0 + 4 * (lane >> 3)) * mit.N + mit.n0 + 4 * (lane & 7); const size_t N_ = mit.N;
          mva = *(const float4*)(p_); mvb = *(const float4*)(p_ + N_); mvc = *(const float4*)(p_ + 2 * N_); mvd = *(const float4*)(p_ + 3 * N_); }
        bf16_t* const mout = mit.WT + (size_t)(mit.drow0 + mit.n0 + 4 * (lane & 7)) * mit.K + mit.k0 + 4 * (lane >> 3); const size_t mK = mit.K;
        float2 lb[8]; float2 run = make_float2(0.f, 0.f);
#pragma unroll
        for (int r = 0; r < 8; ++r) { run.x += pre[r].x; run.y += pre[r].y; }
        const float2 rmid = hf ? run : make_float2(0.f, 0.f);
#pragma unroll
        for (int r = 0; r < 8; ++r) { run.x += lfr[r].x; run.y += lfr[r].y; lb[r] = run; }
        if (hf) *(float2*)(TSH + i * 128 + d) = lb[7];
        if (ch < 63) {
            const size_t adv = (size_t)(t0 + 64);
#pragma unroll
            for (int r = 0; r < 8; ++r) { lfr[r] = *(const float2*)(lp + (adv + r) * 512); if (hf) pre[r] = *(const float2*)(lp + (adv + r) * 512 - 8 * 512); }
        }
        if (ch > 0) {
#pragma unroll
            for (int r = 0; r < 4; ++r) { STT[(16 * vvt + 4 * g4 + r) * PQ + 16 * dt0 + l15] = f2bf(st0[r]); STT[(16 * vvt + 4 * g4 + r) * PQ + 16 * dt1 + l15] = f2bf(st1[r]); }
        }
        __syncthreads();
        {
            const float2 T0 = *(const float2*)(TSH + d), T1 = *(const float2*)(TSH + 128 + d), T2 = *(const float2*)(TSH + 256 + d), T3 = *(const float2*)(TSH + 384 + d);
            const float2 Ti = i == 0 ? T0 : (i == 1 ? T1 : (i == 2 ? T2 : T3));
            const float2 rm = hf ? rmid : lb[7];
            float cQS[2], cQD[2], cKD[2], cKK[2], cKS[2], cQ0[2], cQ1[2], cQ2[2];
#pragma unroll
            for (int x = 0; x < 2; ++x) {
                const float t0x = x ? T0.y : T0.x, t1x = x ? T1.y : T1.x, t2x = x ? T2.y : T2.x, t3x = x ? T3.y : T3.x, tix = x ? Ti.y : Ti.x, rmx = x ? rm.y : rm.x;
                const float Bi = (i > 0 ? t0x : 0.f) + (i > 1 ? t1x : 0.f) + (i > 2 ? t2x : 0.f), B4 = (t0x + t1x) + (t2x + t3x);
                cQS[x] = cexp(Bi); cQD[x] = cexp(-rmx); cKD[x] = cexp(rmx); cKK[x] = cexp(tix); cKS[x] = cKK[x] * cexp(B4 - (Bi + tix));
                cQ0[x] = cexp(Bi - t0x); cQ1[x] = cexp(Bi - (t0x + t1x)); cQ2[x] = cexp(Bi - (t0x + t1x + t2x));
            }
            float ks0[8], ks1[8];
#pragma unroll
            for (int r = 0; r < 8; ++r) {
                const int t = 16 * i + 8 * hf + r;
                const float q0 = __uint_as_float(qraw[r] << 16), q1 = __uint_as_float(qraw[r] & 0xffff0000u), k0 = __uint_as_float(kraw[r] << 16), k1 = __uint_as_float(kraw[r] & 0xffff0000u);
                const float e0 = __expf(fmaxf(lb[r].x, -80.f)), e1 = __expf(fmaxf(lb[r].y, -80.f));
                const float qe0 = q0 * e0, qe1 = q1 * e1, ke0 = k0 * __builtin_amdgcn_rcpf(e0), ke1 = k1 * __builtin_amdgcn_rcpf(e1);
                *(u32*)(QS + t * PQ + d) = pk2(qe0 * cQS[0], qe1 * cQS[1]);
                *(u32*)(QD + t * PQ + d) = pk2(qe0 * cQD[0], qe1 * cQD[1]); *(u32*)(KD + t * PQ + d) = pk2(ke0 * cKD[0], ke1 * cKD[1]);
                if (i < 3) *(u32*)(KK + t * PQ + d) = pk2(ke0 * cKK[0], ke1 * cKK[1]);
                ks0[r] = ke0 * cKS[0]; ks1[r] = ke1 * cKS[1];
                if (i >= 1) *(u32*)(QO + (t - 16) * PQ + d) = pk2(qe0 * cQ0[0], qe1 * cQ0[1]);
                if (i >= 2) *(u32*)(QO + (48 + t - 32) * PQ + d) = pk2(qe0 * cQ1[0], qe1 * cQ1[1]);
                if (i >= 3) *(u32*)(QO + (80 + t - 48) * PQ + d) = pk2(qe0 * cQ2[0], qe1 * cQ2[1]);
            }
            uint4 w0, w1;
            w0.x = pk2(ks0[0], ks0[1]); w0.y = pk2(ks0[2], ks0[3]); w0.z = pk2(ks0[4], ks0[5]); w0.w = pk2(ks0[6], ks0[7]);
            w1.x = pk2(ks1[0], ks1[1]); w1.y = pk2(ks1[2], ks1[3]); w1.z = pk2(ks1[4], ks1[5]); w1.w = pk2(ks1[6], ks1[7]);
            *(uint4*)(KST + d * PS + 16 * i + 8 * hf) = w0; *(uint4*)(KST + (d + 1) * PS + 16 * i + 8 * hf) = w1;
        }
        VT[(vc4 + 0) * PS + vrow] = (bf16_t)(vraw.x & 0xffffu); VT[(vc4 + 1) * PS + vrow] = (bf16_t)(vraw.x >> 16);
        VT[(vc4 + 2) * PS + vrow] = (bf16_t)(vraw.y & 0xffffu); VT[(vc4 + 3) * PS + vrow] = (bf16_t)(vraw.y >> 16);
        if (ch < 63) {
            const size_t adv = (size_t)(t0 + 64);
#pragma unroll
            for (int r = 0; r < 8; ++r) { qraw[r] = *(const u32*)(qp + (adv + r) * EVPP); kraw[r] = *(const u32*)(qp + (adv + r) * EVPP + 512); }
            vraw = *(const uint2*)(vp + adv * EVPP);
        }
        __syncthreads();
        {
            f32x4 Pj[4];
#pragma unroll
            for (int j = 0; j < 4; ++j) {
                Pj[j] = (f32x4){0.f, 0.f, 0.f, 0.f};
                if (j <= tt) {
                    const bf16_t* Ar; const bf16_t* Br;
                    if (j < tt) { Ar = KK + (16 * j + l15) * PQ; Br = QO + ((j == 0 ? 0 : (j == 1 ? 48 : 80)) + 16 * (tt - j - 1) + l15) * PQ; }
                    else { Ar = KD + (16 * tt + l15) * PQ; Br = QD + (16 * tt + l15) * PQ; }
                    f32x4 acc = {0.f, 0.f, 0.f, 0.f};
#pragma unroll
                    for (int ks = 0; ks < 4; ++ks) acc = __builtin_amdgcn_mfma_f32_16x16x32_bf16(*(const bf16x8*)(Ar + 32 * ks + 8 * g4), *(const bf16x8*)(Br + 32 * ks + 8 * g4), acc, 0, 0, 0);
                    __builtin_amdgcn_sched_group_barrier(0x100, 8, 0); __builtin_amdgcn_sched_group_barrier(0x008, 4, 0);
                    if (j == tt) {
#pragma unroll
                        for (int r = 0; r < 4; ++r) if (4 * g4 + r > l15) acc[r] = 0.f;
                    }
                    Pj[j] = acc;
                }
            }
            f32x4 o = {0.f, 0.f, 0.f, 0.f};
            const bf16_t* vt = VT + (16 * vvt + l15) * PS;
#pragma unroll
            for (int p = 0; p < 2; ++p) {
                if (2 * p <= tt) {
                    const bf16x8 af = pack8(Pj[2 * p][0], Pj[2 * p][1], Pj[2 * p][2], Pj[2 * p][3], Pj[2 * p + 1][0], Pj[2 * p + 1][1], Pj[2 * p + 1][2], Pj[2 * p + 1][3]);
                    const uint2 lo = *(const uint2*)(vt + 32 * p + 4 * g4), hi = *(const uint2*)(vt + 32 * p + 16 + 4 * g4);
                    uint4 bw; bw.x = lo.x; bw.y = lo.y; bw.z = hi.x; bw.w = hi.y;
                    o = __builtin_amdgcn_mfma_f32_16x16x32_bf16(af, __builtin_bit_cast(bf16x8, bw), o, 0, 0, 0);
                }
            }
            {
                const bf16_t* Ar = QS + (16 * tt + l15) * PQ; const bf16_t* Br = STT + (16 * vvt + l15) * PQ;
#pragma unroll
                for (int ks = 0; ks < 4; ++ks) o = __builtin_amdgcn_mfma_f32_16x16x32_bf16(*(const bf16x8*)(Ar + 32 * ks + 8 * g4), *(const bf16x8*)(Br + 32 * ks + 8 * g4), o, 0, 0, 0);
                __builtin_amdgcn_sched_group_barrier(0x100, 8, 0); __builtin_amdgcn_sched_group_barrier(0x008, 4, 0);
            }
            bf16_t* op = P + (rowbase + t0 + 16 * tt + 4 * g4) * EVPP + 1024 + h * 128 + 32 * vs + 16 * vvt + l15;
#pragma unroll
            for (int r = 0; r < 4; ++r) op[(size_t)r * EVPP] = f2bf(o[r]);
            {
                const int d0 = 16 * dt0 + l15, d1 = 16 * dt1 + l15;
                const float g0 = cexp((TSH[d0] + TSH[128 + d0]) + (TSH[256 + d0] + TSH[384 + d0])), g1 = cexp((TSH[d1] + TSH[128 + d1]) + (TSH[256 + d1] + TSH[384 + d1]));
                st0 = st0 * g0; st1 = st1 * g1;
#pragma unroll
                for (int ks = 0; ks < 2; ++ks) {
                    const bf16x8 av = *(const bf16x8*)(vt + 32 * ks + 8 * g4);
                    st0 = __builtin_amdgcn_mfma_f32_16x16x32_bf16(av, *(const bf16x8*)(KST + d0 * PS + 32 * ks + 8 * g4), st0, 0, 0, 0);
                    st1 = __builtin_amdgcn_mfma_f32_16x16x32_bf16(av, *(const bf16x8*)(KST + d1 * PS + 32 * ks + 8 * g4), st1, 0, 0, 0);
                }
            }
        }
        if (mok) { uint2 w_;
            w_.x = pk2(mva.x, mvb.x); w_.y = pk2(mvc.x, mvd.x); *(uint2*)(mout) = w_;
            w_.x = pk2(mva.y, mvb.y); w_.y = pk2(mvc.y, mvd.y); *(uint2*)(mout + mK) = w_;
            w_.x = pk2(mva.z, mvb.z); w_.y = pk2(mvc.z, mvd.z); *(uint2*)(mout + 2 * mK) = w_;
            w_.x = pk2(mva.w, mvb.w); w_.y = pk2(mvc.w, mvd.w); *(uint2*)(mout + 3 * mK) = w_; }
        __syncthreads();
    }
}

namespace hg {
constexpr int A_VT = O_KST + 128 * PS * 2, A_TSH = A_VT + 128 * PS * 2, A_END = A_TSH + 4 * 128 * 4;
static_assert(A_END <= 160 * 1024 - 16, "hgrn2 pass A LDS");
constexpr int S_QS = 0, S_STT = 2 * 64 * PQ * 2, S_END = S_STT + 2 * 32 * PQ * 2;
constexpr size_t HG_U = 0, HG_QG = (size_t)128 << 20, HG_OI = (size_t)192 << 20;
}
__device__ __forceinline__ void hgrn2_passA(const Ctx& c, unsigned char* lds_raw, int su) {
    using namespace hg;
    const int cq = su & 3, h = (su >> 2) & 3, b = su >> 4;
    const bf16_t* P = (const bf16_t*)(c.ws + WS_PROJ); const float* LOGF = (const float*)(c.ws + WS_LOGF);
    unsigned char* scr = (unsigned char*)c.xr; float* GD = (float*)(c.ws + WS_H);
    bf16_t* QS = (bf16_t*)(lds_raw + O_QS); bf16_t* QD = (bf16_t*)(lds_raw + O_QD); bf16_t* KD = (bf16_t*)(lds_raw + O_KD); bf16_t* KK = (bf16_t*)(lds_raw + O_KK);
    bf16_t* QO = (bf16_t*)(lds_raw + O_QO); bf16_t* KST = (bf16_t*)(lds_raw + O_KST); bf16_t* VT = (bf16_t*)(lds_raw + A_VT);
    float* TSH = (float*)(lds_raw + A_TSH);
    const int tid = c.tid, lane = c.lane, w = c.wave;
    const int i = w >> 1, hf = w & 1, d = 2 * lane;
    const int tt = w >> 1, vh = w & 1, g4 = lane >> 4, l15 = lane & 15;
    const size_t rowbase = (size_t)b * SEQ + (size_t)cq * 1024;
    const bf16_t* qp = P + (rowbase + 16 * i + 8 * hf) * EVPP + h * 128 + d;
    const float* lp = LOGF + (rowbase + 16 * i + 8 * hf) * 512 + h * 128 + d;
    const int vrow = tid >> 3, vc = (tid & 7) * 16;
    const bf16_t* vp = P + (rowbase + vrow) * EVPP + 1024 + h * 128 + vc;
    u32 qraw[8], kraw[8]; float2 lfr[8], pre[8]; uint4 vr0, vr1;
#pragma unroll
    for (int r = 0; r < 8; ++r) { qraw[r] = *(const u32*)(qp + (size_t)r * EVPP); kraw[r] = *(const u32*)(qp + (size_t)r * EVPP + 512); lfr[r] = *(const float2*)(lp + (size_t)r * 512);
        pre[r] = *(const float2*)(lp + (size_t)r * 512 - (size_t)(8 * hf) * 512); }
    vr0 = *(const uint4*)vp; vr1 = *(const uint4*)(vp + 8);
    __syncthreads();
    for (int k = 0; k < 16; ++k) {
        const int u = ((b * 4 + h) * 64) + cq * 16 + k;
        float2 lb[8]; float2 run = make_float2(0.f, 0.f);
#pragma unroll
        for (int r = 0; r < 8; ++r) { run.x += pre[r].x; run.y += pre[r].y; }
        run.x *= (float)hf; run.y *= (float)hf;
        const float2 rmid = run;
#pragma unroll
        for (int r = 0; r < 8; ++r) { run.x += lfr[r].x; run.y += lfr[r].y; lb[r] = run; }
        if (hf) *(float2*)(TSH + i * 128 + d) = lb[7];
        if (k < 15) {
            const size_t adv = (size_t)(k + 1) * 64;
#pragma unroll
            for (int r = 0; r < 8; ++r) { lfr[r] = *(const float2*)(lp + (adv + r) * 512); pre[r] = *(const float2*)(lp + (adv + r) * 512 - (size_t)(8 * hf) * 512); }
        }
        __syncthreads();
        {
            const float2 T0 = *(const float2*)(TSH + d), T1 = *(const float2*)(TSH + 128 + d), T2 = *(const float2*)(TSH + 256 + d), T3 = *(const float2*)(TSH + 384 + d);
            const float2 Ti = i == 0 ? T0 : (i == 1 ? T1 : (i == 2 ? T2 : T3));
            const float2 rm = hf ? rmid : lb[7];
            float cQS[2], cQD[2], cKD[2], cKK[2], cKS[2], cQ0[2], cQ1[2], cQ2[2];
#pragma unroll
            for (int x = 0; x < 2; ++x) {
                const float t0x = x ? T0.y : T0.x, t1x = x ? T1.y : T1.x, t2x = x ? T2.y : T2.x, t3x = x ? T3.y : T3.x, tix = x ? Ti.y : Ti.x, rmx = x ? rm.y : rm.x;
                const float Bi = (i > 0 ? t0x : 0.f) + (i > 1 ? t1x : 0.f) + (i > 2 ? t2x : 0.f), B4 = (t0x + t1x) + (t2x + t3x);
                cQS[x] = cexp(Bi); cQD[x] = cexp(-rmx); cKD[x] = cexp(rmx); cKK[x] = cexp(tix); cKS[x] = cKK[x] * cexp(B4 - (Bi + tix));
                cQ0[x] = cexp(Bi - t0x); cQ1[x] = cexp(Bi - (t0x + t1x)); cQ2[x] = cexp(Bi - (t0x + t1x + t2x));
            }
            if (tid < 128) GD[(size_t)u * 128 + tid] = cexp((TSH[tid] + TSH[128 + tid]) + (TSH[256 + tid] + TSH[384 + tid]));
            float ks0[8], ks1[8];
#pragma unroll
            for (int r = 0; r < 8; ++r) {
                const int t = 16 * i + 8 * hf + r;
                const float q0 = __uint_as_float(qraw[r] << 16), q1 = __uint_as_float(qraw[r] & 0xffff0000u), k0 = __uint_as_float(kraw[r] << 16), k1 = __uint_as_float(kraw[r] & 0xffff0000u);
                const float e0 = __expf(fmaxf(lb[r].x, -80.f)), e1 = __expf(fmaxf(lb[r].y, -80.f));
                const float qe0 = q0 * e0, qe1 = q1 * e1, ke0 = k0 * __builtin_amdgcn_rcpf(e0), ke1 = k1 * __builtin_amdgcn_rcpf(e1);
                *(u32*)(QS + t * PQ + d) = pk2(qe0 * cQS[0], qe1 * cQS[1]);
                *(u32*)(QD + t * PQ + d) = pk2(qe0 * cQD[0], qe1 * cQD[1]); *(u32*)(KD + t * PQ + d) = pk2(ke0 * cKD[0], ke1 * cKD[1]);
                if (i < 3) *(u32*)(KK + t * PQ + d) = pk2(ke0 * cKK[0], ke1 * cKK[1]);
                ks0[r] = ke0 * cKS[0]; ks1[r] = ke1 * cKS[1];
                if (i >= 1) *(u32*)(QO + (t - 16) * PQ + d) = pk2(qe0 * cQ0[0], qe1 * cQ0[1]);
                if (i >= 2) *(u32*)(QO + (48 + t - 32) * PQ + d) = pk2(qe0 * cQ1[0], qe1 * cQ1[1]);
                if (i >= 3) *(u32*)(QO + (80 + t - 48) * PQ + d) = pk2(qe0 * cQ2[0], qe1 * cQ2[1]);
            }
            uint4 w0, w1;
            w0.x = pk2(ks0[0], ks0[1]); w0.y = pk2(ks0[2], ks0[3]); w0.z = pk2(ks0[4], ks0[5]); w0.w = pk2(ks0[6], ks0[7]);
            w1.x = pk2(ks1[0], ks1[1]); w1.y = pk2(ks1[2], ks1[3]); w1.z = pk2(ks1[4], ks1[5]); w1.w = pk2(ks1[6], ks1[7]);
            *(uint4*)(KST + d * PS + 16 * i + 8 * hf) = w0; *(uint4*)(KST + (d + 1) * PS + 16 * i + 8 * hf) = w1;
        }
        {
            const u32 vw[8] = {vr0.x, vr0.y, vr0.z, vr0.w, vr1.x, vr1.y, vr1.z, vr1.w};
#pragma unroll
            for (int j = 0; j < 8; ++j) { VT[(vc + 2 * j) * PS + vrow] = (bf16_t)(vw[j] & 0xffffu); VT[(vc + 2 * j + 1) * PS + vrow] = (bf16_t)(vw[j] >> 16); }
        }
        if (k < 15) {
            const size_t adv = (size_t)(k + 1) * 64;
#pragma unroll
            for (int r = 0; r < 8; ++r) { qraw[r] = *(const u32*)(qp + (adv + r) * EVPP); kraw[r] = *(const u32*)(qp + (adv + r) * EVPP + 512); }
            vr0 = *(const uint4*)(vp + adv * EVPP); vr1 = *(const uint4*)(vp + adv * EVPP + 8);
        }
        __syncthreads();
        {
            f32x4 Pj[4];
#pragma unroll
            for (int j = 0; j < 4; ++j) {
                Pj[j] = (f32x4){0.f, 0.f, 0.f, 0.f};
                if (j <= tt) {
                    const bf16_t* Ar; const bf16_t* Br;
                    if (j < tt) { Ar = KK + (16 * j + l15) * PQ; Br = QO + ((j == 0 ? 0 : (j == 1 ? 48 : 80)) + 16 * (tt - j - 1) + l15) * PQ; }
                    else { Ar = KD + (16 * tt + l15) * PQ; Br = QD + (16 * tt + l15) * PQ; }
                    f32x4 acc = {0.f, 0.f, 0.f, 0.f};
#pragma unroll
                    for (int ks = 0; ks < 4; ++ks) acc = __builtin_amdgcn_mfma_f32_16x16x32_bf16(*(const bf16x8*)(Ar + 32 * ks + 8 * g4), *(const bf16x8*)(Br + 32 * ks + 8 * g4), acc, 0, 0, 0);
                    __builtin_amdgcn_sched_group_barrier(0x100, 8, 0); __builtin_amdgcn_sched_group_barrier(0x008, 4, 0);
                    if (j == tt) {
#pragma unroll
                        for (int r = 0; r < 4; ++r) if (4 * g4 + r > l15) acc[r] = 0.f;
                    }
                    Pj[j] = acc;
                }
            }
            const bf16x8 af0 = pack8(Pj[0][0], Pj[0][1], Pj[0][2], Pj[0][3], Pj[1][0], Pj[1][1], Pj[1][2], Pj[1][3]);
            const bf16x8 af1 = pack8(Pj[2][0], Pj[2][1], Pj[2][2], Pj[2][3], Pj[3][0], Pj[3][1], Pj[3][2], Pj[3][3]);
            uint2* OI = (uint2*)(scr + HG_OI) + ((size_t)u * 32 + tt * 8) * 64 + lane;
#pragma unroll
            for (int q = 0; q < 4; ++q) {
                const int vt = 4 * vh + q;
                const bf16_t* vrw = VT + (16 * vt + l15) * PS;
                f32x4 o = {0.f, 0.f, 0.f, 0.f};
                { const uint2 lo = *(const uint2*)(vrw + 4 * g4), hi = *(const uint2*)(vrw + 16 + 4 * g4); uint4 bw; bw.x = lo.x; bw.y = lo.y; bw.z = hi.x; bw.w = hi.y;
                  o = __builtin_amdgcn_mfma_f32_16x16x32_bf16(af0, __builtin_bit_cast(bf16x8, bw), o, 0, 0, 0); }
                if (tt >= 2) { const uint2 lo = *(const uint2*)(vrw + 32 + 4 * g4), hi = *(const uint2*)(vrw + 48 + 4 * g4); uint4 bw; bw.x = lo.x; bw.y = lo.y; bw.z = hi.x; bw.w = hi.y;
                  o = __builtin_amdgcn_mfma_f32_16x16x32_bf16(af1, __builtin_bit_cast(bf16x8, bw), o, 0, 0, 0); }
                uint2 ow; ow.x = pk2(o[0], o[1]); ow.y = pk2(o[2], o[3]);
                OI[(size_t)vt * 64] = ow;
            }
            {
                uint2* U = (uint2*)(scr + HG_U) + ((size_t)u * 64 + w * 8) * 64 + lane;
                const bf16_t* vrw = VT + (16 * w + l15) * PS;
                const bf16x8 av0 = *(const bf16x8*)(vrw + 8 * g4), av1 = *(const bf16x8*)(vrw + 32 + 8 * g4);
#pragma unroll
                for (int dt = 0; dt < 8; ++dt) {
                    const bf16_t* kr = KST + (16 * dt + l15) * PS + 8 * g4;
                    f32x4 a = {0.f, 0.f, 0.f, 0.f};
                    a = __builtin_amdgcn_mfma_f32_16x16x32_bf16(av0, *(const bf16x8*)(kr), a, 0, 0, 0);
                    a = __builtin_amdgcn_mfma_f32_16x16x32_bf16(av1, *(const bf16x8*)(kr + 32), a, 0, 0, 0);
                    uint2 uw; uw.x = pk2(a[0], a[1]); uw.y = pk2(a[2], a[3]);
                    U[(size_t)dt * 64] = uw;
                }
            }
            {
                const int row = tid >> 3, ch16 = (tid & 7) * 16;
                const uint4 a0 = *(const uint4*)(QS + row * PQ + ch16), a1 = *(const uint4*)(QS + row * PQ + ch16 + 8);
                uint4* QG = (uint4*)(scr + HG_QG + ((size_t)u * 64 + row) * 256 + ch16 * 2);
                QG[0] = a0; QG[1] = a1;
            }
        }
        __syncthreads();
    }
}

__device__ __forceinline__ void hgrn2_seq(const Ctx& c, unsigned char* lds_raw, int unit) {
    using namespace hg;
    const int vs = unit & 3, h = (unit >> 2) & 3, b = unit >> 4;
    bf16_t* P = (bf16_t*)(c.ws + WS_PROJ);
    const unsigned char* scr = (const unsigned char*)c.xr; const float* GD = (const float*)(c.ws + WS_H);
    const int tid = c.tid, lane = c.lane, w = c.wave;
    const int tt = w >> 1, vvt = w & 1, g4 = lane >> 4, l15 = lane & 15;
    const int dt0 = 2 * (w >> 1), dt1 = dt0 + 1, vt = 2 * vs + vvt;
    const size_t rowbase = (size_t)b * SEQ;
    const int u0 = (b * 4 + h) * 64;
    f32x4 st0 = {0.f, 0.f, 0.f, 0.f}, st1 = {0.f, 0.f, 0.f, 0.f};
    const int qrow = tid >> 3, qc16 = (tid & 7) * 16;
#define HG_LOAD(SET, CH) do { const size_t u_ = (size_t)(u0 + (CH)); \
        const uint4* qg_ = (const uint4*)(scr + HG_QG + (u_ * 64 + qrow) * 256 + qc16 * 2); SET##q0 = qg_[0]; SET##q1 = qg_[1]; \
        const uint2* up_ = (const uint2*)(scr + HG_U) + (u_ * 64 + vt * 8) * 64 + lane; SET##u0 = up_[(size_t)dt0 * 64]; SET##u1 = up_[(size_t)dt1 * 64]; \
        SET##oi = ((const uint2*)(scr + HG_OI))[(u_ * 32 + tt * 8 + vt) * 64 + lane]; \
        SET##g0 = GD[u_ * 128 + 16 * dt0 + l15]; SET##g1 = GD[u_ * 128 + 16 * dt1 + l15]; } while (0)
#define HG_MOE_ISSUE(SET, CH) do { const int ms_ = ((CH) * 256 + unit) * 6 + w; SET##mok = (w < 6) && ms_ < MOE_ITEMS; MoeItem mi_; moe_item_decode(c, SET##mok ? ms_ : 0, mi_); \
        const float* p_ = mi_.W + (size_t)(mi_.k0 + 4 * (lane >> 3)) * mi_.N + mi_.n0 + 4 * (lane & 7); const size_t N_ = mi_.N; \
        SET##ma = *(const float4*)(p_); SET##mb = *(const float4*)(p_ + N_); SET##mc = *(const float4*)(p_ + 2 * N_); SET##md = *(const float4*)(p_ + 3 * N_); \
        SET##mo = mi_.WT + (size_t)(mi_.drow0 + mi_.n0 + 4 * (lane & 7)) * mi_.K + mi_.k0 + 4 * (lane >> 3); SET##mk = mi_.K; } while (0)
#define HG_MOE_FINISH(SET) do { if (SET##mok) { uint2 w_; \
        w_.x = pk2(SET##ma.x, SET##mb.x); w_.y = pk2(SET##mc.x, SET##md.x); *(uint2*)(SET##mo) = w_; \
        w_.x = pk2(SET##ma.y, SET##mb.y); w_.y = pk2(SET##mc.y, SET##md.y); *(uint2*)(SET##mo + SET##mk) = w_; \
        w_.x = pk2(SET##ma.z, SET##mb.z); w_.y = pk2(SET##mc.z, SET##md.z); *(uint2*)(SET##mo + 2 * SET##mk) = w_; \
        w_.x = pk2(SET##ma.w, SET##mb.w); w_.y = pk2(SET##mc.w, SET##md.w); *(uint2*)(SET##mo + 3 * SET##mk) = w_; } } while (0)
#define HG_STEP(SET, CH) do { const int ch_ = (CH); \
        bf16_t* QSL = (bf16_t*)(lds_raw + S_QS) + (ch_ & 1) * 64 * PQ; bf16_t* STT = (bf16_t*)(lds_raw + S_STT) + (ch_ & 1) * 32 * PQ; \
        *(uint4*)(QSL + qrow * PQ + qc16) = SET##q0; *(uint4*)(QSL + qrow * PQ + qc16 + 8) = SET##q1; \
        _Pragma("unroll") for (int r = 0; r < 4; ++r) { STT[(16 * vvt + 4 * g4 + r) * PQ + 16 * dt0 + l15] = f2bf(st0[r]); STT[(16 * vvt + 4 * g4 + r) * PQ + 16 * dt1 + l15] = f2bf(st1[r]); } \
        __syncthreads(); \
        f32x4 o = {__uint_as_float(SET##oi.x << 16), __uint_as_float(SET##oi.x & 0xffff0000u), __uint_as_float(SET##oi.y << 16), __uint_as_float(SET##oi.y & 0xffff0000u)}; \
        { const bf16_t* Ar = QSL + (16 * tt + l15) * PQ; const bf16_t* Br = STT + (16 * vvt + l15) * PQ; \
          _Pragma("unroll") for (int ks = 0; ks < 4; ++ks) o = __builtin_amdgcn_mfma_f32_16x16x32_bf16(*(const bf16x8*)(Ar + 32 * ks + 8 * g4), *(const bf16x8*)(Br + 32 * ks + 8 * g4), o, 0, 0, 0); \
          __builtin_amdgcn_sched_group_barrier(0x100, 8, 0); __builtin_amdgcn_sched_group_barrier(0x008, 4, 0); } \
        bf16_t* op = P + (rowbase + ch_ * 64 + 16 * tt + 4 * g4) * EVPP + 1024 + h * 128 + 32 * vs + 16 * vvt + l15; \
        _Pragma("unroll") for (int r = 0; r < 4; ++r) op[(size_t)r * EVPP] = f2bf(o[r]); \
        st0[0] = st0[0] * SET##g0 + __uint_as_float(SET##u0.x << 16); st0[1] = st0[1] * SET##g0 + __uint_as_float(SET##u0.x & 0xffff0000u); \
        st0[2] = st0[2] * SET##g0 + __uint_as_float(SET##u0.y << 16); st0[3] = st0[3] * SET##g0 + __uint_as_float(SET##u0.y & 0xffff0000u); \
        st1[0] = st1[0] * SET##g1 + __uint_as_float(SET##u1.x << 16); st1[1] = st1[1] * SET##g1 + __uint_as_float(SET##u1.x & 0xffff0000u); \
        st1[2] = st1[2] * SET##g1 + __uint_as_float(SET##u1.y << 16); st1[3] = st1[3] * SET##g1 + __uint_as_float(SET##u1.y & 0xffff0000u); \
        HG_MOE_FINISH(SET); \
        if (ch_ + 2 < 64) { HG_LOAD(SET, ch_ + 2); HG_MOE_ISSUE(SET, ch_ + 2); } else SET##mok = false; } while (0)
    uint4 Aq0, Aq1, Bq0, Bq1; uint2 Au0, Au1, Aoi, Bu0, Bu1, Boi; float Ag0, Ag1, Bg0, Bg1;
    float4 Ama, Amb, Amc, Amd, Bma, Bmb, Bmc, Bmd; bf16_t* Amo; bf16_t* Bmo; size_t Amk, Bmk; bool Amok, Bmok;
    HG_LOAD(A, 0); HG_LOAD(B, 1); HG_MOE_ISSUE(A, 0); HG_MOE_ISSUE(B, 1);
    __syncthreads();
    for (int ch = 0; ch < 64; ch += 2) { HG_STEP(A, ch); HG_STEP(B, ch + 1); }
#undef HG_LOAD
#undef HG_MOE_ISSUE
#undef HG_MOE_FINISH
#undef HG_STEP
    __syncthreads();
}

__device__ __forceinline__ void dot4(const bf16_t* kr, const float* qs, float& s0, float& s1, float& s2, float& s3) {
    s0 = s1 = s2 = s3 = 0.f;
#pragma unroll
    for (int ch = 0; ch < 8; ++ch) {
        const uint4 w = ((const uint4*)kr)[ch]; float kf[8]; unpack8(w, kf);
#pragma unroll
        for (int q4 = 0; q4 < 2; ++q4) {
            const int d = ch * 8 + q4 * 4;
            const float4 a = *(const float4*)(qs + d), b = *(const float4*)(qs + 64 + d), cc = *(const float4*)(qs + 128 + d), e = *(const float4*)(qs + 192 + d);
            const float k0 = kf[q4 * 4], k1 = kf[q4 * 4 + 1], k2 = kf[q4 * 4 + 2], k3 = kf[q4 * 4 + 3];
            s0 += a.x * k0 + a.y * k1 + a.z * k2 + a.w * k3; s1 += b.x * k0 + b.y * k1 + b.z * k2 + b.w * k3;
            s2 += cc.x * k0 + cc.y * k1 + cc.z * k2 + cc.w * k3; s3 += e.x * k0 + e.y * k1 + e.z * k2 + e.w * k3;
        }
    }
}

constexpr int ATT_WSTRIDE = 256 + 2048 + 16;
template <bool SINK>
__device__ __forceinline__ void attn_rounds(const bf16_t* Kb, const bf16_t* Vb, int ld, const int* bases, int nr, int lo, int hi, const float* qs, float* ps,
                                            const float (&sink)[4], float (&o)[4], float (&inv)[4], int lane) {
#pragma unroll 1
    for (int r = 0; r < nr; ++r) {
        const int kp = bases[r] + lane; const bool val = kp >= lo && kp <= hi;
        const int kr = val ? kp : lo;
        float s0, s1, s2, s3; dot4(Kb + (size_t)kr * ld, qs, s0, s1, s2, s3);
        ps[64 * r + lane] = val ? s0 * 0.125f : -INFINITY; ps[512 + 64 * r + lane] = val ? s1 * 0.125f : -INFINITY;
        ps[1024 + 64 * r + lane] = val ? s2 * 0.125f : -INFINITY; ps[1536 + 64 * r + lane] = val ? s3 * 0.125f : -INFINITY;
    }
    LDS_FENCE();
#pragma unroll
    for (int hh = 0; hh < 4; ++hh) {
        float mx = SINK ? sink[hh] : -INFINITY;
#pragma unroll 1
        for (int r = 0; r < nr; ++r) mx = fmaxf(mx, ps[hh * 512 + 64 * r + lane]);
        mx = wmax(mx); if (mx == -INFINITY) mx = 0.f;
        float l = 0.f;
#pragma unroll 1
        for (int r = 0; r < nr; ++r) { const float sv = ps[hh * 512 + 64 * r + lane]; const float p = (sv == -INFINITY) ? 0.f : __expf(sv - mx); ps[hh * 512 + 64 * r + lane] = p; l += p; }
        l = wsum(l); if (SINK) l += __expf(sink[hh] - mx);
        inv[hh] = 1.f / fmaxf(l, 1e-30f);
    }
    LDS_FENCE();
    o[0] = o[1] = o[2] = o[3] = 0.f;
#pragma unroll 1
    for (int r = 0; r < nr; ++r) {
        const int bs = bases[r];
        if (bs < -50000000) continue;
#pragma unroll 4
        for (int kk = 0; kk < 64; ++kk) {
            const int kp = bs + kk; if (kp < lo || kp > hi) continue;
            const float vv = bf2f(Vb[(size_t)kp * ld + lane]);
            o[0] += ps[64 * r + kk] * vv; o[1] += ps[512 + 64 * r + kk] * vv; o[2] += ps[1024 + 64 * r + kk] * vv; o[3] += ps[1536 + 64 * r + kk] * vv;
        }
    }
    o[0] *= inv[0]; o[1] *= inv[1]; o[2] *= inv[2]; o[3] *= inv[3];
}

__device__ __forceinline__ void nsa_naive(const Ctx& c, float* lds) {
    const bf16_t* P = (const bf16_t*)(c.ws + WS_PROJ); bf16_t* MIX = (bf16_t*)(c.ws + WS_H);
    const bf16_t* KCB = (const bf16_t*)(c.ws + WS_KCB); const bf16_t* VCB = (const bf16_t*)(c.ws + WS_VCB);
    float* qs = lds + c.wave * ATT_WSTRIDE; float* ps = qs + 256; int* bl = (int*)(ps + 2048);
    const int lane = c.lane;
    const float nosink[4] = {0.f, 0.f, 0.f, 0.f};
    for (int task = c.gw; task < M * 2; task += c.ngw) {
        const int g = task & 1, m = task >> 1, b = m >> 12, t = m & (SEQ - 1);
        const bf16_t* prow = P + (size_t)m * EVPP;
#pragma unroll
        for (int hh = 0; hh < 4; ++hh) qs[hh * 64 + lane] = bf2f(prow[2048 + (4 * g + hh) * 64 + lane]);
        if (lane < 4) bl[lane] = 64 * lane;
        LDS_FENCE();
        float oc[4], inv[4];
        const int nmax = (t >= 31) ? (t - 31) / 16 : -1;
        attn_rounds<false>(KCB + (size_t)((b * 2 + g) * 256) * 64, VCB + (size_t)((b * 2 + g) * 256) * 64, 64, bl, 4, 0, nmax, qs, ps, nosink, oc, inv, lane);
        float imp = 0.f;
#pragma unroll
        for (int hh = 0; hh < 4; ++hh) {
            float a = 0.f;
#pragma unroll
            for (int dn = -1; dn <= 3; ++dn) { const int n = 4 * lane + dn; if (n >= 0 && n <= nmax) a += ps[hh * 512 + n]; }
            imp += a * inv[hh];
        }
        LDS_FENCE();
        const int i = t >> 6;
        const bool allowed = lane <= i, forced = (lane == 0) || (lane == i) || (lane == i - 1);
        float score = allowed ? imp + (forced ? 1e4f : 0.f) : -INFINITY;
#pragma unroll
        for (int r = 0; r < 8; ++r) {
            const float mx = wmax(score);
            const unsigned long long bal = __ballot(score == mx && mx > -INFINITY);
            const int idx = bal ? (__ffsll((long long)bal) - 1) : 0;
            if (lane == 0) bl[r] = bal ? 64 * idx : -100000000;
            if (bal && lane == idx) score = -INFINITY;
        }
        LDS_FENCE();
        float osel[4];
        attn_rounds<false>(P + (size_t)b * SEQ * EVPP + 2816 + g * 64, P + (size_t)b * SEQ * EVPP + 2944 + g * 64, EVPP, bl, 8, 0, t, qs, ps, nosink, osel, inv, lane);
        float ow[4];
        if (lane < 8) bl[lane] = t - 511 + 64 * lane;
        LDS_FENCE();
        attn_rounds<false>(P + (size_t)b * SEQ * EVPP + 3072 + g * 64, P + (size_t)b * SEQ * EVPP + 3200 + g * 64, EVPP, bl, 8, 0, t, qs, ps, nosink, ow, inv, lane);
#pragma unroll
        for (int hh = 0; hh < 4; ++hh) {
            const int head = 4 * g + hh;
            const float g0 = 1.f / (1.f + __expf(-bf2f(prow[3328 + head * 3 + 0]))), g1 = 1.f / (1.f + __expf(-bf2f(prow[3328 + head * 3 + 1]))), g2 = 1.f / (1.f + __expf(-bf2f(prow[3328 + head * 3 + 2])));
            MIX[(size_t)m * D + 512 + head * 64 + lane] = f2bf(g0 * oc[hh] + g1 * osel[hh] + g2 * ow[hh]);
        }
        LDS_FENCE();
    }
}

namespace fa {
typedef short bf16x8 __attribute__((ext_vector_type(8)));
typedef short s16x4 __attribute__((ext_vector_type(4)));
typedef float f32x16 __attribute__((ext_vector_type(16)));
#define FA_LAS __attribute__((address_space(3)))
constexpr int RPK = 144, RPV = 192;
constexpr int KTB = 64 * RPK, VTB = 64 * RPV;
constexpr int O_KT = 0, O_VT = 2 * KTB, O_IMP = O_VT + 2 * VTB, O_SELM = O_IMP + 64 * 64 * 4, O_JL = O_SELM + 512, O_UM = O_JL + 64 * 4, O_STG = 0  , STG_P = 144, STG_W = 32 * STG_P,
              O_RES = O_UM + 32, RES_P = 68, RES_W = 32 * RES_P * 4, O_END = O_RES + 8 * RES_W;
static_assert(O_END <= LDS_BARST && (O_STG % 16) == 0 && (O_RES % 16) == 0 && 8 * STG_W <= 2 * KTB + 2 * VTB, "attention LDS");
constexpr float SC2 = 0.125f * 1.4426950408889634f;
constexpr float THR = 8.f;
__device__ __forceinline__ int crow(int r, int hi) { return (r & 3) + 8 * (r >> 2) + 4 * hi; }
struct RangeMask { int lo, hi; __device__ __forceinline__ bool operator()(int kl) const { return kl >= lo && kl <= hi; } };
__device__ __forceinline__ s16x4 vtr(const unsigned char* p) {
    typedef short v4i16_t __attribute__((ext_vector_type(4)));
    return __builtin_bit_cast(s16x4, __builtin_amdgcn_ds_read_tr16_b64_v4i16((FA_LAS v4i16_t*)(p))); }
struct State { f32x16 o[2]; float m, l; };
__device__ __forceinline__ void init(State& st, float m0, float l0) {
#pragma unroll
    for (int t = 0; t < 2; ++t)
#pragma unroll
        for (int r = 0; r < 16; ++r) st.o[t][r] = 0.f;
    st.m = m0; st.l = l0; }
__device__ __forceinline__ bf16x8 scale_q(const bf16x8 q) {
    const uint4 w = __builtin_bit_cast(uint4, q); float f[8]; unpack8(w, f); uint4 o;
    o.x = pk2(f[0] * SC2, f[1] * SC2); o.y = pk2(f[2] * SC2, f[3] * SC2); o.z = pk2(f[4] * SC2, f[5] * SC2); o.w = pk2(f[6] * SC2, f[7] * SC2);
    return __builtin_bit_cast(bf16x8, o); }
__device__ __forceinline__ void qnorm_rope(bf16x8 (&qf)[4], const float* gain, const float2* rt  , int hi) {
    float f[4][8]; float ss = 0.f;
#pragma unroll
    for (int sp = 0; sp < 4; ++sp) { unpack8(__builtin_bit_cast(uint4, qf[sp]), f[sp]);
#pragma unroll
        for (int j = 0; j < 8; ++j) ss += f[sp][j] * f[sp][j]; }
    ss += __shfl_xor(ss, 32);
    const float rstd = rsqrtf(ss * (1.f / 64.f) + EPS);
#pragma unroll
    for (int sp = 0; sp < 4; ++sp) { const float4 g0 = *(const float4*)(gain + 16 * sp + 8 * hi), g1 = *(const float4*)(gain + 16 * sp + 8 * hi + 4);
        f[sp][0] *= rstd * g0.x; f[sp][1] *= rstd * g0.y; f[sp][2] *= rstd * g0.z; f[sp][3] *= rstd * g0.w; f[sp][4] *= rstd * g1.x; f[sp][5] *= rstd * g1.y; f[sp][6] *= rstd * g1.z; f[sp][7] *= rstd * g1.w; }
#pragma unroll
    for (int j = 0; j < 8; ++j) { const float other = __shfl_xor(f[0][j], 32); const float2 cs = rt[j];
        f[0][j] = hi ? (f[0][j] * cs.x + other * cs.y) : (f[0][j] * cs.x - other * cs.y); }
#pragma unroll
    for (int sp = 0; sp < 4; ++sp) { uint4 o; o.x = pk2(f[sp][0] * SC2, f[sp][1] * SC2); o.y = pk2(f[sp][2] * SC2, f[sp][3] * SC2); o.z = pk2(f[sp][4] * SC2, f[sp][5] * SC2); o.w = pk2(f[sp][6] * SC2, f[sp][7] * SC2);
        qf[sp] = __builtin_bit_cast(bf16x8, o); }
}
__device__ __forceinline__ uint4 knorm_rope(const uint4 kv, const float* gain, const float2* rt  , int chunk) {
    float f[8]; unpack8(kv, f); float ss = 0.f;
#pragma unroll
    for (int j = 0; j < 8; ++j) ss += f[j] * f[j];
    ss += __shfl_xor(ss, 1); ss += __shfl_xor(ss, 2); ss += __shfl_xor(ss, 4);
    const float rstd = rsqrtf(ss * (1.f / 64.f) + EPS);
    const float4 g0 = *(const float4*)(gain + 8 * chunk), g1 = *(const float4*)(gain + 8 * chunk + 4);
    f[0] *= rstd * g0.x; f[1] *= rstd * g0.y; f[2] *= rstd * g0.z; f[3] *= rstd * g0.w; f[4] *= rstd * g1.x; f[5] *= rstd * g1.y; f[6] *= rstd * g1.z; f[7] *= rstd * g1.w;
#pragma unroll
    for (int j = 0; j < 8; ++j) { const float other = __shfl_xor(f[j], 1);
        if (chunk < 2) { const float2 cs = rt[j]; f[j] = chunk ? (f[j] * cs.x + other * cs.y) : (f[j] * cs.x - other * cs.y); } }
    uint4 o; o.x = pk2(f[0], f[1]); o.y = pk2(f[2], f[3]); o.z = pk2(f[4], f[5]); o.w = pk2(f[6], f[7]); return o;
}
template <int ABL = 0, bool FAST = false, bool ROWM = true>
__device__ __forceinline__ void tile(State& st, const unsigned char* lds, int koff, int voff, const bf16x8 (&qf)[4], float cbias, bool emask, const RangeMask mk, int lane) {
    const int r32 = lane & 31, hi = lane >> 5;
    const float negm = FAST ? (ROWM ? cbias : 0.f) : cbias - st.m;
    f32x16 p0, p1;
#pragma unroll
    for (int r = 0; r < 16; ++r) { p0[r] = negm; p1[r] = negm; }
    const unsigned char* kb = lds + koff + r32 * RPK + hi * 16;
#pragma unroll
    for (int sp = 0; sp < 4; ++sp) {
        const bf16x8 a0 = *(const bf16x8*)(kb + 32 * sp), a1 = *(const bf16x8*)(kb + 32 * RPK + 32 * sp);
        p0 = __builtin_amdgcn_mfma_f32_32x32x16_bf16(a0, qf[sp], p0, 0, 0, 0);
        p1 = __builtin_amdgcn_mfma_f32_32x32x16_bf16(a1, qf[sp], p1, 0, 0, 0);
    }
    __builtin_amdgcn_sched_group_barrier(0x100, 8, 0);
    __builtin_amdgcn_sched_group_barrier(0x008, 8, 0);
    if (emask) {
#pragma unroll
        for (int r = 0; r < 16; ++r) { const int kl = crow(r, hi); if (!mk(kl)) p0[r] = -INFINITY; if (!mk(kl + 32)) p1[r] = -INFINITY; }
    }
    if (ABL == 1) {
#pragma unroll
        for (int r = 0; r < 16; ++r) { p0[r] *= 0.001f; p1[r] *= 0.001f; }
        st.l += p0[0];
    } else if (FAST) {
        float sa = 0.f, sb = 0.f, sc = 0.f, sd = 0.f;
#pragma unroll
        for (int r = 0; r < 16; r += 4) {
            p0[r] = __builtin_amdgcn_exp2f(p0[r]); p1[r] = __builtin_amdgcn_exp2f(p1[r]); p0[r + 1] = __builtin_amdgcn_exp2f(p0[r + 1]); p1[r + 1] = __builtin_amdgcn_exp2f(p1[r + 1]);
            p0[r + 2] = __builtin_amdgcn_exp2f(p0[r + 2]); p1[r + 2] = __builtin_amdgcn_exp2f(p1[r + 2]); p0[r + 3] = __builtin_amdgcn_exp2f(p0[r + 3]); p1[r + 3] = __builtin_amdgcn_exp2f(p1[r + 3]);
            sa += p0[r] + p1[r]; sb += p0[r + 1] + p1[r + 1]; sc += p0[r + 2] + p1[r + 2]; sd += p0[r + 3] + p1[r + 3];
        }
        st.l += (sa + sb) + (sc + sd);
    } else {
        float mxa = fmaxf(p0[0], p1[0]), mxb = fmaxf(p0[1], p1[1]), mxc = fmaxf(p0[2], p1[2]), mxd = fmaxf(p0[3], p1[3]);
#pragma unroll
        for (int r = 4; r < 16; r += 4) { mxa = fmaxf(mxa, fmaxf(p0[r], p1[r])); mxb = fmaxf(mxb, fmaxf(p0[r + 1], p1[r + 1])); mxc = fmaxf(mxc, fmaxf(p0[r + 2], p1[r + 2])); mxd = fmaxf(mxd, fmaxf(p0[r + 3], p1[r + 3])); }
        float mx = fmaxf(fmaxf(mxa, mxb), fmaxf(mxc, mxd));
        mx = fmaxf(mx, __shfl_xor(mx, 32));
        if (!__all(mx <= THR)) {
            const float delta = fmaxf(mx, 0.f), alpha = __builtin_amdgcn_exp2f(-delta);
            st.m += delta; st.l *= alpha;
#pragma unroll
            for (int r = 0; r < 16; ++r) { p0[r] -= delta; p1[r] -= delta; st.o[0][r] *= alpha; st.o[1][r] *= alpha; }
        }
        float sa = 0.f, sb = 0.f, sc = 0.f, sd = 0.f;
#pragma unroll
        for (int r = 0; r < 16; r += 4) {
            p0[r] = __builtin_amdgcn_exp2f(p0[r]); p1[r] = __builtin_amdgcn_exp2f(p1[r]); p0[r + 1] = __builtin_amdgcn_exp2f(p0[r + 1]); p1[r + 1] = __builtin_amdgcn_exp2f(p1[r + 1]);
            p0[r + 2] = __builtin_amdgcn_exp2f(p0[r + 2]); p1[r + 2] = __builtin_amdgcn_exp2f(p1[r + 2]); p0[r + 3] = __builtin_amdgcn_exp2f(p0[r + 3]); p1[r + 3] = __builtin_amdgcn_exp2f(p1[r + 3]);
            sa += p0[r] + p1[r]; sb += p0[r + 1] + p1[r + 1]; sc += p0[r + 2] + p1[r + 2]; sd += p0[r + 3] + p1[r + 3];
        }
        st.l += (sa + sb) + (sc + sd);
    }
    if (ABL == 2) { st.o[0][0] += p0[0] + p0[5] + p1[3] + p1[9]; return; }
    const int vbase = voff + (4 * hi + ((lane & 15) >> 2)) * RPV + ((lane >> 4) & 1) * 32 + (lane & 3) * 8;
#pragma unroll
    for (int sub = 0; sub < 2; ++sub)
#pragma unroll
        for (int ks = 0; ks < 2; ++ks) {
            uint4 pw;
            if (sub == 0) { pw.x = pk2(p0[8 * ks], p0[8 * ks + 1]); pw.y = pk2(p0[8 * ks + 2], p0[8 * ks + 3]); pw.z = pk2(p0[8 * ks + 4], p0[8 * ks + 5]); pw.w = pk2(p0[8 * ks + 6], p0[8 * ks + 7]); }
            else { pw.x = pk2(p1[8 * ks], p1[8 * ks + 1]); pw.y = pk2(p1[8 * ks + 2], p1[8 * ks + 3]); pw.z = pk2(p1[8 * ks + 4], p1[8 * ks + 5]); pw.w = pk2(p1[8 * ks + 6], p1[8 * ks + 7]); }
            const bf16x8 pf = __builtin_bit_cast(bf16x8, pw);
#pragma unroll
            for (int dt = 0; dt < 2; ++dt) {
                const unsigned char* vp = lds + vbase + (32 * sub + 16 * ks) * RPV + dt * 64;
                const s16x4 lo = vtr(vp), hi4 = vtr(vp + 8 * RPV);
                const bf16x8 vf = {lo[0], lo[1], lo[2], lo[3], hi4[0], hi4[1], hi4[2], hi4[3]};
                st.o[dt] = __builtin_amdgcn_mfma_f32_32x32x16_bf16(vf, pf, st.o[dt], 0, 0, 0);
            }
        }
}
__device__ __forceinline__ uint4 ldg_tile(const bf16_t* base, long row, int ld, int tid) { return *(const uint4*)(base + row * ld + (tid & 7) * 8); }
__device__ __forceinline__ void sts_k(unsigned char* lds, int buf, const uint4& v, int tid) { *(uint4*)(lds + O_KT + buf * KTB + (tid >> 3) * RPK + (tid & 7) * 16) = v; }
__device__ __forceinline__ void sts_v(unsigned char* lds, int buf, const uint4& v, int tid) { *(uint4*)(lds + O_VT + buf * VTB + (tid >> 3) * RPV + (tid & 7) * 16) = v; }
template <class Br>
__device__ __forceinline__ void run_tiles(State& st, unsigned char* lds, const bf16x8 (&qf)[4], const Br& br, int tid, int lane) {
    const int n = br.n;
    if (n <= 0) return;
    uint4 kreg, vreg;
    br.load(0, kreg, vreg, tid);
    __syncthreads();
    sts_k(lds, 0, kreg, tid); sts_v(lds, 0, vreg, tid);
    if (n > 1) br.load(1, kreg, vreg, tid);
    __syncthreads();
    for (int idx = 0; idx < n; ++idx) {
        const int cur = idx & 1;
        if (idx + 1 < n) { sts_k(lds, cur ^ 1, kreg, tid); sts_v(lds, cur ^ 1, vreg, tid); if (idx + 2 < n) br.load(idx + 2, kreg, vreg, tid); }
        if (br.active(idx)) tile(st, lds, O_KT + cur * KTB, O_VT + cur * VTB, qf, br.cbias(idx), br.emask(idx), br.mask(idx), lane);
        __syncthreads();
    }
}
struct CmpBranch { const bf16_t* K; const bf16_t* V; int pass, nmaxq, n;
    __device__ __forceinline__ void load(int idx, uint4& k, uint4& v, int tid) const {
        const int key = tid >> 3; k = ldg_tile(K, 64 * idx + key, 64, tid);
        if (pass == 0) v = ldg_tile(V, 64 * idx + key, 64, tid);
        else { const int nn = 64 * idx + key, j0 = (tid & 7) * 8; u32 wv[4];
#pragma unroll
            for (int q = 0; q < 4; ++q) { const int ja = j0 + 2 * q, jb = ja + 1;
                wv[q] = ((nn >= 4 * ja - 1 && nn <= 4 * ja + 3) ? 0x3f80u : 0u) | ((nn >= 4 * jb - 1 && nn <= 4 * jb + 3) ? 0x3f800000u : 0u); }
            v.x = wv[0]; v.y = wv[1]; v.z = wv[2]; v.w = wv[3]; } }
    __device__ __forceinline__ float cbias(int) const { return 0.f; }
    __device__ __forceinline__ bool active(int) const { return true; }
    __device__ __forceinline__ bool emask(int) const { return true; }
    __device__ __forceinline__ RangeMask mask(int idx) const { return RangeMask{0, nmaxq - 64 * idx}; } };
struct SelBranch { const bf16_t* K; const bf16_t* V; const int* JL; unsigned long long mysel; int i, tl, n;
    __device__ __forceinline__ void load(int idx, uint4& k, uint4& v, int tid) const { const long row = 64 * JL[idx] + (tid >> 3); k = ldg_tile(K, row, EVPP, tid); v = ldg_tile(V, row, EVPP, tid); }
    __device__ __forceinline__ float cbias(int idx) const { return ((mysel >> JL[idx]) & 1ull) ? 0.f : -INFINITY; }
    __device__ __forceinline__ bool active(int idx) const { return __any((int)((mysel >> JL[idx]) & 1ull)) != 0; }
    __device__ __forceinline__ bool emask(int idx) const { return JL[idx] == i; }
    __device__ __forceinline__ RangeMask mask(int) const { return RangeMask{0, tl}; } };
template <int NB, int LD> struct WinBranch { const bf16_t* K; const bf16_t* V; int k0, i, tl, n;
    __device__ __forceinline__ void load(int idx, uint4& k, uint4& v, int tid) const { const long row = 64 * (k0 + idx) + (tid >> 3); k = ldg_tile(K, row, LD, tid); v = ldg_tile(V, row, LD, tid); }
    __device__ __forceinline__ float cbias(int) const { return 0.f; }
    __device__ __forceinline__ bool active(int) const { return true; }
    __device__ __forceinline__ bool emask(int idx) const { return (k0 + idx == i) || (k0 + idx == i - NB); }
    __device__ __forceinline__ RangeMask mask(int idx) const { RangeMask mk{0, 63}; if (k0 + idx == i) mk.hi = tl; if (k0 + idx == i - NB) mk.lo = tl + 1; return mk; } };
}

template <int ABL = 0, bool DRY = false, bool FAST = false>
__device__ __forceinline__ void nsa_unit(const Ctx& c, unsigned char* lds, int b, int i, int g) {
    using namespace fa;
    const bf16_t* P = (const bf16_t*)(c.ws + WS_PROJ);
    const bf16_t* KCB = (const bf16_t*)(c.ws + WS_KCB) + (size_t)((b * 2 + g) * 256) * 64; const bf16_t* VCB = (const bf16_t*)(c.ws + WS_VCB) + (size_t)((b * 2 + g) * 256) * 64;
    const int tid = c.tid, lane = c.lane, w = c.wave, r32 = lane & 31, hi = lane >> 5;
    const int tl = 8 * w + (r32 >> 2), hh = r32 & 3, t = 64 * i + tl, head = 4 * g + hh;
    const int key = tid >> 3;
    const size_t m = (size_t)b * SEQ + t;
    const bf16_t* prow = P + m * EVPP;
    const int nt = ((4 * i + 2) >> 6) + 1, nA = 2 * nt;
    uint4 kreg = ldg_tile(KCB, key, 64, tid), vreg = ldg_tile(VCB, key, 64, tid);
    bf16x8 qf[4];
#pragma unroll
    for (int sp = 0; sp < 4; ++sp) qf[sp] = *(const bf16x8*)(prow + 2048 + head * 64 + 16 * sp + 8 * hi);
    qnorm_rope(qf, c.nsa_qg, (const float2*)(c.ws + WS_ROPE) + (size_t)t * 8, hi);
    float* IMP = (float*)(lds + O_IMP); unsigned long long* SELM = (unsigned long long*)(lds + O_SELM); u32* UM = (u32*)(lds + O_UM); int* JL = (int*)(lds + O_JL);
    float* RES = (float*)(lds + O_RES + w * RES_W) + r32 * RES_P;
#define NSA_GATE(k) (1.f / (1.f + __expf(-bf2f(P[((size_t)b * SEQ + t) * EVPP + 3328 + head * 3 + (k)]))))
    const int nmaxq = (t >= 31) ? ((t - 31) >> 4) : -1;
    State st; init(st, 0.f, 0.f);
    float inv = 0.f;
#define NSA_LOAD_A(IDX) do { const int idx_ = (IDX); const int kt_ = idx_ >= nt ? idx_ - nt : idx_; kreg = ldg_tile(KCB, 64 * kt_ + key, 64, tid); \
        if (idx_ < nt) vreg = ldg_tile(VCB, 64 * kt_ + key, 64, tid); \
        else { const int nn = 64 * kt_ + key, j0 = (tid & 7) * 8; u32 wv[4];     \
            _Pragma("unroll") for (int q = 0; q < 4; ++q) { const int ja = j0 + 2 * q, jb = ja + 1; \
                wv[q] = ((nn >= 4 * ja - 1 && nn <= 4 * ja + 3) ? 0x3f80u : 0u) | ((nn >= 4 * jb - 1 && nn <= 4 * jb + 3) ? 0x3f800000u : 0u); } \
            vreg.x = wv[0]; vreg.y = wv[1]; vreg.z = wv[2]; vreg.w = wv[3]; } } while (0)
    __syncthreads();
    sts_k(lds, 0, kreg, tid); sts_v(lds, 0, vreg, tid);
    NSA_LOAD_A(1);
    __syncthreads();
    for (int idx = 0; idx < nA; ++idx) {
        if (idx == nt) {
            const float lt = st.l + __shfl_xor(st.l, 32);
            inv = lt > 0.f ? 1.f / lt : 0.f;
            const float gci = NSA_GATE(0) * inv;
#pragma unroll
            for (int dt = 0; dt < 2; ++dt)
#pragma unroll
                for (int r = 0; r < 16; ++r) RES[32 * dt + crow(r, hi)] = gci * st.o[dt][r];
            const float mfin = st.m; init(st, mfin, 0.f);
        }
        const int kt = idx >= nt ? idx - nt : idx, cur = idx & 1;
        tile<ABL, FAST, false>(st, lds, O_KT + cur * KTB, O_VT + cur * VTB, qf, 0.f, true, RangeMask{0, nmaxq - 64 * kt}, lane);
        if (idx + 1 < nA) { sts_k(lds, cur ^ 1, kreg, tid); sts_v(lds, cur ^ 1, vreg, tid); if (idx + 2 < nA) NSA_LOAD_A(idx + 2); }
        __syncthreads();
    }
#undef NSA_LOAD_A
#pragma unroll
    for (int dt = 0; dt < 2; ++dt)
#pragma unroll
        for (int r = 0; r < 16; ++r) {
            float v = st.o[dt][r] * inv; v += __shfl_xor(v, 1); v += __shfl_xor(v, 2);
            if (hh == 0) IMP[tl * 64 + 32 * dt + crow(r, hi)] = v;
        }
    const bf16_t* PB = P + (size_t)b * SEQ * EVPP + g * 64;
#define KW (PB + 3072)
#define VW (PB + 3200)
#define KS (PB + 2816)
#define VS (PB + 2944)
    const int k0 = (i - 8 > 0) ? i - 8 : 0, nW = i - k0 + 1;
    kreg = ldg_tile(KW, 64 * k0 + key, EVPP, tid); vreg = ldg_tile(VW, 64 * k0 + key, EVPP, tid);
    if (tid < 2) UM[tid] = 0u;
    __syncthreads();
    {
        const int tk = tid >> 3, sub = tid & 7;
        float cand[8];
#pragma unroll
        for (int q = 0; q < 8; ++q) { const int j = 8 * sub + q; const bool allowed = j <= i, forced = (j == 0) || (j == i) || (j == i - 1);
            cand[q] = allowed ? IMP[tk * 64 + j] + (forced ? 1e4f : 0.f) : -INFINITY; }
        unsigned long long msk = 0ull;
#pragma unroll 1
        for (int rnd = 0; rnd < 8; ++rnd) {
            float bv = cand[0]; int bi = 0;
#pragma unroll
            for (int q = 1; q < 8; ++q) if (cand[q] > bv) { bv = cand[q]; bi = q; }
            bi += 8 * sub;
#pragma unroll
            for (int o = 1; o < 8; o <<= 1) { const float ov = __shfl_xor(bv, o); const int oi = __shfl_xor(bi, o); if (ov > bv || (ov == bv && oi < bi)) { bv = ov; bi = oi; } }
            if (bv > -INFINITY) {
                msk |= 1ull << bi;
#pragma unroll
                for (int q = 0; q < 8; ++q) if (8 * sub + q == bi) cand[q] = -INFINITY;
            }
        }
        if (sub == 0) { SELM[tk] = msk; atomicOr(&UM[0], (u32)msk); atomicOr(&UM[1], (u32)(msk >> 32)); }
    }
    __syncthreads();
    int nsel;
    {
        const unsigned long long um = (unsigned long long)UM[0] | ((unsigned long long)UM[1] << 32);
        nsel = __popcll(um);
        if (tid < 64 && ((um >> tid) & 1ull)) JL[__popcll(um & ((1ull << tid) - 1ull))] = tid;
    }
    sts_k(lds, 0, kreg, tid); sts_v(lds, 0, vreg, tid);
    __syncthreads();
    const int nB = nW + nsel;
    const unsigned long long mysel = SELM[tl];
#define NSA_LOAD_B(IDX) do { const int lidx_ = (IDX); if (lidx_ < nW) { const long row_ = 64 * (k0 + lidx_) + key; kreg = ldg_tile(KW, row_, EVPP, tid); vreg = ldg_tile(VW, row_, EVPP, tid); } \
        else { const long row_ = 64 * JL[lidx_ - nW] + key; kreg = ldg_tile(KS, row_, EVPP, tid); vreg = ldg_tile(VS, row_, EVPP, tid); } } while (0)
    NSA_LOAD_B(1);
    init(st, 0.f, 0.f);
#define NSA_STAGE_B(IDX) do { const int idx_ = (IDX); if (idx_ + 1 < nB) { sts_k(lds, (idx_ & 1) ^ 1, kreg, tid); sts_v(lds, (idx_ & 1) ^ 1, vreg, tid); if (idx_ + 2 < nB) NSA_LOAD_B(idx_ + 2); } __syncthreads(); } while (0)
    for (int idx = 0; idx < nW; ++idx) {
        const int cur = idx & 1, kt = k0 + idx; RangeMask mk{0, 63}; if (kt == i) mk.hi = tl; if (kt == i - 8) mk.lo = tl + 1;
        tile<ABL, FAST, false>(st, lds, O_KT + cur * KTB, O_VT + cur * VTB, qf, 0.f, (kt == i) || (kt == i - 8), mk, lane);
        NSA_STAGE_B(idx);
    }
    {
        const float lt = st.l + __shfl_xor(st.l, 32);
        const float sc = NSA_GATE(2) * (lt > 0.f ? 1.f / lt : 0.f);
#pragma unroll
        for (int dt = 0; dt < 2; ++dt)
#pragma unroll
            for (int r = 0; r < 16; ++r) RES[32 * dt + crow(r, hi)] += sc * st.o[dt][r];
        init(st, 0.f, 0.f);
    }
    for (int idx = nW; idx < nB; ++idx) {
        const int cur = idx & 1, j = JL[idx - nW]; const bool mine = ((mysel >> j) & 1ull) != 0ull;
        if (__any((int)mine)) tile<ABL, FAST, true>(st, lds, O_KT + cur * KTB, O_VT + cur * VTB, qf, mine ? 0.f : -INFINITY, j == i, RangeMask{0, tl}, lane);
        NSA_STAGE_B(idx);
    }
#undef NSA_STAGE_B
#undef NSA_LOAD_B
    {
        const float lt = st.l + __shfl_xor(st.l, 32);
        const float sc = NSA_GATE(1) * (lt > 0.f ? 1.f / lt : 0.f);
        unsigned char* stg = lds + O_STG + w * STG_W;
#pragma unroll
        for (int dt = 0; dt < 2; ++dt)
#pragma unroll
            for (int r = 0; r < 16; ++r) *(bf16_t*)(stg + r32 * STG_P + (32 * dt + crow(r, hi)) * 2) = f2bf(RES[32 * dt + crow(r, hi)] + sc * st.o[dt][r]);
        LDS_FENCE();
#pragma unroll
        for (int it = 0; it < 4; ++it) {
            const int row = it * 8 + (lane >> 3), ch = lane & 7;
            const uint4 v = *(const uint4*)(stg + row * STG_P + ch * 16);
            const size_t mm = (size_t)b * SEQ + 64 * i + 8 * w + (row >> 2);
            if (!DRY) *(uint4*)((bf16_t*)(c.ws + WS_H) + mm * D + 512 + (4 * g + (row & 3)) * 64 + ch * 8) = v;
            else if (v.x == 0x12345678u && v.y == 0x9abcdef0u) *(uint4*)((bf16_t*)(c.ws + WS_H) + mm * D + 512 + (4 * g + (row & 3)) * 64 + ch * 8) = v;
        }
        LDS_FENCE();
    }
#undef KW
#undef VW
#undef KS
#undef VS
#undef NSA_GATE
}
__device__ __forceinline__ float score_bound(const float* gq, const float* gk, int nk, int lane) {
    float a = fabsf(gq[lane]), b = 0.f;
    for (int x = 0; x < nk; ++x) b = fmaxf(b, fabsf(gk[64 * x + lane]));
    return fa::SC2 * 64.f * wmax(a) * wmax(b);
}
template <int ABL = 0, bool DRY = false>
__device__ __forceinline__ void nsa_mfma(const Ctx& c, unsigned char* lds) {
    const bool fast = score_bound(c.nsa_qg, c.nsa_kg, 3, c.lane) < 60.f;
    const int G = gridDim.x;
    for (int k = 0; k * G + (int)blockIdx.x < 2048; ++k) {
        const int u = k * G + blockIdx.x;
        int rank = u >> 5; const int bg = u & 31;
        if (G == 256 && (k & 1)) rank = 8 * k + 7 - ((u >> 5) - 8 * k);
        if (fast) nsa_unit<ABL, DRY, true>(c, lds, bg >> 1, 63 - rank, bg & 1); else nsa_unit<ABL, DRY, false>(c, lds, bg >> 1, 63 - rank, bg & 1);
    }
}

__device__ __forceinline__ void swa_load(const Ctx& c, int b, int i, int g, uint4 (&kr)[3], uint4 (&vr)[3], int tid) {
    using namespace fa;
    const bf16_t* P = (const bf16_t*)(c.ws + WS_PROJ);
    const int k0 = (i - 2 > 0) ? i - 2 : 0, n = i - k0 + 1;
    const bf16_t* Kb = P + (size_t)b * SEQ * ODP + 1024 + g * 64; const bf16_t* Vb = P + (size_t)b * SEQ * ODP + 1152 + g * 64;
#pragma unroll
    for (int x = 0; x < 3; ++x) if (x < n) { const long row = 64 * (k0 + x) + (tid >> 3); kr[x] = ldg_tile(Kb, row, ODP, tid); vr[x] = ldg_tile(Vb, row, ODP, tid); }
}
template <bool FAST>
__device__ __forceinline__ void swa_unit(const Ctx& c, unsigned char* lds, int b, int i, int g, uint4 (&kr)[3], uint4 (&vr)[3], bool has_next, int nb, int ni, int ng) {
    using namespace fa;
    constexpr int SW_K = 0, SW_V = 3 * KTB, SW_STG = 3 * KTB + 3 * VTB;
    static_assert(SW_STG + 8 * STG_W <= LDS_BARST, "swa LDS");
    const bf16_t* P = (const bf16_t*)(c.ws + WS_PROJ); bf16_t* ATT = (bf16_t*)(c.ws + WS_H);
    const int tid = c.tid, lane = c.lane, w = c.wave, r32 = lane & 31, hi = lane >> 5;
    const int tl = 8 * w + (r32 >> 2), hh = r32 & 3, t = 64 * i + tl;
    const size_t m = (size_t)b * SEQ + t;
    const int k0 = (i - 2 > 0) ? i - 2 : 0, n = i - k0 + 1;
#pragma unroll
    for (int x = 0; x < 3; ++x) if (x < n) kr[x] = knorm_rope(kr[x], c.swa_kg, (const float2*)(c.ws + WS_ROPE) + (size_t)(64 * (k0 + x) + (tid >> 3)) * 8, tid & 7);
    __syncthreads();
#pragma unroll
    for (int x = 0; x < 3; ++x) if (x < n) { *(uint4*)(lds + SW_K + x * KTB + (tid >> 3) * RPK + (tid & 7) * 16) = kr[x]; *(uint4*)(lds + SW_V + x * VTB + (tid >> 3) * RPV + (tid & 7) * 16) = vr[x]; }
    __syncthreads();
    if (has_next) swa_load(c, nb, ni, ng, kr, vr, tid);
#pragma unroll 1
    for (int hq = 0; hq < 2; ++hq) {
        const int head = 8 * g + 4 * hq + hh;
        bf16x8 qf[4];
#pragma unroll
        for (int sp = 0; sp < 4; ++sp) qf[sp] = *(const bf16x8*)(P + m * ODP + head * 64 + 16 * sp + 8 * hi);
        qnorm_rope(qf, c.swa_qg, (const float2*)(c.ws + WS_ROPE) + (size_t)t * 8, hi);
        State st; const float sink2 = c.swa_sinks[head] * 1.4426950408889634f;
        if (FAST) init(st, 0.f, hi == 0 ? __builtin_amdgcn_exp2f(sink2) : 0.f); else init(st, sink2, hi == 0 ? 1.f : 0.f);
#pragma unroll 1
        for (int x = 0; x < n; ++x) {
            const int kt = k0 + x;
            RangeMask mk{0, 63}; if (kt == i) mk.hi = tl; if (kt == i - 2) mk.lo = tl + 1;
            tile<0, FAST, false>(st, lds, SW_K + x * KTB, SW_V + x * VTB, qf, 0.f, (kt == i) || (kt == i - 2), mk, lane);
        }
        unsigned char* stg = lds + SW_STG + w * STG_W;
        const float lt = st.l + __shfl_xor(st.l, 32);
        const float sc = 1.f / lt;
#pragma unroll
        for (int dt = 0; dt < 2; ++dt)
#pragma unroll
            for (int r = 0; r < 16; ++r) *(bf16_t*)(stg + r32 * STG_P + (32 * dt + crow(r, hi)) * 2) = f2bf(sc * st.o[dt][r]);
        LDS_FENCE();
#pragma unroll
        for (int it = 0; it < 4; ++it) {
            const int row = it * 8 + (lane >> 3), ch = lane & 7;
            const uint4 v = *(const uint4*)(stg + row * STG_P + ch * 16);
            const size_t mm = (size_t)b * SEQ + 64 * i + 8 * w + (row >> 2);
            *(uint4*)(ATT + mm * D + (8 * g + 4 * hq + (row & 3)) * 64 + ch * 8) = v;
        }
        LDS_FENCE();
    }
}
__device__ __forceinline__ void swa_mfma(const Ctx& c, unsigned char* lds) {
    const bool fast = score_bound(c.swa_qg, c.swa_kg, 1, c.lane) < 60.f && wmax(fabsf(c.swa_sinks[c.lane & 15])) < 40.f;
    uint4 kr[3], vr[3];
    if ((int)blockIdx.x < 2048) swa_load(c, blockIdx.x >> 7, (blockIdx.x >> 1) & 63, blockIdx.x & 1, kr, vr, c.tid);
    for (int u = blockIdx.x; u < 2048; u += gridDim.x) {
        const int g = u & 1, i = (u >> 1) & 63, b = u >> 7, un = u + gridDim.x;
        if (fast) swa_unit<true>(c, lds, b, i, g, kr, vr, un < 2048, un >> 7, (un >> 1) & 63, un & 1); else swa_unit<false>(c, lds, b, i, g, kr, vr, un < 2048, un >> 7, (un >> 1) & 63, un & 1);
    }
}

__device__ __forceinline__ void aout_fixup(const Ctx& c) {
    const bf16_t* P = (const bf16_t*)(c.ws + WS_PROJ); bf16_t* MIX = (bf16_t*)(c.ws + WS_H);
    const int lane = c.lane;
    float gn[8];
#pragma unroll
    for (int j = 0; j < 8; ++j) gn[j] = c.hg_gain[8 * (lane & 15) + j];
    for (int m0 = 4 * c.gw; m0 < M; m0 += 4 * c.ngw) {
        uint4 ow[4], gwv[4];
#pragma unroll
        for (int u = 0; u < 4; ++u) { ow[u] = *(const uint4*)(P + (size_t)(m0 + u) * EVPP + 1024 + 8 * lane); gwv[u] = *(const uint4*)(P + (size_t)(m0 + u) * EVPP + 1536 + 8 * lane); }
#pragma unroll
        for (int u = 0; u < 4; ++u) {
            float o[8], g[8]; unpack8(ow[u], o); unpack8(gwv[u], g);
            float sq = 0.f;
#pragma unroll
            for (int j = 0; j < 8; ++j) sq += o[j] * o[j];
            sq += __shfl_xor(sq, 1); sq += __shfl_xor(sq, 2); sq += __shfl_xor(sq, 4); sq += __shfl_xor(sq, 8);
            const float rstd = rsqrtf(sq * (1.f / 128.f) + EPS);
            float r[8];
#pragma unroll
            for (int j = 0; j < 8; ++j) r[j] = o[j] * rstd * gn[j] * (g[j] / (1.f + __expf(-g[j])));
            uint4 w; w.x = pk2(r[0], r[1]); w.y = pk2(r[2], r[3]); w.z = pk2(r[4], r[5]); w.w = pk2(r[6], r[7]);
            *(uint4*)(MIX + (size_t)(m0 + u) * D + 8 * lane) = w;
        }
    }
}

__device__ __forceinline__ void swa_naive(const Ctx& c, float* lds) {
    const bf16_t* P = (const bf16_t*)(c.ws + WS_PROJ); bf16_t* ATT = (bf16_t*)(c.ws + WS_H);
    float* qs = lds + c.wave * ATT_WSTRIDE; float* ps = qs + 256; int* bl = (int*)(ps + 2048);
    const int lane = c.lane;
    for (int task = c.gw; task < M * 4; task += c.ngw) {
        const int hq = task & 1, g = (task >> 1) & 1, m = task >> 2, b = m >> 12, t = m & (SEQ - 1);
        const bf16_t* prow = P + (size_t)m * ODP;
        const int head0 = g * 8 + hq * 4;
#pragma unroll
        for (int hh = 0; hh < 4; ++hh) qs[hh * 64 + lane] = bf2f(prow[(head0 + hh) * 64 + lane]);
        if (lane < 2) bl[lane] = t - 127 + 64 * lane;
        LDS_FENCE();
        const float sink[4] = {c.swa_sinks[head0], c.swa_sinks[head0 + 1], c.swa_sinks[head0 + 2], c.swa_sinks[head0 + 3]};
        float o[4], inv[4];
        attn_rounds<true>(P + (size_t)b * SEQ * ODP + 1024 + g * 64, P + (size_t)b * SEQ * ODP + 1152 + g * 64, ODP, bl, 2, 0, t, qs, ps, sink, o, inv, lane);
#pragma unroll
        for (int hh = 0; hh < 4; ++hh) ATT[(size_t)m * D + (head0 + hh) * 64 + lane] = f2bf(o[hh]);
        LDS_FENCE();
    }
}

__device__ __forceinline__ void phase_router(const Ctx& c, float* lds, int layer) {
    float* wl = lds;
    int* lcnt = (int*)(lds + 36 * 1024);
    int* lbase = lcnt + 32;
    int* tinfo = lbase + 32;
    float* twt = (float*)(tinfo + 1024);
    const float* wg = c.moe_w_grp + (size_t)layer * 1024 * 4; const float* we = c.moe_w_exp + (size_t)layer * 1024 * 32;
    const float* bg = c.moe_b_grp + layer * 4; const float* be = c.moe_b_exp + layer * 32; const float* gain = c.moe_norm + layer * D;
    int* gcnt = (int*)(c.ws + WS_CTL) + layer * 32;
    bf16_t* H = (bf16_t*)(c.ws + WS_H);
    int* TE = (int*)(c.ws + WS_TE); int* TR = (int*)(c.ws + WS_TR); float* TW = (float*)(c.ws + WS_TW);
    for (int i = c.tid; i < 36 * 1024; i += NTHREADS) { const int o = i >> 10, k = i & 1023; wl[i] = o < 4 ? wg[k * 4 + o] : we[k * 32 + (o - 4)]; }
    if (c.tid < 32) lcnt[c.tid] = 0;
    __syncthreads();
    for (int blk = blockIdx.x; blk < M / 256; blk += gridDim.x) {
        const bf16_t* XB = (const bf16_t*)(c.ws + WS_XB);
        uint2 vn[4];
        { const uint2* xr0 = (const uint2*)(XB + (size_t)(blk * 256 + c.wave * 32) * D) + c.lane;
#pragma unroll
          for (int j = 0; j < 4; ++j) vn[j] = xr0[64 * j]; }
        for (int i = 0; i < 32; ++i) {
            const int tl = c.wave * 32 + i, m = blk * 256 + tl;
            float4 v[4]; float s = 0.f;
#pragma unroll
            for (int j = 0; j < 4; ++j) { v[j] = make_float4(__uint_as_float(vn[j].x << 16), __uint_as_float(vn[j].x & 0xffff0000u), __uint_as_float(vn[j].y << 16), __uint_as_float(vn[j].y & 0xffff0000u));
                s += v[j].x * v[j].x + v[j].y * v[j].y + v[j].z * v[j].z + v[j].w * v[j].w; }
            if (i + 1 < 32) {
                const uint2* xr1 = (const uint2*)(XB + (size_t)(m + 1) * D) + c.lane;
#pragma unroll
                for (int j = 0; j < 4; ++j) vn[j] = xr1[64 * j];
            }
            const float rstd = rsqrtf(wsum(s) * (1.f / D) + EPS);
            uint2* ho = (uint2*)(H + (size_t)m * D) + c.lane;
#pragma unroll
            for (int j = 0; j < 4; ++j) {
                const float4 g = ((const float4*)gain)[c.lane + 64 * j];
                v[j].x *= rstd * g.x; v[j].y *= rstd * g.y; v[j].z *= rstd * g.z; v[j].w *= rstd * g.w;
                uint2 w; w.x = pk2(v[j].x, v[j].y); w.y = pk2(v[j].z, v[j].w); ho[64 * j] = w;
            }
            float g4[4]; int gi = 0;
#pragma unroll
            for (int o = 0; o < 4; ++o) {
                float a = 0.f;
#pragma unroll
                for (int j = 0; j < 4; ++j) { const float4 w = ((const float4*)(wl + o * 1024))[c.lane + 64 * j]; a += v[j].x * w.x + v[j].y * w.y + v[j].z * w.z + v[j].w * w.w; }
                g4[o] = wsum(a) + bg[o];
            }
            float gm = g4[0];
#pragma unroll
            for (int q = 1; q < 4; ++q) if (g4[q] > gm) { gm = g4[q]; gi = q; }
            float gs = 0.f;
#pragma unroll
            for (int q = 0; q < 4; ++q) gs += expf(g4[q] - gm);
            const float gwt = 1.f / gs;
            float w8[8];
#pragma unroll
            for (int o = 0; o < 8; ++o) {
                float a = 0.f; const float* wr = wl + (4 + gi * 8 + o) * 1024;
#pragma unroll
                for (int j = 0; j < 4; ++j) { const float4 w = ((const float4*)wr)[c.lane + 64 * j]; a += v[j].x * w.x + v[j].y * w.y + v[j].z * w.z + v[j].w * w.w; }
                w8[o] = wsum(a) + be[gi * 8 + o];
            }
            int j0 = 0; float l0 = w8[0];
#pragma unroll
            for (int j = 1; j < 8; ++j) if (w8[j] > l0) { l0 = w8[j]; j0 = j; }
            int j1 = -1; float l1 = -INFINITY;
#pragma unroll
            for (int j = 0; j < 8; ++j) if (j != j0 && w8[j] > l1) { l1 = w8[j]; j1 = j; }
            const float e1 = expf(l1 - l0); const float w0 = gwt / (1.f + e1), w1 = gwt * e1 / (1.f + e1);
            if (c.lane == 0) {
                const int ea = gi * 8 + j0, eb = gi * 8 + j1;
                const int ra = atomicAdd(&lcnt[ea], 1), rb = atomicAdd(&lcnt[eb], 1);
                tinfo[tl * 4 + 0] = ea; tinfo[tl * 4 + 1] = eb; tinfo[tl * 4 + 2] = ra; tinfo[tl * 4 + 3] = rb; twt[tl * 2] = w0; twt[tl * 2 + 1] = w1;
            }
        }
        __syncthreads();
        if (c.tid < 32) { lbase[c.tid] = atomicAdd(&gcnt[c.tid], lcnt[c.tid]); lcnt[c.tid] = 0; }
        __syncthreads();
        if (c.tid < 256) {
            const int m = blk * 256 + c.tid; const int ea = tinfo[c.tid * 4], eb = tinfo[c.tid * 4 + 1];
            TE[2 * m] = ea; TE[2 * m + 1] = eb; TR[2 * m] = lbase[ea] + tinfo[c.tid * 4 + 2]; TR[2 * m + 1] = lbase[eb] + tinfo[c.tid * 4 + 3];
            TW[2 * m] = twt[c.tid * 2]; TW[2 * m + 1] = twt[c.tid * 2 + 1];
        }
        __syncthreads();
    }
}

__device__ __forceinline__ void phase_router2(const Ctx& c, unsigned char* lds_raw, int layer) {
    typedef short bf16x8 __attribute__((ext_vector_type(8)));
    typedef float f32x4 __attribute__((ext_vector_type(4)));
    const int tid = c.tid, lane = c.lane, w = c.wave, l15 = lane & 15, g4 = lane >> 4;
    float* LG = (float*)(lds_raw + w * 5632);
    float* RS = LG + 32 * 40;
    int* lcnt = (int*)(lds_raw + 8 * 5632);
    int* lbase = lcnt + 32;
    int* tinfo = lbase + 32;
    float* twt = (float*)(tinfo + 1024);
    const bf16_t* XB = (const bf16_t*)(c.ws + WS_XB); const bf16_t* RW = (const bf16_t*)(c.ws + WS_RW) + (size_t)layer * 48 * 2048;
    const float* bg = c.moe_b_grp + layer * 4; const float* be = c.moe_b_exp + layer * 32; const float* gain = c.moe_norm + layer * D;
    int* gcnt = (int*)(c.ws + WS_CTL) + layer * 32;
    bf16_t* H = (bf16_t*)(c.ws + WS_H);
    int* TE = (int*)(c.ws + WS_TE); int* TR = (int*)(c.ws + WS_TR); float* TW = (float*)(c.ws + WS_TW);
    __syncthreads();
    if (tid < 32) lcnt[tid] = 0;
    __syncthreads();
    for (int blk = blockIdx.x; blk < M / 256; blk += gridDim.x) {
        const int tok0 = blk * 256 + w * 32;
        f32x4 acc[2][3];
#pragma unroll
        for (int mt = 0; mt < 2; ++mt)
#pragma unroll
            for (int nt = 0; nt < 3; ++nt) acc[mt][nt] = (f32x4){0.f, 0.f, 0.f, 0.f};
        float sq0 = 0.f, sq1 = 0.f;
        const bf16_t* a0 = XB + (size_t)(tok0 + l15) * D + 8 * g4; const bf16_t* a1 = a0 + (size_t)16 * D;
        const bf16_t* b0 = RW + (size_t)l15 * 2048 + 8 * g4;
#pragma unroll 2
        for (int ks = 0; ks < 32; ++ks) {
            const bf16x8 A0 = *(const bf16x8*)(a0 + 32 * ks), A1 = *(const bf16x8*)(a1 + 32 * ks);
            { float f[8]; unpack8(__builtin_bit_cast(uint4, A0), f);
#pragma unroll
              for (int j = 0; j < 8; ++j) sq0 += f[j] * f[j];
              unpack8(__builtin_bit_cast(uint4, A1), f);
#pragma unroll
              for (int j = 0; j < 8; ++j) sq1 += f[j] * f[j]; }
#pragma unroll
            for (int nt = 0; nt < 3; ++nt) {
                const bf16x8 Bh = *(const bf16x8*)(b0 + (size_t)nt * 16 * 2048 + 32 * ks), Bl = *(const bf16x8*)(b0 + (size_t)nt * 16 * 2048 + 1024 + 32 * ks);
                acc[0][nt] = __builtin_amdgcn_mfma_f32_16x16x32_bf16(A0, Bh, acc[0][nt], 0, 0, 0); acc[0][nt] = __builtin_amdgcn_mfma_f32_16x16x32_bf16(A0, Bl, acc[0][nt], 0, 0, 0);
                acc[1][nt] = __builtin_amdgcn_mfma_f32_16x16x32_bf16(A1, Bh, acc[1][nt], 0, 0, 0); acc[1][nt] = __builtin_amdgcn_mfma_f32_16x16x32_bf16(A1, Bl, acc[1][nt], 0, 0, 0);
            }
        }
        sq0 += __shfl_xor(sq0, 16); sq0 += __shfl_xor(sq0, 32); sq1 += __shfl_xor(sq1, 16); sq1 += __shfl_xor(sq1, 32);
        if (g4 == 0) { RS[l15] = rsqrtf(sq0 * (1.f / D) + EPS); RS[16 + l15] = rsqrtf(sq1 * (1.f / D) + EPS); }
        LDS_FENCE();
#pragma unroll
        for (int nt = 0; nt < 3; ++nt) {
            const int o = 16 * nt + l15;
            if (o < 36) {
                const float bias = o < 4 ? bg[o] : be[o - 4];
#pragma unroll
                for (int mt = 0; mt < 2; ++mt)
#pragma unroll
                    for (int r = 0; r < 4; ++r) { const int tk = 16 * mt + 4 * g4 + r; LG[tk * 40 + o] = acc[mt][nt][r] * RS[tk] + bias; }
            }
        }
        LDS_FENCE();
        if (lane < 32) {
            const float* lg = LG + lane * 40;
            int gi = 0; float gm = lg[0];
#pragma unroll
            for (int q = 1; q < 4; ++q) if (lg[q] > gm) { gm = lg[q]; gi = q; }
            float gs = 0.f;
#pragma unroll
            for (int q = 0; q < 4; ++q) gs += expf(lg[q] - gm);
            const float gwt = 1.f / gs;
            float w8[8];
#pragma unroll
            for (int j = 0; j < 8; ++j) w8[j] = lg[4 + gi * 8 + j];
            int j0 = 0; float l0 = w8[0];
#pragma unroll
            for (int j = 1; j < 8; ++j) if (w8[j] > l0) { l0 = w8[j]; j0 = j; }
            int j1 = -1; float l1 = -INFINITY;
#pragma unroll
            for (int j = 0; j < 8; ++j) if (j != j0 && w8[j] > l1) { l1 = w8[j]; j1 = j; }
            const float e1 = expf(l1 - l0); const float w0 = gwt / (1.f + e1), w1 = gwt * e1 / (1.f + e1);
            const int tl = w * 32 + lane, ea = gi * 8 + j0, eb = gi * 8 + j1;
            const int ra = atomicAdd(&lcnt[ea], 1), rb = atomicAdd(&lcnt[eb], 1);
            tinfo[tl * 4 + 0] = ea; tinfo[tl * 4 + 1] = eb; tinfo[tl * 4 + 2] = ra; tinfo[tl * 4 + 3] = rb; twt[tl * 2] = w0; twt[tl * 2 + 1] = w1;
        }
        {
            float4 gq[4];
#pragma unroll
            for (int j = 0; j < 4; ++j) gq[j] = ((const float4*)gain)[lane + 64 * j];
#pragma unroll 2
            for (int i = 0; i < 32; ++i) {
                const size_t m = (size_t)tok0 + i; const float rs = RS[i];
                const uint2* xr = (const uint2*)(XB + m * D) + lane; uint2* ho = (uint2*)(H + m * D) + lane;
#pragma unroll
                for (int j = 0; j < 4; ++j) { const uint2 xv = xr[64 * j]; uint2 o;
                    o.x = pk2(__uint_as_float(xv.x << 16) * rs * gq[j].x, __uint_as_float(xv.x & 0xffff0000u) * rs * gq[j].y);
                    o.y = pk2(__uint_as_float(xv.y << 16) * rs * gq[j].z, __uint_as_float(xv.y & 0xffff0000u) * rs * gq[j].w); ho[64 * j] = o; }
            }
        }
        __syncthreads();
        if (tid < 32) { lbase[tid] = atomicAdd(&gcnt[tid], lcnt[tid]); lcnt[tid] = 0; }
        __syncthreads();
        if (tid < 256) {
            const int m = blk * 256 + tid; const int ea = tinfo[tid * 4], eb = tinfo[tid * 4 + 1];
            TE[2 * m] = ea; TE[2 * m + 1] = eb; TR[2 * m] = lbase[ea] + tinfo[tid * 4 + 2]; TR[2 * m + 1] = lbase[eb] + tinfo[tid * 4 + 3];
            TW[2 * m] = twt[tid * 2]; TW[2 * m + 1] = twt[tid * 2 + 1];
            int* LIST = (int*)(c.ws + WS_LIST);
            LIST[(size_t)ea * 65536 + lbase[ea] + tinfo[tid * 4 + 2]] = m; LIST[(size_t)eb * 65536 + lbase[eb] + tinfo[tid * 4 + 3]] = m;
        }
        __syncthreads();
    }
}

__device__ __forceinline__ void phase_scatter(const Ctx& c, float* lds, int layer) {
    int* ps = (int*)lds;
    const int* gcnt = (const int*)(c.ws + WS_CTL) + layer * 32;
    if (c.tid == 0) { int a = 0; for (int e = 0; e < 32; ++e) { ps[e] = a; a += (gcnt[e] + 255) / 256 * 256; } ps[32] = a; }
    __syncthreads();
    const int* TE = (const int*)(c.ws + WS_TE); const int* TR = (const int*)(c.ws + WS_TR); const float* TW = (const float*)(c.ws + WS_TW);
    int* TSLOT = (int*)(c.ws + WS_TSLOT); int* ROWTOK = (int*)(c.ws + WS_ROWTOK); float* ROWW = (float*)(c.ws + WS_ROWW); int* TILEE = (int*)(c.ws + WS_TILEE);
    const int gt = blockIdx.x * NTHREADS + c.tid, ngt = gridDim.x * NTHREADS;
    for (int a = gt; a < 2 * M; a += ngt) { const int e = TE[a], slot = ps[e] + TR[a]; TSLOT[a] = slot; ROWTOK[slot] = a >> 1; ROWW[slot] = TW[a]; }
    for (int i = gt; i < 32 * 256; i += ngt) { const int e = i >> 8, r = i & 255; const int cnt = gcnt[e], pc = (cnt + 255) / 256 * 256; if (cnt + r < pc) { ROWTOK[ps[e] + cnt + r] = 0; ROWW[ps[e] + cnt + r] = 0.f; } }
    for (int st = gt; st < MAXTILES; st += ngt) { int e = -1; for (int q = 0; q < 32; ++q) if (st * 256 >= ps[q] && st * 256 < ps[q + 1]) e = q; TILEE[st] = e; }
    if (gt == 0) TILEE[600] = ps[32] / 256;
}

__device__ __forceinline__ void phase_moe1_naive(const Ctx& c, float* lds, int layer) {
    const int* TILEE = (const int*)(c.ws + WS_TILEE); const int nt = TILEE[600];
    const bf16_t* H = (const bf16_t*)(c.ws + WS_H); bf16_t* HID = (bf16_t*)(c.ws + WS_HID);
    ARowGather ar{H, D, (const int*)(c.ws + WS_ROWTOK)}; EpiGU epi{HID};
    const int total = nt * 2 * 16;
    for (int u = blockIdx.x; u < total; u += gridDim.x) {
        const int st128 = u / 16, nvt = u % 16, e = TILEE[st128 >> 1];
        BRowGU br{(const bf16_t*)(c.ws + WS_WGU) + (size_t)(layer * 32 + e) * 1024 * 1024, D};
        gemm_naive_tile(lds, st128 * 128, nvt * 64, D, ar, br, epi);
    }
}
__device__ __forceinline__ void phase_moe2_naive(const Ctx& c, float* lds, int layer) {
    const int* TILEE = (const int*)(c.ws + WS_TILEE); const int nt = TILEE[600];
    const bf16_t* HID = (const bf16_t*)(c.ws + WS_HID); bf16_t* YS = (bf16_t*)(c.ws + WS_YS);
    ARowPlain ar{HID, FF}; EpiDown epi{YS, (const float*)(c.ws + WS_ROWW)};
    const int total = nt * 2 * 16;
    for (int u = blockIdx.x; u < total; u += gridDim.x) {
        const int st128 = u / 16, nt64 = u % 16, e = TILEE[st128 >> 1];
        BRowPlain br{(const bf16_t*)(c.ws + WS_WD) + (size_t)(layer * 32 + e) * 1024 * 512, FF};
        gemm_naive_tile(lds, st128 * 128, nt64 * 64, FF, ar, br, epi);
    }
}


__device__ __forceinline__ int build_tile_table(const Ctx& c, unsigned char* lds_raw, int layer) {
    const int* gcnt = (const int*)(c.ws + WS_CTL) + layer * 32;
    int* pst = (int*)(lds_raw + pg8::STAGE_BYTES); int* te = pst + 64; int* tv = te + MAXTILES; int* tg = tv + MAXTILES;
    __syncthreads();
    if (c.tid == 0) { int a = 0; for (int e = 0; e < 32; ++e) { pst[e] = a; a += (gcnt[e] + 255) >> 8; } pst[32] = a; }
    __syncthreads();
    for (int st = c.tid; st < MAXTILES; st += NTHREADS) {
        int e = 31;
        for (int q = 0; q < 32; ++q) if (st >= pst[q] && st < pst[q + 1]) e = q;
        const int ti = st - pst[e], rem = gcnt[e] - 256 * ti;
        te[st] = e; tv[st] = rem < 256 ? (rem > 0 ? rem : 0) : 256; tg[st] = e * 65536 + 256 * ti;
    }
    __syncthreads();
    return pst[32];
}
__device__ __forceinline__ void phase_moe1_mfma(const Ctx& c, unsigned char* lds_raw, int layer) {
    const int nt = build_tile_table(c, lds_raw, layer);
    const int* te = (const int*)(lds_raw + pg8::STAGE_BYTES) + 64;
    pg8::Gemm g{(const bf16_t*)(c.ws + WS_H), (const bf16_t*)(c.ws + WS_WGU) + (size_t)layer * 32 * 1024 * 1024, D, (const int*)(c.ws + WS_LIST), (size_t)1024 * 1024};
    pg8::MoeOrder S{te, te + MAXTILES, te + 2 * MAXTILES, nt * 4, (int)gridDim.x, (int)blockIdx.x};
    pg8::EpiGUT E{(bf16_t*)(c.ws + WS_HID)};
    pg8::gemm_phase<pg8::EpiGUT, pg8::MoeOrder, true>((PG8_LAS unsigned char*)lds_raw, g, S, E);
}
__device__ __forceinline__ void phase_moe2_mfma(const Ctx& c, unsigned char* lds_raw, int layer) {
    const int nt = build_tile_table(c, lds_raw, layer);
    const int* te = (const int*)(lds_raw + pg8::STAGE_BYTES) + 64;
    pg8::Gemm g{(const bf16_t*)(c.ws + WS_HID), (const bf16_t*)(c.ws + WS_WD) + (size_t)layer * 32 * 1024 * 512, FF, nullptr, (size_t)1024 * 512};
    pg8::MoeOrder S{te, te + MAXTILES, te + 2 * MAXTILES, nt * 4, (int)gridDim.x, (int)blockIdx.x};
    pg8::EpiDownT E{(bf16_t*)(c.ws + WS_YS)};
    pg8::gemm_phase<pg8::EpiDownT, pg8::MoeOrder, false>((PG8_LAS unsigned char*)lds_raw, g, S, E);
}
template <class Epi>
__device__ __forceinline__ void phase_gemm_mfma(unsigned char* lds_raw, const bf16_t* A, const bf16_t* Bt, int Npad, int K, const Epi& E) {
    pg8::Gemm g{A, Bt, K, nullptr, 0}; pg8::StaticOrder S; S.init(M, Npad, (int)gridDim.x, (int)blockIdx.x);
    pg8::gemm_phase<Epi, pg8::StaticOrder, false>((PG8_LAS unsigned char*)lds_raw, g, S, E);
}

typedef const __attribute__((address_space(4))) Args CArgs;
__device__ __forceinline__ void make_ctx(Ctx& c, CArgs& a, int tid_) {
    c.x = a.in[0]; c.ev_norm = a.in[1]; c.ev_w_in = a.in[2]; c.hg_lb = a.in[3]; c.hg_gain = a.in[4]; c.nsa_qg = a.in[5]; c.nsa_kg = a.in[6]; c.cmp_pe = a.in[7];
    c.cmp_w1 = a.in[8]; c.cmp_w2 = a.in[9]; c.ev_w_out = a.in[10]; c.od_norm = a.in[11]; c.od_w_in = a.in[12]; c.swa_qg = a.in[13]; c.swa_kg = a.in[14]; c.swa_sinks = a.in[15];
    c.od_w_out = a.in[16]; c.moe_norm = a.in[17]; c.moe_w_grp = a.in[18]; c.moe_b_grp = a.in[19]; c.moe_w_exp = a.in[20]; c.moe_b_exp = a.in[21];
    c.moe_w_gate = a.in[22]; c.moe_w_up = a.in[23]; c.moe_w_down = a.in[24];
    c.xr = a.out; c.ws = a.ws;
    c.tid = tid_; c.lane = c.tid & 63; c.wave = c.tid >> 6; c.gw = blockIdx.x * NWAVES + c.wave; c.ngw = gridDim.x * NWAVES;
}

#ifndef PSTAMP
#define PSTAMP(k) do {} while (0)
#endif
#define PHASE_BEGIN() Ctx c; { CArgs* ap_ = (CArgs*)__builtin_amdgcn_kernarg_segment_ptr(); asm volatile("" : "+s"(ap_)); int tid_ = threadIdx.x; asm volatile("" : "+v"(tid_)); make_ctx(c, *ap_, tid_); } \
    unsigned char* ws = c.ws; bf16_t* H = (bf16_t*)(ws + WS_H); bf16_t* PROJ = (bf16_t*)(ws + WS_PROJ); (void)H; (void)PROJ;
__global__ void __launch_bounds__(NTHREADS, 2) mega(Args a) {
    extern __shared__ __attribute__((aligned(16))) unsigned char lds_raw[];
    float* lds = (float*)lds_raw;
    if (threadIdx.x < 4) ((volatile XLAS unsigned*)(XLAS unsigned char*)lds_raw)[(LDS_BARST >> 2) + threadIdx.x] = 0u;
    __syncthreads();
    const XcdBarrier xbar = xcd_barrier_post((unsigned*)(a.ws + WS_CTL + CTL_BAR), (volatile XLAS unsigned*)((XLAS unsigned char*)lds_raw + LDS_BARST));
    PSTAMP(0); { PHASE_BEGIN(); phase_prologue(c, lds); PSTAMP(23); phase_norm_x(c, c.x, c.ev_norm, H); }
    xcd_barrier(xbar);
    PSTAMP(1); { PHASE_BEGIN(); pg8::EpiProj0T epi{PROJ, (float*)(ws + WS_LOGF), (const float*)(ws + WS_LB)}; phase_gemm_mfma(lds_raw, H, (const bf16_t*)(ws + WS_W0T), EVPP, D, epi); }
    xcd_barrier(xbar);
    PSTAMP(2); { PHASE_BEGIN();
      post_even(c, blockIdx.x, gridDim.x); PSTAMP(20);
      for (int u = blockIdx.x; u < 256; u += gridDim.x) compress_mfma(c, lds_raw, u);
      PSTAMP(21);
      for (int su = blockIdx.x; su < 256; su += gridDim.x) hgrn2_passA(c, lds_raw, su); }
    xcd_barrier(xbar);
    PSTAMP(24); { PHASE_BEGIN();
      for (int u = blockIdx.x; u < 256; u += gridDim.x) {
        const int unit = (gridDim.x == 256) ? ((((u & 7) * 8 + (u >> 5)) << 2) | ((u >> 3) & 3)) : u;
        hgrn2_seq(c, lds_raw, unit); } }
    xcd_barrier(xbar);
    PSTAMP(3); { PHASE_BEGIN(); nsa_mfma(c, lds_raw); PSTAMP(22);
#ifdef PROBE_NSA_ABL
      nsa_mfma<PROBE_NSA_ABL, true>(c, lds_raw);
#endif
      aout_fixup(c); }
    xcd_barrier(xbar);
    PSTAMP(4); { PHASE_BEGIN(); pg8::EpiResidF2B epi{c.x, (bf16_t*)(ws + WS_XB)}; phase_gemm_mfma(lds_raw, H, (const bf16_t*)(ws + WS_WO0T), D, D, epi); }
    xcd_barrier(xbar);
    PSTAMP(5); { PHASE_BEGIN(); phase_router2(c, lds_raw, 0); }
    xcd_barrier(xbar);
    PSTAMP(7); { PHASE_BEGIN(); phase_moe1_mfma(c, lds_raw, 0); }
    xcd_barrier(xbar);
    PSTAMP(8); { PHASE_BEGIN(); phase_moe2_mfma(c, lds_raw, 0); }
    xcd_barrier(xbar);
    PSTAMP(9); { PHASE_BEGIN(); phase_combine<false>(c, (bf16_t*)(ws + WS_XB), nullptr, c.od_norm, H, (const bf16_t*)(ws + WS_YS), 0); }
    xcd_barrier(xbar);
    PSTAMP(10); { PHASE_BEGIN(); pg8::EpiRawT epi{PROJ, ODP}; phase_gemm_mfma(lds_raw, H, (const bf16_t*)(ws + WS_W1T), ODP, D, epi); }
    xcd_barrier(xbar);
    PSTAMP(12); { PHASE_BEGIN(); swa_mfma(c, lds_raw); }
    xcd_barrier(xbar);
    PSTAMP(13); { PHASE_BEGIN(); pg8::EpiResidB2B epi{(bf16_t*)(ws + WS_XB)}; phase_gemm_mfma(lds_raw, H, (const bf16_t*)(ws + WS_WO1T), D, D, epi); }
    xcd_barrier(xbar);
    PSTAMP(14); { PHASE_BEGIN(); phase_router2(c, lds_raw, 1); }
    xcd_barrier(xbar);
    PSTAMP(16); { PHASE_BEGIN(); phase_moe1_mfma(c, lds_raw, 1); }
    xcd_barrier(xbar);
    PSTAMP(17); { PHASE_BEGIN(); phase_moe2_mfma(c, lds_raw, 1); }
    xcd_barrier(xbar);
    PSTAMP(18); { PHASE_BEGIN(); phase_combine<true>(c, (bf16_t*)(ws + WS_XB), c.xr, nullptr, nullptr, (const bf16_t*)(ws + WS_YS), 1); }
    PSTAMP(19);
#ifdef PROBE_TAIL
    PROBE_TAIL
#endif
}

extern "C" void kernel_launch(void* const* d_in, const int* in_sizes, int n_in, void* d_out, int out_size, void* d_ws, size_t ws_size, hipStream_t stream) {
    static int grid = 0;
    if (grid == 0) {
        if (n_in != 25 || ws_size < WS_END) { fprintf(stderr, "kernel_launch: unexpected n_in %d / ws %zu\n", n_in, ws_size); grid = -1; return; }
        int dev = 0, cus = 0, per_cu = 0;
        hipGetDevice(&dev);
        hipDeviceGetAttribute(&cus, hipDeviceAttributeMultiprocessorCount, dev);
        hipFuncSetAttribute((const void*)mega, hipFuncAttributeMaxDynamicSharedMemorySize, LDS_BYTES);
        hipOccupancyMaxActiveBlocksPerMultiprocessor(&per_cu, (const void*)mega, NTHREADS, LDS_BYTES);
        if (per_cu < 1) { fprintf(stderr, "kernel_launch: occupancy query says %d blocks/CU\n", per_cu); per_cu = 1; }
        (void)hipGetLastError();
        grid = cus;
    }
    if (grid < 0) return;
    hipMemsetAsync((char*)d_ws + WS_CTL, 0, CTL_BYTES, stream);
    Args a{};
    for (int i = 0; i < 25; ++i) a.in[i] = (const float*)d_in[i];
    a.out = (float*)d_out; a.ws = (unsigned char*)d_ws;
    void* args[] = {&a};
    hipError_t e = hipLaunchCooperativeKernel((const void*)mega, dim3(grid), dim3(NTHREADS), args, LDS_BYTES, stream);
    if (e != hipSuccess) fprintf(stderr, "cooperative launch failed: %s (grid %d)\n", hipGetErrorString(e), grid);
}
```

```cpp
#include <hip/hip_runtime.h>
#include <hip/hip_cooperative_groups.h>
#include <cstdio>
#include <cstdint>
namespace cg = cooperative_groups;

constexpr int D = 1024, BATCH = 16, SEQ = 4096, M = BATCH * SEQ;
constexpr int EVP = 3352, EVPP = 3584, ODP = 1280;
constexpr int NEXP = 32, FF = 512;
constexpr int NTHREADS = 512, NWAVES = 8;
constexpr int MAXTILES = 544;
constexpr int NSLOTS = MAXTILES * 256;
constexpr float EPS = 1e-6f;

typedef unsigned short bf16_t;
typedef unsigned int u32;

constexpr size_t MiB = 1u << 20;
constexpr size_t WS_CTL = 0;
constexpr size_t CTL_BYTES = 64 * 1024;
constexpr size_t WS_LB = 1 * MiB;
constexpr size_t WS_CBIAS = WS_LB + 4096;
constexpr size_t WS_ROPE = WS_LB + 8192;
constexpr size_t WS_KCB = 2 * MiB;
constexpr size_t WS_VCB = 3 * MiB;
constexpr size_t WS_TE = 4 * MiB;
constexpr size_t WS_TR = 4 * MiB + 512 * 1024;
constexpr size_t WS_TW = 5 * MiB;
constexpr size_t WS_TSLOT = 5 * MiB + 512 * 1024;
constexpr size_t WS_ROWTOK = 6 * MiB;
constexpr size_t WS_ROWW = 7 * MiB;
constexpr size_t WS_TILEE = 8 * MiB;
constexpr size_t WS_W0T = 16 * MiB;
constexpr size_t WS_WO0T = 23 * MiB;
constexpr size_t WS_W1T = 25 * MiB;
constexpr size_t WS_WO1T = 28 * MiB;
constexpr size_t WS_CW1T = 30 * MiB;
constexpr size_t WS_CW2T = 32 * MiB;
constexpr size_t WS_RW = 33 * MiB;
constexpr size_t WS_WGU = 40 * MiB;
constexpr size_t WS_WD = 168 * MiB;
constexpr size_t WS_H = 232 * MiB;
constexpr size_t WS_PROJ = 360 * MiB;
constexpr size_t WS_HID = WS_PROJ;
constexpr size_t WS_YS = WS_PROJ + 136 * MiB;
constexpr size_t WS_LOGF = 808 * MiB;
constexpr size_t WS_XB = WS_LOGF;
constexpr size_t WS_LIST = 936 * MiB;
constexpr size_t WS_END = 944 * MiB;

constexpr int LDS_BYTES = 160 * 1024;
constexpr int LDS_BARST = LDS_BYTES - 16;
constexpr size_t CTL_BAR = 16 * 1024;

__device__ __forceinline__ float bf2f(bf16_t v) { return __uint_as_float(((u32)v) << 16); }
typedef float f32x2_t __attribute__((ext_vector_type(2))); typedef __bf16 bf16x2_t __attribute__((ext_vector_type(2)));
__device__ __forceinline__ u32 pk2(float lo, float hi) { f32x2_t v = {lo, hi}; bf16x2_t b = __builtin_convertvector(v, bf16x2_t); return __builtin_bit_cast(u32, b); }
__device__ __forceinline__ bf16_t f2bf(float f) { return (bf16_t)(pk2(f, 0.f) & 0xffffu); }
__device__ __forceinline__ float wsum(float v) {
#pragma unroll
    for (int o = 32; o; o >>= 1) v += __shfl_xor(v, o);
    return v;
}
__device__ __forceinline__ float wmax(float v) {
#pragma unroll
    for (int o = 32; o; o >>= 1) v = fmaxf(v, __shfl_xor(v, o));
    return v;
}
__device__ __forceinline__ void unpack8(const uint4& w, float* f) {
    f[0] = __uint_as_float(w.x << 16); f[1] = __uint_as_float(w.x & 0xffff0000u);
    f[2] = __uint_as_float(w.y << 16); f[3] = __uint_as_float(w.y & 0xffff0000u);
    f[4] = __uint_as_float(w.z << 16); f[5] = __uint_as_float(w.z & 0xffff0000u);
    f[6] = __uint_as_float(w.w << 16); f[7] = __uint_as_float(w.w & 0xffff0000u);
}
#define LDS_FENCE() asm volatile("s_waitcnt lgkmcnt(0)" ::: "memory")

#define XB_TMO      128
#define XB_XCNT(j)  (256  + 64 * (j))
#define XB_XSUB(j)  (1280 + 64 * (j))
#define XB_XGEN(j)  (2304 + 64 * (j))
#define XB_TOP      3328
#define XB_TOPGEN   3392
#define XCD_BAR_WORDS 3456
#define XB_SPIN_CAP (1u << 18)
#define XLAS __attribute__((address_space(3)))
__device__ __forceinline__ unsigned xb_ld(unsigned* p)              { return __hip_atomic_load(p, __ATOMIC_RELAXED, __HIP_MEMORY_SCOPE_AGENT); }
__device__ __forceinline__ unsigned xb_add(unsigned* p, unsigned v) { return __hip_atomic_fetch_add(p, v, __ATOMIC_RELAXED, __HIP_MEMORY_SCOPE_AGENT); }
__device__ __forceinline__ unsigned xb_xcc_id() { return (unsigned)__builtin_amdgcn_s_getreg((3 << 11) | 20) & 0xFu; }
#define XB_SPIN(cond, bar) do { unsigned _sp = 0; while (cond) { __builtin_amdgcn_s_sleep(1); \
    if ((++_sp & 255u) == 0u) { if (xb_ld(&(bar)[XB_TMO])) break; if (_sp > XB_SPIN_CAP) { atomicAdd(&(bar)[XB_TMO], 1u); break; } } } } while (0)
struct XcdBarrier { unsigned* bar; unsigned x; volatile XLAS unsigned* st; };
__device__ __forceinline__ XcdBarrier xcd_barrier_post(unsigned* bar, volatile XLAS unsigned* st) {
    XcdBarrier b; b.bar = bar; b.x = xb_xcc_id(); b.st = st;
    if (threadIdx.x == 0) (void)xb_add(&bar[XB_XCNT(b.x)], 1u);
    return b;
}
__device__ __forceinline__ void xcd_barrier_complete(unsigned* bar, unsigned x, unsigned& nloc, unsigned& nx) {
    const unsigned G = gridDim.x * gridDim.y * gridDim.z;
    unsigned sum, cnt, mine, sp = 0u;
    for (;;) {
        sum = 0u; cnt = 0u; mine = 0u;
#pragma unroll
        for (unsigned j = 0; j < 16; ++j) { const unsigned c = xb_ld(&bar[XB_XCNT(j)]); sum += c; cnt += (c > 0u) ? 1u : 0u; mine = (j == x) ? c : mine; }
        if (sum == G) break;
        __builtin_amdgcn_s_sleep(1);
        if ((++sp & 255u) == 0u) { if (xb_ld(&bar[XB_TMO])) break; if (sp > XB_SPIN_CAP) { atomicAdd(&bar[XB_TMO], 1u); break; } }
    }
    nloc = mine > 0u ? mine : 1u; nx = cnt > 0u ? cnt : 1u;
}
__device__ __forceinline__ void xcd_barrier(const XcdBarrier& b) {
    asm volatile("s_waitcnt vmcnt(0)" ::: "memory");
    __syncthreads();
    if (threadIdx.x == 0) {
        unsigned* bar = b.bar;
        __builtin_amdgcn_s_waitcnt(0);
        unsigned nloc = b.st[0], nx = b.st[1];
        if (nloc == 0u) { xcd_barrier_complete(bar, b.x, nloc, nx); b.st[0] = nloc; b.st[1] = nx; }
        const unsigned old = xb_add(&bar[XB_XSUB(b.x)], 1u);
        const unsigned gen = old / nloc;
        if (old + 1u == (gen + 1u) * nloc) {
            __builtin_amdgcn_fence(__ATOMIC_RELEASE, "agent");
            asm volatile("s_waitcnt vmcnt(0)" ::: "memory");
            const unsigned og = xb_add(&bar[XB_TOP], 1u);
            const unsigned tg = og / nx;
            if (og + 1u == (tg + 1u) * nx) xb_add(&bar[XB_TOPGEN], 1u);
            else XB_SPIN(xb_ld(&bar[XB_TOPGEN]) == tg, bar);
            __builtin_amdgcn_fence(__ATOMIC_ACQUIRE, "agent");
            xb_add(&bar[XB_XGEN(b.x)], 1u);
            asm volatile("s_waitcnt vmcnt(0)" ::: "memory");
        } else {
            XB_SPIN(xb_ld(&bar[XB_XGEN(b.x)]) == gen, bar);
            __builtin_amdgcn_fence(__ATOMIC_ACQUIRE, "agent");
            asm volatile("s_waitcnt vmcnt(0)" ::: "memory");
        }
    }
    __syncthreads();
}

struct Args {
    const float* in[25];
    float* out;
    unsigned char* ws;
};

struct Ctx {
    const float *x, *ev_norm, *ev_w_in, *hg_lb, *hg_gain, *nsa_qg, *nsa_kg, *cmp_pe, *cmp_w1, *cmp_w2, *ev_w_out;
    const float *od_norm, *od_w_in, *swa_qg, *swa_kg, *swa_sinks, *od_w_out;
    const float *moe_norm, *moe_w_grp, *moe_b_grp, *moe_w_exp, *moe_b_exp, *moe_w_gate, *moe_w_up, *moe_w_down;
    float* xr;
    unsigned char* ws;
    int tid, lane, wave, gw, ngw;
};

__device__ __forceinline__ void transpose_item(const float* W, int K, int Nsrc, bf16_t* WT, int drow0, int k0, int n0, float* scr, int lane) {
    const int rk = lane >> 3, c4 = 4 * (lane & 7);
    float4 v[8];
#pragma unroll
    for (int i = 0; i < 8; ++i) v[i] = (n0 + c4 < Nsrc) ? *(const float4*)(W + (size_t)(k0 + 8 * i + rk) * Nsrc + n0 + c4) : make_float4(0.f, 0.f, 0.f, 0.f);
#pragma unroll
    for (int i = 0; i < 8; ++i) { float* d = scr + (8 * i + rk) * 33 + c4; d[0] = v[i].x; d[1] = v[i].y; d[2] = v[i].z; d[3] = v[i].w; }
    LDS_FENCE();
    const int c = lane & 7;
#pragma unroll
    for (int j = 0; j < 4; ++j) {
        const int n = (lane >> 3) + 8 * j;
        const float* s = scr + (8 * c) * 33 + n;
        uint4 o;
        o.x = pk2(s[0 * 33], s[1 * 33]); o.y = pk2(s[2 * 33], s[3 * 33]); o.z = pk2(s[4 * 33], s[5 * 33]); o.w = pk2(s[6 * 33], s[7 * 33]);
        *(uint4*)(WT + (size_t)(drow0 + n0 + n) * K + k0 + 8 * c) = o;
    }
    LDS_FENCE();
}

struct MoeItem { const float* W; bf16_t* WT; int K, N, drow0, k0, n0; };
constexpr int MOE_ITEMS_L = 3 * 32 * 512;
static_assert(MOE_ITEMS_L == 64 * 256 * 3 && MOE_ITEMS_L == 2048 * 3 * 8, "layer 0: one item per (chunk, scan unit, wave < 3); layer 1: one per (SWA unit, tile slot < 3, wave)");
__device__ __forceinline__ void moe_item_decode(const Ctx& c, int layer, int r, MoeItem& it) {
    constexpr int IG = 32 * 512;
    bf16_t* WGU = (bf16_t*)(c.ws + WS_WGU); bf16_t* WDt = (bf16_t*)(c.ws + WS_WD);
    if (r < 2 * IG) {
        const bool up = r >= IG; if (up) r -= IG;
        const int le = layer * 32 + (r >> 9), q = r & 511, kb = q >> 4, nb = q & 15, n0 = 32 * nb;
        it.W = (up ? c.moe_w_up : c.moe_w_gate) + (size_t)le * 1024 * 512; it.WT = WGU + (size_t)le * 1024 * 1024; it.K = 1024; it.N = 512;
        it.drow0 = (n0 >> 7) * 256 + (up ? 128 : 0) + (n0 & 127) - n0; it.k0 = 32 * kb; it.n0 = n0;
    } else {
        r -= 2 * IG; const int le = layer * 32 + (r >> 9), q = r & 511;
        it.W = c.moe_w_down + (size_t)le * 512 * 1024; it.WT = WDt + (size_t)le * 1024 * 512; it.K = 512; it.N = 1024; it.drow0 = 0; it.k0 = 32 * (q >> 5); it.n0 = 32 * (q & 31);
    }
}
struct MoeRegs { float4 a, b, c, d; };
__device__ __forceinline__ void moe_item_issue(const MoeItem& it, MoeRegs& v, int lane) {
    const float* p = it.W + (size_t)(it.k0 + 4 * (lane >> 3)) * it.N + it.n0 + 4 * (lane & 7); const size_t N = it.N;
    v.a = *(const float4*)(p); v.b = *(const float4*)(p + N); v.c = *(const float4*)(p + 2 * N); v.d = *(const float4*)(p + 3 * N);
}
__device__ __forceinline__ void moe_item_finish(const MoeItem& it, const MoeRegs& v, int lane) {
    bf16_t* o = it.WT + (size_t)(it.drow0 + it.n0 + 4 * (lane & 7)) * it.K + it.k0 + 4 * (lane >> 3);
    uint2 w;
    w.x = pk2(v.a.x, v.b.x); w.y = pk2(v.c.x, v.d.x); *(uint2*)(o) = w;
    w.x = pk2(v.a.y, v.b.y); w.y = pk2(v.c.y, v.d.y); *(uint2*)(o + it.K) = w;
    w.x = pk2(v.a.z, v.b.z); w.y = pk2(v.c.z, v.d.z); *(uint2*)(o + 2 * (size_t)it.K) = w;
    w.x = pk2(v.a.w, v.b.w); w.y = pk2(v.c.w, v.d.w); *(uint2*)(o + 3 * (size_t)it.K) = w;
}

__device__ __forceinline__ void phase_prologue(const Ctx& c, float* lds) {
    float* scr = lds + c.wave * (64 * 33);
    unsigned char* ws = c.ws;
    bf16_t* W0T = (bf16_t*)(ws + WS_W0T); bf16_t* WO0T = (bf16_t*)(ws + WS_WO0T); bf16_t* W1T = (bf16_t*)(ws + WS_W1T); bf16_t* WO1T = (bf16_t*)(ws + WS_WO1T);
    bf16_t* CW1T = (bf16_t*)(ws + WS_CW1T); bf16_t* CW2T = (bf16_t*)(ws + WS_CW2T);
    constexpr int I0 = 16 * 112, I1 = 16 * 32, I2 = 16 * 40, I3 = 16 * 32, I4 = 2 * 32 * 8, I5 = 2 * 4 * 2;
    constexpr int NITEMS = I0 + I1 + I2 + I3 + I4 + I5;
    for (int it = c.gw; it < NITEMS; it += c.ngw) {
        int r = it;
        if (r < I0) { transpose_item(c.ev_w_in, 1024, EVP, W0T, 0, 64 * (r / 112), 32 * (r % 112), scr, c.lane); continue; } r -= I0;
        if (r < I1) { transpose_item(c.ev_w_out, 1024, 1024, WO0T, 0, 64 * (r / 32), 32 * (r % 32), scr, c.lane); continue; } r -= I1;
        if (r < I2) { transpose_item(c.od_w_in, 1024, ODP, W1T, 0, 64 * (r / 40), 32 * (r % 40), scr, c.lane); continue; } r -= I2;
        if (r < I3) { transpose_item(c.od_w_out, 1024, 1024, WO1T, 0, 64 * (r / 32), 32 * (r % 32), scr, c.lane); continue; } r -= I3;
        if (r < I4) { const int kind = r / 256, q = r % 256; transpose_item(c.cmp_w1 + (size_t)kind * 2048 * 256, 2048, 256, CW1T + (size_t)kind * 256 * 2048, 0, 64 * (q / 8), 32 * (q % 8), scr, c.lane); continue; } r -= I4;
        if (r < I5) { const int kind = r / 8, q = r % 8; transpose_item(c.cmp_w2 + (size_t)kind * 256 * 64, 256, 64, CW2T + (size_t)kind * 64 * 256, 0, 64 * (q / 2), 32 * (q % 2), scr, c.lane); continue; }
    }
    const int gt = blockIdx.x * NTHREADS + c.tid, ngt = gridDim.x * NTHREADS;
    float* LB = (float*)(ws + WS_LB);
    for (int i = gt; i < 512; i += ngt) { const float l0 = c.hg_lb[i], l1 = c.hg_lb[512 + i]; LB[i] = 1.f / (1.f + expf(l1 - l0)); }
    float* CB = (float*)(ws + WS_CBIAS);
    for (int i = c.gw; i < 512; i += c.ngw) {
        const int kind = i >> 8, cc = i & 255; float sacc = 0.f;
        for (int k = c.lane; k < 2048; k += 64) sacc += c.cmp_pe[kind * 2048 + k] * c.cmp_w1[((size_t)kind * 2048 + k) * 256 + cc];
        sacc = wsum(sacc);
        if (c.lane == 0) CB[i] = sacc;
    }
    bf16_t* RW = (bf16_t*)(ws + WS_RW);
    for (int i = gt; i < 2 * 48 * 1024; i += ngt) {
        const int k = i & 1023, o = (i >> 10) % 48, layer = i / (48 * 1024);
        float wv = 0.f;
        if (o < 36) wv = c.moe_norm[layer * D + k] * (o < 4 ? c.moe_w_grp[(size_t)layer * 1024 * 4 + k * 4 + o] : c.moe_w_exp[(size_t)layer * 1024 * 32 + k * 32 + (o - 4)]);
        const bf16_t hi = f2bf(wv); const bf16_t lo = f2bf(wv - bf2f(hi));
        RW[((size_t)layer * 48 + o) * 2048 + k] = hi; RW[((size_t)layer * 48 + o) * 2048 + 1024 + k] = lo;
    }
    float2* RT = (float2*)(ws + WS_ROPE);
    for (int i = gt; i < 4096 * 8; i += ngt) {
        const int pos = i >> 3, f = i & 7;
        const double inv = exp(-(double)f * 0.125 * 13.122363377404328);
        const double a = (double)pos * inv;
        const double r = a - 6.283185307179586476925 * rint(a / 6.283185307179586476925);
        const float rf = (float)r;
        RT[i] = make_float2(cosf(rf), sinf(rf));
    }
}

__device__ __forceinline__ void phase_norm_x(const Ctx& c, const float* src, const float* gain, bf16_t* H) {
    for (int m0 = 2 * c.gw; m0 < M; m0 += 2 * c.ngw) {
        float4 v[2][4];
#pragma unroll
        for (int u = 0; u < 2; ++u) { const float4* xr = (const float4*)(src + (size_t)(m0 + u) * D) + c.lane;
#pragma unroll
            for (int j = 0; j < 4; ++j) v[u][j] = xr[64 * j]; }
#pragma unroll
        for (int u = 0; u < 2; ++u) {
            float s = 0.f;
#pragma unroll
            for (int j = 0; j < 4; ++j) s += v[u][j].x * v[u][j].x + v[u][j].y * v[u][j].y + v[u][j].z * v[u][j].z + v[u][j].w * v[u][j].w;
            const float rstd = rsqrtf(wsum(s) * (1.f / D) + EPS);
            uint2* o = (uint2*)(H + (size_t)(m0 + u) * D) + c.lane;
#pragma unroll
            for (int j = 0; j < 4; ++j) {
                const float4 g = ((const float4*)gain)[c.lane + 64 * j];
                uint2 w; w.x = pk2(v[u][j].x * rstd * g.x, v[u][j].y * rstd * g.y); w.y = pk2(v[u][j].z * rstd * g.z, v[u][j].w * rstd * g.w);
                o[64 * j] = w;
            }
        }
    }
}
template <bool FINAL>
__device__ __forceinline__ void phase_combine(const Ctx& c, bf16_t* XB, float* out, const float* gain, bf16_t* H, const bf16_t* YS, int layer) {
    const float* TWp = (const float*)(c.ws + WS_TW); const int* TEp = (const int*)(c.ws + WS_TE); const int* TRp = (const int*)(c.ws + WS_TR);
    int psrow;
    { const int cnt = ((const int*)(c.ws + WS_CTL))[layer * 32 + (c.lane & 31)]; const int pc = (cnt + 255) & ~255; int incl = pc;
#pragma unroll
      for (int o = 1; o < 32; o <<= 1) { const int t_ = __shfl_up(incl, o, 32); if ((c.lane & 31) >= o) incl += t_; }
      psrow = incl - pc; }
    for (int m0 = 2 * c.gw; m0 < M; m0 += 2 * c.ngw) {
        uint2 xw[2][4], ya[2][4], yb[2][4]; float wa[2], wb[2];
#pragma unroll
        for (int u = 0; u < 2; ++u) {
            const int m = m0 + u; const int s0 = __shfl(psrow, TEp[2 * m]) + TRp[2 * m], s1 = __shfl(psrow, TEp[2 * m + 1]) + TRp[2 * m + 1]; wa[u] = TWp[2 * m]; wb[u] = TWp[2 * m + 1];
            const uint2* xr = (const uint2*)(XB + (size_t)m * D) + c.lane; const uint2* y0 = (const uint2*)(YS + (size_t)s0 * D) + c.lane; const uint2* y1 = (const uint2*)(YS + (size_t)s1 * D) + c.lane;
#pragma unroll
            for (int j = 0; j < 4; ++j) { xw[u][j] = xr[64 * j]; ya[u][j] = y0[64 * j]; yb[u][j] = y1[64 * j]; }
        }
#pragma unroll
        for (int u = 0; u < 2; ++u) {
            const int m = m0 + u;
            float4 v[4]; float s = 0.f;
#pragma unroll
            for (int j = 0; j < 4; ++j) {
                v[j].x = __uint_as_float(xw[u][j].x << 16) + wa[u] * __uint_as_float(ya[u][j].x << 16) + wb[u] * __uint_as_float(yb[u][j].x << 16);
                v[j].y = __uint_as_float(xw[u][j].x & 0xffff0000u) + wa[u] * __uint_as_float(ya[u][j].x & 0xffff0000u) + wb[u] * __uint_as_float(yb[u][j].x & 0xffff0000u);
                v[j].z = __uint_as_float(xw[u][j].y << 16) + wa[u] * __uint_as_float(ya[u][j].y << 16) + wb[u] * __uint_as_float(yb[u][j].y << 16);
                v[j].w = __uint_as_float(xw[u][j].y & 0xffff0000u) + wa[u] * __uint_as_float(ya[u][j].y & 0xffff0000u) + wb[u] * __uint_as_float(yb[u][j].y & 0xffff0000u);
                s += v[j].x * v[j].x + v[j].y * v[j].y + v[j].z * v[j].z + v[j].w * v[j].w;
            }
            if (FINAL) {
                float4* xo = (float4*)(out + (size_t)m * D) + c.lane;
#pragma unroll
                for (int j = 0; j < 4; ++j) xo[64 * j] = v[j];
            } else {
                uint2* xo = (uint2*)(XB + (size_t)m * D) + c.lane;
#pragma unroll
                for (int j = 0; j < 4; ++j) { uint2 w; w.x = pk2(v[j].x, v[j].y); w.y = pk2(v[j].z, v[j].w); xo[64 * j] = w; }
                const float rstd = rsqrtf(wsum(s) * (1.f / D) + EPS);
                uint2* o = (uint2*)(H + (size_t)m * D) + c.lane;
#pragma unroll
                for (int j = 0; j < 4; ++j) {
                    const float4 g = ((const float4*)gain)[c.lane + 64 * j];
                    uint2 w; w.x = pk2(v[j].x * rstd * g.x, v[j].y * rstd * g.y); w.y = pk2(v[j].z * rstd * g.z, v[j].w * rstd * g.w);
                    o[64 * j] = w;
                }
            }
        }
    }
}

struct ARowPlain { const bf16_t* A; int K; __device__ __forceinline__ const bf16_t* operator()(int m) const { return A + (size_t)m * K; } };
struct ARowGather { const bf16_t* A; int K; const int* idx; __device__ __forceinline__ const bf16_t* operator()(int m) const { return A + (size_t)idx[m] * K; } };
struct BRowPlain { const bf16_t* B; int K; __device__ __forceinline__ const bf16_t* operator()(int n) const { return B + (size_t)n * K; } };
struct BRowGU { const bf16_t* B; int K;
    __device__ __forceinline__ const bf16_t* operator()(int nv) const {
        const int cc = (nv >> 6) * 32 + 2 * ((nv & 63) >> 2) + (nv & 1), up = (nv >> 1) & 1;
        return B + (size_t)((cc >> 7) * 256 + (cc & 127) + up * 128) * K; } };

template <class AR, class BR, class Epi>
__device__ __forceinline__ void gemm_naive_tile(float* lds, int m0, int nv0, int K, const AR& arow, const BR& brow, const Epi& epi) {
    const int tid = threadIdx.x, ty = tid >> 4, tx = tid & 15;
    float acc[4][4];
#pragma unroll
    for (int i = 0; i < 4; ++i)
#pragma unroll
        for (int j = 0; j < 4; ++j) acc[i][j] = 0.f;
    float* As = lds; float* Bs = lds + 32 * 132;
    const int lr = tid >> 2, kq = (tid & 3) * 8;
    const bf16_t* ap = arow(m0 + lr) + kq;
    const bf16_t* bp = brow(nv0 + (lr & 63)) + kq;
    for (int k0 = 0; k0 < K; k0 += 32) {
        __syncthreads();
        { const uint4 w = *(const uint4*)(ap + k0); float f[8]; unpack8(w, f);
#pragma unroll
          for (int i = 0; i < 8; ++i) As[(kq + i) * 132 + lr] = f[i]; }
        if (tid < 256) { const uint4 w = *(const uint4*)(bp + k0); float f[8]; unpack8(w, f);
#pragma unroll
          for (int i = 0; i < 8; ++i) Bs[(kq + i) * 68 + lr] = f[i]; }
        __syncthreads();
#pragma unroll 8
        for (int k = 0; k < 32; ++k) {
            const float4 a = *(const float4*)&As[k * 132 + 4 * ty]; const float4 b = *(const float4*)&Bs[k * 68 + 4 * tx];
            acc[0][0] += a.x * b.x; acc[0][1] += a.x * b.y; acc[0][2] += a.x * b.z; acc[0][3] += a.x * b.w;
            acc[1][0] += a.y * b.x; acc[1][1] += a.y * b.y; acc[1][2] += a.y * b.z; acc[1][3] += a.y * b.w;
            acc[2][0] += a.z * b.x; acc[2][1] += a.z * b.y; acc[2][2] += a.z * b.z; acc[2][3] += a.z * b.w;
            acc[3][0] += a.w * b.x; acc[3][1] += a.w * b.y; acc[3][2] += a.w * b.z; acc[3][3] += a.w * b.w;
        }
    }
    epi.tile(m0 + 4 * ty, nv0 + 4 * tx, acc);
}

struct EpiProj0 { bf16_t* P; float* LOGF; const float* LB;
    __device__ __forceinline__ void tile(int m, int n, const float (&acc)[4][4]) const {
#pragma unroll
        for (int i = 0; i < 4; ++i)
#pragma unroll
            for (int j = 0; j < 4; ++j) {
                const int nn = n + j; const float v = acc[i][j]; const size_t mm = m + i;
                if (nn >= 512 && nn < 1024) {
                    const int cc = nn - 512; const float lb = LB[cc];
                    const float sg = 1.f / (1.f + expf(-v)), sn = 1.f / (1.f + expf(v));
                    LOGF[mm * 512 + cc] = logf(lb + (1.f - lb) * sg);
                    P[mm * EVPP + nn] = f2bf((1.f - lb) * sn);
                } else P[mm * EVPP + nn] = f2bf(v);
            }
    } };
struct EpiRaw { bf16_t* P; int ld;
    __device__ __forceinline__ void tile(int m, int n, const float (&acc)[4][4]) const {
#pragma unroll
        for (int i = 0; i < 4; ++i)
#pragma unroll
            for (int j = 0; j < 4; ++j) P[(size_t)(m + i) * ld + n + j] = f2bf(acc[i][j]);
    } };
struct EpiResid { const float* X; float* O;
    __device__ __forceinline__ void tile(int m, int n, const float (&acc)[4][4]) const {
#pragma unroll
        for (int i = 0; i < 4; ++i) { const size_t o = (size_t)(m + i) * D + n; const float4 xv = *(const float4*)(X + o);
            *(float4*)(O + o) = make_float4(xv.x + acc[i][0], xv.y + acc[i][1], xv.z + acc[i][2], xv.w + acc[i][3]); }
    } };
struct EpiGU { bf16_t* HID;
    __device__ __forceinline__ void tile(int m, int nv, const float (&acc)[4][4]) const {
        const int c0 = (nv >> 6) * 32 + 2 * ((nv & 63) >> 2);
#pragma unroll
        for (int i = 0; i < 4; ++i) {
            const float g0 = acc[i][0], g1 = acc[i][1], u0 = acc[i][2], u1 = acc[i][3];
            const float h0 = g0 / (1.f + expf(-g0)) * u0, h1 = g1 / (1.f + expf(-g1)) * u1;
            *(u32*)(HID + (size_t)(m + i) * FF + c0) = pk2(h0, h1);
        }
    } };
struct EpiDown { bf16_t* YS; const float* ROWW;
    __device__ __forceinline__ void tile(int m, int n, const float (&acc)[4][4]) const {
#pragma unroll
        for (int i = 0; i < 4; ++i) { const float w = ROWW[m + i]; uint2 o; o.x = pk2(acc[i][0] * w, acc[i][1] * w); o.y = pk2(acc[i][2] * w, acc[i][3] * w);
            *(uint2*)(YS + (size_t)(m + i) * D + n) = o; }
    } };

template <class Epi>
__device__ __forceinline__ void phase_gemm_naive(float* lds, const bf16_t* A, const bf16_t* Bt, int Npad, int K, const Epi& epi) {
    const int ntn = Npad / 64, ntiles = (M / 128) * ntn;
    ARowPlain ar{A, K}; BRowPlain br{Bt, K};
    for (int t = blockIdx.x; t < ntiles; t += gridDim.x) gemm_naive_tile(lds, (t / ntn) * 128, (t % ntn) * 64, K, ar, br, epi);
}

namespace pg8 {
#define PG8_LAS __attribute__((address_space(3)))
typedef short bf16x8 __attribute__((ext_vector_type(8)));
typedef float f32x4 __attribute__((ext_vector_type(4)));
typedef unsigned u32x4 __attribute__((ext_vector_type(4)));
constexpr int BM = 256, BK = 64, HALF = 128, HTB = HALF * BK * 2, STAGE_BYTES = 8 * HTB, NXCD = 8, WGM = 8;
__device__ __forceinline__ int lds_byte(int r, int c) { const int st = (r >> 4) * 2 + (c >> 5), rr = r & 15, cc = c & 31, ob = rr * 64 + cc * 2; return st * 1024 + (ob ^ (((ob >> 9) & 1) << 5)); }
__device__ __forceinline__ void stage_rc(int b, int& R, int& C) { const int st = b / 1024, sb = b % 1024, swz = sb ^ (((sb >> 9) & 1) << 5); R = (st >> 1) * 16 + swz / 64; C = (st & 1) * 32 + (swz % 64) / 2; }
__device__ __forceinline__ int perm32(int rho) { const int n = rho >> 4, i = rho & 15; return 8 * (i >> 2) + 4 * n + (i & 3); }
struct Unit { int pm, pn, e, nvalid, gbase; };
struct Gemm { const bf16_t* A; const bf16_t* Bt; int K; const int* gather; size_t bstride; };
struct StaticOrder {
    int nM, nN, nwg, G, c;
    __device__ __forceinline__ void init(int Mr, int N, int G_, int c_) { nM = Mr / BM; nN = N / BM; nwg = nM * nN; G = G_; c = c_; }
    __device__ __forceinline__ bool next(int i, Unit& u) const {
        const long L = (long)i * G + c; if (L >= nwg) return false;
        int wgid = (int)L; { const int q = nwg / NXCD, r = nwg % NXCD, xcd = wgid % NXCD, off = wgid / NXCD; wgid = (xcd < r ? xcd * (q + 1) : r * (q + 1) + (xcd - r) * q) + off; }
        const int nig = WGM * nN, gid = wgid / nig, fm = gid * WGM, gsz = (nM - fm) < WGM ? (nM - fm) : WGM;
        u.pm = fm + ((wgid % nig) % gsz); u.pn = (wgid % nig) / gsz; u.e = 0; u.nvalid = BM; u.gbase = 0; return true;
    }
};
struct MoeOrder {
    const int* te; const int* tv; const int* tg; int nwg, G, c;
    __device__ __forceinline__ bool next(int i, Unit& u) const {
        const long L = (long)i * G + c; if (L >= nwg) return false;
        int wgid = (int)L; { const int q = nwg / NXCD, r = nwg % NXCD, xcd = wgid % NXCD, off = wgid / NXCD; wgid = (xcd < r ? xcd * (q + 1) : r * (q + 1) + (xcd - r) * q) + off; }
        u.pm = wgid >> 2; u.pn = wgid & 3; u.e = te[u.pm]; u.nvalid = tv[u.pm]; u.gbase = tg[u.pm]; return true;
    }
};
__device__ __forceinline__ unsigned cvt_pk_bf16(float lo, float hi) { unsigned r; asm volatile("v_cvt_pk_bf16_f32 %0, %1, %2" : "=v"(r) : "v"(lo), "v"(hi)); return r; }

struct EpiRawT { static constexpr bool PERM = true; bf16_t* O; int ldc;
    __device__ __forceinline__ void operator()(const f32x4 (&acc)[2][2][4][2], const Unit& u, int wr, int wc, int fr, int fq) const {
        const int row0 = u.pm * BM + wr * 64 + fr, col0 = u.pn * BM + wc * 32 + 8 * fq;
#pragma unroll
        for (int ai = 0; ai < 2; ++ai)
#pragma unroll
            for (int m = 0; m < 4; ++m) { bf16_t* rowp = O + (size_t)(row0 + ai * HALF + m * 16) * ldc + col0;
#pragma unroll
                for (int bj = 0; bj < 2; ++bj) { const f32x4 v0 = acc[ai][bj][m][0], v1 = acc[ai][bj][m][1]; u32x4 w;
                    w.x = cvt_pk_bf16(v0[0], v0[1]); w.y = cvt_pk_bf16(v0[2], v0[3]); w.z = cvt_pk_bf16(v1[0], v1[1]); w.w = cvt_pk_bf16(v1[2], v1[3]);
                    *(u32x4*)(rowp + bj * HALF) = w; } }
    } };
struct EpiProj0T { static constexpr bool PERM = true; bf16_t* O; float* LOGF; const float* LB;
    __device__ __forceinline__ void operator()(const f32x4 (&acc)[2][2][4][2], const Unit& u, int wr, int wc, int fr, int fq) const {
        const int row0 = u.pm * BM + wr * 64 + fr, col0 = u.pn * BM + wc * 32 + 8 * fq;
        const bool isf = (u.pn == 2 || u.pn == 3);
#pragma unroll
        for (int ai = 0; ai < 2; ++ai)
#pragma unroll
            for (int m = 0; m < 4; ++m) { const size_t r = (size_t)(row0 + ai * HALF + m * 16); bf16_t* rowp = O + r * EVPP + col0;
#pragma unroll
                for (int bj = 0; bj < 2; ++bj) { f32x4 v0 = acc[ai][bj][m][0], v1 = acc[ai][bj][m][1];
                    if (isf) {
                        const int cc = col0 + bj * HALF - 512; const f32x4 lb0 = *(const f32x4*)(LB + cc), lb1 = *(const f32x4*)(LB + cc + 4);
                        f32x4 lf0, lf1;
#pragma unroll
                        for (int j = 0; j < 4; ++j) {
                            { const float z = v0[j], lb = lb0[j], sg = 1.f / (1.f + __expf(-z)), sn = 1.f / (1.f + __expf(z)); lf0[j] = __logf(lb + (1.f - lb) * sg); v0[j] = (1.f - lb) * sn; }
                            { const float z = v1[j], lb = lb1[j], sg = 1.f / (1.f + __expf(-z)), sn = 1.f / (1.f + __expf(z)); lf1[j] = __logf(lb + (1.f - lb) * sg); v1[j] = (1.f - lb) * sn; }
                        }
                        *(f32x4*)(LOGF + r * 512 + cc) = lf0; *(f32x4*)(LOGF + r * 512 + cc + 4) = lf1;
                    }
                    u32x4 w; w.x = cvt_pk_bf16(v0[0], v0[1]); w.y = cvt_pk_bf16(v0[2], v0[3]); w.z = cvt_pk_bf16(v1[0], v1[1]); w.w = cvt_pk_bf16(v1[2], v1[3]);
                    *(u32x4*)(rowp + bj * HALF) = w; } }
    } };
struct EpiResidT { static constexpr bool PERM = false; const float* X; float* O;
    __device__ __forceinline__ void operator()(const f32x4 (&acc)[2][2][4][2], const Unit& u, int wr, int wc, int fr, int fq) const {
        const int row0 = u.pm * BM + wr * 64 + fr, col0 = u.pn * BM + wc * 32 + 4 * fq;
#pragma unroll
        for (int ai = 0; ai < 2; ++ai)
#pragma unroll
            for (int m = 0; m < 4; ++m) { const size_t off = (size_t)(row0 + ai * HALF + m * 16) * D + col0;
#pragma unroll
                for (int bj = 0; bj < 2; ++bj)
#pragma unroll
                    for (int n = 0; n < 2; ++n) { const f32x4 xv = *(const f32x4*)(X + off + bj * HALF + n * 16); *(f32x4*)(O + off + bj * HALF + n * 16) = xv + acc[ai][bj][m][n]; } }
    } };
struct EpiResidF2B { static constexpr bool PERM = true; const float* X; bf16_t* O;
    __device__ __forceinline__ void operator()(const f32x4 (&acc)[2][2][4][2], const Unit& u, int wr, int wc, int fr, int fq) const {
        const int row0 = u.pm * BM + wr * 64 + fr, col0 = u.pn * BM + wc * 32 + 8 * fq;
#pragma unroll
        for (int ai = 0; ai < 2; ++ai)
#pragma unroll
            for (int m = 0; m < 4; ++m) { const size_t off = (size_t)(row0 + ai * HALF + m * 16) * D + col0;
#pragma unroll
                for (int bj = 0; bj < 2; ++bj) { const f32x4 x0 = *(const f32x4*)(X + off + bj * HALF), x1 = *(const f32x4*)(X + off + bj * HALF + 4);
                    const f32x4 v0 = x0 + acc[ai][bj][m][0], v1 = x1 + acc[ai][bj][m][1]; u32x4 w;
                    w.x = cvt_pk_bf16(v0[0], v0[1]); w.y = cvt_pk_bf16(v0[2], v0[3]); w.z = cvt_pk_bf16(v1[0], v1[1]); w.w = cvt_pk_bf16(v1[2], v1[3]);
                    *(u32x4*)(O + off + bj * HALF) = w; } }
    } };
struct EpiResidB2B { static constexpr bool PERM = true; bf16_t* XO;
    __device__ __forceinline__ void operator()(const f32x4 (&acc)[2][2][4][2], const Unit& u, int wr, int wc, int fr, int fq) const {
        const int row0 = u.pm * BM + wr * 64 + fr, col0 = u.pn * BM + wc * 32 + 8 * fq;
#pragma unroll
        for (int ai = 0; ai < 2; ++ai)
#pragma unroll
            for (int m = 0; m < 4; ++m) { const size_t off = (size_t)(row0 + ai * HALF + m * 16) * D + col0;
#pragma unroll
                for (int bj = 0; bj < 2; ++bj) { const u32x4 xw = *(const u32x4*)(XO + off + bj * HALF);
                    const f32x4 a0 = acc[ai][bj][m][0], a1 = acc[ai][bj][m][1]; u32x4 w;
                    w.x = cvt_pk_bf16(__uint_as_float(xw.x << 16) + a0[0], __uint_as_float(xw.x & 0xffff0000u) + a0[1]); w.y = cvt_pk_bf16(__uint_as_float(xw.y << 16) + a0[2], __uint_as_float(xw.y & 0xffff0000u) + a0[3]);
                    w.z = cvt_pk_bf16(__uint_as_float(xw.z << 16) + a1[0], __uint_as_float(xw.z & 0xffff0000u) + a1[1]); w.w = cvt_pk_bf16(__uint_as_float(xw.w << 16) + a1[2], __uint_as_float(xw.w & 0xffff0000u) + a1[3]);
                    *(u32x4*)(XO + off + bj * HALF) = w; } }
    } };
struct EpiGUT { static constexpr bool PERM = true; bf16_t* HID;
    __device__ __forceinline__ void operator()(const f32x4 (&acc)[2][2][4][2], const Unit& u, int wr, int wc, int fr, int fq) const {
        const int row0 = u.pm * BM + wr * 64 + fr, col0 = u.pn * HALF + wc * 32 + 8 * fq;
#pragma unroll
        for (int ai = 0; ai < 2; ++ai)
#pragma unroll
            for (int m = 0; m < 4; ++m) { bf16_t* rowp = HID + (size_t)(row0 + ai * HALF + m * 16) * FF + col0; float h[8];
#pragma unroll
                for (int n = 0; n < 2; ++n)
#pragma unroll
                    for (int j = 0; j < 4; ++j) { const float g = acc[ai][0][m][n][j], uu = acc[ai][1][m][n][j]; h[4 * n + j] = g / (1.f + __expf(-g)) * uu; }
                u32x4 w; w.x = cvt_pk_bf16(h[0], h[1]); w.y = cvt_pk_bf16(h[2], h[3]); w.z = cvt_pk_bf16(h[4], h[5]); w.w = cvt_pk_bf16(h[6], h[7]);
                *(u32x4*)rowp = w; }
    } };
struct EpiDownT { static constexpr bool PERM = true; bf16_t* YS;
    __device__ __forceinline__ void operator()(const f32x4 (&acc)[2][2][4][2], const Unit& u, int wr, int wc, int fr, int fq) const {
        const int row0 = u.pm * BM + wr * 64 + fr, col0 = u.pn * BM + wc * 32 + 8 * fq;
#pragma unroll
        for (int ai = 0; ai < 2; ++ai)
#pragma unroll
            for (int m = 0; m < 4; ++m) { bf16_t* rowp = YS + (size_t)(row0 + ai * HALF + m * 16) * D + col0;
#pragma unroll
                for (int bj = 0; bj < 2; ++bj) { const f32x4 v0 = acc[ai][bj][m][0], v1 = acc[ai][bj][m][1]; u32x4 w;
                    w.x = cvt_pk_bf16(v0[0], v0[1]); w.y = cvt_pk_bf16(v0[2], v0[3]); w.z = cvt_pk_bf16(v1[0], v1[1]); w.w = cvt_pk_bf16(v1[2], v1[3]);
                    *(u32x4*)(rowp + bj * HALF) = w; } }
    } };

template <class Epi, class Sched, bool GATHER>
__device__ __forceinline__ void gemm_phase(PG8_LAS unsigned char* lds, const Gemm g, const Sched& S, const Epi& E) {
    int tid_o = threadIdx.x; asm volatile("" : "+v"(tid_o));
    const int tid = tid_o, wid = __builtin_amdgcn_readfirstlane(tid >> 6), lane = tid & 63, wr = wid >> 2, wc = wid & 3, fr = lane & 15, fq = lane >> 4;
    const int K = g.K, nt = K / BK;
    int stR[2], stC[2]; unsigned voffB[2];
#pragma unroll
    for (int i = 0; i < 2; ++i) { int R, C; stage_rc(tid * 16 + i * 8192, R, C); const int Rb = Epi::PERM ? ((R & ~31) + perm32(R & 31)) : R; stR[i] = R; stC[i] = C; voffB[i] = (unsigned)(Rb * K + C) * 2u; }
    const size_t kstep = (size_t)(BK * 2);
    const size_t hstep = (size_t)HALF * K * 2;
    const size_t tstep = 2 * hstep;
    const unsigned ldsw = (unsigned)wid * 1024u;
    const int aoff = lds_byte(wr * 64 + fr, fq * 8), boff = lds_byte(wc * 32 + fr, fq * 8);
#define PG8_SA(b, h) (((b) * 2 + (h)) * HTB)
#define PG8_SB(b, h) ((4 + (b) * 2 + (h)) * HTB)
#define PG8_STAGE(bufoff, gbase, voff) do { _Pragma("unroll") for (int _i = 0; _i < 2; ++_i) \
        __builtin_amdgcn_global_load_lds((const unsigned*)((const char*)(gbase) + (voff)[_i]), (PG8_LAS unsigned*)(lds + (bufoff) + ldsw + _i * 8192), 16, 0, 0); } while (0)
#define PG8_LDA(dst, b, h) do { _Pragma("unroll") for (int m = 0; m < 4; ++m) _Pragma("unroll") for (int k = 0; k < 2; ++k) dst[m][k] = *(const PG8_LAS bf16x8*)(lds + PG8_SA(b, h) + aoff + m * 2048 + k * 1024); } while (0)
#define PG8_LDB(dst, b, h) do { _Pragma("unroll") for (int n = 0; n < 2; ++n) _Pragma("unroll") for (int k = 0; k < 2; ++k) dst[n][k] = *(const PG8_LAS bf16x8*)(lds + PG8_SB(b, h) + boff + n * 2048 + k * 1024); } while (0)
#define PG8_MMA(ai, bj, At, Bt) do { __builtin_amdgcn_s_setprio(1); _Pragma("unroll") for (int m = 0; m < 4; ++m) _Pragma("unroll") for (int n = 0; n < 2; ++n) _Pragma("unroll") for (int k = 0; k < 2; ++k) \
        acc[ai][bj][m][n] = __builtin_amdgcn_mfma_f32_16x16x32_bf16(Bt[n][k], At[m][k], acc[ai][bj][m][n], 0, 0, 0); __builtin_amdgcn_s_setprio(0); } while (0)
#define PG8_WAIT_V(n) asm volatile("s_waitcnt vmcnt(" #n ")" ::: "memory")
#define PG8_WAIT_L(n) asm volatile("s_waitcnt lgkmcnt(" #n ")" ::: "memory")
#define PG8_BAR __builtin_amdgcn_s_barrier()
#define PG8_SCHED __builtin_amdgcn_sched_barrier(0)
#define PG8_OFFS(dst, u) do { _Pragma("unroll") for (int _h = 0; _h < 2; ++_h) _Pragma("unroll") for (int _i = 0; _i < 2; ++_i) { \
        int _row = (u).pm * BM + _h * HALF + stR[_i]; if (GATHER) { const int _lr = _h * HALF + stR[_i]; _row = _lr < (u).nvalid ? g.gather[(u).gbase + _lr] : 0; } dst[_h][_i] = (unsigned)(_row * K + stC[_i]) * 2u; } } while (0)
    Unit cur, nxt; int ui = 0;
    if (!S.next(0, cur)) return;
    f32x4 acc[2][2][4][2];
#pragma unroll
    for (int a = 0; a < 2; ++a)
#pragma unroll
        for (int b = 0; b < 2; ++b)
#pragma unroll
            for (int m = 0; m < 4; ++m)
#pragma unroll
                for (int n = 0; n < 2; ++n) acc[a][b][m][n] = (f32x4){0.f, 0.f, 0.f, 0.f};
    bf16x8 At[4][2], B0[2][2], B1[2][2];
    unsigned offC[2][2], offN[2][2];
    PG8_OFFS(offC, cur);
    const char* const A0 = (const char*)g.A;
    const char* cB = (const char*)g.Bt + ((size_t)cur.e * g.bstride) * 2 + (size_t)cur.pn * tstep;
    PG8_STAGE(PG8_SB(0, 0), cB, voffB); PG8_STAGE(PG8_SB(0, 1), cB + hstep, voffB); PG8_STAGE(PG8_SA(0, 0), A0, offC[0]); PG8_STAGE(PG8_SA(0, 1), A0, offC[1]);
    if (wr == 1) PG8_BAR;
    PG8_WAIT_V(2); PG8_BAR;
    PG8_STAGE(PG8_SB(1, 0), cB + kstep, voffB); PG8_STAGE(PG8_SA(1, 0), A0 + kstep, offC[0]); PG8_STAGE(PG8_SB(1, 1), cB + hstep + kstep, voffB);
    PG8_WAIT_V(6); PG8_BAR;
    for (;;) {
        const bool has_next = S.next(ui + 1, nxt);
        const char* nB = cB;
        if (has_next) { PG8_OFFS(offN, nxt); nB = (const char*)g.Bt + ((size_t)nxt.e * g.bstride) * 2 + (size_t)nxt.pn * tstep; }
        else {
#pragma unroll
            for (int _h = 0; _h < 2; ++_h)
#pragma unroll
                for (int _i = 0; _i < 2; ++_i) offN[_h][_i] = offC[_h][_i];
        }
        for (int t = 0; t < nt; t += 2) {
            const bool last = (t == nt - 2);
            const char* a1 = A0 + (size_t)(t + 1) * kstep;
            const char* a2 = A0 + (last ? (size_t)0 : (size_t)(t + 2) * kstep); const char* b2 = last ? nB : cB + (size_t)(t + 2) * kstep;
            const char* a3 = a2 + kstep; const char* b3 = b2 + kstep;
            unsigned off2[2][2];
            if (last) {
#pragma unroll
                for (int _h = 0; _h < 2; ++_h)
#pragma unroll
                    for (int _i = 0; _i < 2; ++_i) off2[_h][_i] = offN[_h][_i];
            } else {
#pragma unroll
                for (int _h = 0; _h < 2; ++_h)
#pragma unroll
                    for (int _i = 0; _i < 2; ++_i) off2[_h][_i] = offC[_h][_i];
            }
            PG8_LDB(B0, 0, 0); PG8_LDB(B1, 0, 1); PG8_SCHED; PG8_LDA(At, 0, 0); PG8_STAGE(PG8_SA(1, 1), a1, offC[1]);
            PG8_WAIT_V(8); PG8_WAIT_L(0); PG8_BAR; PG8_MMA(0, 0, At, B0); PG8_MMA(0, 1, At, B1); PG8_BAR; PG8_SCHED;
            PG8_LDA(At, 0, 1); PG8_STAGE(PG8_SB(0, 0), b2, voffB); PG8_STAGE(PG8_SB(0, 1), b2 + hstep, voffB); PG8_STAGE(PG8_SA(0, 0), a2, off2[0]);
            PG8_WAIT_V(8); PG8_WAIT_L(0); PG8_BAR; PG8_MMA(1, 0, At, B0); PG8_MMA(1, 1, At, B1); PG8_BAR; PG8_SCHED;
            PG8_LDB(B0, 1, 0); PG8_LDB(B1, 1, 1); PG8_SCHED; PG8_LDA(At, 1, 0); PG8_STAGE(PG8_SA(0, 1), a2, off2[1]);
            PG8_WAIT_V(8); PG8_WAIT_L(0); PG8_BAR; PG8_MMA(0, 0, At, B0); PG8_MMA(0, 1, At, B1); PG8_BAR; PG8_SCHED;
            PG8_LDA(At, 1, 1); PG8_STAGE(PG8_SB(1, 0), b3, voffB); PG8_STAGE(PG8_SB(1, 1), b3 + hstep, voffB); PG8_STAGE(PG8_SA(1, 0), a3, off2[0]);
            PG8_WAIT_V(8); PG8_WAIT_L(0); PG8_BAR; PG8_MMA(1, 0, At, B0); PG8_MMA(1, 1, At, B1); PG8_BAR; PG8_SCHED;
        }
        if (wr == 0) PG8_BAR;
        E(acc, cur, wr, wc, fr, fq);
        if (!has_next) break;
#pragma unroll
        for (int a = 0; a < 2; ++a)
#pragma unroll
            for (int b = 0; b < 2; ++b)
#pragma unroll
                for (int m = 0; m < 4; ++m)
#pragma unroll
                    for (int n = 0; n < 2; ++n) acc[a][b][m][n] = (f32x4){0.f, 0.f, 0.f, 0.f};
        cur = nxt; cB = nB; ++ui;
#pragma unroll
        for (int _h = 0; _h < 2; ++_h)
#pragma unroll
            for (int _i = 0; _i < 2; ++_i) offC[_h][_i] = offN[_h][_i];
        if (wr == 1) PG8_BAR;
    }
    PG8_WAIT_V(0);
    PG8_BAR;
#undef PG8_SA
#undef PG8_SB
#undef PG8_STAGE
#undef PG8_LDA
#undef PG8_LDB
#undef PG8_MMA
#undef PG8_WAIT_V
#undef PG8_WAIT_L
#undef PG8_BAR
#undef PG8_SCHED
#undef PG8_OFFS
}
}

__device__ __forceinline__ void normrope64(bf16_t* p, const float* gain, const float2* rt  ) {
    uint4 w[8]; float f[64];
#pragma unroll
    for (int i = 0; i < 8; ++i) { w[i] = ((const uint4*)p)[i]; unpack8(w[i], f + 8 * i); }
    float s = 0.f;
#pragma unroll
    for (int i = 0; i < 64; ++i) s += f[i] * f[i];
    const float rstd = rsqrtf(s * (1.f / 64.f) + EPS);
#pragma unroll
    for (int i = 0; i < 64; ++i) f[i] = f[i] * rstd * gain[i];
#pragma unroll
    for (int i = 0; i < 8; ++i) { const float2 cs = rt[i]; const float x1 = f[i], x2 = f[8 + i]; f[i] = x1 * cs.x - x2 * cs.y; f[8 + i] = x2 * cs.x + x1 * cs.y; }
#pragma unroll
    for (int i = 0; i < 8; ++i) { uint4 o; o.x = pk2(f[8 * i], f[8 * i + 1]); o.y = pk2(f[8 * i + 2], f[8 * i + 3]); o.z = pk2(f[8 * i + 4], f[8 * i + 5]); o.w = pk2(f[8 * i + 6], f[8 * i + 7]); ((uint4*)p)[i] = o; }
}

__device__ __forceinline__ void post_even(const Ctx& c, int vb, int nvb) {
    bf16_t* P = (bf16_t*)(c.ws + WS_PROJ); const float2* RT = (const float2*)(c.ws + WS_ROPE);
    const long total = (long)M * 4;
    for (long it = (long)vb * NTHREADS + c.tid; it < total; it += (long)nvb * NTHREADS) {
        const int m = (int)(it >> 2), s = (int)(it & 3); const int pos = m & (SEQ - 1);
        int col; const float* gain;
        if (s < 2) { col = 2816 + 64 * s; gain = c.nsa_kg + 64; }
        else { col = 3072 + 64 * (s - 2); gain = c.nsa_kg + 128; }
        normrope64(P + (size_t)m * EVPP + col, gain, RT + pos * 8);
    }
}
__device__ __forceinline__ void post_odd(const Ctx& c) {
    bf16_t* P = (bf16_t*)(c.ws + WS_PROJ); const float2* RT = (const float2*)(c.ws + WS_ROPE);
    const long total = (long)M * 18;
    for (long it = (long)blockIdx.x * NTHREADS + c.tid; it < total; it += (long)gridDim.x * NTHREADS) {
        const int m = (int)(it / 18), s = (int)(it % 18); const int pos = m & (SEQ - 1);
        normrope64(P + (size_t)m * ODP + 64 * s, s < 16 ? c.swa_qg : c.swa_kg, RT + pos * 8);
    }
}

__device__ __forceinline__ float gelu_tanh(float x) { const float u = 0.7978845608028654f * (x + 0.044715f * x * x * x); return 0.5f * x * (1.f + tanhf(u)); }

__device__ __forceinline__ void compress_naive(const Ctx& c, float* lds, int vb, int nvb) {
    const bf16_t* P = (const bf16_t*)(c.ws + WS_PROJ);
    const bf16_t* CW1T = (const bf16_t*)(c.ws + WS_CW1T); const bf16_t* CW2T = (const bf16_t*)(c.ws + WS_CW2T);
    const float* CB = (const float*)(c.ws + WS_CBIAS); const float2* RT = (const float2*)(c.ws + WS_ROPE);
    bf16_t* KCB = (bf16_t*)(c.ws + WS_KCB); bf16_t* VCB = (bf16_t*)(c.ws + WS_VCB);
    float* Xs = lds; float* hs = lds + 4096; float* os = lds + 4096 + 512;
    const int tid = c.tid, rs = tid >> 8, cc = tid & 255;
    constexpr int NROWS = 2 * 16 * 2 * 255;
    for (int rp = vb; rp < NROWS / 2; rp += nvb) {
        __syncthreads();
        for (int e = tid; e < 4096; e += NTHREADS) {
            const int r2 = e >> 11, k = e & 2047, row = 2 * rp + r2;
            const int n = row % 255, q = row / 255, g = q & 1, b = (q >> 1) & 15, kind = q >> 5;
            Xs[e] = bf2f(P[(size_t)(b * SEQ + 16 * n + (k >> 6)) * EVPP + 2560 + kind * 128 + g * 64 + (k & 63)]);
        }
        __syncthreads();
        const int row = 2 * rp + rs;
        const int n = row % 255, q = row / 255, g = q & 1, b = (q >> 1) & 15, kind = q >> 5;
        {
            float hv = CB[kind * 256 + cc];
            const bf16_t* w = CW1T + ((size_t)kind * 256 + cc) * 2048; const float* xs = Xs + rs * 2048;
            for (int k = 0; k < 2048; k += 8) { const uint4 ww = *(const uint4*)(w + k); float f[8]; unpack8(ww, f);
#pragma unroll
                for (int i = 0; i < 8; ++i) hv += xs[k + i] * f[i]; }
            hs[rs * 256 + cc] = bf2f(f2bf(gelu_tanh(hv)));
        }
        __syncthreads();
        float o = 0.f;
        if (cc < 64) {
            const bf16_t* w = CW2T + ((size_t)kind * 64 + cc) * 256;
            for (int k = 0; k < 256; ++k) o += hs[rs * 256 + k] * bf2f(w[k]);
            os[rs * 64 + cc] = o;
        }
        __syncthreads();
        if (cc < 64) {
            const size_t dst = ((size_t)((b * 2 + g) * 256 + n)) * 64 + cc;
            if (kind == 0) {
                float s = 0.f;
                for (int k = 0; k < 64; ++k) s += os[rs * 64 + k] * os[rs * 64 + k];
                const float rstd = rsqrtf(s * (1.f / 64.f) + EPS);
                const float* gain = c.nsa_kg;
                float y = o * rstd * gain[cc];
                if (cc < 16) {
                    const int pc = cc < 8 ? cc + 8 : cc - 8; const float yp = os[rs * 64 + pc] * rstd * gain[pc];
                    const float2 cs = RT[(16 * n + 31) * 8 + (cc & 7)];
                    y = cc < 8 ? y * cs.x - yp * cs.y : y * cs.x + yp * cs.y;
                }
                KCB[dst] = f2bf(y);
            } else VCB[dst] = f2bf(o);
        }
    }
    for (int i = vb * NTHREADS + tid; i < 32 * 64; i += nvb * NTHREADS) { const size_t dst = ((size_t)((i >> 6) * 256 + 255)) * 64 + (i & 63); KCB[dst] = 0; VCB[dst] = 0; }
}

__device__ __forceinline__ void compress_mfma(const Ctx& c, unsigned char* lds, int unit) {
    typedef short bf16x8 __attribute__((ext_vector_type(8)));
    typedef float f32x4 __attribute__((ext_vector_type(4)));
    const int kind = unit >> 7, b = (unit >> 3) & 15, g = (unit >> 2) & 1, n0 = (unit & 3) * 64;
    const bf16_t* P = (const bf16_t*)(c.ws + WS_PROJ);
    const bf16_t* W1 = (const bf16_t*)(c.ws + WS_CW1T) + (size_t)kind * 256 * 2048; const bf16_t* W2 = (const bf16_t*)(c.ws + WS_CW2T) + (size_t)kind * 64 * 256;
    const float* CB = (const float*)(c.ws + WS_CBIAS) + kind * 256; const float2* RT = (const float2*)(c.ws + WS_ROPE);
    bf16_t* OUTB = (bf16_t*)(c.ws + (kind == 0 ? WS_KCB : WS_VCB)) + (size_t)((b * 2 + g) * 256) * 64;
    const int tid = c.tid, lane = c.lane, w = c.wave, l15 = lane & 15, g4 = lane >> 4;
    constexpr int HP = 264;
    bf16_t* HS = (bf16_t*)lds; float* OS = (float*)(lds + 64 * HP * 2);
    __syncthreads();
    f32x4 acc[4][2];
#pragma unroll
    for (int mt = 0; mt < 4; ++mt) { acc[mt][0] = (f32x4){0.f, 0.f, 0.f, 0.f}; acc[mt][1] = (f32x4){0.f, 0.f, 0.f, 0.f}; }
    const bf16_t* xb[4];
#pragma unroll
    for (int mt = 0; mt < 4; ++mt) { int n = n0 + 16 * mt + l15; if (n > 254) n = 254; xb[mt] = P + ((size_t)b * SEQ + 16 * n) * EVPP + 2560 + kind * 128 + g * 64 + 8 * (g4 & 1); }
    const bf16_t* wb0 = W1 + (size_t)(32 * w + l15) * 2048 + 8 * g4; const bf16_t* wb1 = wb0 + (size_t)16 * 2048;
#pragma unroll 4
    for (int ks = 0; ks < 64; ++ks) {
        const size_t xo = (size_t)(ks >> 1) * EVPP + 32 * (ks & 1) + 16 * (g4 >> 1);
        const bf16x8 b0 = *(const bf16x8*)(wb0 + 32 * ks), b1 = *(const bf16x8*)(wb1 + 32 * ks);
#pragma unroll
        for (int mt = 0; mt < 4; ++mt) {
            const bf16x8 af = *(const bf16x8*)(xb[mt] + xo);
            acc[mt][0] = __builtin_amdgcn_mfma_f32_16x16x32_bf16(af, b0, acc[mt][0], 0, 0, 0);
            acc[mt][1] = __builtin_amdgcn_mfma_f32_16x16x32_bf16(af, b1, acc[mt][1], 0, 0, 0);
        }
    }
#pragma unroll
    for (int mt = 0; mt < 4; ++mt)
#pragma unroll
        for (int nt = 0; nt < 2; ++nt) { const int cc = 32 * w + 16 * nt + l15; const float bias = CB[cc];
#pragma unroll
            for (int r = 0; r < 4; ++r) HS[(16 * mt + 4 * g4 + r) * HP + cc] = f2bf(gelu_tanh(acc[mt][nt][r] + bias)); }
    __syncthreads();
    {
        const int mt = w >> 1, nt0 = 2 * (w & 1);
        f32x4 o0 = {0.f, 0.f, 0.f, 0.f}, o1 = {0.f, 0.f, 0.f, 0.f};
        const bf16_t* ar = HS + (16 * mt + l15) * HP + 8 * g4;
        const bf16_t* br0 = W2 + (size_t)(16 * nt0 + l15) * 256 + 8 * g4; const bf16_t* br1 = br0 + 16 * 256;
#pragma unroll
        for (int ks = 0; ks < 8; ++ks) {
            const bf16x8 af = *(const bf16x8*)(ar + 32 * ks);
            o0 = __builtin_amdgcn_mfma_f32_16x16x32_bf16(af, *(const bf16x8*)(br0 + 32 * ks), o0, 0, 0, 0);
            o1 = __builtin_amdgcn_mfma_f32_16x16x32_bf16(af, *(const bf16x8*)(br1 + 32 * ks), o1, 0, 0, 0);
        }
#pragma unroll
        for (int r = 0; r < 4; ++r) { OS[(16 * mt + 4 * g4 + r) * 68 + 16 * nt0 + l15] = o0[r]; OS[(16 * mt + 4 * g4 + r) * 68 + 16 * nt0 + 16 + l15] = o1[r]; }
    }
    __syncthreads();
    {
        const int row = tid >> 3, sub = tid & 7, n = n0 + row;
        float v[8];
#pragma unroll
        for (int j = 0; j < 8; ++j) v[j] = OS[row * 68 + 8 * sub + j];
        if (kind == 0) {
            float sq = 0.f;
#pragma unroll
            for (int j = 0; j < 8; ++j) sq += v[j] * v[j];
            sq += __shfl_xor(sq, 1); sq += __shfl_xor(sq, 2); sq += __shfl_xor(sq, 4);
            const float rstd = rsqrtf(sq * (1.f / 64.f) + EPS);
#pragma unroll
            for (int j = 0; j < 8; ++j) v[j] = v[j] * rstd * c.nsa_kg[8 * sub + j];
            const int pos = (16 * n + 31) & (SEQ - 1);
#pragma unroll
            for (int j = 0; j < 8; ++j) {
                const float other = __shfl_xor(v[j], 1);
                const float2 cs = RT[pos * 8 + j];
                if (sub == 0) v[j] = v[j] * cs.x - other * cs.y; else if (sub == 1) v[j] = v[j] * cs.x + other * cs.y;
            }
        }
        uint4 o; o.x = pk2(v[0], v[1]); o.y = pk2(v[2], v[3]); o.z = pk2(v[4], v[5]); o.w = pk2(v[6], v[7]);
        if (n > 254) { o.x = 0u; o.y = 0u; o.z = 0u; o.w = 0u; }
        *(uint4*)(OUTB + (size_t)n * 64 + 8 * sub) = o;
    }
}

__device__ __forceinline__ void hgrn2_naive(const Ctx& c, int vb) {
    bf16_t* P = (bf16_t*)(c.ws + WS_PROJ); const float* LOGF = (const float*)(c.ws + WS_LOGF);
    const int id = vb * NTHREADS + c.tid;
    const int half = id & 1, v = (id >> 1) & 127, h = (id >> 8) & 3, b = id >> 10;
    float S[64];
#pragma unroll
    for (int d = 0; d < 64; ++d) S[d] = 0.f;
    for (int t = 0; t < SEQ; ++t) {
        const size_t m = (size_t)b * SEQ + t;
        bf16_t* row = P + m * EVPP; const float* lf = LOGF + m * 512 + h * 128 + half * 64;
        const float vv = bf2f(row[1024 + h * 128 + v]);
        float o = 0.f;
#pragma unroll
        for (int d8 = 0; d8 < 8; ++d8) {
            const uint4 qw = *(const uint4*)(row + h * 128 + half * 64 + 8 * d8); const uint4 kw = *(const uint4*)(row + 512 + h * 128 + half * 64 + 8 * d8);
            const float4 l0 = *(const float4*)(lf + 8 * d8), l1 = *(const float4*)(lf + 8 * d8 + 4);
            float qf[8], kf[8]; unpack8(qw, qf); unpack8(kw, kf);
            const float lfv[8] = {l0.x, l0.y, l0.z, l0.w, l1.x, l1.y, l1.z, l1.w};
#pragma unroll
            for (int i = 0; i < 8; ++i) { const int d = 8 * d8 + i; S[d] = __expf(lfv[i]) * S[d] + kf[i] * vv; o += qf[i] * S[d]; }
        }
        o += __shfl_xor(o, 1);
        asm volatile("" ::: "memory");
        if (half == 0) row[1024 + h * 128 + v] = f2bf(o);
    }
}

namespace hg {
typedef short bf16x8 __attribute__((ext_vector_type(8)));
typedef float f32x4 __attribute__((ext_vector_type(4)));
constexpr int PQ = 136, PS = 72;
constexpr int O_QS = 0, O_QD = O_QS + 64 * PQ * 2, O_KD = O_QD + 64 * PQ * 2, O_KK = O_KD + 64 * PQ * 2, O_QO = O_KK + 48 * PQ * 2, O_KST = O_QO + 96 * PQ * 2,
              O_VT = O_KST + 128 * PS * 2, O_STT = O_VT + 32 * PS * 2, O_TSH = O_STT + 32 * PQ * 2, O_END = O_TSH + 4 * 128 * 4;
static_assert(O_END <= 160 * 1024, "hgrn2 LDS");
__device__ __forceinline__ bf16x8 pack8(float a0, float a1, float a2, float a3, float a4, float a5, float a6, float a7) {
    uint4 w; w.x = pk2(a0, a1); w.y = pk2(a2, a3); w.z = pk2(a4, a5); w.w = pk2(a6, a7); return __builtin_bit_cast(bf16x8, w); }
__device__ __forceinline__ float cexp(float x) { return __expf(fminf(fmaxf(x, -80.f), 80.f)); }
}
__device__ __forceinline__ void hgrn2_chunk(const Ctx& c, unsigned char* lds_raw, int unit) {
    using namespace hg;
    const int vs = unit & 3, h = (unit >> 2) & 3, b = unit >> 4;
    bf16_t* P = (bf16_t*)(c.ws + WS_PROJ); const float* LOGF = (const float*)(c.ws + WS_LOGF);
    bf16_t* QS = (bf16_t*)(lds_raw + O_QS); bf16_t* QD = (bf16_t*)(lds_raw + O_QD); bf16_t* KD = (bf16_t*)(lds_raw + O_KD); bf16_t* KK = (bf16_t*)(lds_raw + O_KK);
    bf16_t* QO = (bf16_t*)(lds_raw + O_QO); bf16_t* KST = (bf16_t*)(lds_raw + O_KST); bf16_t* VT = (bf16_t*)(lds_raw + O_VT); bf16_t* STT = (bf16_t*)(lds_raw + O_STT);
    float* TSH = (float*)(lds_raw + O_TSH);
    const int tid = c.tid, lane = c.lane, w = c.wave;
    const int i = w >> 1, hf = w & 1, d = 2 * lane;
    const int tt = w >> 1, vvt = w & 1, g4 = lane >> 4, l15 = lane & 15;
    const int dt0 = 2 * (w >> 1), dt1 = dt0 + 1;
    __syncthreads();
    for (int x = tid; x < 32 * PQ / 2; x += NTHREADS) ((u32*)STT)[x] = 0u;
    f32x4 st0 = {0.f, 0.f, 0.f, 0.f}, st1 = {0.f, 0.f, 0.f, 0.f};
    const size_t rowbase = (size_t)b * SEQ;
    const bf16_t* qp = P + (rowbase + 16 * i + 8 * hf) * EVPP + h * 128 + d;
    const float* lp = LOGF + (rowbase + 16 * i + 8 * hf) * 512 + h * 128 + d;
    const int vrow = tid >> 3, vc4 = (tid & 7) * 4;
    const bf16_t* vp = P + (rowbase + vrow) * EVPP + 1024 + h * 128 + 32 * vs + vc4;
    u32 qraw[8], kraw[8]; float2 lfr[8], pre[8]; uint2 vraw;
#pragma unroll
    for (int r = 0; r < 8; ++r) { qraw[r] = *(const u32*)(qp + (size_t)r * EVPP); kraw[r] = *(const u32*)(qp + (size_t)r * EVPP + 512); lfr[r] = *(const float2*)(lp + (size_t)r * 512);
        pre[r] = hf ? *(const float2*)(lp + (size_t)r * 512 - 8 * 512) : make_float2(0.f, 0.f); }
    vraw = *(const uint2*)vp;
    for (int ch = 0; ch < 64; ++ch) {
        const int t0 = ch * 64;
        const int mslot = (ch * 256 + unit) * 3 + w; const bool mok = (w < 3) && mslot < MOE_ITEMS_L;
        MoeItem mit; moe_item_decode(c, 0, mok ? mslot : 0, mit);
        float4 mva, mvb, mvc, mvd;
        { const float* p_ = mit.W + (size_t)(mit.k0 + 4 * (lane >> 3)) * mit.N + mit.n0 + 4 * (lane & 7); const size_t N_ = mit.N;
          mva = *(const float4*)(p_); mvb = *(const float4*)(p_ + N_); mvc = *(const float4*)(p_ + 2 * N_); mvd = *(const float4*)(p_ + 3 * N_); }
        bf16_t* const mout = mit.WT + (size_t)(mit.drow0 + mit.n0 + 4 * (lane & 7)) * mit.K + mit.k0 + 4 * (lane >> 3); const size_t mK = mit.K;
        float2 lb[8]; float2 run = make_float2(0.f, 0.f);
#pragma unroll
        for (int r = 0; r < 8; ++r) { run.x += pre[r].x; run.y += pre[r].y; }
        const float2 rmid = hf ? run : make_float2(0.f, 0.f);
#pragma unroll
        for (int r = 0; r < 8; ++r) { run.x += lfr[r].x; run.y += lfr[r].y; lb[r] = run; }
        if (hf) *(float2*)(TSH + i * 128 + d) = lb[7];
        if (ch < 63) {
            const size_t adv = (size_t)(t0 + 64);
#pragma unroll
            for (int r = 0; r < 8; ++r) { lfr[r] = *(const float2*)(lp + (adv + r) * 512); if (hf) pre[r] = *(const float2*)(lp + (adv + r) * 512 - 8 * 512); }
        }
        if (ch > 0) {
#pragma unroll
            for (int r = 0; r < 4; ++r) { STT[(16 * vvt + 4 * g4 + r) * PQ + 16 * dt0 + l15] = f2bf(st0[r]); STT[(16 * vvt + 4 * g4 + r) * PQ + 16 * dt1 + l15] = f2bf(st1[r]); }
        }
        __syncthreads();
        {
            const float2 T0 = *(const float2*)(TSH + d), T1 = *(const float2*)(TSH + 128 + d), T2 = *(const float2*)(TSH + 256 + d), T3 = *(const float2*)(TSH + 384 + d);
            const float2 Ti = i == 0 ? T0 : (i == 1 ? T1 : (i == 2 ? T2 : T3));
            const float2 rm = hf ? rmid : lb[7];
            float cQS[2], cQD[2], cKD[2], cKK[2], cKS[2], cQ0[2], cQ1[2], cQ2[2];
#pragma unroll
            for (int x = 0; x < 2; ++x) {
                const float t0x = x ? T0.y : T0.x, t1x = x ? T1.y : T1.x, t2x = x ? T2.y : T2.x, t3x = x ? T3.y : T3.x, tix = x ? Ti.y : Ti.x, rmx = x ? rm.y : rm.x;
                const float Bi = (i > 0 ? t0x : 0.f) + (i > 1 ? t1x : 0.f) + (i > 2 ? t2x : 0.f), B4 = (t0x + t1x) + (t2x + t3x);
                cQS[x] = cexp(Bi); cQD[x] = cexp(-rmx); cKD[x] = cexp(rmx); cKK[x] = cexp(tix); cKS[x] = cKK[x] * cexp(B4 - (Bi + tix));
                cQ0[x] = cexp(Bi - t0x); cQ1[x] = cexp(Bi - (t0x + t1x)); cQ2[x] = cexp(Bi - (t0x + t1x + t2x));
            }
            float ks0[8], ks1[8];
#pragma unroll
            for (int r = 0; r < 8; ++r) {
                const int t = 16 * i + 8 * hf + r;
                const float q0 = __uint_as_float(qraw[r] << 16), q1 = __uint_as_float(qraw[r] & 0xffff0000u), k0 = __uint_as_float(kraw[r] << 16), k1 = __uint_as_float(kraw[r] & 0xffff0000u);
                const float e0 = __expf(fmaxf(lb[r].x, -80.f)), e1 = __expf(fmaxf(lb[r].y, -80.f));
                const float qe0 = q0 * e0, qe1 = q1 * e1, ke0 = k0 * __builtin_amdgcn_rcpf(e0), ke1 = k1 * __builtin_amdgcn_rcpf(e1);
                *(u32*)(QS + t * PQ + d) = pk2(qe0 * cQS[0], qe1 * cQS[1]);
                *(u32*)(QD + t * PQ + d) = pk2(qe0 * cQD[0], qe1 * cQD[1]); *(u32*)(KD + t * PQ + d) = pk2(ke0 * cKD[0], ke1 * cKD[1]);
                if (i < 3) *(u32*)(KK + t * PQ + d) = pk2(ke0 * cKK[0], ke1 * cKK[1]);
                ks0[r] = ke0 * cKS[0]; ks1[r] = ke1 * cKS[1];
                if (i >= 1) *(u32*)(QO + (t - 16) * PQ + d) = pk2(qe0 * cQ0[0], qe1 * cQ0[1]);
                if (i >= 2) *(u32*)(QO + (48 + t - 32) * PQ + d) = pk2(qe0 * cQ1[0], qe1 * cQ1[1]);
                if (i >= 3) *(u32*)(QO + (80 + t - 48) * PQ + d) = pk2(qe0 * cQ2[0], qe1 * cQ2[1]);
            }
            uint4 w0, w1;
            w0.x = pk2(ks0[0], ks0[1]); w0.y = pk2(ks0[2], ks0[3]); w0.z = pk2(ks0[4], ks0[5]); w0.w = pk2(ks0[6], ks0[7]);
            w1.x = pk2(ks1[0], ks1[1]); w1.y = pk2(ks1[2], ks1[3]); w1.z = pk2(ks1[4], ks1[5]); w1.w = pk2(ks1[6], ks1[7]);
            *(uint4*)(KST + d * PS + 16 * i + 8 * hf) = w0; *(uint4*)(KST + (d + 1) * PS + 16 * i + 8 * hf) = w1;
        }
        VT[(vc4 + 0) * PS + vrow] = (bf16_t)(vraw.x & 0xffffu); VT[(vc4 + 1) * PS + vrow] = (bf16_t)(vraw.x >> 16);
        VT[(vc4 + 2) * PS + vrow] = (bf16_t)(vraw.y & 0xffffu); VT[(vc4 + 3) * PS + vrow] = (bf16_t)(vraw.y >> 16);
        if (ch < 63) {
            const size_t adv = (size_t)(t0 + 64);
#pragma unroll
            for (int r = 0; r < 8; ++r) { qraw[r] = *(const u32*)(qp + (adv + r) * EVPP); kraw[r] = *(const u32*)(qp + (adv + r) * EVPP + 512); }
            vraw = *(const uint2*)(vp + adv * EVPP);
        }
        __syncthreads();
        {
            f32x4 Pj[4];
#pragma unroll
            for (int j = 0; j < 4; ++j) {
                Pj[j] = (f32x4){0.f, 0.f, 0.f, 0.f};
                if (j <= tt) {
                    const bf16_t* Ar; const bf16_t* Br;
                    if (j < tt) { Ar = KK + (16 * j + l15) * PQ; Br = QO + ((j == 0 ? 0 : (j == 1 ? 48 : 80)) + 16 * (tt - j - 1) + l15) * PQ; }
                    else { Ar = KD + (16 * tt + l15) * PQ; Br = QD + (16 * tt + l15) * PQ; }
                    f32x4 acc = {0.f, 0.f, 0.f, 0.f};
#pragma unroll
                    for (int ks = 0; ks < 4; ++ks) acc = __builtin_amdgcn_mfma_f32_16x16x32_bf16(*(const bf16x8*)(Ar + 32 * ks + 8 * g4), *(const bf16x8*)(Br + 32 * ks + 8 * g4), acc, 0, 0, 0);
                    __builtin_amdgcn_sched_group_barrier(0x100, 8, 0); __builtin_amdgcn_sched_group_barrier(0x008, 4, 0);
                    if (j == tt) {
#pragma unroll
                        for (int r = 0; r < 4; ++r) if (4 * g4 + r > l15) acc[r] = 0.f;
                    }
                    Pj[j] = acc;
                }
            }
            f32x4 o = {0.f, 0.f, 0.f, 0.f};
            const bf16_t* vt = VT + (16 * vvt + l15) * PS;
#pragma unroll
            for (int p = 0; p < 2; ++p) {
                if (2 * p <= tt) {
                    const bf16x8 af = pack8(Pj[2 * p][0], Pj[2 * p][1], Pj[2 * p][2], Pj[2 * p][3], Pj[2 * p + 1][0], Pj[2 * p + 1][1], Pj[2 * p + 1][2], Pj[2 * p + 1][3]);
                    const uint2 lo = *(const uint2*)(vt + 32 * p + 4 * g4), hi = *(const uint2*)(vt + 32 * p + 16 + 4 * g4);
                    uint4 bw; bw.x = lo.x; bw.y = lo.y; bw.z = hi.x; bw.w = hi.y;
                    o = __builtin_amdgcn_mfma_f32_16x16x32_bf16(af, __builtin_bit_cast(bf16x8, bw), o, 0, 0, 0);
                }
            }
            {
                const bf16_t* Ar = QS + (16 * tt + l15) * PQ; const bf16_t* Br = STT + (16 * vvt + l15) * PQ;
#pragma unroll
                for (int ks = 0; ks < 4; ++ks) o = __builtin_amdgcn_mfma_f32_16x16x32_bf16(*(const bf16x8*)(Ar + 32 * ks + 8 * g4), *(const bf16x8*)(Br + 32 * ks + 8 * g4), o, 0, 0, 0);
                __builtin_amdgcn_sched_group_barrier(0x100, 8, 0); __builtin_amdgcn_sched_group_barrier(0x008, 4, 0);
            }
            bf16_t* op = P + (rowbase + t0 + 16 * tt + 4 * g4) * EVPP + 1024 + h * 128 + 32 * vs + 16 * vvt + l15;
#pragma unroll
            for (int r = 0; r < 4; ++r) op[(size_t)r * EVPP] = f2bf(o[r]);
            {
                const int d0 = 16 * dt0 + l15, d1 = 16 * dt1 + l15;
                const float g0 = cexp((TSH[d0] + TSH[128 + d0]) + (TSH[256 + d0] + TSH[384 + d0])), g1 = cexp((TSH[d1] + TSH[128 + d1]) + (TSH[256 + d1] + TSH[384 + d1]));
                st0 = st0 * g0; st1 = st1 * g1;
#pragma unroll
                for (int ks = 0; ks < 2; ++ks) {
                    const bf16x8 av = *(const bf16x8*)(vt + 32 * ks + 8 * g4);
                    st0 = __builtin_amdgcn_mfma_f32_16x16x32_bf16(av, *(const bf16x8*)(KST + d0 * PS + 32 * ks + 8 * g4), st0, 0, 0, 0);
                    st1 = __builtin_amdgcn_mfma_f32_16x16x32_bf16(av, *(const bf16x8*)(KST + d1 * PS + 32 * ks + 8 * g4), st1, 0, 0, 0);
                }
            }
        }
        if (mok) { uint2 w_;
            w_.x = pk2(mva.x, mvb.x); w_.y = pk2(mvc.x, mvd.x); *(uint2*)(mout) = w_;
            w_.x = pk2(mva.y, mvb.y); w_.y = pk2(mvc.y, mvd.y); *(uint2*)(mout + mK) = w_;
            w_.x = pk2(mva.z, mvb.z); w_.y = pk2(mvc.z, mvd.z); *(uint2*)(mout + 2 * mK) = w_;
            w_.x = pk2(mva.w, mvb.w); w_.y = pk2(mvc.w, mvd.w); *(uint2*)(mout + 3 * mK) = w_; }
        __syncthreads();
    }
}

namespace hg {
constexpr int A_VT = O_KST + 128 * PS * 2, A_TSH = A_VT + 128 * PS * 2, A_END = A_TSH + 4 * 128 * 4;
static_assert(A_END <= 160 * 1024 - 16, "hgrn2 pass A LDS");
constexpr int S_QS = 0, S_STT = 2 * 64 * PQ * 2, S_END = S_STT + 2 * 32 * PQ * 2;
constexpr size_t HG_U = 0, HG_QG = (size_t)128 << 20, HG_OI = (size_t)192 << 20;
}
__device__ __forceinline__ void hgrn2_passA(const Ctx& c, unsigned char* lds_raw, int su) {
    using namespace hg;
    const int cq = su & 3, h = (su >> 2) & 3, b = su >> 4;
    const bf16_t* P = (const bf16_t*)(c.ws + WS_PROJ); const float* LOGF = (const float*)(c.ws + WS_LOGF);
    unsigned char* scr = (unsigned char*)c.xr; float* GD = (float*)(c.ws + WS_H);
    bf16_t* QS = (bf16_t*)(lds_raw + O_QS); bf16_t* QD = (bf16_t*)(lds_raw + O_QD); bf16_t* KD = (bf16_t*)(lds_raw + O_KD); bf16_t* KK = (bf16_t*)(lds_raw + O_KK);
    bf16_t* QO = (bf16_t*)(lds_raw + O_QO); bf16_t* KST = (bf16_t*)(lds_raw + O_KST); bf16_t* VT = (bf16_t*)(lds_raw + A_VT);
    float* TSH = (float*)(lds_raw + A_TSH);
    const int tid = c.tid, lane = c.lane, w = c.wave;
    const int i = w >> 1, hf = w & 1, d = 2 * lane;
    const int tt = w >> 1, vh = w & 1, g4 = lane >> 4, l15 = lane & 15;
    const size_t rowbase = (size_t)b * SEQ + (size_t)cq * 1024;
    const bf16_t* qp = P + (rowbase + 16 * i + 8 * hf) * EVPP + h * 128 + d;
    const float* lp = LOGF + (rowbase + 16 * i + 8 * hf) * 512 + h * 128 + d;
    const int vrow = tid >> 3, vc = (tid & 7) * 16;
    const bf16_t* vp = P + (rowbase + vrow) * EVPP + 1024 + h * 128 + vc;
    u32 qraw[8], kraw[8]; float2 lfr[8], pre[8]; uint4 vr0, vr1;
#pragma unroll
    for (int r = 0; r < 8; ++r) { qraw[r] = *(const u32*)(qp + (size_t)r * EVPP); kraw[r] = *(const u32*)(qp + (size_t)r * EVPP + 512); lfr[r] = *(const float2*)(lp + (size_t)r * 512);
        pre[r] = *(const float2*)(lp + (size_t)r * 512 - (size_t)(8 * hf) * 512); }
    vr0 = *(const uint4*)vp; vr1 = *(const uint4*)(vp + 8);
    __syncthreads();
    for (int k = 0; k < 16; ++k) {
        const int u = ((b * 4 + h) * 64) + cq * 16 + k;
        float2 lb[8]; float2 run = make_float2(0.f, 0.f);
#pragma unroll
        for (int r = 0; r < 8; ++r) { run.x += pre[r].x; run.y += pre[r].y; }
        run.x *= (float)hf; run.y *= (float)hf;
        const float2 rmid = run;
#pragma unroll
        for (int r = 0; r < 8; ++r) { run.x += lfr[r].x; run.y += lfr[r].y; lb[r] = run; }
        if (hf) *(float2*)(TSH + i * 128 + d) = lb[7];
        if (k < 15) {
            const size_t adv = (size_t)(k + 1) * 64;
#pragma unroll
            for (int r = 0; r < 8; ++r) { lfr[r] = *(const float2*)(lp + (adv + r) * 512); pre[r] = *(const float2*)(lp + (adv + r) * 512 - (size_t)(8 * hf) * 512); }
        }
        __syncthreads();
        {
            const float2 T0 = *(const float2*)(TSH + d), T1 = *(const float2*)(TSH + 128 + d), T2 = *(const float2*)(TSH + 256 + d), T3 = *(const float2*)(TSH + 384 + d);
            const float2 Ti = i == 0 ? T0 : (i == 1 ? T1 : (i == 2 ? T2 : T3));
            const float2 rm = hf ? rmid : lb[7];
            float cQS[2], cQD[2], cKD[2], cKK[2], cKS[2], cQ0[2], cQ1[2], cQ2[2];
#pragma unroll
            for (int x = 0; x < 2; ++x) {
                const float t0x = x ? T0.y : T0.x, t1x = x ? T1.y : T1.x, t2x = x ? T2.y : T2.x, t3x = x ? T3.y : T3.x, tix = x ? Ti.y : Ti.x, rmx = x ? rm.y : rm.x;
                const float Bi = (i > 0 ? t0x : 0.f) + (i > 1 ? t1x : 0.f) + (i > 2 ? t2x : 0.f), B4 = (t0x + t1x) + (t2x + t3x);
                cQS[x] = cexp(Bi); cQD[x] = cexp(-rmx); cKD[x] = cexp(rmx); cKK[x] = cexp(tix); cKS[x] = cKK[x] * cexp(B4 - (Bi + tix));
                cQ0[x] = cexp(Bi - t0x); cQ1[x] = cexp(Bi - (t0x + t1x)); cQ2[x] = cexp(Bi - (t0x + t1x + t2x));
            }
            if (tid < 128) GD[(size_t)u * 128 + tid] = cexp((TSH[tid] + TSH[128 + tid]) + (TSH[256 + tid] + TSH[384 + tid]));
            float ks0[8], ks1[8];
#pragma unroll
            for (int r = 0; r < 8; ++r) {
                const int t = 16 * i + 8 * hf + r;
                const float q0 = __uint_as_float(qraw[r] << 16), q1 = __uint_as_float(qraw[r] & 0xffff0000u), k0 = __uint_as_float(kraw[r] << 16), k1 = __uint_as_float(kraw[r] & 0xffff0000u);
                const float e0 = __expf(fmaxf(lb[r].x, -80.f)), e1 = __expf(fmaxf(lb[r].y, -80.f));
                const float qe0 = q0 * e0, qe1 = q1 * e1, ke0 = k0 * __builtin_amdgcn_rcpf(e0), ke1 = k1 * __builtin_amdgcn_rcpf(e1);
                *(u32*)(QS + t * PQ + d) = pk2(qe0 * cQS[0], qe1 * cQS[1]);
                *(u32*)(QD + t * PQ + d) = pk2(qe0 * cQD[0], qe1 * cQD[1]); *(u32*)(KD + t * PQ + d) = pk2(ke0 * cKD[0], ke1 * cKD[1]);
                if (i < 3) *(u32*)(KK + t * PQ + d) = pk2(ke0 * cKK[0], ke1 * cKK[1]);
                ks0[r] = ke0 * cKS[0]; ks1[r] = ke1 * cKS[1];
                if (i >= 1) *(u32*)(QO + (t - 16) * PQ + d) = pk2(qe0 * cQ0[0], qe1 * cQ0[1]);
                if (i >= 2) *(u32*)(QO + (48 + t - 32) * PQ + d) = pk2(qe0 * cQ1[0], qe1 * cQ1[1]);
                if (i >= 3) *(u32*)(QO + (80 + t - 48) * PQ + d) = pk2(qe0 * cQ2[0], qe1 * cQ2[1]);
            }
            uint4 w0, w1;
            w0.x = pk2(ks0[0], ks0[1]); w0.y = pk2(ks0[2], ks0[3]); w0.z = pk2(ks0[4], ks0[5]); w0.w = pk2(ks0[6], ks0[7]);
            w1.x = pk2(ks1[0], ks1[1]); w1.y = pk2(ks1[2], ks1[3]); w1.z = pk2(ks1[4], ks1[5]); w1.w = pk2(ks1[6], ks1[7]);
            *(uint4*)(KST + d * PS + 16 * i + 8 * hf) = w0; *(uint4*)(KST + (d + 1) * PS + 16 * i + 8 * hf) = w1;
        }
        {
            const u32 vw[8] = {vr0.x, vr0.y, vr0.z, vr0.w, vr1.x, vr1.y, vr1.z, vr1.w};
#pragma unroll
            for (int j = 0; j < 8; ++j) { VT[(vc + 2 * j) * PS + vrow] = (bf16_t)(vw[j] & 0xffffu); VT[(vc + 2 * j + 1) * PS + vrow] = (bf16_t)(vw[j] >> 16); }
        }
        if (k < 15) {
            const size_t adv = (size_t)(k + 1) * 64;
#pragma unroll
            for (int r = 0; r < 8; ++r) { qraw[r] = *(const u32*)(qp + (adv + r) * EVPP); kraw[r] = *(const u32*)(qp + (adv + r) * EVPP + 512); }
            vr0 = *(const uint4*)(vp + adv * EVPP); vr1 = *(const uint4*)(vp + adv * EVPP + 8);
        }
        __syncthreads();
        {
            f32x4 Pj[4];
#pragma unroll
            for (int j = 0; j < 4; ++j) {
                Pj[j] = (f32x4){0.f, 0.f, 0.f, 0.f};
                if (j <= tt) {
                    const bf16_t* Ar; const bf16_t* Br;
                    if (j < tt) { Ar = KK + (16 * j + l15) * PQ; Br = QO + ((j == 0 ? 0 : (j == 1 ? 48 : 80)) + 16 * (tt - j - 1) + l15) * PQ; }
                    else { Ar = KD + (16 * tt + l15) * PQ; Br = QD + (16 * tt + l15) * PQ; }
                    f32x4 acc = {0.f, 0.f, 0.f, 0.f};
#pragma unroll
                    for (int ks = 0; ks < 4; ++ks) acc = __builtin_amdgcn_mfma_f32_16x16x32_bf16(*(const bf16x8*)(Ar + 32 * ks + 8 * g4), *(const bf16x8*)(Br + 32 * ks + 8 * g4), acc, 0, 0, 0);
                    __builtin_amdgcn_sched_group_barrier(0x100, 8, 0); __builtin_amdgcn_sched_group_barrier(0x008, 4, 0);
                    if (j == tt) {
#pragma unroll
                        for (int r = 0; r < 4; ++r) if (4 * g4 + r > l15) acc[r] = 0.f;
                    }
                    Pj[j] = acc;
                }
            }
            const bf16x8 af0 = pack8(Pj[0][0], Pj[0][1], Pj[0][2], Pj[0][3], Pj[1][0], Pj[1][1], Pj[1][2], Pj[1][3]);
            const bf16x8 af1 = pack8(Pj[2][0], Pj[2][1], Pj[2][2], Pj[2][3], Pj[3][0], Pj[3][1], Pj[3][2], Pj[3][3]);
            uint2* OI = (uint2*)(scr + HG_OI) + ((size_t)u * 32 + tt * 8) * 64 + lane;
#pragma unroll
            for (int q = 0; q < 4; ++q) {
                const int vt = 4 * vh + q;
                const bf16_t* vrw = VT + (16 * vt + l15) * PS;
                f32x4 o = {0.f, 0.f, 0.f, 0.f};
                { const uint2 lo = *(const uint2*)(vrw + 4 * g4), hi = *(const uint2*)(vrw + 16 + 4 * g4); uint4 bw; bw.x = lo.x; bw.y = lo.y; bw.z = hi.x; bw.w = hi.y;
                  o = __builtin_amdgcn_mfma_f32_16x16x32_bf16(af0, __builtin_bit_cast(bf16x8, bw), o, 0, 0, 0); }
                if (tt >= 2) { const uint2 lo = *(const uint2*)(vrw + 32 + 4 * g4), hi = *(const uint2*)(vrw + 48 + 4 * g4); uint4 bw; bw.x = lo.x; bw.y = lo.y; bw.z = hi.x; bw.w = hi.y;
                  o = __builtin_amdgcn_mfma_f32_16x16x32_bf16(af1, __builtin_bit_cast(bf16x8, bw), o, 0, 0, 0); }
                uint2 ow; ow.x = pk2(o[0], o[1]); ow.y = pk2(o[2], o[3]);
                OI[(size_t)vt * 64] = ow;
            }
            {
                uint2* U = (uint2*)(scr + HG_U) + ((size_t)u * 64 + w * 8) * 64 + lane;
                const bf16_t* vrw = VT + (16 * w + l15) * PS;
                const bf16x8 av0 = *(const bf16x8*)(vrw + 8 * g4), av1 = *(const bf16x8*)(vrw + 32 + 8 * g4);
#pragma unroll
                for (int dt = 0; dt < 8; ++dt) {
                    const bf16_t* kr = KST + (16 * dt + l15) * PS + 8 * g4;
                    f32x4 a = {0.f, 0.f, 0.f, 0.f};
                    a = __builtin_amdgcn_mfma_f32_16x16x32_bf16(av0, *(const bf16x8*)(kr), a, 0, 0, 0);
                    a = __builtin_amdgcn_mfma_f32_16x16x32_bf16(av1, *(const bf16x8*)(kr + 32), a, 0, 0, 0);
                    uint2 uw; uw.x = pk2(a[0], a[1]); uw.y = pk2(a[2], a[3]);
                    U[(size_t)dt * 64] = uw;
                }
            }
            {
                const int row = tid >> 3, ch16 = (tid & 7) * 16;
                const uint4 a0 = *(const uint4*)(QS + row * PQ + ch16), a1 = *(const uint4*)(QS + row * PQ + ch16 + 8);
                uint4* QG = (uint4*)(scr + HG_QG + ((size_t)u * 64 + row) * 256 + ch16 * 2);
                QG[0] = a0; QG[1] = a1;
            }
        }
        __syncthreads();
    }
}

__device__ __forceinline__ void hgrn2_seq(const Ctx& c, unsigned char* lds_raw, int unit) {
    using namespace hg;
    const int vs = unit & 3, h = (unit >> 2) & 3, b = unit >> 4;
    bf16_t* P = (bf16_t*)(c.ws + WS_PROJ);
    const unsigned char* scr = (const unsigned char*)c.xr; const float* GD = (const float*)(c.ws + WS_H);
    const int tid = c.tid, lane = c.lane, w = c.wave;
    const int tt = w >> 1, vvt = w & 1, g4 = lane >> 4, l15 = lane & 15;
    const int dt0 = 2 * (w >> 1), dt1 = dt0 + 1, vt = 2 * vs + vvt;
    const size_t rowbase = (size_t)b * SEQ;
    const int u0 = (b * 4 + h) * 64;
    f32x4 st0 = {0.f, 0.f, 0.f, 0.f}, st1 = {0.f, 0.f, 0.f, 0.f};
    const int qrow = tid >> 3, qc16 = (tid & 7) * 16;
#define HG_LOAD(SET, CH) do { const size_t u_ = (size_t)(u0 + (CH)); \
        const uint4* qg_ = (const uint4*)(scr + HG_QG + (u_ * 64 + qrow) * 256 + qc16 * 2); SET##q0 = qg_[0]; SET##q1 = qg_[1]; \
        const uint2* up_ = (const uint2*)(scr + HG_U) + (u_ * 64 + vt * 8) * 64 + lane; SET##u0 = up_[(size_t)dt0 * 64]; SET##u1 = up_[(size_t)dt1 * 64]; \
        SET##oi = ((const uint2*)(scr + HG_OI))[(u_ * 32 + tt * 8 + vt) * 64 + lane]; \
        SET##g0 = GD[u_ * 128 + 16 * dt0 + l15]; SET##g1 = GD[u_ * 128 + 16 * dt1 + l15]; } while (0)
#define HG_MOE_ISSUE(SET, CH) do { const int ms_ = ((CH) * 256 + unit) * 3 + w; SET##mok = (w < 3) && ms_ < MOE_ITEMS_L; MoeItem mi_; moe_item_decode(c, 0, SET##mok ? ms_ : 0, mi_); \
        const float* p_ = mi_.W + (size_t)(mi_.k0 + 4 * (lane >> 3)) * mi_.N + mi_.n0 + 4 * (lane & 7); const size_t N_ = mi_.N; \
        SET##ma = *(const float4*)(p_); SET##mb = *(const float4*)(p_ + N_); SET##mc = *(const float4*)(p_ + 2 * N_); SET##md = *(const float4*)(p_ + 3 * N_); \
        SET##mo = mi_.WT + (size_t)(mi_.drow0 + mi_.n0 + 4 * (lane & 7)) * mi_.K + mi_.k0 + 4 * (lane >> 3); SET##mk = mi_.K; } while (0)
#define HG_MOE_FINISH(SET) do { if (SET##mok) { uint2 w_; \
        w_.x = pk2(SET##ma.x, SET##mb.x); w_.y = pk2(SET##mc.x, SET##md.x); *(uint2*)(SET##mo) = w_; \
        w_.x = pk2(SET##ma.y, SET##mb.y); w_.y = pk2(SET##mc.y, SET##md.y); *(uint2*)(SET##mo + SET##mk) = w_; \
        w_.x = pk2(SET##ma.z, SET##mb.z); w_.y = pk2(SET##mc.z, SET##md.z); *(uint2*)(SET##mo + 2 * SET##mk) = w_; \
        w_.x = pk2(SET##ma.w, SET##mb.w); w_.y = pk2(SET##mc.w, SET##md.w); *(uint2*)(SET##mo + 3 * SET##mk) = w_; } } while (0)
#define HG_STEP(SET, CH) do { const int ch_ = (CH); \
        bf16_t* QSL = (bf16_t*)(lds_raw + S_QS) + (ch_ & 1) * 64 * PQ; bf16_t* STT = (bf16_t*)(lds_raw + S_STT) + (ch_ & 1) * 32 * PQ; \
        *(uint4*)(QSL + qrow * PQ + qc16) = SET##q0; *(uint4*)(QSL + qrow * PQ + qc16 + 8) = SET##q1; \
        _Pragma("unroll") for (int r = 0; r < 4; ++r) { STT[(16 * vvt + 4 * g4 + r) * PQ + 16 * dt0 + l15] = f2bf(st0[r]); STT[(16 * vvt + 4 * g4 + r) * PQ + 16 * dt1 + l15] = f2bf(st1[r]); } \
        __syncthreads(); \
        f32x4 o = {__uint_as_float(SET##oi.x << 16), __uint_as_float(SET##oi.x & 0xffff0000u), __uint_as_float(SET##oi.y << 16), __uint_as_float(SET##oi.y & 0xffff0000u)}; \
        { const bf16_t* Ar = QSL + (16 * tt + l15) * PQ; const bf16_t* Br = STT + (16 * vvt + l15) * PQ; \
          _Pragma("unroll") for (int ks = 0; ks < 4; ++ks) o = __builtin_amdgcn_mfma_f32_16x16x32_bf16(*(const bf16x8*)(Ar + 32 * ks + 8 * g4), *(const bf16x8*)(Br + 32 * ks + 8 * g4), o, 0, 0, 0); \
          __builtin_amdgcn_sched_group_barrier(0x100, 8, 0); __builtin_amdgcn_sched_group_barrier(0x008, 4, 0); } \
        bf16_t* op = P + (rowbase + ch_ * 64 + 16 * tt + 4 * g4) * EVPP + 1024 + h * 128 + 32 * vs + 16 * vvt + l15; \
        _Pragma("unroll") for (int r = 0; r < 4; ++r) op[(size_t)r * EVPP] = f2bf(o[r]); \
        st0[0] = st0[0] * SET##g0 + __uint_as_float(SET##u0.x << 16); st0[1] = st0[1] * SET##g0 + __uint_as_float(SET##u0.x & 0xffff0000u); \
        st0[2] = st0[2] * SET##g0 + __uint_as_float(SET##u0.y << 16); st0[3] = st0[3] * SET##g0 + __uint_as_float(SET##u0.y & 0xffff0000u); \
        st1[0] = st1[0] * SET##g1 + __uint_as_float(SET##u1.x << 16); st1[1] = st1[1] * SET##g1 + __uint_as_float(SET##u1.x & 0xffff0000u); \
        st1[2] = st1[2] * SET##g1 + __uint_as_float(SET##u1.y << 16); st1[3] = st1[3] * SET##g1 + __uint_as_float(SET##u1.y & 0xffff0000u); \
        HG_MOE_FINISH(SET); \
        if (ch_ + 2 < 64) { HG_LOAD(SET, ch_ + 2); HG_MOE_ISSUE(SET, ch_ + 2); } else SET##mok = false; } while (0)
    uint4 Aq0, Aq1, Bq0, Bq1; uint2 Au0, Au1, Aoi, Bu0, Bu1, Boi; float Ag0, Ag1, Bg0, Bg1;
    float4 Ama, Amb, Amc, Amd, Bma, Bmb, Bmc, Bmd; bf16_t* Amo; bf16_t* Bmo; size_t Amk, Bmk; bool Amok, Bmok;
    HG_LOAD(A, 0); HG_LOAD(B, 1); HG_MOE_ISSUE(A, 0); HG_MOE_ISSUE(B, 1);
    __syncthreads();
    for (int ch = 0; ch < 64; ch += 2) { HG_STEP(A, ch); HG_STEP(B, ch + 1); }
#undef HG_LOAD
#undef HG_MOE_ISSUE
#undef HG_MOE_FINISH
#undef HG_STEP
    __syncthreads();
}

__device__ __forceinline__ void dot4(const bf16_t* kr, const float* qs, float& s0, float& s1, float& s2, float& s3) {
    s0 = s1 = s2 = s3 = 0.f;
#pragma unroll
    for (int ch = 0; ch < 8; ++ch) {
        const uint4 w = ((const uint4*)kr)[ch]; float kf[8]; unpack8(w, kf);
#pragma unroll
        for (int q4 = 0; q4 < 2; ++q4) {
            const int d = ch * 8 + q4 * 4;
            const float4 a = *(const float4*)(qs + d), b = *(const float4*)(qs + 64 + d), cc = *(const float4*)(qs + 128 + d), e = *(const float4*)(qs + 192 + d);
            const float k0 = kf[q4 * 4], k1 = kf[q4 * 4 + 1], k2 = kf[q4 * 4 + 2], k3 = kf[q4 * 4 + 3];
            s0 += a.x * k0 + a.y * k1 + a.z * k2 + a.w * k3; s1 += b.x * k0 + b.y * k1 + b.z * k2 + b.w * k3;
            s2 += cc.x * k0 + cc.y * k1 + cc.z * k2 + cc.w * k3; s3 += e.x * k0 + e.y * k1 + e.z * k2 + e.w * k3;
        }
    }
}

constexpr int ATT_WSTRIDE = 256 + 2048 + 16;
template <bool SINK>
__device__ __forceinline__ void attn_rounds(const bf16_t* Kb, const bf16_t* Vb, int ld, const int* bases, int nr, int lo, int hi, const float* qs, float* ps,
                                            const float (&sink)[4], float (&o)[4], float (&inv)[4], int lane) {
#pragma unroll 1
    for (int r = 0; r < nr; ++r) {
        const int kp = bases[r] + lane; const bool val = kp >= lo && kp <= hi;
        const int kr = val ? kp : lo;
        float s0, s1, s2, s3; dot4(Kb + (size_t)kr * ld, qs, s0, s1, s2, s3);
        ps[64 * r + lane] = val ? s0 * 0.125f : -INFINITY; ps[512 + 64 * r + lane] = val ? s1 * 0.125f : -INFINITY;
        ps[1024 + 64 * r + lane] = val ? s2 * 0.125f : -INFINITY; ps[1536 + 64 * r + lane] = val ? s3 * 0.125f : -INFINITY;
    }
    LDS_FENCE();
#pragma unroll
    for (int hh = 0; hh < 4; ++hh) {
        float mx = SINK ? sink[hh] : -INFINITY;
#pragma unroll 1
        for (int r = 0; r < nr; ++r) mx = fmaxf(mx, ps[hh * 512 + 64 * r + lane]);
        mx = wmax(mx); if (mx == -INFINITY) mx = 0.f;
        float l = 0.f;
#pragma unroll 1
        for (int r = 0; r < nr; ++r) { const float sv = ps[hh * 512 + 64 * r + lane]; const float p = (sv == -INFINITY) ? 0.f : __expf(sv - mx); ps[hh * 512 + 64 * r + lane] = p; l += p; }
        l = wsum(l); if (SINK) l += __expf(sink[hh] - mx);
        inv[hh] = 1.f / fmaxf(l, 1e-30f);
    }
    LDS_FENCE();
    o[0] = o[1] = o[2] = o[3] = 0.f;
#pragma unroll 1
    for (int r = 0; r < nr; ++r) {
        const int bs = bases[r];
        if (bs < -50000000) continue;
#pragma unroll 4
        for (int kk = 0; kk < 64; ++kk) {
            const int kp = bs + kk; if (kp < lo || kp > hi) continue;
            const float vv = bf2f(Vb[(size_t)kp * ld + lane]);
            o[0] += ps[64 * r + kk] * vv; o[1] += ps[512 + 64 * r + kk] * vv; o[2] += ps[1024 + 64 * r + kk] * vv; o[3] += ps[1536 + 64 * r + kk] * vv;
        }
    }
    o[0] *= inv[0]; o[1] *= inv[1]; o[2] *= inv[2]; o[3] *= inv[3];
}

__device__ __forceinline__ void nsa_naive(const Ctx& c, float* lds) {
    const bf16_t* P = (const bf16_t*)(c.ws + WS_PROJ); bf16_t* MIX = (bf16_t*)(c.ws + WS_H);
    const bf16_t* KCB = (const bf16_t*)(c.ws + WS_KCB); const bf16_t* VCB = (const bf16_t*)(c.ws + WS_VCB);
    float* qs = lds + c.wave * ATT_WSTRIDE; float* ps = qs + 256; int* bl = (int*)(ps + 2048);
    const int lane = c.lane;
    const float nosink[4] = {0.f, 0.f, 0.f, 0.f};
    for (int task = c.gw; task < M * 2; task += c.ngw) {
        const int g = task & 1, m = task >> 1, b = m >> 12, t = m & (SEQ - 1);
        const bf16_t* prow = P + (size_t)m * EVPP;
#pragma unroll
        for (int hh = 0; hh < 4; ++hh) qs[hh * 64 + lane] = bf2f(prow[2048 + (4 * g + hh) * 64 + lane]);
        if (lane < 4) bl[lane] = 64 * lane;
        LDS_FENCE();
        float oc[4], inv[4];
        const int nmax = (t >= 31) ? (t - 31) / 16 : -1;
        attn_rounds<false>(KCB + (size_t)((b * 2 + g) * 256) * 64, VCB + (size_t)((b * 2 + g) * 256) * 64, 64, bl, 4, 0, nmax, qs, ps, nosink, oc, inv, lane);
        float imp = 0.f;
#pragma unroll
        for (int hh = 0; hh < 4; ++hh) {
            float a = 0.f;
#pragma unroll
            for (int dn = -1; dn <= 3; ++dn) { const int n = 4 * lane + dn; if (n >= 0 && n <= nmax) a += ps[hh * 512 + n]; }
            imp += a * inv[hh];
        }
        LDS_FENCE();
        const int i = t >> 6;
        const bool allowed = lane <= i, forced = (lane == 0) || (lane == i) || (lane == i - 1);
        float score = allowed ? imp + (forced ? 1e4f : 0.f) : -INFINITY;
#pragma unroll
        for (int r = 0; r < 8; ++r) {
            const float mx = wmax(score);
            const unsigned long long bal = __ballot(score == mx && mx > -INFINITY);
            const int idx = bal ? (__ffsll((long long)bal) - 1) : 0;
            if (lane == 0) bl[r] = bal ? 64 * idx : -100000000;
            if (bal && lane == idx) score = -INFINITY;
        }
        LDS_FENCE();
        float osel[4];
        attn_rounds<false>(P + (size_t)b * SEQ * EVPP + 2816 + g * 64, P + (size_t)b * SEQ * EVPP + 2944 + g * 64, EVPP, bl, 8, 0, t, qs, ps, nosink, osel, inv, lane);
        float ow[4];
        if (lane < 8) bl[lane] = t - 511 + 64 * lane;
        LDS_FENCE();
        attn_rounds<false>(P + (size_t)b * SEQ * EVPP + 3072 + g * 64, P + (size_t)b * SEQ * EVPP + 3200 + g * 64, EVPP, bl, 8, 0, t, qs, ps, nosink, ow, inv, lane);
#pragma unroll
        for (int hh = 0; hh < 4; ++hh) {
            const int head = 4 * g + hh;
            const float g0 = 1.f / (1.f + __expf(-bf2f(prow[3328 + head * 3 + 0]))), g1 = 1.f / (1.f + __expf(-bf2f(prow[3328 + head * 3 + 1]))), g2 = 1.f / (1.f + __expf(-bf2f(prow[3328 + head * 3 + 2])));
            MIX[(size_t)m * D + 512 + head * 64 + lane] = f2bf(g0 * oc[hh] + g1 * osel[hh] + g2 * ow[hh]);
        }
        LDS_FENCE();
    }
}

namespace fa {
typedef short bf16x8 __attribute__((ext_vector_type(8)));
typedef short s16x4 __attribute__((ext_vector_type(4)));
typedef float f32x16 __attribute__((ext_vector_type(16)));
#define FA_LAS __attribute__((address_space(3)))
constexpr int RPK = 144, RPV = 192;
constexpr int KTB = 64 * RPK, VTB = 64 * RPV;
constexpr int O_KT = 0, O_VT = 2 * KTB, O_IMP = O_VT + 2 * VTB, O_SELM = O_IMP + 64 * 64 * 4, O_JL = O_SELM + 512, O_UM = O_JL + 64 * 4, O_STG = 0  , STG_P = 144, STG_W = 32 * STG_P,
              O_RES = O_UM + 32, RES_P = 68, RES_W = 32 * RES_P * 4, O_END = O_RES + 8 * RES_W;
static_assert(O_END <= LDS_BARST && (O_STG % 16) == 0 && (O_RES % 16) == 0 && 8 * STG_W <= 2 * KTB + 2 * VTB, "attention LDS");
constexpr float SC2 = 0.125f * 1.4426950408889634f;
constexpr float THR = 8.f;
__device__ __forceinline__ int crow(int r, int hi) { return (r & 3) + 8 * (r >> 2) + 4 * hi; }
struct RangeMask { int lo, hi; __device__ __forceinline__ bool operator()(int kl) const { return kl >= lo && kl <= hi; } };
__device__ __forceinline__ s16x4 vtr(const unsigned char* p) {
    typedef short v4i16_t __attribute__((ext_vector_type(4)));
    return __builtin_bit_cast(s16x4, __builtin_amdgcn_ds_read_tr16_b64_v4i16((FA_LAS v4i16_t*)(p))); }
struct State { f32x16 o[2]; float m, l; };
__device__ __forceinline__ void init(State& st, float m0, float l0) {
#pragma unroll
    for (int t = 0; t < 2; ++t)
#pragma unroll
        for (int r = 0; r < 16; ++r) st.o[t][r] = 0.f;
    st.m = m0; st.l = l0; }
__device__ __forceinline__ bf16x8 scale_q(const bf16x8 q) {
    const uint4 w = __builtin_bit_cast(uint4, q); float f[8]; unpack8(w, f); uint4 o;
    o.x = pk2(f[0] * SC2, f[1] * SC2); o.y = pk2(f[2] * SC2, f[3] * SC2); o.z = pk2(f[4] * SC2, f[5] * SC2); o.w = pk2(f[6] * SC2, f[7] * SC2);
    return __builtin_bit_cast(bf16x8, o); }
__device__ __forceinline__ void qnorm_rope(bf16x8 (&qf)[4], const float* gain, const float2* rt  , int hi) {
    float f[4][8]; float ss = 0.f;
#pragma unroll
    for (int sp = 0; sp < 4; ++sp) { unpack8(__builtin_bit_cast(uint4, qf[sp]), f[sp]);
#pragma unroll
        for (int j = 0; j < 8; ++j) ss += f[sp][j] * f[sp][j]; }
    ss += __shfl_xor(ss, 32);
    const float rstd = rsqrtf(ss * (1.f / 64.f) + EPS);
#pragma unroll
    for (int sp = 0; sp < 4; ++sp) { const float4 g0 = *(const float4*)(gain + 16 * sp + 8 * hi), g1 = *(const float4*)(gain + 16 * sp + 8 * hi + 4);
        f[sp][0] *= rstd * g0.x; f[sp][1] *= rstd * g0.y; f[sp][2] *= rstd * g0.z; f[sp][3] *= rstd * g0.w; f[sp][4] *= rstd * g1.x; f[sp][5] *= rstd * g1.y; f[sp][6] *= rstd * g1.z; f[sp][7] *= rstd * g1.w; }
#pragma unroll
    for (int j = 0; j < 8; ++j) { const float other = __shfl_xor(f[0][j], 32); const float2 cs = rt[j];
        f[0][j] = hi ? (f[0][j] * cs.x + other * cs.y) : (f[0][j] * cs.x - other * cs.y); }
#pragma unroll
    for (int sp = 0; sp < 4; ++sp) { uint4 o; o.x = pk2(f[sp][0] * SC2, f[sp][1] * SC2); o.y = pk2(f[sp][2] * SC2, f[sp][3] * SC2); o.z = pk2(f[sp][4] * SC2, f[sp][5] * SC2); o.w = pk2(f[sp][6] * SC2, f[sp][7] * SC2);
        qf[sp] = __builtin_bit_cast(bf16x8, o); }
}
__device__ __forceinline__ uint4 knorm_rope(const uint4 kv, const float* gain, const float2* rt  , int chunk) {
    float f[8]; unpack8(kv, f); float ss = 0.f;
#pragma unroll
    for (int j = 0; j < 8; ++j) ss += f[j] * f[j];
    ss += __shfl_xor(ss, 1); ss += __shfl_xor(ss, 2); ss += __shfl_xor(ss, 4);
    const float rstd = rsqrtf(ss * (1.f / 64.f) + EPS);
    const float4 g0 = *(const float4*)(gain + 8 * chunk), g1 = *(const float4*)(gain + 8 * chunk + 4);
    f[0] *= rstd * g0.x; f[1] *= rstd * g0.y; f[2] *= rstd * g0.z; f[3] *= rstd * g0.w; f[4] *= rstd * g1.x; f[5] *= rstd * g1.y; f[6] *= rstd * g1.z; f[7] *= rstd * g1.w;
#pragma unroll
    for (int j = 0; j < 8; ++j) { const float other = __shfl_xor(f[j], 1);
        if (chunk < 2) { const float2 cs = rt[j]; f[j] = chunk ? (f[j] * cs.x + other * cs.y) : (f[j] * cs.x - other * cs.y); } }
    uint4 o; o.x = pk2(f[0], f[1]); o.y = pk2(f[2], f[3]); o.z = pk2(f[4], f[5]); o.w = pk2(f[6], f[7]); return o;
}
template <int ABL = 0, bool FAST = false, bool ROWM = true>
__device__ __forceinline__ void tile(State& st, const unsigned char* lds, int koff, int voff, const bf16x8 (&qf)[4], float cbias, bool emask, const RangeMask mk, int lane) {
    const int r32 = lane & 31, hi = lane >> 5;
    const float negm = FAST ? (ROWM ? cbias : 0.f) : cbias - st.m;
    f32x16 p0, p1;
#pragma unroll
    for (int r = 0; r < 16; ++r) { p0[r] = negm; p1[r] = negm; }
    const unsigned char* kb = lds + koff + r32 * RPK + hi * 16;
#pragma unroll
    for (int sp = 0; sp < 4; ++sp) {
        const bf16x8 a0 = *(const bf16x8*)(kb + 32 * sp), a1 = *(const bf16x8*)(kb + 32 * RPK + 32 * sp);
        p0 = __builtin_amdgcn_mfma_f32_32x32x16_bf16(a0, qf[sp], p0, 0, 0, 0);
        p1 = __builtin_amdgcn_mfma_f32_32x32x16_bf16(a1, qf[sp], p1, 0, 0, 0);
    }
    __builtin_amdgcn_sched_group_barrier(0x100, 8, 0);
    __builtin_amdgcn_sched_group_barrier(0x008, 8, 0);
    if (emask) {
#pragma unroll
        for (int r = 0; r < 16; ++r) { const int kl = crow(r, hi); if (!mk(kl)) p0[r] = -INFINITY; if (!mk(kl + 32)) p1[r] = -INFINITY; }
    }
    if (ABL == 1) {
#pragma unroll
        for (int r = 0; r < 16; ++r) { p0[r] *= 0.001f; p1[r] *= 0.001f; }
        st.l += p0[0];
    } else if (FAST) {
        float sa = 0.f, sb = 0.f, sc = 0.f, sd = 0.f;
#pragma unroll
        for (int r = 0; r < 16; r += 4) {
            p0[r] = __builtin_amdgcn_exp2f(p0[r]); p1[r] = __builtin_amdgcn_exp2f(p1[r]); p0[r + 1] = __builtin_amdgcn_exp2f(p0[r + 1]); p1[r + 1] = __builtin_amdgcn_exp2f(p1[r + 1]);
            p0[r + 2] = __builtin_amdgcn_exp2f(p0[r + 2]); p1[r + 2] = __builtin_amdgcn_exp2f(p1[r + 2]); p0[r + 3] = __builtin_amdgcn_exp2f(p0[r + 3]); p1[r + 3] = __builtin_amdgcn_exp2f(p1[r + 3]);
            sa += p0[r] + p1[r]; sb += p0[r + 1] + p1[r + 1]; sc += p0[r + 2] + p1[r + 2]; sd += p0[r + 3] + p1[r + 3];
        }
        st.l += (sa + sb) + (sc + sd);
    } else {
        float mxa = fmaxf(p0[0], p1[0]), mxb = fmaxf(p0[1], p1[1]), mxc = fmaxf(p0[2], p1[2]), mxd = fmaxf(p0[3], p1[3]);
#pragma unroll
        for (int r = 4; r < 16; r += 4) { mxa = fmaxf(mxa, fmaxf(p0[r], p1[r])); mxb = fmaxf(mxb, fmaxf(p0[r + 1], p1[r + 1])); mxc = fmaxf(mxc, fmaxf(p0[r + 2], p1[r + 2])); mxd = fmaxf(mxd, fmaxf(p0[r + 3], p1[r + 3])); }
        float mx = fmaxf(fmaxf(mxa, mxb), fmaxf(mxc, mxd));
        mx = fmaxf(mx, __shfl_xor(mx, 32));
        if (!__all(mx <= THR)) {
            const float delta = fmaxf(mx, 0.f), alpha = __builtin_amdgcn_exp2f(-delta);
            st.m += delta; st.l *= alpha;
#pragma unroll
            for (int r = 0; r < 16; ++r) { p0[r] -= delta; p1[r] -= delta; st.o[0][r] *= alpha; st.o[1][r] *= alpha; }
        }
        float sa = 0.f, sb = 0.f, sc = 0.f, sd = 0.f;
#pragma unroll
        for (int r = 0; r < 16; r += 4) {
            p0[r] = __builtin_amdgcn_exp2f(p0[r]); p1[r] = __builtin_amdgcn_exp2f(p1[r]); p0[r + 1] = __builtin_amdgcn_exp2f(p0[r + 1]); p1[r + 1] = __builtin_amdgcn_exp2f(p1[r + 1]);
            p0[r + 2] = __builtin_amdgcn_exp2f(p0[r + 2]); p1[r + 2] = __builtin_amdgcn_exp2f(p1[r + 2]); p0[r + 3] = __builtin_amdgcn_exp2f(p0[r + 3]); p1[r + 3] = __builtin_amdgcn_exp2f(p1[r + 3]);
            sa += p0[r] + p1[r]; sb += p0[r + 1] + p1[r + 1]; sc += p0[r + 2] + p1[r + 2]; sd += p0[r + 3] + p1[r + 3];
        }
        st.l += (sa + sb) + (sc + sd);
    }
    if (ABL == 2) { st.o[0][0] += p0[0] + p0[5] + p1[3] + p1[9]; return; }
    const int vbase = voff + (4 * hi + ((lane & 15) >> 2)) * RPV + ((lane >> 4) & 1) * 32 + (lane & 3) * 8;
#pragma unroll
    for (int sub = 0; sub < 2; ++sub)
#pragma unroll
        for (int ks = 0; ks < 2; ++ks) {
            uint4 pw;
            if (sub == 0) { pw.x = pk2(p0[8 * ks], p0[8 * ks + 1]); pw.y = pk2(p0[8 * ks + 2], p0[8 * ks + 3]); pw.z = pk2(p0[8 * ks + 4], p0[8 * ks + 5]); pw.w = pk2(p0[8 * ks + 6], p0[8 * ks + 7]); }
            else { pw.x = pk2(p1[8 * ks], p1[8 * ks + 1]); pw.y = pk2(p1[8 * ks + 2], p1[8 * ks + 3]); pw.z = pk2(p1[8 * ks + 4], p1[8 * ks + 5]); pw.w = pk2(p1[8 * ks + 6], p1[8 * ks + 7]); }
            const bf16x8 pf = __builtin_bit_cast(bf16x8, pw);
#pragma unroll
            for (int dt = 0; dt < 2; ++dt) {
                const unsigned char* vp = lds + vbase + (32 * sub + 16 * ks) * RPV + dt * 64;
                const s16x4 lo = vtr(vp), hi4 = vtr(vp + 8 * RPV);
                const bf16x8 vf = {lo[0], lo[1], lo[2], lo[3], hi4[0], hi4[1], hi4[2], hi4[3]};
                st.o[dt] = __builtin_amdgcn_mfma_f32_32x32x16_bf16(vf, pf, st.o[dt], 0, 0, 0);
            }
        }
}
__device__ __forceinline__ uint4 ldg_tile(const bf16_t* base, long row, int ld, int tid) { return *(const uint4*)(base + row * ld + (tid & 7) * 8); }
__device__ __forceinline__ void sts_k(unsigned char* lds, int buf, const uint4& v, int tid) { *(uint4*)(lds + O_KT + buf * KTB + (tid >> 3) * RPK + (tid & 7) * 16) = v; }
__device__ __forceinline__ void sts_v(unsigned char* lds, int buf, const uint4& v, int tid) { *(uint4*)(lds + O_VT + buf * VTB + (tid >> 3) * RPV + (tid & 7) * 16) = v; }
template <class Br>
__device__ __forceinline__ void run_tiles(State& st, unsigned char* lds, const bf16x8 (&qf)[4], const Br& br, int tid, int lane) {
    const int n = br.n;
    if (n <= 0) return;
    uint4 kreg, vreg;
    br.load(0, kreg, vreg, tid);
    __syncthreads();
    sts_k(lds, 0, kreg, tid); sts_v(lds, 0, vreg, tid);
    if (n > 1) br.load(1, kreg, vreg, tid);
    __syncthreads();
    for (int idx = 0; idx < n; ++idx) {
        const int cur = idx & 1;
        if (idx + 1 < n) { sts_k(lds, cur ^ 1, kreg, tid); sts_v(lds, cur ^ 1, vreg, tid); if (idx + 2 < n) br.load(idx + 2, kreg, vreg, tid); }
        if (br.active(idx)) tile(st, lds, O_KT + cur * KTB, O_VT + cur * VTB, qf, br.cbias(idx), br.emask(idx), br.mask(idx), lane);
        __syncthreads();
    }
}
struct CmpBranch { const bf16_t* K; const bf16_t* V; int pass, nmaxq, n;
    __device__ __forceinline__ void load(int idx, uint4& k, uint4& v, int tid) const {
        const int key = tid >> 3; k = ldg_tile(K, 64 * idx + key, 64, tid);
        if (pass == 0) v = ldg_tile(V, 64 * idx + key, 64, tid);
        else { const int nn = 64 * idx + key, j0 = (tid & 7) * 8; u32 wv[4];
#pragma unroll
            for (int q = 0; q < 4; ++q) { const int ja = j0 + 2 * q, jb = ja + 1;
                wv[q] = ((nn >= 4 * ja - 1 && nn <= 4 * ja + 3) ? 0x3f80u : 0u) | ((nn >= 4 * jb - 1 && nn <= 4 * jb + 3) ? 0x3f800000u : 0u); }
            v.x = wv[0]; v.y = wv[1]; v.z = wv[2]; v.w = wv[3]; } }
    __device__ __forceinline__ float cbias(int) const { return 0.f; }
    __device__ __forceinline__ bool active(int) const { return true; }
    __device__ __forceinline__ bool emask(int) const { return true; }
    __device__ __forceinline__ RangeMask mask(int idx) const { return RangeMask{0, nmaxq - 64 * idx}; } };
struct SelBranch { const bf16_t* K; const bf16_t* V; const int* JL; unsigned long long mysel; int i, tl, n;
    __device__ __forceinline__ void load(int idx, uint4& k, uint4& v, int tid) const { const long row = 64 * JL[idx] + (tid >> 3); k = ldg_tile(K, row, EVPP, tid); v = ldg_tile(V, row, EVPP, tid); }
    __device__ __forceinline__ float cbias(int idx) const { return ((mysel >> JL[idx]) & 1ull) ? 0.f : -INFINITY; }
    __device__ __forceinline__ bool active(int idx) const { return __any((int)((mysel >> JL[idx]) & 1ull)) != 0; }
    __device__ __forceinline__ bool emask(int idx) const { return JL[idx] == i; }
    __device__ __forceinline__ RangeMask mask(int) const { return RangeMask{0, tl}; } };
template <int NB, int LD> struct WinBranch { const bf16_t* K; const bf16_t* V; int k0, i, tl, n;
    __device__ __forceinline__ void load(int idx, uint4& k, uint4& v, int tid) const { const long row = 64 * (k0 + idx) + (tid >> 3); k = ldg_tile(K, row, LD, tid); v = ldg_tile(V, row, LD, tid); }
    __device__ __forceinline__ float cbias(int) const { return 0.f; }
    __device__ __forceinline__ bool active(int) const { return true; }
    __device__ __forceinline__ bool emask(int idx) const { return (k0 + idx == i) || (k0 + idx == i - NB); }
    __device__ __forceinline__ RangeMask mask(int idx) const { RangeMask mk{0, 63}; if (k0 + idx == i) mk.hi = tl; if (k0 + idx == i - NB) mk.lo = tl + 1; return mk; } };
}

template <int ABL = 0, bool DRY = false, bool FAST = false>
__device__ __forceinline__ void nsa_unit(const Ctx& c, unsigned char* lds, int b, int i, int g) {
    using namespace fa;
    const bf16_t* P = (const bf16_t*)(c.ws + WS_PROJ);
    const bf16_t* KCB = (const bf16_t*)(c.ws + WS_KCB) + (size_t)((b * 2 + g) * 256) * 64; const bf16_t* VCB = (const bf16_t*)(c.ws + WS_VCB) + (size_t)((b * 2 + g) * 256) * 64;
    const int tid = c.tid, lane = c.lane, w = c.wave, r32 = lane & 31, hi = lane >> 5;
    const int tl = 8 * w + (r32 >> 2), hh = r32 & 3, t = 64 * i + tl, head = 4 * g + hh;
    const int key = tid >> 3;
    const size_t m = (size_t)b * SEQ + t;
    const bf16_t* prow = P + m * EVPP;
    const int nt = ((4 * i + 2) >> 6) + 1, nA = 2 * nt;
    uint4 kreg = ldg_tile(KCB, key, 64, tid), vreg = ldg_tile(VCB, key, 64, tid);
    bf16x8 qf[4];
#pragma unroll
    for (int sp = 0; sp < 4; ++sp) qf[sp] = *(const bf16x8*)(prow + 2048 + head * 64 + 16 * sp + 8 * hi);
    qnorm_rope(qf, c.nsa_qg, (const float2*)(c.ws + WS_ROPE) + (size_t)t * 8, hi);
    float* IMP = (float*)(lds + O_IMP); unsigned long long* SELM = (unsigned long long*)(lds + O_SELM); u32* UM = (u32*)(lds + O_UM); int* JL = (int*)(lds + O_JL);
    float* RES = (float*)(lds + O_RES + w * RES_W) + r32 * RES_P;
#define NSA_GATE(k) (1.f / (1.f + __expf(-bf2f(P[((size_t)b * SEQ + t) * EVPP + 3328 + head * 3 + (k)]))))
    const int nmaxq = (t >= 31) ? ((t - 31) >> 4) : -1;
    State st; init(st, 0.f, 0.f);
    float inv = 0.f;
#define NSA_LOAD_A(IDX) do { const int idx_ = (IDX); const int kt_ = idx_ >= nt ? idx_ - nt : idx_; kreg = ldg_tile(KCB, 64 * kt_ + key, 64, tid); \
        if (idx_ < nt) vreg = ldg_tile(VCB, 64 * kt_ + key, 64, tid); \
        else { const int nn = 64 * kt_ + key, j0 = (tid & 7) * 8; u32 wv[4];     \
            _Pragma("unroll") for (int q = 0; q < 4; ++q) { const int ja = j0 + 2 * q, jb = ja + 1; \
                wv[q] = ((nn >= 4 * ja - 1 && nn <= 4 * ja + 3) ? 0x3f80u : 0u) | ((nn >= 4 * jb - 1 && nn <= 4 * jb + 3) ? 0x3f800000u : 0u); } \
            vreg.x = wv[0]; vreg.y = wv[1]; vreg.z = wv[2]; vreg.w = wv[3]; } } while (0)
    __syncthreads();
    sts_k(lds, 0, kreg, tid); sts_v(lds, 0, vreg, tid);
    NSA_LOAD_A(1);
    __syncthreads();
    for (int idx = 0; idx < nA; ++idx) {
        if (idx == nt) {
            const float lt = st.l + __shfl_xor(st.l, 32);
            inv = lt > 0.f ? 1.f / lt : 0.f;
            const float gci = NSA_GATE(0) * inv;
#pragma unroll
            for (int dt = 0; dt < 2; ++dt)
#pragma unroll
                for (int r = 0; r < 16; ++r) RES[32 * dt + crow(r, hi)] = gci * st.o[dt][r];
            const float mfin = st.m; init(st, mfin, 0.f);
        }
        const int kt = idx >= nt ? idx - nt : idx, cur = idx & 1;
        tile<ABL, FAST, false>(st, lds, O_KT + cur * KTB, O_VT + cur * VTB, qf, 0.f, true, RangeMask{0, nmaxq - 64 * kt}, lane);
        if (idx + 1 < nA) { sts_k(lds, cur ^ 1, kreg, tid); sts_v(lds, cur ^ 1, vreg, tid); if (idx + 2 < nA) NSA_LOAD_A(idx + 2); }
        __syncthreads();
    }
#undef NSA_LOAD_A
#pragma unroll
    for (int dt = 0; dt < 2; ++dt)
#pragma unroll
        for (int r = 0; r < 16; ++r) {
            float v = st.o[dt][r] * inv; v += __shfl_xor(v, 1); v += __shfl_xor(v, 2);
            if (hh == 0) IMP[tl * 64 + 32 * dt + crow(r, hi)] = v;
        }
    const bf16_t* PB = P + (size_t)b * SEQ * EVPP + g * 64;
#define KW (PB + 3072)
#define VW (PB + 3200)
#define KS (PB + 2816)
#define VS (PB + 2944)
    const int k0 = (i - 8 > 0) ? i - 8 : 0, nW = i - k0 + 1;
    kreg = ldg_tile(KW, 64 * k0 + key, EVPP, tid); vreg = ldg_tile(VW, 64 * k0 + key, EVPP, tid);
    if (tid < 2) UM[tid] = 0u;
    __syncthreads();
    {
        const int tk = tid >> 3, sub = tid & 7;
        float cand[8];
#pragma unroll
        for (int q = 0; q < 8; ++q) { const int j = 8 * sub + q; const bool allowed = j <= i, forced = (j == 0) || (j == i) || (j == i - 1);
            cand[q] = allowed ? IMP[tk * 64 + j] + (forced ? 1e4f : 0.f) : -INFINITY; }
        unsigned long long msk = 0ull;
#pragma unroll 1
        for (int rnd = 0; rnd < 8; ++rnd) {
            float bv = cand[0]; int bi = 0;
#pragma unroll
            for (int q = 1; q < 8; ++q) if (cand[q] > bv) { bv = cand[q]; bi = q; }
            bi += 8 * sub;
#pragma unroll
            for (int o = 1; o < 8; o <<= 1) { const float ov = __shfl_xor(bv, o); const int oi = __shfl_xor(bi, o); if (ov > bv || (ov == bv && oi < bi)) { bv = ov; bi = oi; } }
            if (bv > -INFINITY) {
                msk |= 1ull << bi;
#pragma unroll
                for (int q = 0; q < 8; ++q) if (8 * sub + q == bi) cand[q] = -INFINITY;
            }
        }
        if (sub == 0) { SELM[tk] = msk; atomicOr(&UM[0], (u32)msk); atomicOr(&UM[1], (u32)(msk >> 32)); }
    }
    __syncthreads();
    int nsel;
    {
        const unsigned long long um = (unsigned long long)UM[0] | ((unsigned long long)UM[1] << 32);
        nsel = __popcll(um);
        if (tid < 64 && ((um >> tid) & 1ull)) JL[__popcll(um & ((1ull << tid) - 1ull))] = tid;
    }
    sts_k(lds, 0, kreg, tid); sts_v(lds, 0, vreg, tid);
    __syncthreads();
    const int nB = nW + nsel;
    const unsigned long long mysel = SELM[tl];
#define NSA_LOAD_B(IDX) do { const int lidx_ = (IDX); if (lidx_ < nW) { const long row_ = 64 * (k0 + lidx_) + key; kreg = ldg_tile(KW, row_, EVPP, tid); vreg = ldg_tile(VW, row_, EVPP, tid); } \
        else { const long row_ = 64 * JL[lidx_ - nW] + key; kreg = ldg_tile(KS, row_, EVPP, tid); vreg = ldg_tile(VS, row_, EVPP, tid); } } while (0)
    NSA_LOAD_B(1);
    init(st, 0.f, 0.f);
#define NSA_STAGE_B(IDX) do { const int idx_ = (IDX); if (idx_ + 1 < nB) { sts_k(lds, (idx_ & 1) ^ 1, kreg, tid); sts_v(lds, (idx_ & 1) ^ 1, vreg, tid); if (idx_ + 2 < nB) NSA_LOAD_B(idx_ + 2); } __syncthreads(); } while (0)
    for (int idx = 0; idx < nW; ++idx) {
        const int cur = idx & 1, kt = k0 + idx; RangeMask mk{0, 63}; if (kt == i) mk.hi = tl; if (kt == i - 8) mk.lo = tl + 1;
        tile<ABL, FAST, false>(st, lds, O_KT + cur * KTB, O_VT + cur * VTB, qf, 0.f, (kt == i) || (kt == i - 8), mk, lane);
        NSA_STAGE_B(idx);
    }
    {
        const float lt = st.l + __shfl_xor(st.l, 32);
        const float sc = NSA_GATE(2) * (lt > 0.f ? 1.f / lt : 0.f);
#pragma unroll
        for (int dt = 0; dt < 2; ++dt)
#pragma unroll
            for (int r = 0; r < 16; ++r) RES[32 * dt + crow(r, hi)] += sc * st.o[dt][r];
        init(st, 0.f, 0.f);
    }
    for (int idx = nW; idx < nB; ++idx) {
        const int cur = idx & 1, j = JL[idx - nW]; const bool mine = ((mysel >> j) & 1ull) != 0ull;
        if (__any((int)mine)) tile<ABL, FAST, true>(st, lds, O_KT + cur * KTB, O_VT + cur * VTB, qf, mine ? 0.f : -INFINITY, j == i, RangeMask{0, tl}, lane);
        NSA_STAGE_B(idx);
    }
#undef NSA_STAGE_B
#undef NSA_LOAD_B
    {
        const float lt = st.l + __shfl_xor(st.l, 32);
        const float sc = NSA_GATE(1) * (lt > 0.f ? 1.f / lt : 0.f);
        unsigned char* stg = lds + O_STG + w * STG_W;
#pragma unroll
        for (int dt = 0; dt < 2; ++dt)
#pragma unroll
            for (int r = 0; r < 16; ++r) *(bf16_t*)(stg + r32 * STG_P + (32 * dt + crow(r, hi)) * 2) = f2bf(RES[32 * dt + crow(r, hi)] + sc * st.o[dt][r]);
        LDS_FENCE();
#pragma unroll
        for (int it = 0; it < 4; ++it) {
            const int row = it * 8 + (lane >> 3), ch = lane & 7;
            const uint4 v = *(const uint4*)(stg + row * STG_P + ch * 16);
            const size_t mm = (size_t)b * SEQ + 64 * i + 8 * w + (row >> 2);
            if (!DRY) *(uint4*)((bf16_t*)(c.ws + WS_H) + mm * D + 512 + (4 * g + (row & 3)) * 64 + ch * 8) = v;
            else if (v.x == 0x12345678u && v.y == 0x9abcdef0u) *(uint4*)((bf16_t*)(c.ws + WS_H) + mm * D + 512 + (4 * g + (row & 3)) * 64 + ch * 8) = v;
        }
        LDS_FENCE();
    }
#undef KW
#undef VW
#undef KS
#undef VS
#undef NSA_GATE
}
__device__ __forceinline__ float score_bound(const float* gq, const float* gk, int nk, int lane) {
    float a = fabsf(gq[lane]), b = 0.f;
    for (int x = 0; x < nk; ++x) b = fmaxf(b, fabsf(gk[64 * x + lane]));
    return fa::SC2 * 64.f * wmax(a) * wmax(b);
}
template <int ABL = 0, bool DRY = false>
__device__ __forceinline__ void nsa_mfma(const Ctx& c, unsigned char* lds) {
    const bool fast = score_bound(c.nsa_qg, c.nsa_kg, 3, c.lane) < 60.f;
    const int G = gridDim.x;
    for (int k = 0; k * G + (int)blockIdx.x < 2048; ++k) {
        const int u = k * G + blockIdx.x;
        int rank = u >> 5; const int bg = u & 31;
        if (G == 256 && (k & 1)) rank = 8 * k + 7 - ((u >> 5) - 8 * k);
        if (fast) nsa_unit<ABL, DRY, true>(c, lds, bg >> 1, 63 - rank, bg & 1); else nsa_unit<ABL, DRY, false>(c, lds, bg >> 1, 63 - rank, bg & 1);
    }
}

__device__ __forceinline__ void swa_load(const Ctx& c, int b, int i, int g, uint4 (&kr)[3], uint4 (&vr)[3], int tid) {
    using namespace fa;
    const bf16_t* P = (const bf16_t*)(c.ws + WS_PROJ);
    const int k0 = (i - 2 > 0) ? i - 2 : 0, n = i - k0 + 1;
    const bf16_t* Kb = P + (size_t)b * SEQ * ODP + 1024 + g * 64; const bf16_t* Vb = P + (size_t)b * SEQ * ODP + 1152 + g * 64;
#pragma unroll
    for (int x = 0; x < 3; ++x) if (x < n) { const long row = 64 * (k0 + x) + (tid >> 3); kr[x] = ldg_tile(Kb, row, ODP, tid); vr[x] = ldg_tile(Vb, row, ODP, tid); }
}
template <bool FAST>
__device__ __forceinline__ void swa_unit(const Ctx& c, unsigned char* lds, int b, int i, int g, uint4 (&kr)[3], uint4 (&vr)[3], bool has_next, int nb, int ni, int ng) {
    using namespace fa;
    constexpr int SW_K = 0, SW_V = 3 * KTB, SW_STG = 3 * KTB + 3 * VTB;
    static_assert(SW_STG + 8 * STG_W <= LDS_BARST, "swa LDS");
    const bf16_t* P = (const bf16_t*)(c.ws + WS_PROJ); bf16_t* ATT = (bf16_t*)(c.ws + WS_H);
    const int tid = c.tid, lane = c.lane, w = c.wave, r32 = lane & 31, hi = lane >> 5;
    const int tl = 8 * w + (r32 >> 2), hh = r32 & 3, t = 64 * i + tl;
    const size_t m = (size_t)b * SEQ + t;
    const int k0 = (i - 2 > 0) ? i - 2 : 0, n = i - k0 + 1;
#pragma unroll
    for (int x = 0; x < 3; ++x) if (x < n) kr[x] = knorm_rope(kr[x], c.swa_kg, (const float2*)(c.ws + WS_ROPE) + (size_t)(64 * (k0 + x) + (tid >> 3)) * 8, tid & 7);
    __syncthreads();
#pragma unroll
    for (int x = 0; x < 3; ++x) if (x < n) { *(uint4*)(lds + SW_K + x * KTB + (tid >> 3) * RPK + (tid & 7) * 16) = kr[x]; *(uint4*)(lds + SW_V + x * VTB + (tid >> 3) * RPV + (tid & 7) * 16) = vr[x]; }
    __syncthreads();
    if (has_next) swa_load(c, nb, ni, ng, kr, vr, tid);
#pragma unroll 1
    for (int hq = 0; hq < 2; ++hq) {
        const int head = 8 * g + 4 * hq + hh;
        bf16x8 qf[4];
#pragma unroll
        for (int sp = 0; sp < 4; ++sp) qf[sp] = *(const bf16x8*)(P + m * ODP + head * 64 + 16 * sp + 8 * hi);
        qnorm_rope(qf, c.swa_qg, (const float2*)(c.ws + WS_ROPE) + (size_t)t * 8, hi);
        State st; const float sink2 = c.swa_sinks[head] * 1.4426950408889634f;
        if (FAST) init(st, 0.f, hi == 0 ? __builtin_amdgcn_exp2f(sink2) : 0.f); else init(st, sink2, hi == 0 ? 1.f : 0.f);
#pragma unroll 1
        for (int x = 0; x < 3; ++x) {
            MoeItem mit; moe_item_decode(c, 1, ((((b * 64 + i) * 2 + g) * 3 + x) * 8 + w), mit);
            float4 mva, mvb, mvc, mvd;
            if (hq == 0) { const float* p_ = mit.W + (size_t)(mit.k0 + 4 * (lane >> 3)) * mit.N + mit.n0 + 4 * (lane & 7); const size_t N_ = mit.N;
                mva = *(const float4*)(p_); mvb = *(const float4*)(p_ + N_); mvc = *(const float4*)(p_ + 2 * N_); mvd = *(const float4*)(p_ + 3 * N_); }
            else { mva = mvb = mvc = mvd = make_float4(0.f, 0.f, 0.f, 0.f); }
            if (x < n) {
            const int kt = k0 + x;
            RangeMask mk{0, 63}; if (kt == i) mk.hi = tl; if (kt == i - 2) mk.lo = tl + 1;
            tile<0, FAST, false>(st, lds, SW_K + x * KTB, SW_V + x * VTB, qf, 0.f, (kt == i) || (kt == i - 2), mk, lane);
            }
            if (hq == 0) { bf16_t* const mout = mit.WT + (size_t)(mit.drow0 + mit.n0 + 4 * (lane & 7)) * mit.K + mit.k0 + 4 * (lane >> 3); const size_t mK = mit.K; uint2 w_;
                w_.x = pk2(mva.x, mvb.x); w_.y = pk2(mvc.x, mvd.x); *(uint2*)(mout) = w_;
                w_.x = pk2(mva.y, mvb.y); w_.y = pk2(mvc.y, mvd.y); *(uint2*)(mout + mK) = w_;
                w_.x = pk2(mva.z, mvb.z); w_.y = pk2(mvc.z, mvd.z); *(uint2*)(mout + 2 * mK) = w_;
                w_.x = pk2(mva.w, mvb.w); w_.y = pk2(mvc.w, mvd.w); *(uint2*)(mout + 3 * mK) = w_; }
        }
        unsigned char* stg = lds + SW_STG + w * STG_W;
        const float lt = st.l + __shfl_xor(st.l, 32);
        const float sc = 1.f / lt;
#pragma unroll
        for (int dt = 0; dt < 2; ++dt)
#pragma unroll
            for (int r = 0; r < 16; ++r) *(bf16_t*)(stg + r32 * STG_P + (32 * dt + crow(r, hi)) * 2) = f2bf(sc * st.o[dt][r]);
        LDS_FENCE();
#pragma unroll
        for (int it = 0; it < 4; ++it) {
            const int row = it * 8 + (lane >> 3), ch = lane & 7;
            const uint4 v = *(const uint4*)(stg + row * STG_P + ch * 16);
            const size_t mm = (size_t)b * SEQ + 64 * i + 8 * w + (row >> 2);
            *(uint4*)(ATT + mm * D + (8 * g + 4 * hq + (row & 3)) * 64 + ch * 8) = v;
        }
        LDS_FENCE();
    }
}
__device__ __forceinline__ void swa_mfma(const Ctx& c, unsigned char* lds) {
    const bool fast = score_bound(c.swa_qg, c.swa_kg, 1, c.lane) < 60.f && wmax(fabsf(c.swa_sinks[c.lane & 15])) < 40.f;
    uint4 kr[3], vr[3];
    if ((int)blockIdx.x < 2048) swa_load(c, blockIdx.x >> 7, (blockIdx.x >> 1) & 63, blockIdx.x & 1, kr, vr, c.tid);
    for (int u = blockIdx.x; u < 2048; u += gridDim.x) {
        const int g = u & 1, i = (u >> 1) & 63, b = u >> 7, un = u + gridDim.x;
        if (fast) swa_unit<true>(c, lds, b, i, g, kr, vr, un < 2048, un >> 7, (un >> 1) & 63, un & 1); else swa_unit<false>(c, lds, b, i, g, kr, vr, un < 2048, un >> 7, (un >> 1) & 63, un & 1);
    }
}

__device__ __forceinline__ void aout_fixup(const Ctx& c) {
    const bf16_t* P = (const bf16_t*)(c.ws + WS_PROJ); bf16_t* MIX = (bf16_t*)(c.ws + WS_H);
    const int lane = c.lane;
    float gn[8];
#pragma unroll
    for (int j = 0; j < 8; ++j) gn[j] = c.hg_gain[8 * (lane & 15) + j];
    for (int m0 = 4 * c.gw; m0 < M; m0 += 4 * c.ngw) {
        uint4 ow[4], gwv[4];
#pragma unroll
        for (int u = 0; u < 4; ++u) { ow[u] = *(const uint4*)(P + (size_t)(m0 + u) * EVPP + 1024 + 8 * lane); gwv[u] = *(const uint4*)(P + (size_t)(m0 + u) * EVPP + 1536 + 8 * lane); }
#pragma unroll
        for (int u = 0; u < 4; ++u) {
            float o[8], g[8]; unpack8(ow[u], o); unpack8(gwv[u], g);
            float sq = 0.f;
#pragma unroll
            for (int j = 0; j < 8; ++j) sq += o[j] * o[j];
            sq += __shfl_xor(sq, 1); sq += __shfl_xor(sq, 2); sq += __shfl_xor(sq, 4); sq += __shfl_xor(sq, 8);
            const float rstd = rsqrtf(sq * (1.f / 128.f) + EPS);
            float r[8];
#pragma unroll
            for (int j = 0; j < 8; ++j) r[j] = o[j] * rstd * gn[j] * (g[j] / (1.f + __expf(-g[j])));
            uint4 w; w.x = pk2(r[0], r[1]); w.y = pk2(r[2], r[3]); w.z = pk2(r[4], r[5]); w.w = pk2(r[6], r[7]);
            *(uint4*)(MIX + (size_t)(m0 + u) * D + 8 * lane) = w;
        }
    }
}

__device__ __forceinline__ void swa_naive(const Ctx& c, float* lds) {
    const bf16_t* P = (const bf16_t*)(c.ws + WS_PROJ); bf16_t* ATT = (bf16_t*)(c.ws + WS_H);
    float* qs = lds + c.wave * ATT_WSTRIDE; float* ps = qs + 256; int* bl = (int*)(ps + 2048);
    const int lane = c.lane;
    for (int task = c.gw; task < M * 4; task += c.ngw) {
        const int hq = task & 1, g = (task >> 1) & 1, m = task >> 2, b = m >> 12, t = m & (SEQ - 1);
        const bf16_t* prow = P + (size_t)m * ODP;
        const int head0 = g * 8 + hq * 4;
#pragma unroll
        for (int hh = 0; hh < 4; ++hh) qs[hh * 64 + lane] = bf2f(prow[(head0 + hh) * 64 + lane]);
        if (lane < 2) bl[lane] = t - 127 + 64 * lane;
        LDS_FENCE();
        const float sink[4] = {c.swa_sinks[head0], c.swa_sinks[head0 + 1], c.swa_sinks[head0 + 2], c.swa_sinks[head0 + 3]};
        float o[4], inv[4];
        attn_rounds<true>(P + (size_t)b * SEQ * ODP + 1024 + g * 64, P + (size_t)b * SEQ * ODP + 1152 + g * 64, ODP, bl, 2, 0, t, qs, ps, sink, o, inv, lane);
#pragma unroll
        for (int hh = 0; hh < 4; ++hh) ATT[(size_t)m * D + (head0 + hh) * 64 + lane] = f2bf(o[hh]);
        LDS_FENCE();
    }
}

__device__ __forceinline__ void phase_router(const Ctx& c, float* lds, int layer) {
    float* wl = lds;
    int* lcnt = (int*)(lds + 36 * 1024);
    int* lbase = lcnt + 32;
    int* tinfo = lbase + 32;
    float* twt = (float*)(tinfo + 1024);
    const float* wg = c.moe_w_grp + (size_t)layer * 1024 * 4; const float* we = c.moe_w_exp + (size_t)layer * 1024 * 32;
    const float* bg = c.moe_b_grp + layer * 4; const float* be = c.moe_b_exp + layer * 32; const float* gain = c.moe_norm + layer * D;
    int* gcnt = (int*)(c.ws + WS_CTL) + layer * 32;
    bf16_t* H = (bf16_t*)(c.ws + WS_H);
    int* TE = (int*)(c.ws + WS_TE); int* TR = (int*)(c.ws + WS_TR); float* TW = (float*)(c.ws + WS_TW);
    for (int i = c.tid; i < 36 * 1024; i += NTHREADS) { const int o = i >> 10, k = i & 1023; wl[i] = o < 4 ? wg[k * 4 + o] : we[k * 32 + (o - 4)]; }
    if (c.tid < 32) lcnt[c.tid] = 0;
    __syncthreads();
    for (int blk = blockIdx.x; blk < M / 256; blk += gridDim.x) {
        const bf16_t* XB = (const bf16_t*)(c.ws + WS_XB);
        uint2 vn[4];
        { const uint2* xr0 = (const uint2*)(XB + (size_t)(blk * 256 + c.wave * 32) * D) + c.lane;
#pragma unroll
          for (int j = 0; j < 4; ++j) vn[j] = xr0[64 * j]; }
        for (int i = 0; i < 32; ++i) {
            const int tl = c.wave * 32 + i, m = blk * 256 + tl;
            float4 v[4]; float s = 0.f;
#pragma unroll
            for (int j = 0; j < 4; ++j) { v[j] = make_float4(__uint_as_float(vn[j].x << 16), __uint_as_float(vn[j].x & 0xffff0000u), __uint_as_float(vn[j].y << 16), __uint_as_float(vn[j].y & 0xffff0000u));
                s += v[j].x * v[j].x + v[j].y * v[j].y + v[j].z * v[j].z + v[j].w * v[j].w; }
            if (i + 1 < 32) {
                const uint2* xr1 = (const uint2*)(XB + (size_t)(m + 1) * D) + c.lane;
#pragma unroll
                for (int j = 0; j < 4; ++j) vn[j] = xr1[64 * j];
            }
            const float rstd = rsqrtf(wsum(s) * (1.f / D) + EPS);
            uint2* ho = (uint2*)(H + (size_t)m * D) + c.lane;
#pragma unroll
            for (int j = 0; j < 4; ++j) {
                const float4 g = ((const float4*)gain)[c.lane + 64 * j];
                v[j].x *= rstd * g.x; v[j].y *= rstd * g.y; v[j].z *= rstd * g.z; v[j].w *= rstd * g.w;
                uint2 w; w.x = pk2(v[j].x, v[j].y); w.y = pk2(v[j].z, v[j].w); ho[64 * j] = w;
            }
            float g4[4]; int gi = 0;
#pragma unroll
            for (int o = 0; o < 4; ++o) {
                float a = 0.f;
#pragma unroll
                for (int j = 0; j < 4; ++j) { const float4 w = ((const float4*)(wl + o * 1024))[c.lane + 64 * j]; a += v[j].x * w.x + v[j].y * w.y + v[j].z * w.z + v[j].w * w.w; }
                g4[o] = wsum(a) + bg[o];
            }
            float gm = g4[0];
#pragma unroll
            for (int q = 1; q < 4; ++q) if (g4[q] > gm) { gm = g4[q]; gi = q; }
            float gs = 0.f;
#pragma unroll
            for (int q = 0; q < 4; ++q) gs += expf(g4[q] - gm);
            const float gwt = 1.f / gs;
            float w8[8];
#pragma unroll
            for (int o = 0; o < 8; ++o) {
                float a = 0.f; const float* wr = wl + (4 + gi * 8 + o) * 1024;
#pragma unroll
                for (int j = 0; j < 4; ++j) { const float4 w = ((const float4*)wr)[c.lane + 64 * j]; a += v[j].x * w.x + v[j].y * w.y + v[j].z * w.z + v[j].w * w.w; }
                w8[o] = wsum(a) + be[gi * 8 + o];
            }
            int j0 = 0; float l0 = w8[0];
#pragma unroll
            for (int j = 1; j < 8; ++j) if (w8[j] > l0) { l0 = w8[j]; j0 = j; }
            int j1 = -1; float l1 = -INFINITY;
#pragma unroll
            for (int j = 0; j < 8; ++j) if (j != j0 && w8[j] > l1) { l1 = w8[j]; j1 = j; }
            const float e1 = expf(l1 - l0); const float w0 = gwt / (1.f + e1), w1 = gwt * e1 / (1.f + e1);
            if (c.lane == 0) {
                const int ea = gi * 8 + j0, eb = gi * 8 + j1;
                const int ra = atomicAdd(&lcnt[ea], 1), rb = atomicAdd(&lcnt[eb], 1);
                tinfo[tl * 4 + 0] = ea; tinfo[tl * 4 + 1] = eb; tinfo[tl * 4 + 2] = ra; tinfo[tl * 4 + 3] = rb; twt[tl * 2] = w0; twt[tl * 2 + 1] = w1;
            }
        }
        __syncthreads();
        if (c.tid < 32) { lbase[c.tid] = atomicAdd(&gcnt[c.tid], lcnt[c.tid]); lcnt[c.tid] = 0; }
        __syncthreads();
        if (c.tid < 256) {
            const int m = blk * 256 + c.tid; const int ea = tinfo[c.tid * 4], eb = tinfo[c.tid * 4 + 1];
            TE[2 * m] = ea; TE[2 * m + 1] = eb; TR[2 * m] = lbase[ea] + tinfo[c.tid * 4 + 2]; TR[2 * m + 1] = lbase[eb] + tinfo[c.tid * 4 + 3];
            TW[2 * m] = twt[c.tid * 2]; TW[2 * m + 1] = twt[c.tid * 2 + 1];
        }
        __syncthreads();
    }
}

__device__ __forceinline__ void phase_router2(const Ctx& c, unsigned char* lds_raw, int layer) {
    typedef short bf16x8 __attribute__((ext_vector_type(8)));
    typedef float f32x4 __attribute__((ext_vector_type(4)));
    const int tid = c.tid, lane = c.lane, w = c.wave, l15 = lane & 15, g4 = lane >> 4;
    float* LG = (float*)(lds_raw + w * 5632);
    float* RS = LG + 32 * 40;
    int* lcnt = (int*)(lds_raw + 8 * 5632);
    int* lbase = lcnt + 32;
    int* tinfo = lbase + 32;
    float* twt = (float*)(tinfo + 1024);
    const bf16_t* XB = (const bf16_t*)(c.ws + WS_XB); const bf16_t* RW = (const bf16_t*)(c.ws + WS_RW) + (size_t)layer * 48 * 2048;
    const float* bg = c.moe_b_grp + layer * 4; const float* be = c.moe_b_exp + layer * 32; const float* gain = c.moe_norm + layer * D;
    int* gcnt = (int*)(c.ws + WS_CTL) + layer * 32;
    bf16_t* H = (bf16_t*)(c.ws + WS_H);
    int* TE = (int*)(c.ws + WS_TE); int* TR = (int*)(c.ws + WS_TR); float* TW = (float*)(c.ws + WS_TW);
    __syncthreads();
    if (tid < 32) lcnt[tid] = 0;
    __syncthreads();
    for (int blk = blockIdx.x; blk < M / 256; blk += gridDim.x) {
        const int tok0 = blk * 256 + w * 32;
        f32x4 acc[2][3];
#pragma unroll
        for (int mt = 0; mt < 2; ++mt)
#pragma unroll
            for (int nt = 0; nt < 3; ++nt) acc[mt][nt] = (f32x4){0.f, 0.f, 0.f, 0.f};
        float sq0 = 0.f, sq1 = 0.f;
        const bf16_t* a0 = XB + (size_t)(tok0 + l15) * D + 8 * g4; const bf16_t* a1 = a0 + (size_t)16 * D;
        const bf16_t* b0 = RW + (size_t)l15 * 2048 + 8 * g4;
#pragma unroll 2
        for (int ks = 0; ks < 32; ++ks) {
            const bf16x8 A0 = *(const bf16x8*)(a0 + 32 * ks), A1 = *(const bf16x8*)(a1 + 32 * ks);
            { float f[8]; unpack8(__builtin_bit_cast(uint4, A0), f);
#pragma unroll
              for (int j = 0; j < 8; ++j) sq0 += f[j] * f[j];
              unpack8(__builtin_bit_cast(uint4, A1), f);
#pragma unroll
              for (int j = 0; j < 8; ++j) sq1 += f[j] * f[j]; }
#pragma unroll
            for (int nt = 0; nt < 3; ++nt) {
                const bf16x8 Bh = *(const bf16x8*)(b0 + (size_t)nt * 16 * 2048 + 32 * ks), Bl = *(const bf16x8*)(b0 + (size_t)nt * 16 * 2048 + 1024 + 32 * ks);
                acc[0][nt] = __builtin_amdgcn_mfma_f32_16x16x32_bf16(A0, Bh, acc[0][nt], 0, 0, 0); acc[0][nt] = __builtin_amdgcn_mfma_f32_16x16x32_bf16(A0, Bl, acc[0][nt], 0, 0, 0);
                acc[1][nt] = __builtin_amdgcn_mfma_f32_16x16x32_bf16(A1, Bh, acc[1][nt], 0, 0, 0); acc[1][nt] = __builtin_amdgcn_mfma_f32_16x16x32_bf16(A1, Bl, acc[1][nt], 0, 0, 0);
            }
        }
        sq0 += __shfl_xor(sq0, 16); sq0 += __shfl_xor(sq0, 32); sq1 += __shfl_xor(sq1, 16); sq1 += __shfl_xor(sq1, 32);
        if (g4 == 0) { RS[l15] = rsqrtf(sq0 * (1.f / D) + EPS); RS[16 + l15] = rsqrtf(sq1 * (1.f / D) + EPS); }
        LDS_FENCE();
#pragma unroll
        for (int nt = 0; nt < 3; ++nt) {
            const int o = 16 * nt + l15;
            if (o < 36) {
                const float bias = o < 4 ? bg[o] : be[o - 4];
#pragma unroll
                for (int mt = 0; mt < 2; ++mt)
#pragma unroll
                    for (int r = 0; r < 4; ++r) { const int tk = 16 * mt + 4 * g4 + r; LG[tk * 40 + o] = acc[mt][nt][r] * RS[tk] + bias; }
            }
        }
        LDS_FENCE();
        if (lane < 32) {
            const float* lg = LG + lane * 40;
            int gi = 0; float gm = lg[0];
#pragma unroll
            for (int q = 1; q < 4; ++q) if (lg[q] > gm) { gm = lg[q]; gi = q; }
            float gs = 0.f;
#pragma unroll
            for (int q = 0; q < 4; ++q) gs += expf(lg[q] - gm);
            const float gwt = 1.f / gs;
            float w8[8];
#pragma unroll
            for (int j = 0; j < 8; ++j) w8[j] = lg[4 + gi * 8 + j];
            int j0 = 0; float l0 = w8[0];
#pragma unroll
            for (int j = 1; j < 8; ++j) if (w8[j] > l0) { l0 = w8[j]; j0 = j; }
            int j1 = -1; float l1 = -INFINITY;
#pragma unroll
            for (int j = 0; j < 8; ++j) if (j != j0 && w8[j] > l1) { l1 = w8[j]; j1 = j; }
            const float e1 = expf(l1 - l0); const float w0 = gwt / (1.f + e1), w1 = gwt * e1 / (1.f + e1);
            const int tl = w * 32 + lane, ea = gi * 8 + j0, eb = gi * 8 + j1;
            const int ra = atomicAdd(&lcnt[ea], 1), rb = atomicAdd(&lcnt[eb], 1);
            tinfo[tl * 4 + 0] = ea; tinfo[tl * 4 + 1] = eb; tinfo[tl * 4 + 2] = ra; tinfo[tl * 4 + 3] = rb; twt[tl * 2] = w0; twt[tl * 2 + 1] = w1;
        }
        {
            float4 gq[4];
#pragma unroll
            for (int j = 0; j < 4; ++j) gq[j] = ((const float4*)gain)[lane + 64 * j];
#pragma unroll 2
            for (int i = 0; i < 32; ++i) {
                const size_t m = (size_t)tok0 + i; const float rs = RS[i];
                const uint2* xr = (const uint2*)(XB + m * D) + lane; uint2* ho = (uint2*)(H + m * D) + lane;
#pragma unroll
                for (int j = 0; j < 4; ++j) { const uint2 xv = xr[64 * j]; uint2 o;
                    o.x = pk2(__uint_as_float(xv.x << 16) * rs * gq[j].x, __uint_as_float(xv.x & 0xffff0000u) * rs * gq[j].y);
                    o.y = pk2(__uint_as_float(xv.y << 16) * rs * gq[j].z, __uint_as_float(xv.y & 0xffff0000u) * rs * gq[j].w); ho[64 * j] = o; }
            }
        }
        __syncthreads();
        if (tid < 32) { lbase[tid] = atomicAdd(&gcnt[tid], lcnt[tid]); lcnt[tid] = 0; }
        __syncthreads();
        if (tid < 256) {
            const int m = blk * 256 + tid; const int ea = tinfo[tid * 4], eb = tinfo[tid * 4 + 1];
            TE[2 * m] = ea; TE[2 * m + 1] = eb; TR[2 * m] = lbase[ea] + tinfo[tid * 4 + 2]; TR[2 * m + 1] = lbase[eb] + tinfo[tid * 4 + 3];
            TW[2 * m] = twt[tid * 2]; TW[2 * m + 1] = twt[tid * 2 + 1];
            int* LIST = (int*)(c.ws + WS_LIST);
            LIST[(size_t)ea * 65536 + lbase[ea] + tinfo[tid * 4 + 2]] = m; LIST[(size_t)eb * 65536 + lbase[eb] + tinfo[tid * 4 + 3]] = m;
        }
        __syncthreads();
    }
}

__device__ __forceinline__ void phase_scatter(const Ctx& c, float* lds, int layer) {
    int* ps = (int*)lds;
    const int* gcnt = (const int*)(c.ws + WS_CTL) + layer * 32;
    if (c.tid == 0) { int a = 0; for (int e = 0; e < 32; ++e) { ps[e] = a; a += (gcnt[e] + 255) / 256 * 256; } ps[32] = a; }
    __syncthreads();
    const int* TE = (const int*)(c.ws + WS_TE); const int* TR = (const int*)(c.ws + WS_TR); const float* TW = (const float*)(c.ws + WS_TW);
    int* TSLOT = (int*)(c.ws + WS_TSLOT); int* ROWTOK = (int*)(c.ws + WS_ROWTOK); float* ROWW = (float*)(c.ws + WS_ROWW); int* TILEE = (int*)(c.ws + WS_TILEE);
    const int gt = blockIdx.x * NTHREADS + c.tid, ngt = gridDim.x * NTHREADS;
    for (int a = gt; a < 2 * M; a += ngt) { const int e = TE[a], slot = ps[e] + TR[a]; TSLOT[a] = slot; ROWTOK[slot] = a >> 1; ROWW[slot] = TW[a]; }
    for (int i = gt; i < 32 * 256; i += ngt) { const int e = i >> 8, r = i & 255; const int cnt = gcnt[e], pc = (cnt + 255) / 256 * 256; if (cnt + r < pc) { ROWTOK[ps[e] + cnt + r] = 0; ROWW[ps[e] + cnt + r] = 0.f; } }
    for (int st = gt; st < MAXTILES; st += ngt) { int e = -1; for (int q = 0; q < 32; ++q) if (st * 256 >= ps[q] && st * 256 < ps[q + 1]) e = q; TILEE[st] = e; }
    if (gt == 0) TILEE[600] = ps[32] / 256;
}

__device__ __forceinline__ void phase_moe1_naive(const Ctx& c, float* lds, int layer) {
    const int* TILEE = (const int*)(c.ws + WS_TILEE); const int nt = TILEE[600];
    const bf16_t* H = (const bf16_t*)(c.ws + WS_H); bf16_t* HID = (bf16_t*)(c.ws + WS_HID);
    ARowGather ar{H, D, (const int*)(c.ws + WS_ROWTOK)}; EpiGU epi{HID};
    const int total = nt * 2 * 16;
    for (int u = blockIdx.x; u < total; u += gridDim.x) {
        const int st128 = u / 16, nvt = u % 16, e = TILEE[st128 >> 1];
        BRowGU br{(const bf16_t*)(c.ws + WS_WGU) + (size_t)(layer * 32 + e) * 1024 * 1024, D};
        gemm_naive_tile(lds, st128 * 128, nvt * 64, D, ar, br, epi);
    }
}
__device__ __forceinline__ void phase_moe2_naive(const Ctx& c, float* lds, int layer) {
    const int* TILEE = (const int*)(c.ws + WS_TILEE); const int nt = TILEE[600];
    const bf16_t* HID = (const bf16_t*)(c.ws + WS_HID); bf16_t* YS = (bf16_t*)(c.ws + WS_YS);
    ARowPlain ar{HID, FF}; EpiDown epi{YS, (const float*)(c.ws + WS_ROWW)};
    const int total = nt * 2 * 16;
    for (int u = blockIdx.x; u < total; u += gridDim.x) {
        const int st128 = u / 16, nt64 = u % 16, e = TILEE[st128 >> 1];
        BRowPlain br{(const bf16_t*)(c.ws + WS_WD) + (size_t)(layer * 32 + e) * 1024 * 512, FF};
        gemm_naive_tile(lds, st128 * 128, nt64 * 64, FF, ar, br, epi);
    }
}


__device__ __forceinline__ int build_tile_table(const Ctx& c, unsigned char* lds_raw, int layer) {
    const int* gcnt = (const int*)(c.ws + WS_CTL) + layer * 32;
    int* pst = (int*)(lds_raw + pg8::STAGE_BYTES); int* te = pst + 64; int* tv = te + MAXTILES; int* tg = tv + MAXTILES;
    __syncthreads();
    if (c.tid == 0) { int a = 0; for (int e = 0; e < 32; ++e) { pst[e] = a; a += (gcnt[e] + 255) >> 8; } pst[32] = a; }
    __syncthreads();
    for (int st = c.tid; st < MAXTILES; st += NTHREADS) {
        int e = 31;
        for (int q = 0; q < 32; ++q) if (st >= pst[q] && st < pst[q + 1]) e = q;
        const int ti = st - pst[e], rem = gcnt[e] - 256 * ti;
        te[st] = e; tv[st] = rem < 256 ? (rem > 0 ? rem : 0) : 256; tg[st] = e * 65536 + 256 * ti;
    }
    __syncthreads();
    return pst[32];
}
__device__ __forceinline__ void phase_moe1_mfma(const Ctx& c, unsigned char* lds_raw, int layer) {
    const int nt = build_tile_table(c, lds_raw, layer);
    const int* te = (const int*)(lds_raw + pg8::STAGE_BYTES) + 64;
    pg8::Gemm g{(const bf16_t*)(c.ws + WS_H), (const bf16_t*)(c.ws + WS_WGU) + (size_t)layer * 32 * 1024 * 1024, D, (const int*)(c.ws + WS_LIST), (size_t)1024 * 1024};
    pg8::MoeOrder S{te, te + MAXTILES, te + 2 * MAXTILES, nt * 4, (int)gridDim.x, (int)blockIdx.x};
    pg8::EpiGUT E{(bf16_t*)(c.ws + WS_HID)};
    pg8::gemm_phase<pg8::EpiGUT, pg8::MoeOrder, true>((PG8_LAS unsigned char*)lds_raw, g, S, E);
}
__device__ __forceinline__ void phase_moe2_mfma(const Ctx& c, unsigned char* lds_raw, int layer) {
    const int nt = build_tile_table(c, lds_raw, layer);
    const int* te = (const int*)(lds_raw + pg8::STAGE_BYTES) + 64;
    pg8::Gemm g{(const bf16_t*)(c.ws + WS_HID), (const bf16_t*)(c.ws + WS_WD) + (size_t)layer * 32 * 1024 * 512, FF, nullptr, (size_t)1024 * 512};
    pg8::MoeOrder S{te, te + MAXTILES, te + 2 * MAXTILES, nt * 4, (int)gridDim.x, (int)blockIdx.x};
    pg8::EpiDownT E{(bf16_t*)(c.ws + WS_YS)};
    pg8::gemm_phase<pg8::EpiDownT, pg8::MoeOrder, false>((PG8_LAS unsigned char*)lds_raw, g, S, E);
}
template <class Epi>
__device__ __forceinline__ void phase_gemm_mfma(unsigned char* lds_raw, const bf16_t* A, const bf16_t* Bt, int Npad, int K, const Epi& E) {
    pg8::Gemm g{A, Bt, K, nullptr, 0}; pg8::StaticOrder S; S.init(M, Npad, (int)gridDim.x, (int)blockIdx.x);
    pg8::gemm_phase<Epi, pg8::StaticOrder, false>((PG8_LAS unsigned char*)lds_raw, g, S, E);
}

typedef const __attribute__((address_space(4))) Args CArgs;
__device__ __forceinline__ void make_ctx(Ctx& c, CArgs& a, int tid_) {
    c.x = a.in[0]; c.ev_norm = a.in[1]; c.ev_w_in = a.in[2]; c.hg_lb = a.in[3]; c.hg_gain = a.in[4]; c.nsa_qg = a.in[5]; c.nsa_kg = a.in[6]; c.cmp_pe = a.in[7];
    c.cmp_w1 = a.in[8]; c.cmp_w2 = a.in[9]; c.ev_w_out = a.in[10]; c.od_norm = a.in[11]; c.od_w_in = a.in[12]; c.swa_qg = a.in[13]; c.swa_kg = a.in[14]; c.swa_sinks = a.in[15];
    c.od_w_out = a.in[16]; c.moe_norm = a.in[17]; c.moe_w_grp = a.in[18]; c.moe_b_grp = a.in[19]; c.moe_w_exp = a.in[20]; c.moe_b_exp = a.in[21];
    c.moe_w_gate = a.in[22]; c.moe_w_up = a.in[23]; c.moe_w_down = a.in[24];
    c.xr = a.out; c.ws = a.ws;
    c.tid = tid_; c.lane = c.tid & 63; c.wave = c.tid >> 6; c.gw = blockIdx.x * NWAVES + c.wave; c.ngw = gridDim.x * NWAVES;
}

#ifndef PSTAMP
#define PSTAMP(k) do {} while (0)
#endif
#define PHASE_BEGIN() Ctx c; { CArgs* ap_ = (CArgs*)__builtin_amdgcn_kernarg_segment_ptr(); asm volatile("" : "+s"(ap_)); int tid_ = threadIdx.x; asm volatile("" : "+v"(tid_)); make_ctx(c, *ap_, tid_); } \
    unsigned char* ws = c.ws; bf16_t* H = (bf16_t*)(ws + WS_H); bf16_t* PROJ = (bf16_t*)(ws + WS_PROJ); (void)H; (void)PROJ;
__global__ void __launch_bounds__(NTHREADS, 2) mega(Args a) {
    extern __shared__ __attribute__((aligned(16))) unsigned char lds_raw[];
    float* lds = (float*)lds_raw;
    if (threadIdx.x < 4) ((volatile XLAS unsigned*)(XLAS unsigned char*)lds_raw)[(LDS_BARST >> 2) + threadIdx.x] = 0u;
    __syncthreads();
    const XcdBarrier xbar = xcd_barrier_post((unsigned*)(a.ws + WS_CTL + CTL_BAR), (volatile XLAS unsigned*)((XLAS unsigned char*)lds_raw + LDS_BARST));
    PSTAMP(0); { PHASE_BEGIN(); phase_prologue(c, lds); PSTAMP(23); phase_norm_x(c, c.x, c.ev_norm, H); }
    xcd_barrier(xbar);
    PSTAMP(1); { PHASE_BEGIN(); pg8::EpiProj0T epi{PROJ, (float*)(ws + WS_LOGF), (const float*)(ws + WS_LB)}; phase_gemm_mfma(lds_raw, H, (const bf16_t*)(ws + WS_W0T), EVPP, D, epi); }
    xcd_barrier(xbar);
    PSTAMP(2); { PHASE_BEGIN();
      post_even(c, blockIdx.x, gridDim.x); PSTAMP(20);
      for (int u = blockIdx.x; u < 256; u += gridDim.x) compress_mfma(c, lds_raw, u);
      PSTAMP(21);
      for (int su = blockIdx.x; su < 256; su += gridDim.x) hgrn2_passA(c, lds_raw, su); }
    xcd_barrier(xbar);
    PSTAMP(24); { PHASE_BEGIN();
      for (int u = blockIdx.x; u < 256; u += gridDim.x) hgrn2_seq(c, lds_raw, u); }
    xcd_barrier(xbar);
    PSTAMP(3); { PHASE_BEGIN(); nsa_mfma(c, lds_raw); PSTAMP(22);
#ifdef PROBE_NSA_ABL
      nsa_mfma<PROBE_NSA_ABL, true>(c, lds_raw);
#endif
      aout_fixup(c); }
    xcd_barrier(xbar);
    PSTAMP(4); { PHASE_BEGIN(); pg8::EpiResidF2B epi{c.x, (bf16_t*)(ws + WS_XB)}; phase_gemm_mfma(lds_raw, H, (const bf16_t*)(ws + WS_WO0T), D, D, epi); }
    xcd_barrier(xbar);
    PSTAMP(5); { PHASE_BEGIN(); phase_router2(c, lds_raw, 0); }
    xcd_barrier(xbar);
    PSTAMP(7); { PHASE_BEGIN(); phase_moe1_mfma(c, lds_raw, 0); }
    xcd_barrier(xbar);
    PSTAMP(8); { PHASE_BEGIN(); phase_moe2_mfma(c, lds_raw, 0); }
    xcd_barrier(xbar);
    PSTAMP(9); { PHASE_BEGIN(); phase_combine<false>(c, (bf16_t*)(ws + WS_XB), nullptr, c.od_norm, H, (const bf16_t*)(ws + WS_YS), 0); }
    xcd_barrier(xbar);
    PSTAMP(10); { PHASE_BEGIN(); pg8::EpiRawT epi{PROJ, ODP}; phase_gemm_mfma(lds_raw, H, (const bf16_t*)(ws + WS_W1T), ODP, D, epi); }
    xcd_barrier(xbar);
    PSTAMP(12); { PHASE_BEGIN(); swa_mfma(c, lds_raw); }
    xcd_barrier(xbar);
    PSTAMP(13); { PHASE_BEGIN(); pg8::EpiResidB2B epi{(bf16_t*)(ws + WS_XB)}; phase_gemm_mfma(lds_raw, H, (const bf16_t*)(ws + WS_WO1T), D, D, epi); }
    xcd_barrier(xbar);
    PSTAMP(14); { PHASE_BEGIN(); phase_router2(c, lds_raw, 1); }
    xcd_barrier(xbar);
    PSTAMP(16); { PHASE_BEGIN(); phase_moe1_mfma(c, lds_raw, 1); }
    xcd_barrier(xbar);
    PSTAMP(17); { PHASE_BEGIN(); phase_moe2_mfma(c, lds_raw, 1); }
    xcd_barrier(xbar);
    PSTAMP(18); { PHASE_BEGIN(); phase_combine<true>(c, (bf16_t*)(ws + WS_XB), c.xr, nullptr, nullptr, (const bf16_t*)(ws + WS_YS), 1); }
    PSTAMP(19);
#ifdef PROBE_TAIL
    PROBE_TAIL
#endif
}

extern "C" void kernel_launch(void* const* d_in, const int* in_sizes, int n_in, void* d_out, int out_size, void* d_ws, size_t ws_size, hipStream_t stream) {
    static int grid = 0;
    if (grid == 0) {
        if (n_in != 25 || ws_size < WS_END) { fprintf(stderr, "kernel_launch: unexpected n_in %d / ws %zu\n", n_in, ws_size); grid = -1; return; }
        int dev = 0, cus = 0, per_cu = 0;
        hipGetDevice(&dev);
        hipDeviceGetAttribute(&cus, hipDeviceAttributeMultiprocessorCount, dev);
        hipFuncSetAttribute((const void*)mega, hipFuncAttributeMaxDynamicSharedMemorySize, LDS_BYTES);
        hipOccupancyMaxActiveBlocksPerMultiprocessor(&per_cu, (const void*)mega, NTHREADS, LDS_BYTES);
        if (per_cu < 1) { fprintf(stderr, "kernel_launch: occupancy query says %d blocks/CU\n", per_cu); per_cu = 1; }
        (void)hipGetLastError();
        grid = cus;
    }
    if (grid < 0) return;
    hipMemsetAsync((char*)d_ws + WS_CTL, 0, CTL_BYTES, stream);
    Args a{};
    for (int i = 0; i < 25; ++i) a.in[i] = (const float*)d_in[i];
    a.out = (float*)d_out; a.ws = (unsigned char*)d_ws;
    void* args[] = {&a};
    hipError_t e = hipLaunchCooperativeKernel((const void*)mega, dim3(grid), dim3(NTHREADS), args, LDS_BYTES, stream);
    if (e != hipSuccess) fprintf(stderr, "cooperative launch failed: %s (grid %d)\n", hipGetErrorString(e), grid);
}
```

```cpp
#include <hip/hip_runtime.h>
#include <hip/hip_cooperative_groups.h>
#include <cstdio>
#include <cstdint>
namespace cg = cooperative_groups;

constexpr int D = 1024, BATCH = 16, SEQ = 4096, M = BATCH * SEQ;
constexpr int EVP = 3352, EVPP = 3584, ODP = 1280;
constexpr int NEXP = 32, FF = 512;
constexpr int NTHREADS = 512, NWAVES = 8;
constexpr int MAXTILES = 544;
constexpr int NSLOTS = MAXTILES * 256;
constexpr float EPS = 1e-6f;

typedef unsigned short bf16_t;
typedef unsigned int u32;

constexpr size_t MiB = 1u << 20;
constexpr size_t WS_CTL = 0;
constexpr size_t CTL_BYTES = 64 * 1024;
constexpr size_t WS_LB = 1 * MiB;
constexpr size_t WS_CBIAS = WS_LB + 4096;
constexpr size_t WS_ROPE = WS_LB + 8192;
constexpr size_t WS_KCB = 2 * MiB;
constexpr size_t WS_VCB = 3 * MiB;
constexpr size_t WS_TE = 4 * MiB;
constexpr size_t WS_TR = 4 * MiB + 512 * 1024;
constexpr size_t WS_TW = 5 * MiB;
constexpr size_t WS_TSLOT = 5 * MiB + 512 * 1024;
constexpr size_t WS_ROWTOK = 6 * MiB;
constexpr size_t WS_ROWW = 7 * MiB;
constexpr size_t WS_TILEE = 8 * MiB;
constexpr size_t WS_W0T = 16 * MiB;
constexpr size_t WS_WO0T = 23 * MiB;
constexpr size_t WS_W1T = 25 * MiB;
constexpr size_t WS_WO1T = 28 * MiB;
constexpr size_t WS_CW1T = 30 * MiB;
constexpr size_t WS_CW2T = 32 * MiB;
constexpr size_t WS_RW = 33 * MiB;
constexpr size_t WS_WGU = 40 * MiB;
constexpr size_t WS_WD = 168 * MiB;
constexpr size_t WS_H = 232 * MiB;
constexpr size_t WS_PROJ = 360 * MiB;
constexpr size_t WS_HID = WS_PROJ;
constexpr size_t WS_YS = WS_PROJ + 136 * MiB;
constexpr size_t WS_LOGF = 808 * MiB;
constexpr size_t WS_XB = WS_LOGF;
constexpr size_t WS_LIST = 936 * MiB;
constexpr size_t WS_RSL = 944 * MiB;
constexpr size_t WS_RSTD = 952 * MiB;
constexpr size_t WS_END = 953 * MiB;

constexpr int LDS_BYTES = 160 * 1024;
constexpr int LDS_BARST = LDS_BYTES - 16;
constexpr size_t CTL_BAR = 16 * 1024;

__device__ __forceinline__ float bf2f(bf16_t v) { return __uint_as_float(((u32)v) << 16); }
typedef float f32x2_t __attribute__((ext_vector_type(2))); typedef __bf16 bf16x2_t __attribute__((ext_vector_type(2)));
__device__ __forceinline__ u32 pk2(float lo, float hi) { f32x2_t v = {lo, hi}; bf16x2_t b = __builtin_convertvector(v, bf16x2_t); return __builtin_bit_cast(u32, b); }
__device__ __forceinline__ bf16_t f2bf(float f) { return (bf16_t)(pk2(f, 0.f) & 0xffffu); }
__device__ __forceinline__ float wsum(float v) {
#pragma unroll
    for (int o = 32; o; o >>= 1) v += __shfl_xor(v, o);
    return v;
}
__device__ __forceinline__ float wmax(float v) {
#pragma unroll
    for (int o = 32; o; o >>= 1) v = fmaxf(v, __shfl_xor(v, o));
    return v;
}
__device__ __forceinline__ void unpack8(const uint4& w, float* f) {
    f[0] = __uint_as_float(w.x << 16); f[1] = __uint_as_float(w.x & 0xffff0000u);
    f[2] = __uint_as_float(w.y << 16); f[3] = __uint_as_float(w.y & 0xffff0000u);
    f[4] = __uint_as_float(w.z << 16); f[5] = __uint_as_float(w.z & 0xffff0000u);
    f[6] = __uint_as_float(w.w << 16); f[7] = __uint_as_float(w.w & 0xffff0000u);
}
#define LDS_FENCE() asm volatile("s_waitcnt lgkmcnt(0)" ::: "memory")

#define XB_TMO      128
#define XB_XCNT(j)  (256  + 64 * (j))
#define XB_XSUB(j)  (1280 + 64 * (j))
#define XB_XGEN(j)  (2304 + 64 * (j))
#define XB_TOP      3328
#define XB_TOPGEN   3392
#define XCD_BAR_WORDS 3456
#define XB_SPIN_CAP (1u << 18)
#define XLAS __attribute__((address_space(3)))
__device__ __forceinline__ unsigned xb_ld(unsigned* p)              { return __hip_atomic_load(p, __ATOMIC_RELAXED, __HIP_MEMORY_SCOPE_AGENT); }
__device__ __forceinline__ unsigned xb_add(unsigned* p, unsigned v) { return __hip_atomic_fetch_add(p, v, __ATOMIC_RELAXED, __HIP_MEMORY_SCOPE_AGENT); }
__device__ __forceinline__ unsigned xb_xcc_id() { return (unsigned)__builtin_amdgcn_s_getreg((3 << 11) | 20) & 0xFu; }
#define XB_SPIN(cond, bar) do { unsigned _sp = 0; while (cond) { __builtin_amdgcn_s_sleep(1); \
    if ((++_sp & 255u) == 0u) { if (xb_ld(&(bar)[XB_TMO])) break; if (_sp > XB_SPIN_CAP) { atomicAdd(&(bar)[XB_TMO], 1u); break; } } } } while (0)
struct XcdBarrier { unsigned* bar; unsigned x; volatile XLAS unsigned* st; };
__device__ __forceinline__ XcdBarrier xcd_barrier_post(unsigned* bar, volatile XLAS unsigned* st) {
    XcdBarrier b; b.bar = bar; b.x = xb_xcc_id(); b.st = st;
    if (threadIdx.x == 0) (void)xb_add(&bar[XB_XCNT(b.x)], 1u);
    return b;
}
__device__ __forceinline__ void xcd_barrier_complete(unsigned* bar, unsigned x, unsigned& nloc, unsigned& nx) {
    const unsigned G = gridDim.x * gridDim.y * gridDim.z;
    unsigned sum, cnt, mine, sp = 0u;
    for (;;) {
        sum = 0u; cnt = 0u; mine = 0u;
#pragma unroll
        for (unsigned j = 0; j < 16; ++j) { const unsigned c = xb_ld(&bar[XB_XCNT(j)]); sum += c; cnt += (c > 0u) ? 1u : 0u; mine = (j == x) ? c : mine; }
        if (sum == G) break;
        __builtin_amdgcn_s_sleep(1);
        if ((++sp & 255u) == 0u) { if (xb_ld(&bar[XB_TMO])) break; if (sp > XB_SPIN_CAP) { atomicAdd(&bar[XB_TMO], 1u); break; } }
    }
    nloc = mine > 0u ? mine : 1u; nx = cnt > 0u ? cnt : 1u;
}
__device__ __forceinline__ void xcd_barrier(const XcdBarrier& b) {
    asm volatile("s_waitcnt vmcnt(0)" ::: "memory");
    __syncthreads();
    if (threadIdx.x == 0) {
        unsigned* bar = b.bar;
        __builtin_amdgcn_s_waitcnt(0);
        unsigned nloc = b.st[0], nx = b.st[1];
        if (nloc == 0u) { xcd_barrier_complete(bar, b.x, nloc, nx); b.st[0] = nloc; b.st[1] = nx; }
        const unsigned old = xb_add(&bar[XB_XSUB(b.x)], 1u);
        const unsigned gen = old / nloc;
        if (old + 1u == (gen + 1u) * nloc) {
            __builtin_amdgcn_fence(__ATOMIC_RELEASE, "agent");
            asm volatile("s_waitcnt vmcnt(0)" ::: "memory");
            const unsigned og = xb_add(&bar[XB_TOP], 1u);
            const unsigned tg = og / nx;
            if (og + 1u == (tg + 1u) * nx) xb_add(&bar[XB_TOPGEN], 1u);
            else XB_SPIN(xb_ld(&bar[XB_TOPGEN]) == tg, bar);
            __builtin_amdgcn_fence(__ATOMIC_ACQUIRE, "agent");
            xb_add(&bar[XB_XGEN(b.x)], 1u);
            asm volatile("s_waitcnt vmcnt(0)" ::: "memory");
        } else {
            XB_SPIN(xb_ld(&bar[XB_XGEN(b.x)]) == gen, bar);
            __builtin_amdgcn_fence(__ATOMIC_ACQUIRE, "agent");
            asm volatile("s_waitcnt vmcnt(0)" ::: "memory");
        }
    }
    __syncthreads();
}

struct Args {
    const float* in[25];
    float* out;
    unsigned char* ws;
};

struct Ctx {
    const float *x, *ev_norm, *ev_w_in, *hg_lb, *hg_gain, *nsa_qg, *nsa_kg, *cmp_pe, *cmp_w1, *cmp_w2, *ev_w_out;
    const float *od_norm, *od_w_in, *swa_qg, *swa_kg, *swa_sinks, *od_w_out;
    const float *moe_norm, *moe_w_grp, *moe_b_grp, *moe_w_exp, *moe_b_exp, *moe_w_gate, *moe_w_up, *moe_w_down;
    float* xr;
    unsigned char* ws;
    int tid, lane, wave, gw, ngw;
};

__device__ __forceinline__ void transpose_item(const float* W, int K, int Nsrc, bf16_t* WT, int drow0, int k0, int n0, float* scr, int lane, const float* gain = nullptr) {
    const int rk = lane >> 3, c4 = 4 * (lane & 7);
    float4 v[8];
#pragma unroll
    for (int i = 0; i < 8; ++i) v[i] = (n0 + c4 < Nsrc) ? *(const float4*)(W + (size_t)(k0 + 8 * i + rk) * Nsrc + n0 + c4) : make_float4(0.f, 0.f, 0.f, 0.f);
#pragma unroll
    for (int i = 0; i < 8; ++i) { float* d = scr + (8 * i + rk) * 33 + c4; d[0] = v[i].x; d[1] = v[i].y; d[2] = v[i].z; d[3] = v[i].w; }
    LDS_FENCE();
    const int c = lane & 7;
#pragma unroll
    for (int j = 0; j < 4; ++j) {
        const int n = (lane >> 3) + 8 * j;
        const float* s = scr + (8 * c) * 33 + n;
        uint4 o;
        float4 ga = make_float4(1.f, 1.f, 1.f, 1.f), gb = ga;
        if (gain) { ga = *(const float4*)(gain + k0 + 8 * c); gb = *(const float4*)(gain + k0 + 8 * c + 4); }
        o.x = pk2(s[0 * 33] * ga.x, s[1 * 33] * ga.y); o.y = pk2(s[2 * 33] * ga.z, s[3 * 33] * ga.w); o.z = pk2(s[4 * 33] * gb.x, s[5 * 33] * gb.y); o.w = pk2(s[6 * 33] * gb.z, s[7 * 33] * gb.w);
        *(uint4*)(WT + (size_t)(drow0 + n0 + n) * K + k0 + 8 * c) = o;
    }
    LDS_FENCE();
}

struct MoeItem { const float* W; bf16_t* WT; const float* gain; int K, N, drow0, k0, n0; };
constexpr int MOE_ITEMS = 3 * 64 * 512;
static_assert(MOE_ITEMS == 64 * 256 * 6, "one MoE conversion item per (chunk, scan unit, wave < 6) slot");
__device__ __forceinline__ void moe_item_decode(const Ctx& c, int r, MoeItem& it) {
    constexpr int IG = 64 * 512;
    bf16_t* WGU = (bf16_t*)(c.ws + WS_WGU); bf16_t* WDt = (bf16_t*)(c.ws + WS_WD);
    if (r < 2 * IG) {
        const bool up = r >= IG; if (up) r -= IG;
        const int le = r >> 9, q = r & 511, kb = q >> 4, nb = q & 15, n0 = 32 * nb;
        it.W = (up ? c.moe_w_up : c.moe_w_gate) + (size_t)le * 1024 * 512; it.WT = WGU + (size_t)le * 1024 * 1024; it.K = 1024; it.N = 512; it.gain = c.moe_norm + (le >> 5) * D;
        it.drow0 = (n0 >> 7) * 256 + (up ? 128 : 0) + (n0 & 127) - n0; it.k0 = 32 * kb; it.n0 = n0;
    } else {
        r -= 2 * IG; const int le = r >> 9, q = r & 511;
        it.W = c.moe_w_down + (size_t)le * 512 * 1024; it.WT = WDt + (size_t)le * 1024 * 512; it.K = 512; it.N = 1024; it.drow0 = 0; it.k0 = 32 * (q >> 5); it.n0 = 32 * (q & 31); it.gain = nullptr;
    }
}
struct MoeRegs { float4 a, b, c, d; };
__device__ __forceinline__ void moe_item_issue(const MoeItem& it, MoeRegs& v, int lane) {
    const float* p = it.W + (size_t)(it.k0 + 4 * (lane >> 3)) * it.N + it.n0 + 4 * (lane & 7); const size_t N = it.N;
    v.a = *(const float4*)(p); v.b = *(const float4*)(p + N); v.c = *(const float4*)(p + 2 * N); v.d = *(const float4*)(p + 3 * N);
}
__device__ __forceinline__ void moe_item_finish(const MoeItem& it, const MoeRegs& v, int lane) {
    bf16_t* o = it.WT + (size_t)(it.drow0 + it.n0 + 4 * (lane & 7)) * it.K + it.k0 + 4 * (lane >> 3);
    uint2 w;
    w.x = pk2(v.a.x, v.b.x); w.y = pk2(v.c.x, v.d.x); *(uint2*)(o) = w;
    w.x = pk2(v.a.y, v.b.y); w.y = pk2(v.c.y, v.d.y); *(uint2*)(o + it.K) = w;
    w.x = pk2(v.a.z, v.b.z); w.y = pk2(v.c.z, v.d.z); *(uint2*)(o + 2 * (size_t)it.K) = w;
    w.x = pk2(v.a.w, v.b.w); w.y = pk2(v.c.w, v.d.w); *(uint2*)(o + 3 * (size_t)it.K) = w;
}

__device__ __forceinline__ void phase_prologue(const Ctx& c, float* lds) {
    float* scr = lds + c.wave * (64 * 33);
    unsigned char* ws = c.ws;
    bf16_t* W0T = (bf16_t*)(ws + WS_W0T); bf16_t* WO0T = (bf16_t*)(ws + WS_WO0T); bf16_t* W1T = (bf16_t*)(ws + WS_W1T); bf16_t* WO1T = (bf16_t*)(ws + WS_WO1T);
    bf16_t* CW1T = (bf16_t*)(ws + WS_CW1T); bf16_t* CW2T = (bf16_t*)(ws + WS_CW2T);
    constexpr int I0 = 16 * 112, I1 = 16 * 32, I2 = 16 * 40, I3 = 16 * 32, I4 = 2 * 32 * 8, I5 = 2 * 4 * 2;
    constexpr int NITEMS = I0 + I1 + I2 + I3 + I4 + I5;
    for (int it = c.gw; it < NITEMS; it += c.ngw) {
        int r = it;
        if (r < I0) { transpose_item(c.ev_w_in, 1024, EVP, W0T, 0, 64 * (r / 112), 32 * (r % 112), scr, c.lane); continue; } r -= I0;
        if (r < I1) { transpose_item(c.ev_w_out, 1024, 1024, WO0T, 0, 64 * (r / 32), 32 * (r % 32), scr, c.lane); continue; } r -= I1;
        if (r < I2) { transpose_item(c.od_w_in, 1024, ODP, W1T, 0, 64 * (r / 40), 32 * (r % 40), scr, c.lane, c.od_norm); continue; } r -= I2;
        if (r < I3) { transpose_item(c.od_w_out, 1024, 1024, WO1T, 0, 64 * (r / 32), 32 * (r % 32), scr, c.lane); continue; } r -= I3;
        if (r < I4) { const int kind = r / 256, q = r % 256; transpose_item(c.cmp_w1 + (size_t)kind * 2048 * 256, 2048, 256, CW1T + (size_t)kind * 256 * 2048, 0, 64 * (q / 8), 32 * (q % 8), scr, c.lane); continue; } r -= I4;
        if (r < I5) { const int kind = r / 8, q = r % 8; transpose_item(c.cmp_w2 + (size_t)kind * 256 * 64, 256, 64, CW2T + (size_t)kind * 64 * 256, 0, 64 * (q / 2), 32 * (q % 2), scr, c.lane); continue; }
    }
    const int gt = blockIdx.x * NTHREADS + c.tid, ngt = gridDim.x * NTHREADS;
    float* LB = (float*)(ws + WS_LB);
    for (int i = gt; i < 512; i += ngt) { const float l0 = c.hg_lb[i], l1 = c.hg_lb[512 + i]; LB[i] = 1.f / (1.f + expf(l1 - l0)); }
    float* CB = (float*)(ws + WS_CBIAS);
    for (int i = c.gw; i < 512; i += c.ngw) {
        const int kind = i >> 8, cc = i & 255; float sacc = 0.f;
        for (int k = c.lane; k < 2048; k += 64) sacc += c.cmp_pe[kind * 2048 + k] * c.cmp_w1[((size_t)kind * 2048 + k) * 256 + cc];
        sacc = wsum(sacc);
        if (c.lane == 0) CB[i] = sacc;
    }
    bf16_t* RW = (bf16_t*)(ws + WS_RW);
    for (int i = gt; i < 2 * 48 * 1024; i += ngt) {
        const int k = i & 1023, o = (i >> 10) % 48, layer = i / (48 * 1024);
        float wv = 0.f;
        if (o < 36) wv = c.moe_norm[layer * D + k] * (o < 4 ? c.moe_w_grp[(size_t)layer * 1024 * 4 + k * 4 + o] : c.moe_w_exp[(size_t)layer * 1024 * 32 + k * 32 + (o - 4)]);
        const bf16_t hi = f2bf(wv); const bf16_t lo = f2bf(wv - bf2f(hi));
        RW[((size_t)layer * 48 + o) * 2048 + k] = hi; RW[((size_t)layer * 48 + o) * 2048 + 1024 + k] = lo;
    }
    float2* RT = (float2*)(ws + WS_ROPE);
    for (int i = gt; i < 4096 * 8; i += ngt) {
        const int pos = i >> 3, f = i & 7;
        const double inv = exp(-(double)f * 0.125 * 13.122363377404328);
        const double a = (double)pos * inv;
        const double r = a - 6.283185307179586476925 * rint(a / 6.283185307179586476925);
        const float rf = (float)r;
        RT[i] = make_float2(cosf(rf), sinf(rf));
    }
}

__device__ __forceinline__ void phase_norm_x(const Ctx& c, const float* src, const float* gain, bf16_t* H) {
    for (int m0 = 2 * c.gw; m0 < M; m0 += 2 * c.ngw) {
        float4 v[2][4];
#pragma unroll
        for (int u = 0; u < 2; ++u) { const float4* xr = (const float4*)(src + (size_t)(m0 + u) * D) + c.lane;
#pragma unroll
            for (int j = 0; j < 4; ++j) v[u][j] = xr[64 * j]; }
#pragma unroll
        for (int u = 0; u < 2; ++u) {
            float s = 0.f;
#pragma unroll
            for (int j = 0; j < 4; ++j) s += v[u][j].x * v[u][j].x + v[u][j].y * v[u][j].y + v[u][j].z * v[u][j].z + v[u][j].w * v[u][j].w;
            const float rstd = rsqrtf(wsum(s) * (1.f / D) + EPS);
            uint2* o = (uint2*)(H + (size_t)(m0 + u) * D) + c.lane;
#pragma unroll
            for (int j = 0; j < 4; ++j) {
                const float4 g = ((const float4*)gain)[c.lane + 64 * j];
                uint2 w; w.x = pk2(v[u][j].x * rstd * g.x, v[u][j].y * rstd * g.y); w.y = pk2(v[u][j].z * rstd * g.z, v[u][j].w * rstd * g.w);
                o[64 * j] = w;
            }
        }
    }
}
template <bool FINAL>
__device__ __forceinline__ void phase_combine(const Ctx& c, bf16_t* XB, float* out, const float* gain, bf16_t* H, const bf16_t* YS, int layer) {
    const float* TWp = (const float*)(c.ws + WS_TW); const int* TEp = (const int*)(c.ws + WS_TE); const int* TRp = (const int*)(c.ws + WS_TR);
    int psrow;
    { const int cnt = ((const int*)(c.ws + WS_CTL))[layer * 32 + (c.lane & 31)]; const int pc = (cnt + 255) & ~255; int incl = pc;
#pragma unroll
      for (int o = 1; o < 32; o <<= 1) { const int t_ = __shfl_up(incl, o, 32); if ((c.lane & 31) >= o) incl += t_; }
      psrow = incl - pc; }
    for (int m0 = 2 * c.gw; m0 < M; m0 += 2 * c.ngw) {
        uint2 xw[2][4], ya[2][4], yb[2][4]; float wa[2], wb[2];
#pragma unroll
        for (int u = 0; u < 2; ++u) {
            const int m = m0 + u; const int s0 = __shfl(psrow, TEp[2 * m]) + TRp[2 * m], s1 = __shfl(psrow, TEp[2 * m + 1]) + TRp[2 * m + 1]; wa[u] = TWp[2 * m]; wb[u] = TWp[2 * m + 1];
            const uint2* xr = (const uint2*)(XB + (size_t)m * D) + c.lane; const uint2* y0 = (const uint2*)(YS + (size_t)s0 * D) + c.lane; const uint2* y1 = (const uint2*)(YS + (size_t)s1 * D) + c.lane;
#pragma unroll
            for (int j = 0; j < 4; ++j) { xw[u][j] = xr[64 * j]; ya[u][j] = y0[64 * j]; yb[u][j] = y1[64 * j]; }
        }
#pragma unroll
        for (int u = 0; u < 2; ++u) {
            const int m = m0 + u;
            float4 v[4]; float s = 0.f;
#pragma unroll
            for (int j = 0; j < 4; ++j) {
                v[j].x = __uint_as_float(xw[u][j].x << 16) + wa[u] * __uint_as_float(ya[u][j].x << 16) + wb[u] * __uint_as_float(yb[u][j].x << 16);
                v[j].y = __uint_as_float(xw[u][j].x & 0xffff0000u) + wa[u] * __uint_as_float(ya[u][j].x & 0xffff0000u) + wb[u] * __uint_as_float(yb[u][j].x & 0xffff0000u);
                v[j].z = __uint_as_float(xw[u][j].y << 16) + wa[u] * __uint_as_float(ya[u][j].y << 16) + wb[u] * __uint_as_float(yb[u][j].y << 16);
                v[j].w = __uint_as_float(xw[u][j].y & 0xffff0000u) + wa[u] * __uint_as_float(ya[u][j].y & 0xffff0000u) + wb[u] * __uint_as_float(yb[u][j].y & 0xffff0000u);
                s += v[j].x * v[j].x + v[j].y * v[j].y + v[j].z * v[j].z + v[j].w * v[j].w;
            }
            if (FINAL) {
                float4* xo = (float4*)(out + (size_t)m * D) + c.lane;
#pragma unroll
                for (int j = 0; j < 4; ++j) xo[64 * j] = v[j];
            } else {
                uint2* xo = (uint2*)(XB + (size_t)m * D) + c.lane;
#pragma unroll
                for (int j = 0; j < 4; ++j) { uint2 w; w.x = pk2(v[j].x, v[j].y); w.y = pk2(v[j].z, v[j].w); xo[64 * j] = w; }
                float s2 = 0.f;
#pragma unroll
                for (int j = 0; j < 4; ++j) { const float a0 = bf2f(f2bf(v[j].x)), a1 = bf2f(f2bf(v[j].y)), a2 = bf2f(f2bf(v[j].z)), a3 = bf2f(f2bf(v[j].w)); s2 += a0 * a0 + a1 * a1 + a2 * a2 + a3 * a3; }
                const float rstd = rsqrtf(wsum(s2) * (1.f / D) + EPS);
                if (c.lane == 0) ((float*)(c.ws + WS_RSTD))[m] = rstd;
            }
        }
    }
}

struct ARowPlain { const bf16_t* A; int K; __device__ __forceinline__ const bf16_t* operator()(int m) const { return A + (size_t)m * K; } };
struct ARowGather { const bf16_t* A; int K; const int* idx; __device__ __forceinline__ const bf16_t* operator()(int m) const { return A + (size_t)idx[m] * K; } };
struct BRowPlain { const bf16_t* B; int K; __device__ __forceinline__ const bf16_t* operator()(int n) const { return B + (size_t)n * K; } };
struct BRowGU { const bf16_t* B; int K;
    __device__ __forceinline__ const bf16_t* operator()(int nv) const {
        const int cc = (nv >> 6) * 32 + 2 * ((nv & 63) >> 2) + (nv & 1), up = (nv >> 1) & 1;
        return B + (size_t)((cc >> 7) * 256 + (cc & 127) + up * 128) * K; } };

template <class AR, class BR, class Epi>
__device__ __forceinline__ void gemm_naive_tile(float* lds, int m0, int nv0, int K, const AR& arow, const BR& brow, const Epi& epi) {
    const int tid = threadIdx.x, ty = tid >> 4, tx = tid & 15;
    float acc[4][4];
#pragma unroll
    for (int i = 0; i < 4; ++i)
#pragma unroll
        for (int j = 0; j < 4; ++j) acc[i][j] = 0.f;
    float* As = lds; float* Bs = lds + 32 * 132;
    const int lr = tid >> 2, kq = (tid & 3) * 8;
    const bf16_t* ap = arow(m0 + lr) + kq;
    const bf16_t* bp = brow(nv0 + (lr & 63)) + kq;
    for (int k0 = 0; k0 < K; k0 += 32) {
        __syncthreads();
        { const uint4 w = *(const uint4*)(ap + k0); float f[8]; unpack8(w, f);
#pragma unroll
          for (int i = 0; i < 8; ++i) As[(kq + i) * 132 + lr] = f[i]; }
        if (tid < 256) { const uint4 w = *(const uint4*)(bp + k0); float f[8]; unpack8(w, f);
#pragma unroll
          for (int i = 0; i < 8; ++i) Bs[(kq + i) * 68 + lr] = f[i]; }
        __syncthreads();
#pragma unroll 8
        for (int k = 0; k < 32; ++k) {
            const float4 a = *(const float4*)&As[k * 132 + 4 * ty]; const float4 b = *(const float4*)&Bs[k * 68 + 4 * tx];
            acc[0][0] += a.x * b.x; acc[0][1] += a.x * b.y; acc[0][2] += a.x * b.z; acc[0][3] += a.x * b.w;
            acc[1][0] += a.y * b.x; acc[1][1] += a.y * b.y; acc[1][2] += a.y * b.z; acc[1][3] += a.y * b.w;
            acc[2][0] += a.z * b.x; acc[2][1] += a.z * b.y; acc[2][2] += a.z * b.z; acc[2][3] += a.z * b.w;
            acc[3][0] += a.w * b.x; acc[3][1] += a.w * b.y; acc[3][2] += a.w * b.z; acc[3][3] += a.w * b.w;
        }
    }
    epi.tile(m0 + 4 * ty, nv0 + 4 * tx, acc);
}

struct EpiProj0 { bf16_t* P; float* LOGF; const float* LB;
    __device__ __forceinline__ void tile(int m, int n, const float (&acc)[4][4]) const {
#pragma unroll
        for (int i = 0; i < 4; ++i)
#pragma unroll
            for (int j = 0; j < 4; ++j) {
                const int nn = n + j; const float v = acc[i][j]; const size_t mm = m + i;
                if (nn >= 512 && nn < 1024) {
                    const int cc = nn - 512; const float lb = LB[cc];
                    const float sg = 1.f / (1.f + expf(-v)), sn = 1.f / (1.f + expf(v));
                    LOGF[mm * 512 + cc] = logf(lb + (1.f - lb) * sg);
                    P[mm * EVPP + nn] = f2bf((1.f - lb) * sn);
                } else P[mm * EVPP + nn] = f2bf(v);
            }
    } };
struct EpiRaw { bf16_t* P; int ld;
    __device__ __forceinline__ void tile(int m, int n, const float (&acc)[4][4]) const {
#pragma unroll
        for (int i = 0; i < 4; ++i)
#pragma unroll
            for (int j = 0; j < 4; ++j) P[(size_t)(m + i) * ld + n + j] = f2bf(acc[i][j]);
    } };
struct EpiResid { const float* X; float* O;
    __device__ __forceinline__ void tile(int m, int n, const float (&acc)[4][4]) const {
#pragma unroll
        for (int i = 0; i < 4; ++i) { const size_t o = (size_t)(m + i) * D + n; const float4 xv = *(const float4*)(X + o);
            *(float4*)(O + o) = make_float4(xv.x + acc[i][0], xv.y + acc[i][1], xv.z + acc[i][2], xv.w + acc[i][3]); }
    } };
struct EpiGU { bf16_t* HID;
    __device__ __forceinline__ void tile(int m, int nv, const float (&acc)[4][4]) const {
        const int c0 = (nv >> 6) * 32 + 2 * ((nv & 63) >> 2);
#pragma unroll
        for (int i = 0; i < 4; ++i) {
            const float g0 = acc[i][0], g1 = acc[i][1], u0 = acc[i][2], u1 = acc[i][3];
            const float h0 = g0 / (1.f + expf(-g0)) * u0, h1 = g1 / (1.f + expf(-g1)) * u1;
            *(u32*)(HID + (size_t)(m + i) * FF + c0) = pk2(h0, h1);
        }
    } };
struct EpiDown { bf16_t* YS; const float* ROWW;
    __device__ __forceinline__ void tile(int m, int n, const float (&acc)[4][4]) const {
#pragma unroll
        for (int i = 0; i < 4; ++i) { const float w = ROWW[m + i]; uint2 o; o.x = pk2(acc[i][0] * w, acc[i][1] * w); o.y = pk2(acc[i][2] * w, acc[i][3] * w);
            *(uint2*)(YS + (size_t)(m + i) * D + n) = o; }
    } };

template <class Epi>
__device__ __forceinline__ void phase_gemm_naive(float* lds, const bf16_t* A, const bf16_t* Bt, int Npad, int K, const Epi& epi) {
    const int ntn = Npad / 64, ntiles = (M / 128) * ntn;
    ARowPlain ar{A, K}; BRowPlain br{Bt, K};
    for (int t = blockIdx.x; t < ntiles; t += gridDim.x) gemm_naive_tile(lds, (t / ntn) * 128, (t % ntn) * 64, K, ar, br, epi);
}

namespace pg8 {
#define PG8_LAS __attribute__((address_space(3)))
typedef short bf16x8 __attribute__((ext_vector_type(8)));
typedef float f32x4 __attribute__((ext_vector_type(4)));
typedef unsigned u32x4 __attribute__((ext_vector_type(4)));
constexpr int BM = 256, BK = 64, HALF = 128, HTB = HALF * BK * 2, STAGE_BYTES = 8 * HTB, NXCD = 8, WGM = 8;
__device__ __forceinline__ int lds_byte(int r, int c) { const int st = (r >> 4) * 2 + (c >> 5), rr = r & 15, cc = c & 31, ob = rr * 64 + cc * 2; return st * 1024 + (ob ^ (((ob >> 9) & 1) << 5)); }
__device__ __forceinline__ void stage_rc(int b, int& R, int& C) { const int st = b / 1024, sb = b % 1024, swz = sb ^ (((sb >> 9) & 1) << 5); R = (st >> 1) * 16 + swz / 64; C = (st & 1) * 32 + (swz % 64) / 2; }
__device__ __forceinline__ int perm32(int rho) { const int n = rho >> 4, i = rho & 15; return 8 * (i >> 2) + 4 * n + (i & 3); }
struct Unit { int pm, pn, e, nvalid, gbase; };
struct Gemm { const bf16_t* A; const bf16_t* Bt; int K; const int* gather; size_t bstride; };
struct StaticOrder {
    int nM, nN, nwg, G, c;
    __device__ __forceinline__ void init(int Mr, int N, int G_, int c_) { nM = Mr / BM; nN = N / BM; nwg = nM * nN; G = G_; c = c_; }
    __device__ __forceinline__ bool next(int i, Unit& u) const {
        const long L = (long)i * G + c; if (L >= nwg) return false;
        int wgid = (int)L; { const int q = nwg / NXCD, r = nwg % NXCD, xcd = wgid % NXCD, off = wgid / NXCD; wgid = (xcd < r ? xcd * (q + 1) : r * (q + 1) + (xcd - r) * q) + off; }
        const int nig = WGM * nN, gid = wgid / nig, fm = gid * WGM, gsz = (nM - fm) < WGM ? (nM - fm) : WGM;
        u.pm = fm + ((wgid % nig) % gsz); u.pn = (wgid % nig) / gsz; u.e = 0; u.nvalid = BM; u.gbase = 0; return true;
    }
};
struct MoeOrder {
    const int* te; const int* tv; const int* tg; int nwg, G, c;
    __device__ __forceinline__ bool next(int i, Unit& u) const {
        const long L = (long)i * G + c; if (L >= nwg) return false;
        int wgid = (int)L; { const int q = nwg / NXCD, r = nwg % NXCD, xcd = wgid % NXCD, off = wgid / NXCD; wgid = (xcd < r ? xcd * (q + 1) : r * (q + 1) + (xcd - r) * q) + off; }
        u.pm = wgid >> 2; u.pn = wgid & 3; u.e = te[u.pm]; u.nvalid = tv[u.pm]; u.gbase = tg[u.pm]; return true;
    }
};
__device__ __forceinline__ unsigned cvt_pk_bf16(float lo, float hi) { unsigned r; asm volatile("v_cvt_pk_bf16_f32 %0, %1, %2" : "=v"(r) : "v"(lo), "v"(hi)); return r; }

struct EpiRawT { static constexpr bool PERM = true; bf16_t* O; int ldc;
    __device__ __forceinline__ void operator()(const f32x4 (&acc)[2][2][4][2], const Unit& u, int wr, int wc, int fr, int fq) const {
        const int row0 = u.pm * BM + wr * 64 + fr, col0 = u.pn * BM + wc * 32 + 8 * fq;
#pragma unroll
        for (int ai = 0; ai < 2; ++ai)
#pragma unroll
            for (int m = 0; m < 4; ++m) { bf16_t* rowp = O + (size_t)(row0 + ai * HALF + m * 16) * ldc + col0;
#pragma unroll
                for (int bj = 0; bj < 2; ++bj) { const f32x4 v0 = acc[ai][bj][m][0], v1 = acc[ai][bj][m][1]; u32x4 w;
                    w.x = cvt_pk_bf16(v0[0], v0[1]); w.y = cvt_pk_bf16(v0[2], v0[3]); w.z = cvt_pk_bf16(v1[0], v1[1]); w.w = cvt_pk_bf16(v1[2], v1[3]);
                    *(u32x4*)(rowp + bj * HALF) = w; } }
    } };
struct EpiRawScaleT { static constexpr bool PERM = true; bf16_t* O; int ldc; const float* RS;
    __device__ __forceinline__ void operator()(const f32x4 (&acc)[2][2][4][2], const Unit& u, int wr, int wc, int fr, int fq) const {
        const int row0 = u.pm * BM + wr * 64 + fr, col0 = u.pn * BM + wc * 32 + 8 * fq;
#pragma unroll
        for (int ai = 0; ai < 2; ++ai)
#pragma unroll
            for (int m = 0; m < 4; ++m) { const int r = row0 + ai * HALF + m * 16; const float sc = RS[r]; bf16_t* rowp = O + (size_t)r * ldc + col0;
#pragma unroll
                for (int bj = 0; bj < 2; ++bj) { const f32x4 v0 = acc[ai][bj][m][0] * sc, v1 = acc[ai][bj][m][1] * sc; u32x4 w;
                    w.x = cvt_pk_bf16(v0[0], v0[1]); w.y = cvt_pk_bf16(v0[2], v0[3]); w.z = cvt_pk_bf16(v1[0], v1[1]); w.w = cvt_pk_bf16(v1[2], v1[3]);
                    *(u32x4*)(rowp + bj * HALF) = w; } }
    } };
struct EpiProj0T { static constexpr bool PERM = true; bf16_t* O; float* LOGF; const float* LB;
    __device__ __forceinline__ void operator()(const f32x4 (&acc)[2][2][4][2], const Unit& u, int wr, int wc, int fr, int fq) const {
        const int row0 = u.pm * BM + wr * 64 + fr, col0 = u.pn * BM + wc * 32 + 8 * fq;
        const bool isf = (u.pn == 2 || u.pn == 3);
#pragma unroll
        for (int ai = 0; ai < 2; ++ai)
#pragma unroll
            for (int m = 0; m < 4; ++m) { const size_t r = (size_t)(row0 + ai * HALF + m * 16); bf16_t* rowp = O + r * EVPP + col0;
#pragma unroll
                for (int bj = 0; bj < 2; ++bj) { f32x4 v0 = acc[ai][bj][m][0], v1 = acc[ai][bj][m][1];
                    if (isf) {
                        const int cc = col0 + bj * HALF - 512; const f32x4 lb0 = *(const f32x4*)(LB + cc), lb1 = *(const f32x4*)(LB + cc + 4);
                        f32x4 lf0, lf1;
#pragma unroll
                        for (int j = 0; j < 4; ++j) {
                            { const float z = v0[j], lb = lb0[j], sg = 1.f / (1.f + __expf(-z)), sn = 1.f / (1.f + __expf(z)); lf0[j] = __logf(lb + (1.f - lb) * sg); v0[j] = (1.f - lb) * sn; }
                            { const float z = v1[j], lb = lb1[j], sg = 1.f / (1.f + __expf(-z)), sn = 1.f / (1.f + __expf(z)); lf1[j] = __logf(lb + (1.f - lb) * sg); v1[j] = (1.f - lb) * sn; }
                        }
                        *(f32x4*)(LOGF + r * 512 + cc) = lf0; *(f32x4*)(LOGF + r * 512 + cc + 4) = lf1;
                    }
                    u32x4 w; w.x = cvt_pk_bf16(v0[0], v0[1]); w.y = cvt_pk_bf16(v0[2], v0[3]); w.z = cvt_pk_bf16(v1[0], v1[1]); w.w = cvt_pk_bf16(v1[2], v1[3]);
                    *(u32x4*)(rowp + bj * HALF) = w; } }
    } };
struct EpiResidT { static constexpr bool PERM = false; const float* X; float* O;
    __device__ __forceinline__ void operator()(const f32x4 (&acc)[2][2][4][2], const Unit& u, int wr, int wc, int fr, int fq) const {
        const int row0 = u.pm * BM + wr * 64 + fr, col0 = u.pn * BM + wc * 32 + 4 * fq;
#pragma unroll
        for (int ai = 0; ai < 2; ++ai)
#pragma unroll
            for (int m = 0; m < 4; ++m) { const size_t off = (size_t)(row0 + ai * HALF + m * 16) * D + col0;
#pragma unroll
                for (int bj = 0; bj < 2; ++bj)
#pragma unroll
                    for (int n = 0; n < 2; ++n) { const f32x4 xv = *(const f32x4*)(X + off + bj * HALF + n * 16); *(f32x4*)(O + off + bj * HALF + n * 16) = xv + acc[ai][bj][m][n]; } }
    } };
struct EpiResidF2B { static constexpr bool PERM = true; const float* X; bf16_t* O;
    __device__ __forceinline__ void operator()(const f32x4 (&acc)[2][2][4][2], const Unit& u, int wr, int wc, int fr, int fq) const {
        const int row0 = u.pm * BM + wr * 64 + fr, col0 = u.pn * BM + wc * 32 + 8 * fq;
#pragma unroll
        for (int ai = 0; ai < 2; ++ai)
#pragma unroll
            for (int m = 0; m < 4; ++m) { const size_t off = (size_t)(row0 + ai * HALF + m * 16) * D + col0;
#pragma unroll
                for (int bj = 0; bj < 2; ++bj) { const f32x4 x0 = *(const f32x4*)(X + off + bj * HALF), x1 = *(const f32x4*)(X + off + bj * HALF + 4);
                    const f32x4 v0 = x0 + acc[ai][bj][m][0], v1 = x1 + acc[ai][bj][m][1]; u32x4 w;
                    w.x = cvt_pk_bf16(v0[0], v0[1]); w.y = cvt_pk_bf16(v0[2], v0[3]); w.z = cvt_pk_bf16(v1[0], v1[1]); w.w = cvt_pk_bf16(v1[2], v1[3]);
                    *(u32x4*)(O + off + bj * HALF) = w; } }
    } };
struct EpiResidB2B { static constexpr bool PERM = true; bf16_t* XO;
    __device__ __forceinline__ void operator()(const f32x4 (&acc)[2][2][4][2], const Unit& u, int wr, int wc, int fr, int fq) const {
        const int row0 = u.pm * BM + wr * 64 + fr, col0 = u.pn * BM + wc * 32 + 8 * fq;
#pragma unroll
        for (int ai = 0; ai < 2; ++ai)
#pragma unroll
            for (int m = 0; m < 4; ++m) { const size_t off = (size_t)(row0 + ai * HALF + m * 16) * D + col0;
#pragma unroll
                for (int bj = 0; bj < 2; ++bj) { const u32x4 xw = *(const u32x4*)(XO + off + bj * HALF);
                    const f32x4 a0 = acc[ai][bj][m][0], a1 = acc[ai][bj][m][1]; u32x4 w;
                    w.x = cvt_pk_bf16(__uint_as_float(xw.x << 16) + a0[0], __uint_as_float(xw.x & 0xffff0000u) + a0[1]); w.y = cvt_pk_bf16(__uint_as_float(xw.y << 16) + a0[2], __uint_as_float(xw.y & 0xffff0000u) + a0[3]);
                    w.z = cvt_pk_bf16(__uint_as_float(xw.z << 16) + a1[0], __uint_as_float(xw.z & 0xffff0000u) + a1[1]); w.w = cvt_pk_bf16(__uint_as_float(xw.w << 16) + a1[2], __uint_as_float(xw.w & 0xffff0000u) + a1[3]);
                    *(u32x4*)(XO + off + bj * HALF) = w; } }
    } };
struct EpiGUT { static constexpr bool PERM = true; bf16_t* HID; const float* RSL;
    __device__ __forceinline__ void operator()(const f32x4 (&acc)[2][2][4][2], const Unit& u, int wr, int wc, int fr, int fq) const {
        const int lr0 = wr * 64 + fr, row0 = u.pm * BM + lr0, col0 = u.pn * HALF + wc * 32 + 8 * fq;
        float rs[2][4];
#pragma unroll
        for (int ai = 0; ai < 2; ++ai)
#pragma unroll
            for (int m = 0; m < 4; ++m) { const int lr = lr0 + ai * HALF + m * 16; rs[ai][m] = RSL[u.gbase + (lr < u.nvalid ? lr : 0)]; }
#pragma unroll
        for (int ai = 0; ai < 2; ++ai)
#pragma unroll
            for (int m = 0; m < 4; ++m) { bf16_t* rowp = HID + (size_t)(row0 + ai * HALF + m * 16) * FF + col0; float h[8]; const float r_ = rs[ai][m];
#pragma unroll
                for (int n = 0; n < 2; ++n)
#pragma unroll
                    for (int j = 0; j < 4; ++j) { const float g = acc[ai][0][m][n][j] * r_, uu = acc[ai][1][m][n][j] * r_; h[4 * n + j] = g / (1.f + __expf(-g)) * uu; }
                u32x4 w; w.x = cvt_pk_bf16(h[0], h[1]); w.y = cvt_pk_bf16(h[2], h[3]); w.z = cvt_pk_bf16(h[4], h[5]); w.w = cvt_pk_bf16(h[6], h[7]);
                *(u32x4*)rowp = w; }
    } };
struct EpiDownT { static constexpr bool PERM = true; bf16_t* YS;
    __device__ __forceinline__ void operator()(const f32x4 (&acc)[2][2][4][2], const Unit& u, int wr, int wc, int fr, int fq) const {
        const int row0 = u.pm * BM + wr * 64 + fr, col0 = u.pn * BM + wc * 32 + 8 * fq;
#pragma unroll
        for (int ai = 0; ai < 2; ++ai)
#pragma unroll
            for (int m = 0; m < 4; ++m) { bf16_t* rowp = YS + (size_t)(row0 + ai * HALF + m * 16) * D + col0;
#pragma unroll
                for (int bj = 0; bj < 2; ++bj) { const f32x4 v0 = acc[ai][bj][m][0], v1 = acc[ai][bj][m][1]; u32x4 w;
                    w.x = cvt_pk_bf16(v0[0], v0[1]); w.y = cvt_pk_bf16(v0[2], v0[3]); w.z = cvt_pk_bf16(v1[0], v1[1]); w.w = cvt_pk_bf16(v1[2], v1[3]);
                    *(u32x4*)(rowp + bj * HALF) = w; } }
    } };

template <class Epi, class Sched, bool GATHER>
__device__ __forceinline__ void gemm_phase(PG8_LAS unsigned char* lds, const Gemm g, const Sched& S, const Epi& E) {
    int tid_o = threadIdx.x; asm volatile("" : "+v"(tid_o));
    const int tid = tid_o, wid = __builtin_amdgcn_readfirstlane(tid >> 6), lane = tid & 63, wr = wid >> 2, wc = wid & 3, fr = lane & 15, fq = lane >> 4;
    const int K = g.K, nt = K / BK;
    int stR[2], stC[2]; unsigned voffB[2];
#pragma unroll
    for (int i = 0; i < 2; ++i) { int R, C; stage_rc(tid * 16 + i * 8192, R, C); const int Rb = Epi::PERM ? ((R & ~31) + perm32(R & 31)) : R; stR[i] = R; stC[i] = C; voffB[i] = (unsigned)(Rb * K + C) * 2u; }
    const size_t kstep = (size_t)(BK * 2);
    const size_t hstep = (size_t)HALF * K * 2;
    const size_t tstep = 2 * hstep;
    const unsigned ldsw = (unsigned)wid * 1024u;
    const int aoff = lds_byte(wr * 64 + fr, fq * 8), boff = lds_byte(wc * 32 + fr, fq * 8);
#define PG8_SA(b, h) (((b) * 2 + (h)) * HTB)
#define PG8_SB(b, h) ((4 + (b) * 2 + (h)) * HTB)
#define PG8_STAGE(bufoff, gbase, voff) do { _Pragma("unroll") for (int _i = 0; _i < 2; ++_i) \
        __builtin_amdgcn_global_load_lds((const unsigned*)((const char*)(gbase) + (voff)[_i]), (PG8_LAS unsigned*)(lds + (bufoff) + ldsw + _i * 8192), 16, 0, 0); } while (0)
#define PG8_LDA(dst, b, h) do { _Pragma("unroll") for (int m = 0; m < 4; ++m) _Pragma("unroll") for (int k = 0; k < 2; ++k) dst[m][k] = *(const PG8_LAS bf16x8*)(lds + PG8_SA(b, h) + aoff + m * 2048 + k * 1024); } while (0)
#define PG8_LDB(dst, b, h) do { _Pragma("unroll") for (int n = 0; n < 2; ++n) _Pragma("unroll") for (int k = 0; k < 2; ++k) dst[n][k] = *(const PG8_LAS bf16x8*)(lds + PG8_SB(b, h) + boff + n * 2048 + k * 1024); } while (0)
#define PG8_MMA(ai, bj, At, Bt) do { __builtin_amdgcn_s_setprio(1); _Pragma("unroll") for (int m = 0; m < 4; ++m) _Pragma("unroll") for (int n = 0; n < 2; ++n) _Pragma("unroll") for (int k = 0; k < 2; ++k) \
        acc[ai][bj][m][n] = __builtin_amdgcn_mfma_f32_16x16x32_bf16(Bt[n][k], At[m][k], acc[ai][bj][m][n], 0, 0, 0); __builtin_amdgcn_s_setprio(0); } while (0)
#define PG8_WAIT_V(n) asm volatile("s_waitcnt vmcnt(" #n ")" ::: "memory")
#define PG8_WAIT_L(n) asm volatile("s_waitcnt lgkmcnt(" #n ")" ::: "memory")
#define PG8_BAR __builtin_amdgcn_s_barrier()
#define PG8_SCHED __builtin_amdgcn_sched_barrier(0)
#define PG8_OFFS(dst, u) do { _Pragma("unroll") for (int _h = 0; _h < 2; ++_h) _Pragma("unroll") for (int _i = 0; _i < 2; ++_i) { \
        int _row = (u).pm * BM + _h * HALF + stR[_i]; if (GATHER) { const int _lr = _h * HALF + stR[_i]; _row = _lr < (u).nvalid ? g.gather[(u).gbase + _lr] : 0; } dst[_h][_i] = (unsigned)(_row * K + stC[_i]) * 2u; } } while (0)
    Unit cur, nxt; int ui = 0;
    if (!S.next(0, cur)) return;
    f32x4 acc[2][2][4][2];
#pragma unroll
    for (int a = 0; a < 2; ++a)
#pragma unroll
        for (int b = 0; b < 2; ++b)
#pragma unroll
            for (int m = 0; m < 4; ++m)
#pragma unroll
                for (int n = 0; n < 2; ++n) acc[a][b][m][n] = (f32x4){0.f, 0.f, 0.f, 0.f};
    bf16x8 At[4][2], B0[2][2], B1[2][2];
    unsigned offC[2][2], offN[2][2];
    PG8_OFFS(offC, cur);
    const char* const A0 = (const char*)g.A;
    const char* cB = (const char*)g.Bt + ((size_t)cur.e * g.bstride) * 2 + (size_t)cur.pn * tstep;
    PG8_STAGE(PG8_SB(0, 0), cB, voffB); PG8_STAGE(PG8_SB(0, 1), cB + hstep, voffB); PG8_STAGE(PG8_SA(0, 0), A0, offC[0]); PG8_STAGE(PG8_SA(0, 1), A0, offC[1]);
    if (wr == 1) PG8_BAR;
    PG8_WAIT_V(2); PG8_BAR;
    PG8_STAGE(PG8_SB(1, 0), cB + kstep, voffB); PG8_STAGE(PG8_SA(1, 0), A0 + kstep, offC[0]); PG8_STAGE(PG8_SB(1, 1), cB + hstep + kstep, voffB);
    PG8_WAIT_V(6); PG8_BAR;
    for (;;) {
        const bool has_next = S.next(ui + 1, nxt);
        const char* nB = cB;
        if (has_next) { PG8_OFFS(offN, nxt); nB = (const char*)g.Bt + ((size_t)nxt.e * g.bstride) * 2 + (size_t)nxt.pn * tstep; }
        else {
#pragma unroll
            for (int _h = 0; _h < 2; ++_h)
#pragma unroll
                for (int _i = 0; _i < 2; ++_i) offN[_h][_i] = offC[_h][_i];
        }
        for (int t = 0; t < nt; t += 2) {
            const bool last = (t == nt - 2);
            const char* a1 = A0 + (size_t)(t + 1) * kstep;
            const char* a2 = A0 + (last ? (size_t)0 : (size_t)(t + 2) * kstep); const char* b2 = last ? nB : cB + (size_t)(t + 2) * kstep;
            const char* a3 = a2 + kstep; const char* b3 = b2 + kstep;
            unsigned off2[2][2];
            if (last) {
#pragma unroll
                for (int _h = 0; _h < 2; ++_h)
#pragma unroll
                    for (int _i = 0; _i < 2; ++_i) off2[_h][_i] = offN[_h][_i];
            } else {
#pragma unroll
                for (int _h = 0; _h < 2; ++_h)
#pragma unroll
                    for (int _i = 0; _i < 2; ++_i) off2[_h][_i] = offC[_h][_i];
            }
            PG8_LDB(B0, 0, 0); PG8_LDB(B1, 0, 1); PG8_SCHED; PG8_LDA(At, 0, 0); PG8_STAGE(PG8_SA(1, 1), a1, offC[1]);
            PG8_WAIT_V(8); PG8_WAIT_L(0); PG8_BAR; PG8_MMA(0, 0, At, B0); PG8_MMA(0, 1, At, B1); PG8_BAR; PG8_SCHED;
            PG8_LDA(At, 0, 1); PG8_STAGE(PG8_SB(0, 0), b2, voffB); PG8_STAGE(PG8_SB(0, 1), b2 + hstep, voffB); PG8_STAGE(PG8_SA(0, 0), a2, off2[0]);
            PG8_WAIT_V(8); PG8_WAIT_L(0); PG8_BAR; PG8_MMA(1, 0, At, B0); PG8_MMA(1, 1, At, B1); PG8_BAR; PG8_SCHED;
            PG8_LDB(B0, 1, 0); PG8_LDB(B1, 1, 1); PG8_SCHED; PG8_LDA(At, 1, 0); PG8_STAGE(PG8_SA(0, 1), a2, off2[1]);
            PG8_WAIT_V(8); PG8_WAIT_L(0); PG8_BAR; PG8_MMA(0, 0, At, B0); PG8_MMA(0, 1, At, B1); PG8_BAR; PG8_SCHED;
            PG8_LDA(At, 1, 1); PG8_STAGE(PG8_SB(1, 0), b3, voffB); PG8_STAGE(PG8_SB(1, 1), b3 + hstep, voffB); PG8_STAGE(PG8_SA(1, 0), a3, off2[0]);
            PG8_WAIT_V(8); PG8_WAIT_L(0); PG8_BAR; PG8_MMA(1, 0, At, B0); PG8_MMA(1, 1, At, B1); PG8_BAR; PG8_SCHED;
        }
        if (wr == 0) PG8_BAR;
        E(acc, cur, wr, wc, fr, fq);
        if (!has_next) break;
#pragma unroll
        for (int a = 0; a < 2; ++a)
#pragma unroll
            for (int b = 0; b < 2; ++b)
#pragma unroll
                for (int m = 0; m < 4; ++m)
#pragma unroll
                    for (int n = 0; n < 2; ++n) acc[a][b][m][n] = (f32x4){0.f, 0.f, 0.f, 0.f};
        cur = nxt; cB = nB; ++ui;
#pragma unroll
        for (int _h = 0; _h < 2; ++_h)
#pragma unroll
            for (int _i = 0; _i < 2; ++_i) offC[_h][_i] = offN[_h][_i];
        if (wr == 1) PG8_BAR;
    }
    PG8_WAIT_V(0);
    PG8_BAR;
#undef PG8_SA
#undef PG8_SB
#undef PG8_STAGE
#undef PG8_LDA
#undef PG8_LDB
#undef PG8_MMA
#undef PG8_WAIT_V
#undef PG8_WAIT_L
#undef PG8_BAR
#undef PG8_SCHED
#undef PG8_OFFS
}
}

__device__ __forceinline__ void normrope64(bf16_t* p, const float* gain, const float2* rt  ) {
    uint4 w[8]; float f[64];
#pragma unroll
    for (int i = 0; i < 8; ++i) { w[i] = ((const uint4*)p)[i]; unpack8(w[i], f + 8 * i); }
    float s = 0.f;
#pragma unroll
    for (int i = 0; i < 64; ++i) s += f[i] * f[i];
    const float rstd = rsqrtf(s * (1.f / 64.f) + EPS);
#pragma unroll
    for (int i = 0; i < 64; ++i) f[i] = f[i] * rstd * gain[i];
#pragma unroll
    for (int i = 0; i < 8; ++i) { const float2 cs = rt[i]; const float x1 = f[i], x2 = f[8 + i]; f[i] = x1 * cs.x - x2 * cs.y; f[8 + i] = x2 * cs.x + x1 * cs.y; }
#pragma unroll
    for (int i = 0; i < 8; ++i) { uint4 o; o.x = pk2(f[8 * i], f[8 * i + 1]); o.y = pk2(f[8 * i + 2], f[8 * i + 3]); o.z = pk2(f[8 * i + 4], f[8 * i + 5]); o.w = pk2(f[8 * i + 6], f[8 * i + 7]); ((uint4*)p)[i] = o; }
}

__device__ __forceinline__ void post_even(const Ctx& c, int vb, int nvb) {
    bf16_t* P = (bf16_t*)(c.ws + WS_PROJ); const float2* RT = (const float2*)(c.ws + WS_ROPE);
    const long total = (long)M * 4;
    for (long it = (long)vb * NTHREADS + c.tid; it < total; it += (long)nvb * NTHREADS) {
        const int m = (int)(it >> 2), s = (int)(it & 3); const int pos = m & (SEQ - 1);
        int col; const float* gain;
        if (s < 2) { col = 2816 + 64 * s; gain = c.nsa_kg + 64; }
        else { col = 3072 + 64 * (s - 2); gain = c.nsa_kg + 128; }
        normrope64(P + (size_t)m * EVPP + col, gain, RT + pos * 8);
    }
}
__device__ __forceinline__ void post_odd(const Ctx& c) {
    bf16_t* P = (bf16_t*)(c.ws + WS_PROJ); const float2* RT = (const float2*)(c.ws + WS_ROPE);
    const long total = (long)M * 18;
    for (long it = (long)blockIdx.x * NTHREADS + c.tid; it < total; it += (long)gridDim.x * NTHREADS) {
        const int m = (int)(it / 18), s = (int)(it % 18); const int pos = m & (SEQ - 1);
        normrope64(P + (size_t)m * ODP + 64 * s, s < 16 ? c.swa_qg : c.swa_kg, RT + pos * 8);
    }
}

__device__ __forceinline__ float gelu_tanh(float x) { const float u = 0.7978845608028654f * (x + 0.044715f * x * x * x); return 0.5f * x * (1.f + tanhf(u)); }

__device__ __forceinline__ void compress_naive(const Ctx& c, float* lds, int vb, int nvb) {
    const bf16_t* P = (const bf16_t*)(c.ws + WS_PROJ);
    const bf16_t* CW1T = (const bf16_t*)(c.ws + WS_CW1T); const bf16_t* CW2T = (const bf16_t*)(c.ws + WS_CW2T);
    const float* CB = (const float*)(c.ws + WS_CBIAS); const float2* RT = (const float2*)(c.ws + WS_ROPE);
    bf16_t* KCB = (bf16_t*)(c.ws + WS_KCB); bf16_t* VCB = (bf16_t*)(c.ws + WS_VCB);
    float* Xs = lds; float* hs = lds + 4096; float* os = lds + 4096 + 512;
    const int tid = c.tid, rs = tid >> 8, cc = tid & 255;
    constexpr int NROWS = 2 * 16 * 2 * 255;
    for (int rp = vb; rp < NROWS / 2; rp += nvb) {
        __syncthreads();
        for (int e = tid; e < 4096; e += NTHREADS) {
            const int r2 = e >> 11, k = e & 2047, row = 2 * rp + r2;
            const int n = row % 255, q = row / 255, g = q & 1, b = (q >> 1) & 15, kind = q >> 5;
            Xs[e] = bf2f(P[(size_t)(b * SEQ + 16 * n + (k >> 6)) * EVPP + 2560 + kind * 128 + g * 64 + (k & 63)]);
        }
        __syncthreads();
        const int row = 2 * rp + rs;
        const int n = row % 255, q = row / 255, g = q & 1, b = (q >> 1) & 15, kind = q >> 5;
        {
            float hv = CB[kind * 256 + cc];
            const bf16_t* w = CW1T + ((size_t)kind * 256 + cc) * 2048; const float* xs = Xs + rs * 2048;
            for (int k = 0; k < 2048; k += 8) { const uint4 ww = *(const uint4*)(w + k); float f[8]; unpack8(ww, f);
#pragma unroll
                for (int i = 0; i < 8; ++i) hv += xs[k + i] * f[i]; }
            hs[rs * 256 + cc] = bf2f(f2bf(gelu_tanh(hv)));
        }
        __syncthreads();
        float o = 0.f;
        if (cc < 64) {
            const bf16_t* w = CW2T + ((size_t)kind * 64 + cc) * 256;
            for (int k = 0; k < 256; ++k) o += hs[rs * 256 + k] * bf2f(w[k]);
            os[rs * 64 + cc] = o;
        }
        __syncthreads();
        if (cc < 64) {
            const size_t dst = ((size_t)((b * 2 + g) * 256 + n)) * 64 + cc;
            if (kind == 0) {
                float s = 0.f;
                for (int k = 0; k < 64; ++k) s += os[rs * 64 + k] * os[rs * 64 + k];
                const float rstd = rsqrtf(s * (1.f / 64.f) + EPS);
                const float* gain = c.nsa_kg;
                float y = o * rstd * gain[cc];
                if (cc < 16) {
                    const int pc = cc < 8 ? cc + 8 : cc - 8; const float yp = os[rs * 64 + pc] * rstd * gain[pc];
                    const float2 cs = RT[(16 * n + 31) * 8 + (cc & 7)];
                    y = cc < 8 ? y * cs.x - yp * cs.y : y * cs.x + yp * cs.y;
                }
                KCB[dst] = f2bf(y);
            } else VCB[dst] = f2bf(o);
        }
    }
    for (int i = vb * NTHREADS + tid; i < 32 * 64; i += nvb * NTHREADS) { const size_t dst = ((size_t)((i >> 6) * 256 + 255)) * 64 + (i & 63); KCB[dst] = 0; VCB[dst] = 0; }
}

__device__ __forceinline__ void compress_mfma(const Ctx& c, unsigned char* lds, int unit) {
    typedef short bf16x8 __attribute__((ext_vector_type(8)));
    typedef float f32x4 __attribute__((ext_vector_type(4)));
    const int kind = unit >> 7, b = (unit >> 3) & 15, g = (unit >> 2) & 1, n0 = (unit & 3) * 64;
    const bf16_t* P = (const bf16_t*)(c.ws + WS_PROJ);
    const bf16_t* W1 = (const bf16_t*)(c.ws + WS_CW1T) + (size_t)kind * 256 * 2048; const bf16_t* W2 = (const bf16_t*)(c.ws + WS_CW2T) + (size_t)kind * 64 * 256;
    const float* CB = (const float*)(c.ws + WS_CBIAS) + kind * 256; const float2* RT = (const float2*)(c.ws + WS_ROPE);
    bf16_t* OUTB = (bf16_t*)(c.ws + (kind == 0 ? WS_KCB : WS_VCB)) + (size_t)((b * 2 + g) * 256) * 64;
    const int tid = c.tid, lane = c.lane, w = c.wave, l15 = lane & 15, g4 = lane >> 4;
    constexpr int HP = 264;
    bf16_t* HS = (bf16_t*)lds; float* OS = (float*)(lds + 64 * HP * 2);
    __syncthreads();
    f32x4 acc[4][2];
#pragma unroll
    for (int mt = 0; mt < 4; ++mt) { acc[mt][0] = (f32x4){0.f, 0.f, 0.f, 0.f}; acc[mt][1] = (f32x4){0.f, 0.f, 0.f, 0.f}; }
    const bf16_t* xb[4];
#pragma unroll
    for (int mt = 0; mt < 4; ++mt) { int n = n0 + 16 * mt + l15; if (n > 254) n = 254; xb[mt] = P + ((size_t)b * SEQ + 16 * n) * EVPP + 2560 + kind * 128 + g * 64 + 8 * (g4 & 1); }
    const bf16_t* wb0 = W1 + (size_t)(32 * w + l15) * 2048 + 8 * g4; const bf16_t* wb1 = wb0 + (size_t)16 * 2048;
#pragma unroll 4
    for (int ks = 0; ks < 64; ++ks) {
        const size_t xo = (size_t)(ks >> 1) * EVPP + 32 * (ks & 1) + 16 * (g4 >> 1);
        const bf16x8 b0 = *(const bf16x8*)(wb0 + 32 * ks), b1 = *(const bf16x8*)(wb1 + 32 * ks);
#pragma unroll
        for (int mt = 0; mt < 4; ++mt) {
            const bf16x8 af = *(const bf16x8*)(xb[mt] + xo);
            acc[mt][0] = __builtin_amdgcn_mfma_f32_16x16x32_bf16(af, b0, acc[mt][0], 0, 0, 0);
            acc[mt][1] = __builtin_amdgcn_mfma_f32_16x16x32_bf16(af, b1, acc[mt][1], 0, 0, 0);
        }
    }
#pragma unroll
    for (int mt = 0; mt < 4; ++mt)
#pragma unroll
        for (int nt = 0; nt < 2; ++nt) { const int cc = 32 * w + 16 * nt + l15; const float bias = CB[cc];
#pragma unroll
            for (int r = 0; r < 4; ++r) HS[(16 * mt + 4 * g4 + r) * HP + cc] = f2bf(gelu_tanh(acc[mt][nt][r] + bias)); }
    __syncthreads();
    {
        const int mt = w >> 1, nt0 = 2 * (w & 1);
        f32x4 o0 = {0.f, 0.f, 0.f, 0.f}, o1 = {0.f, 0.f, 0.f, 0.f};
        const bf16_t* ar = HS + (16 * mt + l15) * HP + 8 * g4;
        const bf16_t* br0 = W2 + (size_t)(16 * nt0 + l15) * 256 + 8 * g4; const bf16_t* br1 = br0 + 16 * 256;
#pragma unroll
        for (int ks = 0; ks < 8; ++ks) {
            const bf16x8 af = *(const bf16x8*)(ar + 32 * ks);
            o0 = __builtin_amdgcn_mfma_f32_16x16x32_bf16(af, *(const bf16x8*)(br0 + 32 * ks), o0, 0, 0, 0);
            o1 = __builtin_amdgcn_mfma_f32_16x16x32_bf16(af, *(const bf16x8*)(br1 + 32 * ks), o1, 0, 0, 0);
        }
#pragma unroll
        for (int r = 0; r < 4; ++r) { OS[(16 * mt + 4 * g4 + r) * 68 + 16 * nt0 + l15] = o0[r]; OS[(16 * mt + 4 * g4 + r) * 68 + 16 * nt0 + 16 + l15] = o1[r]; }
    }
    __syncthreads();
    {
        const int row = tid >> 3, sub = tid & 7, n = n0 + row;
        float v[8];
#pragma unroll
        for (int j = 0; j < 8; ++j) v[j] = OS[row * 68 + 8 * sub + j];
        if (kind == 0) {
            float sq = 0.f;
#pragma unroll
            for (int j = 0; j < 8; ++j) sq += v[j] * v[j];
            sq += __shfl_xor(sq, 1); sq += __shfl_xor(sq, 2); sq += __shfl_xor(sq, 4);
            const float rstd = rsqrtf(sq * (1.f / 64.f) + EPS);
#pragma unroll
            for (int j = 0; j < 8; ++j) v[j] = v[j] * rstd * c.nsa_kg[8 * sub + j];
            const int pos = (16 * n + 31) & (SEQ - 1);
#pragma unroll
            for (int j = 0; j < 8; ++j) {
                const float other = __shfl_xor(v[j], 1);
                const float2 cs = RT[pos * 8 + j];
                if (sub == 0) v[j] = v[j] * cs.x - other * cs.y; else if (sub == 1) v[j] = v[j] * cs.x + other * cs.y;
            }
        }
        uint4 o; o.x = pk2(v[0], v[1]); o.y = pk2(v[2], v[3]); o.z = pk2(v[4], v[5]); o.w = pk2(v[6], v[7]);
        if (n > 254) { o.x = 0u; o.y = 0u; o.z = 0u; o.w = 0u; }
        *(uint4*)(OUTB + (size_t)n * 64 + 8 * sub) = o;
    }
}

__device__ __forceinline__ void hgrn2_naive(const Ctx& c, int vb) {
    bf16_t* P = (bf16_t*)(c.ws + WS_PROJ); const float* LOGF = (const float*)(c.ws + WS_LOGF);
    const int id = vb * NTHREADS + c.tid;
    const int half = id & 1, v = (id >> 1) & 127, h = (id >> 8) & 3, b = id >> 10;
    float S[64];
#pragma unroll
    for (int d = 0; d < 64; ++d) S[d] = 0.f;
    for (int t = 0; t < SEQ; ++t) {
        const size_t m = (size_t)b * SEQ + t;
        bf16_t* row = P + m * EVPP; const float* lf = LOGF + m * 512 + h * 128 + half * 64;
        const float vv = bf2f(row[1024 + h * 128 + v]);
        float o = 0.f;
#pragma unroll
        for (int d8 = 0; d8 < 8; ++d8) {
            const uint4 qw = *(const uint4*)(row + h * 128 + half * 64 + 8 * d8); const uint4 kw = *(const uint4*)(row + 512 + h * 128 + half * 64 + 8 * d8);
            const float4 l0 = *(const float4*)(lf + 8 * d8), l1 = *(const float4*)(lf + 8 * d8 + 4);
            float qf[8], kf[8]; unpack8(qw, qf); unpack8(kw, kf);
            const float lfv[8] = {l0.x, l0.y, l0.z, l0.w, l1.x, l1.y, l1.z, l1.w};
#pragma unroll
            for (int i = 0; i < 8; ++i) { const int d = 8 * d8 + i; S[d] = __expf(lfv[i]) * S[d] + kf[i] * vv; o += qf[i] * S[d]; }
        }
        o += __shfl_xor(o, 1);
        asm volatile("" ::: "memory");
        if (half == 0) row[1024 + h * 128 + v] = f2bf(o);
    }
}

namespace hg {
typedef short bf16x8 __attribute__((ext_vector_type(8)));
typedef float f32x4 __attribute__((ext_vector_type(4)));
constexpr int PQ = 136, PS = 72;
constexpr int O_QS = 0, O_QD = O_QS + 64 * PQ * 2, O_KD = O_QD + 64 * PQ * 2, O_KK = O_KD + 64 * PQ * 2, O_QO = O_KK + 48 * PQ * 2, O_KST = O_QO + 96 * PQ * 2,
              O_VT = O_KST + 128 * PS * 2, O_STT = O_VT + 32 * PS * 2, O_TSH = O_STT + 32 * PQ * 2, O_END = O_TSH + 4 * 128 * 4;
static_assert(O_END <= 160 * 1024, "hgrn2 LDS");
__device__ __forceinline__ bf16x8 pack8(float a0, float a1, float a2, float a3, float a4, float a5, float a6, float a7) {
    uint4 w; w.x = pk2(a0, a1); w.y = pk2(a2, a3); w.z = pk2(a4, a5); w.w = pk2(a6, a7); return __builtin_bit_cast(bf16x8, w); }
__device__ __forceinline__ float cexp(float x) { return __expf(fminf(fmaxf(x, -80.f), 80.f)); }
}
__device__ __forceinline__ void hgrn2_chunk(const Ctx& c, unsigned char* lds_raw, int unit) {
    using namespace hg;
    const int vs = unit & 3, h = (unit >> 2) & 3, b = unit >> 4;
    bf16_t* P = (bf16_t*)(c.ws + WS_PROJ); const float* LOGF = (const float*)(c.ws + WS_LOGF);
    bf16_t* QS = (bf16_t*)(lds_raw + O_QS); bf16_t* QD = (bf16_t*)(lds_raw + O_QD); bf16_t* KD = (bf16_t*)(lds_raw + O_KD); bf16_t* KK = (bf16_t*)(lds_raw + O_KK);
    bf16_t* QO = (bf16_t*)(lds_raw + O_QO); bf16_t* KST = (bf16_t*)(lds_raw + O_KST); bf16_t* VT = (bf16_t*)(lds_raw + O_VT); bf16_t* STT = (bf16_t*)(lds_raw + O_STT);
    float* TSH = (float*)(lds_raw + O_TSH);
    const int tid = c.tid, lane = c.lane, w = c.wave;
    const int i = w >> 1, hf = w & 1, d = 2 * lane;
    const int tt = w >> 1, vvt = w & 1, g4 = lane >> 4, l15 = lane & 15;
    const int dt0 = 2 * (w >> 1), dt1 = dt0 + 1;
    __syncthreads();
    for (int x = tid; x < 32 * PQ / 2; x += NTHREADS) ((u32*)STT)[x] = 0u;
    f32x4 st0 = {0.f, 0.f, 0.f, 0.f}, st1 = {0.f, 0.f, 0.f, 0.f};
    const size_t rowbase = (size_t)b * SEQ;
    const bf16_t* qp = P + (rowbase + 16 * i + 8 * hf) * EVPP + h * 128 + d;
    const float* lp = LOGF + (rowbase + 16 * i + 8 * hf) * 512 + h * 128 + d;
    const int vrow = tid >> 3, vc4 = (tid & 7) * 4;
    const bf16_t* vp = P + (rowbase + vrow) * EVPP + 1024 + h * 128 + 32 * vs + vc4;
    u32 qraw[8], kraw[8]; float2 lfr[8], pre[8]; uint2 vraw;
#pragma unroll
    for (int r = 0; r < 8; ++r) { qraw[r] = *(const u32*)(qp + (size_t)r * EVPP); kraw[r] = *(const u32*)(qp + (size_t)r * EVPP + 512); lfr[r] = *(const float2*)(lp + (size_t)r * 512);
        pre[r] = hf ? *(const float2*)(lp + (size_t)r * 512 - 8 * 512) : make_float2(0.f, 0.f); }
    vraw = *(const uint2*)vp;
    for (int ch = 0; ch < 64; ++ch) {
        const int t0 = ch * 64;
        const int mslot = (ch * 256 + unit) * 6 + w; const bool mok = (w < 6) && mslot < MOE_ITEMS;
        MoeItem mit; moe_item_decode(c, mok ? mslot : 0, mit);
        float4 mva, mvb, mvc, mvd;
        { const float* p_ = mit.W + (size_t)(mit.k0 + 4 * (lane >> 3)) * mit.N + mit.n0 + 4 * (lane & 7); const size_t N_ = mit.N;
          mva = *(const float4*)(p_); mvb = *(const float4*)(p_ + N_); mvc = *(const float4*)(p_ + 2 * N_); mvd = *(const float4*)(p_ + 3 * N_); }
        bf16_t* const mout = mit.WT + (size_t)(mit.drow0 + mit.n0 + 4 * (lane & 7)) * mit.K + mit.k0 + 4 * (lane >> 3); const size_t mK = mit.K;
        float2 lb[8]; float2 run = make_float2(0.f, 0.f);
#pragma unroll
        for (int r = 0; r < 8; ++r) { run.x += pre[r].x; run.y += pre[r].y; }
        const float2 rmid = hf ? run : make_float2(0.f, 0.f);
#pragma unroll
        for (int r = 0; r < 8; ++r) { run.x += lfr[r].x; run.y += lfr[r].y; lb[r] = run; }
        if (hf) *(float2*)(TSH + i * 128 + d) = lb[7];
        if (ch < 63) {
            const size_t adv = (size_t)(t0 + 64);
#pragma unroll
            for (int r = 0; r < 8; ++r) { lfr[r] = *(const float2*)(lp + (adv + r) * 512); if (hf) pre[r] = *(const float2*)(lp + (adv + r) * 512 - 8 * 512); }
        }
        if (ch > 0) {
#pragma unroll
            for (int r = 0; r < 4; ++r) { STT[(16 * vvt + 4 * g4 + r) * PQ + 16 * dt0 + l15] = f2bf(st0[r]); STT[(16 * vvt + 4 * g4 + r) * PQ + 16 * dt1 + l15] = f2bf(st1[r]); }
        }
        __syncthreads();
        {
            const float2 T0 = *(const float2*)(TSH + d), T1 = *(const float2*)(TSH + 128 + d), T2 = *(const float2*)(TSH + 256 + d), T3 = *(const float2*)(TSH + 384 + d);
            const float2 Ti = i == 0 ? T0 : (i == 1 ? T1 : (i == 2 ? T2 : T3));
            const float2 rm = hf ? rmid : lb[7];
            float cQS[2], cQD[2], cKD[2], cKK[2], cKS[2], cQ0[2], cQ1[2], cQ2[2];
#pragma unroll
            for (int x = 0; x < 2; ++x) {
                const float t0x = x ? T0.y : T0.x, t1x = x ? T1.y : T1.x, t2x = x ? T2.y : T2.x, t3x = x ? T3.y : T3.x, tix = x ? Ti.y : Ti.x, rmx = x ? rm.y : rm.x;
                const float Bi = (i > 0 ? t0x : 0.f) + (i > 1 ? t1x : 0.f) + (i > 2 ? t2x : 0.f), B4 = (t0x + t1x) + (t2x + t3x);
                cQS[x] = cexp(Bi); cQD[x] = cexp(-rmx); cKD[x] = cexp(rmx); cKK[x] = cexp(tix); cKS[x] = cKK[x] * cexp(B4 - (Bi + tix));
                cQ0[x] = cexp(Bi - t0x); cQ1[x] = cexp(Bi - (t0x + t1x)); cQ2[x] = cexp(Bi - (t0x + t1x + t2x));
            }
            float ks0[8], ks1[8];
#pragma unroll
            for (int r = 0; r < 8; ++r) {
                const int t = 16 * i + 8 * hf + r;
                const float q0 = __uint_as_float(qraw[r] << 16), q1 = __uint_as_float(qraw[r] & 0xffff0000u), k0 = __uint_as_float(kraw[r] << 16), k1 = __uint_as_float(kraw[r] & 0xffff0000u);
                const float e0 = __expf(fmaxf(lb[r].x, -80.f)), e1 = __expf(fmaxf(lb[r].y, -80.f));
                const float qe0 = q0 * e0, qe1 = q1 * e1, ke0 = k0 * __builtin_amdgcn_rcpf(e0), ke1 = k1 * __builtin_amdgcn_rcpf(e1);
                *(u32*)(QS + t * PQ + d) = pk2(qe0 * cQS[0], qe1 * cQS[1]);
                *(u32*)(QD + t * PQ + d) = pk2(qe0 * cQD[0], qe1 * cQD[1]); *(u32*)(KD + t * PQ + d) = pk2(ke0 * cKD[0], ke1 * cKD[1]);
                if (i < 3) *(u32*)(KK + t * PQ + d) = pk2(ke0 * cKK[0], ke1 * cKK[1]);
                ks0[r] = ke0 * cKS[0]; ks1[r] = ke1 * cKS[1];
                if (i >= 1) *(u32*)(QO + (t - 16) * PQ + d) = pk2(qe0 * cQ0[0], qe1 * cQ0[1]);
                if (i >= 2) *(u32*)(QO + (48 + t - 32) * PQ + d) = pk2(qe0 * cQ1[0], qe1 * cQ1[1]);
                if (i >= 3) *(u32*)(QO + (80 + t - 48) * PQ + d) = pk2(qe0 * cQ2[0], qe1 * cQ2[1]);
            }
            uint4 w0, w1;
            w0.x = pk2(ks0[0], ks0[1]); w0.y = pk2(ks0[2], ks0[3]); w0.z = pk2(ks0[4], ks0[5]); w0.w = pk2(ks0[6], ks0[7]);
            w1.x = pk2(ks1[0], ks1[1]); w1.y = pk2(ks1[2], ks1[3]); w1.z = pk2(ks1[4], ks1[5]); w1.w = pk2(ks1[6], ks1[7]);
            *(uint4*)(KST + d * PS + 16 * i + 8 * hf) = w0; *(uint4*)(KST + (d + 1) * PS + 16 * i + 8 * hf) = w1;
        }
        VT[(vc4 + 0) * PS + vrow] = (bf16_t)(vraw.x & 0xffffu); VT[(vc4 + 1) * PS + vrow] = (bf16_t)(vraw.x >> 16);
        VT[(vc4 + 2) * PS + vrow] = (bf16_t)(vraw.y & 0xffffu); VT[(vc4 + 3) * PS + vrow] = (bf16_t)(vraw.y >> 16);
        if (ch < 63) {
            const size_t adv = (size_t)(t0 + 64);
#pragma unroll
            for (int r = 0; r < 8; ++r) { qraw[r] = *(const u32*)(qp + (adv + r) * EVPP); kraw[r] = *(const u32*)(qp + (adv + r) * EVPP + 512); }
            vraw = *(const uint2*)(vp + adv * EVPP);
        }
        __syncthreads();
        {
            f32x4 Pj[4];
#pragma unroll
            for (int j = 0; j < 4; ++j) {
                Pj[j] = (f32x4){0.f, 0.f, 0.f, 0.f};
                if (j <= tt) {
                    const bf16_t* Ar; const bf16_t* Br;
                    if (j < tt) { Ar = KK + (16 * j + l15) * PQ; Br = QO + ((j == 0 ? 0 : (j == 1 ? 48 : 80)) + 16 * (tt - j - 1) + l15) * PQ; }
                    else { Ar = KD + (16 * tt + l15) * PQ; Br = QD + (16 * tt + l15) * PQ; }
                    f32x4 acc = {0.f, 0.f, 0.f, 0.f};
#pragma unroll
                    for (int ks = 0; ks < 4; ++ks) acc = __builtin_amdgcn_mfma_f32_16x16x32_bf16(*(const bf16x8*)(Ar + 32 * ks + 8 * g4), *(const bf16x8*)(Br + 32 * ks + 8 * g4), acc, 0, 0, 0);
                    __builtin_amdgcn_sched_group_barrier(0x100, 8, 0); __builtin_amdgcn_sched_group_barrier(0x008, 4, 0);
                    if (j == tt) {
#pragma unroll
                        for (int r = 0; r < 4; ++r) if (4 * g4 + r > l15) acc[r] = 0.f;
                    }
                    Pj[j] = acc;
                }
            }
            f32x4 o = {0.f, 0.f, 0.f, 0.f};
            const bf16_t* vt = VT + (16 * vvt + l15) * PS;
#pragma unroll
            for (int p = 0; p < 2; ++p) {
                if (2 * p <= tt) {
                    const bf16x8 af = pack8(Pj[2 * p][0], Pj[2 * p][1], Pj[2 * p][2], Pj[2 * p][3], Pj[2 * p + 1][0], Pj[2 * p + 1][1], Pj[2 * p + 1][2], Pj[2 * p + 1][3]);
                    const uint2 lo = *(const uint2*)(vt + 32 * p + 4 * g4), hi = *(const uint2*)(vt + 32 * p + 16 + 4 * g4);
                    uint4 bw; bw.x = lo.x; bw.y = lo.y; bw.z = hi.x; bw.w = hi.y;
                    o = __builtin_amdgcn_mfma_f32_16x16x32_bf16(af, __builtin_bit_cast(bf16x8, bw), o, 0, 0, 0);
                }
            }
            {
                const bf16_t* Ar = QS + (16 * tt + l15) * PQ; const bf16_t* Br = STT + (16 * vvt + l15) * PQ;
#pragma unroll
                for (int ks = 0; ks < 4; ++ks) o = __builtin_amdgcn_mfma_f32_16x16x32_bf16(*(const bf16x8*)(Ar + 32 * ks + 8 * g4), *(const bf16x8*)(Br + 32 * ks + 8 * g4), o, 0, 0, 0);
                __builtin_amdgcn_sched_group_barrier(0x100, 8, 0); __builtin_amdgcn_sched_group_barrier(0x008, 4, 0);
            }
            bf16_t* op = P + (rowbase + t0 + 16 * tt + 4 * g4) * EVPP + 1024 + h * 128 + 32 * vs + 16 * vvt + l15;
#pragma unroll
            for (int r = 0; r < 4; ++r) op[(size_t)r * EVPP] = f2bf(o[r]);
            {
                const int d0 = 16 * dt0 + l15, d1 = 16 * dt1 + l15;
                const float g0 = cexp((TSH[d0] + TSH[128 + d0]) + (TSH[256 + d0] + TSH[384 + d0])), g1 = cexp((TSH[d1] + TSH[128 + d1]) + (TSH[256 + d1] + TSH[384 + d1]));
                st0 = st0 * g0; st1 = st1 * g1;
#pragma unroll
                for (int ks = 0; ks < 2; ++ks) {
                    const bf16x8 av = *(const bf16x8*)(vt + 32 * ks + 8 * g4);
                    st0 = __builtin_amdgcn_mfma_f32_16x16x32_bf16(av, *(const bf16x8*)(KST + d0 * PS + 32 * ks + 8 * g4), st0, 0, 0, 0);
                    st1 = __builtin_amdgcn_mfma_f32_16x16x32_bf16(av, *(const bf16x8*)(KST + d1 * PS + 32 * ks + 8 * g4), st1, 0, 0, 0);
                }
            }
        }
        if (mok) { uint2 w_;
            w_.x = pk2(mva.x, mvb.x); w_.y = pk2(mvc.x, mvd.x); *(uint2*)(mout) = w_;
            w_.x = pk2(mva.y, mvb.y); w_.y = pk2(mvc.y, mvd.y); *(uint2*)(mout + mK) = w_;
            w_.x = pk2(mva.z, mvb.z); w_.y = pk2(mvc.z, mvd.z); *(uint2*)(mout + 2 * mK) = w_;
            w_.x = pk2(mva.w, mvb.w); w_.y = pk2(mvc.w, mvd.w); *(uint2*)(mout + 3 * mK) = w_; }
        __syncthreads();
    }
}

namespace hg {
constexpr int A_VT = O_KST + 128 * PS * 2, A_TSH = A_VT + 128 * PS * 2, A_END = A_TSH + 4 * 128 * 4;
static_assert(A_END <= 160 * 1024 - 16, "hgrn2 pass A LDS");
constexpr int S_QS = 0, S_STT = 2 * 64 * PQ * 2, S_END = S_STT + 2 * 32 * PQ * 2;
constexpr size_t HG_U = 0, HG_QG = (size_t)128 << 20, HG_OI = (size_t)192 << 20;
}
__device__ __forceinline__ void hgrn2_passA(const Ctx& c, unsigned char* lds_raw, int su) {
    using namespace hg;
    const int cq = su & 3, h = (su >> 2) & 3, b = su >> 4;
    const bf16_t* P = (const bf16_t*)(c.ws + WS_PROJ); const float* LOGF = (const float*)(c.ws + WS_LOGF);
    unsigned char* scr = (unsigned char*)c.xr; float* GD = (float*)(c.ws + WS_H);
    bf16_t* QS = (bf16_t*)(lds_raw + O_QS); bf16_t* QD = (bf16_t*)(lds_raw + O_QD); bf16_t* KD = (bf16_t*)(lds_raw + O_KD); bf16_t* KK = (bf16_t*)(lds_raw + O_KK);
    bf16_t* QO = (bf16_t*)(lds_raw + O_QO); bf16_t* KST = (bf16_t*)(lds_raw + O_KST); bf16_t* VT = (bf16_t*)(lds_raw + A_VT);
    float* TSH = (float*)(lds_raw + A_TSH);
    const int tid = c.tid, lane = c.lane, w = c.wave;
    const int i = w >> 1, hf = w & 1, d = 2 * lane;
    const int tt = w >> 1, vh = w & 1, g4 = lane >> 4, l15 = lane & 15;
    const size_t rowbase = (size_t)b * SEQ + (size_t)cq * 1024;
    const bf16_t* qp = P + (rowbase + 16 * i + 8 * hf) * EVPP + h * 128 + d;
    const float* lp = LOGF + (rowbase + 16 * i + 8 * hf) * 512 + h * 128 + d;
    const int vrow = tid >> 3, vc = (tid & 7) * 16;
    const bf16_t* vp = P + (rowbase + vrow) * EVPP + 1024 + h * 128 + vc;
    u32 qraw[8], kraw[8]; float2 lfr[8], pre[8]; uint4 vr0, vr1;
#pragma unroll
    for (int r = 0; r < 8; ++r) { qraw[r] = *(const u32*)(qp + (size_t)r * EVPP); kraw[r] = *(const u32*)(qp + (size_t)r * EVPP + 512); lfr[r] = *(const float2*)(lp + (size_t)r * 512);
        pre[r] = *(const float2*)(lp + (size_t)r * 512 - (size_t)(8 * hf) * 512); }
    vr0 = *(const uint4*)vp; vr1 = *(const uint4*)(vp + 8);
    __syncthreads();
    for (int k = 0; k < 16; ++k) {
        const int u = ((b * 4 + h) * 64) + cq * 16 + k;
        float2 lb[8]; float2 run = make_float2(0.f, 0.f);
#pragma unroll
        for (int r = 0; r < 8; ++r) { run.x += pre[r].x; run.y += pre[r].y; }
        run.x *= (float)hf; run.y *= (float)hf;
        const float2 rmid = run;
#pragma unroll
        for (int r = 0; r < 8; ++r) { run.x += lfr[r].x; run.y += lfr[r].y; lb[r] = run; }
        if (hf) *(float2*)(TSH + i * 128 + d) = lb[7];
        if (k < 15) {
            const size_t adv = (size_t)(k + 1) * 64;
#pragma unroll
            for (int r = 0; r < 8; ++r) { lfr[r] = *(const float2*)(lp + (adv + r) * 512); pre[r] = *(const float2*)(lp + (adv + r) * 512 - (size_t)(8 * hf) * 512); }
        }
        __syncthreads();
        {
            const float2 T0 = *(const float2*)(TSH + d), T1 = *(const float2*)(TSH + 128 + d), T2 = *(const float2*)(TSH + 256 + d), T3 = *(const float2*)(TSH + 384 + d);
            const float2 Ti = i == 0 ? T0 : (i == 1 ? T1 : (i == 2 ? T2 : T3));
            const float2 rm = hf ? rmid : lb[7];
            float cQS[2], cQD[2], cKD[2], cKK[2], cKS[2], cQ0[2], cQ1[2], cQ2[2];
#pragma unroll
            for (int x = 0; x < 2; ++x) {
                const float t0x = x ? T0.y : T0.x, t1x = x ? T1.y : T1.x, t2x = x ? T2.y : T2.x, t3x = x ? T3.y : T3.x, tix = x ? Ti.y : Ti.x, rmx = x ? rm.y : rm.x;
                const float Bi = (i > 0 ? t0x : 0.f) + (i > 1 ? t1x : 0.f) + (i > 2 ? t2x : 0.f), B4 = (t0x + t1x) + (t2x + t3x);
                cQS[x] = cexp(Bi); cQD[x] = cexp(-rmx); cKD[x] = cexp(rmx); cKK[x] = cexp(tix); cKS[x] = cKK[x] * cexp(B4 - (Bi + tix));
                cQ0[x] = cexp(Bi - t0x); cQ1[x] = cexp(Bi - (t0x + t1x)); cQ2[x] = cexp(Bi - (t0x + t1x + t2x));
            }
            if (tid < 128) GD[(size_t)u * 128 + tid] = cexp((TSH[tid] + TSH[128 + tid]) + (TSH[256 + tid] + TSH[384 + tid]));
            float ks0[8], ks1[8];
#pragma unroll
            for (int r = 0; r < 8; ++r) {
                const int t = 16 * i + 8 * hf + r;
                const float q0 = __uint_as_float(qraw[r] << 16), q1 = __uint_as_float(qraw[r] & 0xffff0000u), k0 = __uint_as_float(kraw[r] << 16), k1 = __uint_as_float(kraw[r] & 0xffff0000u);
                const float e0 = __expf(fmaxf(lb[r].x, -80.f)), e1 = __expf(fmaxf(lb[r].y, -80.f));
                const float qe0 = q0 * e0, qe1 = q1 * e1, ke0 = k0 * __builtin_amdgcn_rcpf(e0), ke1 = k1 * __builtin_amdgcn_rcpf(e1);
                *(u32*)(QS + t * PQ + d) = pk2(qe0 * cQS[0], qe1 * cQS[1]);
                *(u32*)(QD + t * PQ + d) = pk2(qe0 * cQD[0], qe1 * cQD[1]); *(u32*)(KD + t * PQ + d) = pk2(ke0 * cKD[0], ke1 * cKD[1]);
                if (i < 3) *(u32*)(KK + t * PQ + d) = pk2(ke0 * cKK[0], ke1 * cKK[1]);
                ks0[r] = ke0 * cKS[0]; ks1[r] = ke1 * cKS[1];
                if (i >= 1) *(u32*)(QO + (t - 16) * PQ + d) = pk2(qe0 * cQ0[0], qe1 * cQ0[1]);
                if (i >= 2) *(u32*)(QO + (48 + t - 32) * PQ + d) = pk2(qe0 * cQ1[0], qe1 * cQ1[1]);
                if (i >= 3) *(u32*)(QO + (80 + t - 48) * PQ + d) = pk2(qe0 * cQ2[0], qe1 * cQ2[1]);
            }
            uint4 w0, w1;
            w0.x = pk2(ks0[0], ks0[1]); w0.y = pk2(ks0[2], ks0[3]); w0.z = pk2(ks0[4], ks0[5]); w0.w = pk2(ks0[6], ks0[7]);
            w1.x = pk2(ks1[0], ks1[1]); w1.y = pk2(ks1[2], ks1[3]); w1.z = pk2(ks1[4], ks1[5]); w1.w = pk2(ks1[6], ks1[7]);
            *(uint4*)(KST + d * PS + 16 * i + 8 * hf) = w0; *(uint4*)(KST + (d + 1) * PS + 16 * i + 8 * hf) = w1;
        }
        {
            const u32 vw[8] = {vr0.x, vr0.y, vr0.z, vr0.w, vr1.x, vr1.y, vr1.z, vr1.w};
#pragma unroll
            for (int j = 0; j < 8; ++j) { VT[(vc + 2 * j) * PS + vrow] = (bf16_t)(vw[j] & 0xffffu); VT[(vc + 2 * j + 1) * PS + vrow] = (bf16_t)(vw[j] >> 16); }
        }
        if (k < 15) {
            const size_t adv = (size_t)(k + 1) * 64;
#pragma unroll
            for (int r = 0; r < 8; ++r) { qraw[r] = *(const u32*)(qp + (adv + r) * EVPP); kraw[r] = *(const u32*)(qp + (adv + r) * EVPP + 512); }
            vr0 = *(const uint4*)(vp + adv * EVPP); vr1 = *(const uint4*)(vp + adv * EVPP + 8);
        }
        __syncthreads();
        {
            f32x4 Pj[4];
#pragma unroll
            for (int j = 0; j < 4; ++j) {
                Pj[j] = (f32x4){0.f, 0.f, 0.f, 0.f};
                if (j <= tt) {
                    const bf16_t* Ar; const bf16_t* Br;
                    if (j < tt) { Ar = KK + (16 * j + l15) * PQ; Br = QO + ((j == 0 ? 0 : (j == 1 ? 48 : 80)) + 16 * (tt - j - 1) + l15) * PQ; }
                    else { Ar = KD + (16 * tt + l15) * PQ; Br = QD + (16 * tt + l15) * PQ; }
                    f32x4 acc = {0.f, 0.f, 0.f, 0.f};
#pragma unroll
                    for (int ks = 0; ks < 4; ++ks) acc = __builtin_amdgcn_mfma_f32_16x16x32_bf16(*(const bf16x8*)(Ar + 32 * ks + 8 * g4), *(const bf16x8*)(Br + 32 * ks + 8 * g4), acc, 0, 0, 0);
                    __builtin_amdgcn_sched_group_barrier(0x100, 8, 0); __builtin_amdgcn_sched_group_barrier(0x008, 4, 0);
                    if (j == tt) {
#pragma unroll
                        for (int r = 0; r < 4; ++r) if (4 * g4 + r > l15) acc[r] = 0.f;
                    }
                    Pj[j] = acc;
                }
            }
            const bf16x8 af0 = pack8(Pj[0][0], Pj[0][1], Pj[0][2], Pj[0][3], Pj[1][0], Pj[1][1], Pj[1][2], Pj[1][3]);
            const bf16x8 af1 = pack8(Pj[2][0], Pj[2][1], Pj[2][2], Pj[2][3], Pj[3][0], Pj[3][1], Pj[3][2], Pj[3][3]);
            uint2* OI = (uint2*)(scr + HG_OI) + ((size_t)u * 32 + tt * 8) * 64 + lane;
#pragma unroll
            for (int q = 0; q < 4; ++q) {
                const int vt = 4 * vh + q;
                const bf16_t* vrw = VT + (16 * vt + l15) * PS;
                f32x4 o = {0.f, 0.f, 0.f, 0.f};
                { const uint2 lo = *(const uint2*)(vrw + 4 * g4), hi = *(const uint2*)(vrw + 16 + 4 * g4); uint4 bw; bw.x = lo.x; bw.y = lo.y; bw.z = hi.x; bw.w = hi.y;
                  o = __builtin_amdgcn_mfma_f32_16x16x32_bf16(af0, __builtin_bit_cast(bf16x8, bw), o, 0, 0, 0); }
                if (tt >= 2) { const uint2 lo = *(const uint2*)(vrw + 32 + 4 * g4), hi = *(const uint2*)(vrw + 48 + 4 * g4); uint4 bw; bw.x = lo.x; bw.y = lo.y; bw.z = hi.x; bw.w = hi.y;
                  o = __builtin_amdgcn_mfma_f32_16x16x32_bf16(af1, __builtin_bit_cast(bf16x8, bw), o, 0, 0, 0); }
                uint2 ow; ow.x = pk2(o[0], o[1]); ow.y = pk2(o[2], o[3]);
                OI[(size_t)vt * 64] = ow;
            }
            {
                uint2* U = (uint2*)(scr + HG_U) + ((size_t)u * 64 + w * 8) * 64 + lane;
                const bf16_t* vrw = VT + (16 * w + l15) * PS;
                const bf16x8 av0 = *(const bf16x8*)(vrw + 8 * g4), av1 = *(const bf16x8*)(vrw + 32 + 8 * g4);
#pragma unroll
                for (int dt = 0; dt < 8; ++dt) {
                    const bf16_t* kr = KST + (16 * dt + l15) * PS + 8 * g4;
                    f32x4 a = {0.f, 0.f, 0.f, 0.f};
                    a = __builtin_amdgcn_mfma_f32_16x16x32_bf16(av0, *(const bf16x8*)(kr), a, 0, 0, 0);
                    a = __builtin_amdgcn_mfma_f32_16x16x32_bf16(av1, *(const bf16x8*)(kr + 32), a, 0, 0, 0);
                    uint2 uw; uw.x = pk2(a[0], a[1]); uw.y = pk2(a[2], a[3]);
                    U[(size_t)dt * 64] = uw;
                }
            }
            {
                const int row = tid >> 3, ch16 = (tid & 7) * 16;
                const uint4 a0 = *(const uint4*)(QS + row * PQ + ch16), a1 = *(const uint4*)(QS + row * PQ + ch16 + 8);
                uint4* QG = (uint4*)(scr + HG_QG + ((size_t)u * 64 + row) * 256 + ch16 * 2);
                QG[0] = a0; QG[1] = a1;
            }
        }
        __syncthreads();
    }
}

__device__ __forceinline__ void hgrn2_seq(const Ctx& c, unsigned char* lds_raw, int unit) {
    using namespace hg;
    const int vs = unit & 3, h = (unit >> 2) & 3, b = unit >> 4;
    bf16_t* P = (bf16_t*)(c.ws + WS_PROJ);
    const unsigned char* scr = (const unsigned char*)c.xr; const float* GD = (const float*)(c.ws + WS_H);
    const int tid = c.tid, lane = c.lane, w = c.wave;
    const int tt = w >> 1, vvt = w & 1, g4 = lane >> 4, l15 = lane & 15;
    const int dt0 = 2 * (w >> 1), dt1 = dt0 + 1, vt = 2 * vs + vvt;
    const size_t rowbase = (size_t)b * SEQ;
    const int u0 = (b * 4 + h) * 64;
    f32x4 st0 = {0.f, 0.f, 0.f, 0.f}, st1 = {0.f, 0.f, 0.f, 0.f};
    const int qrow = tid >> 3, qc16 = (tid & 7) * 16;
#define HG_LOAD(SET, CH) do { const size_t u_ = (size_t)(u0 + (CH)); \
        const uint4* qg_ = (const uint4*)(scr + HG_QG + (u_ * 64 + qrow) * 256 + qc16 * 2); SET##q0 = qg_[0]; SET##q1 = qg_[1]; \
        const uint2* up_ = (const uint2*)(scr + HG_U) + (u_ * 64 + vt * 8) * 64 + lane; SET##u0 = up_[(size_t)dt0 * 64]; SET##u1 = up_[(size_t)dt1 * 64]; \
        SET##oi = ((const uint2*)(scr + HG_OI))[(u_ * 32 + tt * 8 + vt) * 64 + lane]; \
        SET##g0 = GD[u_ * 128 + 16 * dt0 + l15]; SET##g1 = GD[u_ * 128 + 16 * dt1 + l15]; } while (0)
#define HG_MOE_ISSUE(SET, CH) do { const int ms_ = ((CH) * 256 + unit) * 6 + w; SET##mok = (w < 6) && ms_ < MOE_ITEMS; MoeItem mi_; moe_item_decode(c, SET##mok ? ms_ : 0, mi_); \
        const float* p_ = mi_.W + (size_t)(mi_.k0 + 4 * (lane >> 3)) * mi_.N + mi_.n0 + 4 * (lane & 7); const size_t N_ = mi_.N; \
        SET##ma = *(const float4*)(p_); SET##mb = *(const float4*)(p_ + N_); SET##mc = *(const float4*)(p_ + 2 * N_); SET##md = *(const float4*)(p_ + 3 * N_); \
        SET##mg = mi_.gain ? *(const float4*)(mi_.gain + mi_.k0 + 4 * (lane >> 3)) : make_float4(1.f, 1.f, 1.f, 1.f); \
        SET##mo = mi_.WT + (size_t)(mi_.drow0 + mi_.n0 + 4 * (lane & 7)) * mi_.K + mi_.k0 + 4 * (lane >> 3); SET##mk = mi_.K; } while (0)
#define HG_MOE_FINISH(SET) do { if (SET##mok) { uint2 w_; \
        SET##ma.x *= SET##mg.x; SET##ma.y *= SET##mg.x; SET##ma.z *= SET##mg.x; SET##ma.w *= SET##mg.x; SET##mb.x *= SET##mg.y; SET##mb.y *= SET##mg.y; SET##mb.z *= SET##mg.y; SET##mb.w *= SET##mg.y; \
        SET##mc.x *= SET##mg.z; SET##mc.y *= SET##mg.z; SET##mc.z *= SET##mg.z; SET##mc.w *= SET##mg.z; SET##md.x *= SET##mg.w; SET##md.y *= SET##mg.w; SET##md.z *= SET##mg.w; SET##md.w *= SET##mg.w; \
        w_.x = pk2(SET##ma.x, SET##mb.x); w_.y = pk2(SET##mc.x, SET##md.x); *(uint2*)(SET##mo) = w_; \
        w_.x = pk2(SET##ma.y, SET##mb.y); w_.y = pk2(SET##mc.y, SET##md.y); *(uint2*)(SET##mo + SET##mk) = w_; \
        w_.x = pk2(SET##ma.z, SET##mb.z); w_.y = pk2(SET##mc.z, SET##md.z); *(uint2*)(SET##mo + 2 * SET##mk) = w_; \
        w_.x = pk2(SET##ma.w, SET##mb.w); w_.y = pk2(SET##mc.w, SET##md.w); *(uint2*)(SET##mo + 3 * SET##mk) = w_; } } while (0)
#define HG_STEP(SET, CH) do { const int ch_ = (CH); \
        bf16_t* QSL = (bf16_t*)(lds_raw + S_QS) + (ch_ & 1) * 64 * PQ; bf16_t* STT = (bf16_t*)(lds_raw + S_STT) + (ch_ & 1) * 32 * PQ; \
        *(uint4*)(QSL + qrow * PQ + qc16) = SET##q0; *(uint4*)(QSL + qrow * PQ + qc16 + 8) = SET##q1; \
        _Pragma("unroll") for (int r = 0; r < 4; ++r) { STT[(16 * vvt + 4 * g4 + r) * PQ + 16 * dt0 + l15] = f2bf(st0[r]); STT[(16 * vvt + 4 * g4 + r) * PQ + 16 * dt1 + l15] = f2bf(st1[r]); } \
        __syncthreads(); \
        f32x4 o = {__uint_as_float(SET##oi.x << 16), __uint_as_float(SET##oi.x & 0xffff0000u), __uint_as_float(SET##oi.y << 16), __uint_as_float(SET##oi.y & 0xffff0000u)}; \
        { const bf16_t* Ar = QSL + (16 * tt + l15) * PQ; const bf16_t* Br = STT + (16 * vvt + l15) * PQ; \
          _Pragma("unroll") for (int ks = 0; ks < 4; ++ks) o = __builtin_amdgcn_mfma_f32_16x16x32_bf16(*(const bf16x8*)(Ar + 32 * ks + 8 * g4), *(const bf16x8*)(Br + 32 * ks + 8 * g4), o, 0, 0, 0); \
          __builtin_amdgcn_sched_group_barrier(0x100, 8, 0); __builtin_amdgcn_sched_group_barrier(0x008, 4, 0); } \
        bf16_t* op = P + (rowbase + ch_ * 64 + 16 * tt + 4 * g4) * EVPP + 1024 + h * 128 + 32 * vs + 16 * vvt + l15; \
        _Pragma("unroll") for (int r = 0; r < 4; ++r) op[(size_t)r * EVPP] = f2bf(o[r]); \
        st0[0] = st0[0] * SET##g0 + __uint_as_float(SET##u0.x << 16); st0[1] = st0[1] * SET##g0 + __uint_as_float(SET##u0.x & 0xffff0000u); \
        st0[2] = st0[2] * SET##g0 + __uint_as_float(SET##u0.y << 16); st0[3] = st0[3] * SET##g0 + __uint_as_float(SET##u0.y & 0xffff0000u); \
        st1[0] = st1[0] * SET##g1 + __uint_as_float(SET##u1.x << 16); st1[1] = st1[1] * SET##g1 + __uint_as_float(SET##u1.x & 0xffff0000u); \
        st1[2] = st1[2] * SET##g1 + __uint_as_float(SET##u1.y << 16); st1[3] = st1[3] * SET##g1 + __uint_as_float(SET##u1.y & 0xffff0000u); \
        HG_MOE_FINISH(SET); \
        if (ch_ + 2 < 64) { HG_LOAD(SET, ch_ + 2); HG_MOE_ISSUE(SET, ch_ + 2); } else SET##mok = false; } while (0)
    uint4 Aq0, Aq1, Bq0, Bq1; uint2 Au0, Au1, Aoi, Bu0, Bu1, Boi; float Ag0, Ag1, Bg0, Bg1;
    float4 Ama, Amb, Amc, Amd, Bma, Bmb, Bmc, Bmd, Amg, Bmg; bf16_t* Amo; bf16_t* Bmo; size_t Amk, Bmk; bool Amok, Bmok;
    HG_LOAD(A, 0); HG_LOAD(B, 1); HG_MOE_ISSUE(A, 0); HG_MOE_ISSUE(B, 1);
    __syncthreads();
    for (int ch = 0; ch < 64; ch += 2) { HG_STEP(A, ch); HG_STEP(B, ch + 1); }
#undef HG_LOAD
#undef HG_MOE_ISSUE
#undef HG_MOE_FINISH
#undef HG_STEP
    __syncthreads();
}

__device__ __forceinline__ void dot4(const bf16_t* kr, const float* qs, float& s0, float& s1, float& s2, float& s3) {
    s0 = s1 = s2 = s3 = 0.f;
#pragma unroll
    for (int ch = 0; ch < 8; ++ch) {
        const uint4 w = ((const uint4*)kr)[ch]; float kf[8]; unpack8(w, kf);
#pragma unroll
        for (int q4 = 0; q4 < 2; ++q4) {
            const int d = ch * 8 + q4 * 4;
            const float4 a = *(const float4*)(qs + d), b = *(const float4*)(qs + 64 + d), cc = *(const float4*)(qs + 128 + d), e = *(const float4*)(qs + 192 + d);
            const float k0 = kf[q4 * 4], k1 = kf[q4 * 4 + 1], k2 = kf[q4 * 4 + 2], k3 = kf[q4 * 4 + 3];
            s0 += a.x * k0 + a.y * k1 + a.z * k2 + a.w * k3; s1 += b.x * k0 + b.y * k1 + b.z * k2 + b.w * k3;
            s2 += cc.x * k0 + cc.y * k1 + cc.z * k2 + cc.w * k3; s3 += e.x * k0 + e.y * k1 + e.z * k2 + e.w * k3;
        }
    }
}

constexpr int ATT_WSTRIDE = 256 + 2048 + 16;
template <bool SINK>
__device__ __forceinline__ void attn_rounds(const bf16_t* Kb, const bf16_t* Vb, int ld, const int* bases, int nr, int lo, int hi, const float* qs, float* ps,
                                            const float (&sink)[4], float (&o)[4], float (&inv)[4], int lane) {
#pragma unroll 1
    for (int r = 0; r < nr; ++r) {
        const int kp = bases[r] + lane; const bool val = kp >= lo && kp <= hi;
        const int kr = val ? kp : lo;
        float s0, s1, s2, s3; dot4(Kb + (size_t)kr * ld, qs, s0, s1, s2, s3);
        ps[64 * r + lane] = val ? s0 * 0.125f : -INFINITY; ps[512 + 64 * r + lane] = val ? s1 * 0.125f : -INFINITY;
        ps[1024 + 64 * r + lane] = val ? s2 * 0.125f : -INFINITY; ps[1536 + 64 * r + lane] = val ? s3 * 0.125f : -INFINITY;
    }
    LDS_FENCE();
#pragma unroll
    for (int hh = 0; hh < 4; ++hh) {
        float mx = SINK ? sink[hh] : -INFINITY;
#pragma unroll 1
        for (int r = 0; r < nr; ++r) mx = fmaxf(mx, ps[hh * 512 + 64 * r + lane]);
        mx = wmax(mx); if (mx == -INFINITY) mx = 0.f;
        float l = 0.f;
#pragma unroll 1
        for (int r = 0; r < nr; ++r) { const float sv = ps[hh * 512 + 64 * r + lane]; const float p = (sv == -INFINITY) ? 0.f : __expf(sv - mx); ps[hh * 512 + 64 * r + lane] = p; l += p; }
        l = wsum(l); if (SINK) l += __expf(sink[hh] - mx);
        inv[hh] = 1.f / fmaxf(l, 1e-30f);
    }
    LDS_FENCE();
    o[0] = o[1] = o[2] = o[3] = 0.f;
#pragma unroll 1
    for (int r = 0; r < nr; ++r) {
        const int bs = bases[r];
        if (bs < -50000000) continue;
#pragma unroll 4
        for (int kk = 0; kk < 64; ++kk) {
            const int kp = bs + kk; if (kp < lo || kp > hi) continue;
            const float vv = bf2f(Vb[(size_t)kp * ld + lane]);
            o[0] += ps[64 * r + kk] * vv; o[1] += ps[512 + 64 * r + kk] * vv; o[2] += ps[1024 + 64 * r + kk] * vv; o[3] += ps[1536 + 64 * r + kk] * vv;
        }
    }
    o[0] *= inv[0]; o[1] *= inv[1]; o[2] *= inv[2]; o[3] *= inv[3];
}

__device__ __forceinline__ void nsa_naive(const Ctx& c, float* lds) {
    const bf16_t* P = (const bf16_t*)(c.ws + WS_PROJ); bf16_t* MIX = (bf16_t*)(c.ws + WS_H);
    const bf16_t* KCB = (const bf16_t*)(c.ws + WS_KCB); const bf16_t* VCB = (const bf16_t*)(c.ws + WS_VCB);
    float* qs = lds + c.wave * ATT_WSTRIDE; float* ps = qs + 256; int* bl = (int*)(ps + 2048);
    const int lane = c.lane;
    const float nosink[4] = {0.f, 0.f, 0.f, 0.f};
    for (int task = c.gw; task < M * 2; task += c.ngw) {
        const int g = task & 1, m = task >> 1, b = m >> 12, t = m & (SEQ - 1);
        const bf16_t* prow = P + (size_t)m * EVPP;
#pragma unroll
        for (int hh = 0; hh < 4; ++hh) qs[hh * 64 + lane] = bf2f(prow[2048 + (4 * g + hh) * 64 + lane]);
        if (lane < 4) bl[lane] = 64 * lane;
        LDS_FENCE();
        float oc[4], inv[4];
        const int nmax = (t >= 31) ? (t - 31) / 16 : -1;
        attn_rounds<false>(KCB + (size_t)((b * 2 + g) * 256) * 64, VCB + (size_t)((b * 2 + g) * 256) * 64, 64, bl, 4, 0, nmax, qs, ps, nosink, oc, inv, lane);
        float imp = 0.f;
#pragma unroll
        for (int hh = 0; hh < 4; ++hh) {
            float a = 0.f;
#pragma unroll
            for (int dn = -1; dn <= 3; ++dn) { const int n = 4 * lane + dn; if (n >= 0 && n <= nmax) a += ps[hh * 512 + n]; }
            imp += a * inv[hh];
        }
        LDS_FENCE();
        const int i = t >> 6;
        const bool allowed = lane <= i, forced = (lane == 0) || (lane == i) || (lane == i - 1);
        float score = allowed ? imp + (forced ? 1e4f : 0.f) : -INFINITY;
#pragma unroll
        for (int r = 0; r < 8; ++r) {
            const float mx = wmax(score);
            const unsigned long long bal = __ballot(score == mx && mx > -INFINITY);
            const int idx = bal ? (__ffsll((long long)bal) - 1) : 0;
            if (lane == 0) bl[r] = bal ? 64 * idx : -100000000;
            if (bal && lane == idx) score = -INFINITY;
        }
        LDS_FENCE();
        float osel[4];
        attn_rounds<false>(P + (size_t)b * SEQ * EVPP + 2816 + g * 64, P + (size_t)b * SEQ * EVPP + 2944 + g * 64, EVPP, bl, 8, 0, t, qs, ps, nosink, osel, inv, lane);
        float ow[4];
        if (lane < 8) bl[lane] = t - 511 + 64 * lane;
        LDS_FENCE();
        attn_rounds<false>(P + (size_t)b * SEQ * EVPP + 3072 + g * 64, P + (size_t)b * SEQ * EVPP + 3200 + g * 64, EVPP, bl, 8, 0, t, qs, ps, nosink, ow, inv, lane);
#pragma unroll
        for (int hh = 0; hh < 4; ++hh) {
            const int head = 4 * g + hh;
            const float g0 = 1.f / (1.f + __expf(-bf2f(prow[3328 + head * 3 + 0]))), g1 = 1.f / (1.f + __expf(-bf2f(prow[3328 + head * 3 + 1]))), g2 = 1.f / (1.f + __expf(-bf2f(prow[3328 + head * 3 + 2])));
            MIX[(size_t)m * D + 512 + head * 64 + lane] = f2bf(g0 * oc[hh] + g1 * osel[hh] + g2 * ow[hh]);
        }
        LDS_FENCE();
    }
}

namespace fa {
typedef short bf16x8 __attribute__((ext_vector_type(8)));
typedef short s16x4 __attribute__((ext_vector_type(4)));
typedef float f32x16 __attribute__((ext_vector_type(16)));
#define FA_LAS __attribute__((address_space(3)))
constexpr int RPK = 144, RPV = 192;
constexpr int KTB = 64 * RPK, VTB = 64 * RPV;
constexpr int O_KT = 0, O_VT = 2 * KTB, O_IMP = O_VT + 2 * VTB, O_SELM = O_IMP + 64 * 64 * 4, O_JL = O_SELM + 512, O_UM = O_JL + 64 * 4, O_STG = 0  , STG_P = 144, STG_W = 32 * STG_P,
              O_RES = O_UM + 32, RES_P = 68, RES_W = 32 * RES_P * 4, O_END = O_RES + 8 * RES_W;
static_assert(O_END <= LDS_BARST && (O_STG % 16) == 0 && (O_RES % 16) == 0 && 8 * STG_W <= 2 * KTB + 2 * VTB, "attention LDS");
constexpr float SC2 = 0.125f * 1.4426950408889634f;
constexpr float THR = 8.f;
__device__ __forceinline__ int crow(int r, int hi) { return (r & 3) + 8 * (r >> 2) + 4 * hi; }
struct RangeMask { int lo, hi; __device__ __forceinline__ bool operator()(int kl) const { return kl >= lo && kl <= hi; } };
__device__ __forceinline__ s16x4 vtr(const unsigned char* p) {
    typedef short v4i16_t __attribute__((ext_vector_type(4)));
    return __builtin_bit_cast(s16x4, __builtin_amdgcn_ds_read_tr16_b64_v4i16((FA_LAS v4i16_t*)(p))); }
struct State { f32x16 o[2]; float m, l; };
__device__ __forceinline__ void init(State& st, float m0, float l0) {
#pragma unroll
    for (int t = 0; t < 2; ++t)
#pragma unroll
        for (int r = 0; r < 16; ++r) st.o[t][r] = 0.f;
    st.m = m0; st.l = l0; }
__device__ __forceinline__ bf16x8 scale_q(const bf16x8 q) {
    const uint4 w = __builtin_bit_cast(uint4, q); float f[8]; unpack8(w, f); uint4 o;
    o.x = pk2(f[0] * SC2, f[1] * SC2); o.y = pk2(f[2] * SC2, f[3] * SC2); o.z = pk2(f[4] * SC2, f[5] * SC2); o.w = pk2(f[6] * SC2, f[7] * SC2);
    return __builtin_bit_cast(bf16x8, o); }
__device__ __forceinline__ void qnorm_rope(bf16x8 (&qf)[4], const float* gain, const float2* rt  , int hi) {
    float f[4][8]; float ss = 0.f;
#pragma unroll
    for (int sp = 0; sp < 4; ++sp) { unpack8(__builtin_bit_cast(uint4, qf[sp]), f[sp]);
#pragma unroll
        for (int j = 0; j < 8; ++j) ss += f[sp][j] * f[sp][j]; }
    ss += __shfl_xor(ss, 32);
    const float rstd = rsqrtf(ss * (1.f / 64.f) + EPS);
#pragma unroll
    for (int sp = 0; sp < 4; ++sp) { const float4 g0 = *(const float4*)(gain + 16 * sp + 8 * hi), g1 = *(const float4*)(gain + 16 * sp + 8 * hi + 4);
        f[sp][0] *= rstd * g0.x; f[sp][1] *= rstd * g0.y; f[sp][2] *= rstd * g0.z; f[sp][3] *= rstd * g0.w; f[sp][4] *= rstd * g1.x; f[sp][5] *= rstd * g1.y; f[sp][6] *= rstd * g1.z; f[sp][7] *= rstd * g1.w; }
#pragma unroll
    for (int j = 0; j < 8; ++j) { const float other = __shfl_xor(f[0][j], 32); const float2 cs = rt[j];
        f[0][j] = hi ? (f[0][j] * cs.x + other * cs.y) : (f[0][j] * cs.x - other * cs.y); }
#pragma unroll
    for (int sp = 0; sp < 4; ++sp) { uint4 o; o.x = pk2(f[sp][0] * SC2, f[sp][1] * SC2); o.y = pk2(f[sp][2] * SC2, f[sp][3] * SC2); o.z = pk2(f[sp][4] * SC2, f[sp][5] * SC2); o.w = pk2(f[sp][6] * SC2, f[sp][7] * SC2);
        qf[sp] = __builtin_bit_cast(bf16x8, o); }
}
__device__ __forceinline__ uint4 knorm_rope(const uint4 kv, const float* gain, const float2* rt  , int chunk) {
    float f[8]; unpack8(kv, f); float ss = 0.f;
#pragma unroll
    for (int j = 0; j < 8; ++j) ss += f[j] * f[j];
    ss += __shfl_xor(ss, 1); ss += __shfl_xor(ss, 2); ss += __shfl_xor(ss, 4);
    const float rstd = rsqrtf(ss * (1.f / 64.f) + EPS);
    const float4 g0 = *(const float4*)(gain + 8 * chunk), g1 = *(const float4*)(gain + 8 * chunk + 4);
    f[0] *= rstd * g0.x; f[1] *= rstd * g0.y; f[2] *= rstd * g0.z; f[3] *= rstd * g0.w; f[4] *= rstd * g1.x; f[5] *= rstd * g1.y; f[6] *= rstd * g1.z; f[7] *= rstd * g1.w;
#pragma unroll
    for (int j = 0; j < 8; ++j) { const float other = __shfl_xor(f[j], 1);
        if (chunk < 2) { const float2 cs = rt[j]; f[j] = chunk ? (f[j] * cs.x + other * cs.y) : (f[j] * cs.x - other * cs.y); } }
    uint4 o; o.x = pk2(f[0], f[1]); o.y = pk2(f[2], f[3]); o.z = pk2(f[4], f[5]); o.w = pk2(f[6], f[7]); return o;
}
template <int ABL = 0, bool FAST = false, bool ROWM = true>
__device__ __forceinline__ void tile(State& st, const unsigned char* lds, int koff, int voff, const bf16x8 (&qf)[4], float cbias, bool emask, const RangeMask mk, int lane) {
    const int r32 = lane & 31, hi = lane >> 5;
    const float negm = FAST ? (ROWM ? cbias : 0.f) : cbias - st.m;
    f32x16 p0, p1;
#pragma unroll
    for (int r = 0; r < 16; ++r) { p0[r] = negm; p1[r] = negm; }
    const unsigned char* kb = lds + koff + r32 * RPK + hi * 16;
#pragma unroll
    for (int sp = 0; sp < 4; ++sp) {
        const bf16x8 a0 = *(const bf16x8*)(kb + 32 * sp), a1 = *(const bf16x8*)(kb + 32 * RPK + 32 * sp);
        p0 = __builtin_amdgcn_mfma_f32_32x32x16_bf16(a0, qf[sp], p0, 0, 0, 0);
        p1 = __builtin_amdgcn_mfma_f32_32x32x16_bf16(a1, qf[sp], p1, 0, 0, 0);
    }
    __builtin_amdgcn_sched_group_barrier(0x100, 8, 0);
    __builtin_amdgcn_sched_group_barrier(0x008, 8, 0);
    if (emask) {
#pragma unroll
        for (int r = 0; r < 16; ++r) { const int kl = crow(r, hi); if (!mk(kl)) p0[r] = -INFINITY; if (!mk(kl + 32)) p1[r] = -INFINITY; }
    }
    if (ABL == 1) {
#pragma unroll
        for (int r = 0; r < 16; ++r) { p0[r] *= 0.001f; p1[r] *= 0.001f; }
        st.l += p0[0];
    } else if (FAST) {
        float sa = 0.f, sb = 0.f, sc = 0.f, sd = 0.f;
#pragma unroll
        for (int r = 0; r < 16; r += 4) {
            p0[r] = __builtin_amdgcn_exp2f(p0[r]); p1[r] = __builtin_amdgcn_exp2f(p1[r]); p0[r + 1] = __builtin_amdgcn_exp2f(p0[r + 1]); p1[r + 1] = __builtin_amdgcn_exp2f(p1[r + 1]);
            p0[r + 2] = __builtin_amdgcn_exp2f(p0[r + 2]); p1[r + 2] = __builtin_amdgcn_exp2f(p1[r + 2]); p0[r + 3] = __builtin_amdgcn_exp2f(p0[r + 3]); p1[r + 3] = __builtin_amdgcn_exp2f(p1[r + 3]);
            sa += p0[r] + p1[r]; sb += p0[r + 1] + p1[r + 1]; sc += p0[r + 2] + p1[r + 2]; sd += p0[r + 3] + p1[r + 3];
        }
        st.l += (sa + sb) + (sc + sd);
    } else {
        float mxa = fmaxf(p0[0], p1[0]), mxb = fmaxf(p0[1], p1[1]), mxc = fmaxf(p0[2], p1[2]), mxd = fmaxf(p0[3], p1[3]);
#pragma unroll
        for (int r = 4; r < 16; r += 4) { mxa = fmaxf(mxa, fmaxf(p0[r], p1[r])); mxb = fmaxf(mxb, fmaxf(p0[r + 1], p1[r + 1])); mxc = fmaxf(mxc, fmaxf(p0[r + 2], p1[r + 2])); mxd = fmaxf(mxd, fmaxf(p0[r + 3], p1[r + 3])); }
        float mx = fmaxf(fmaxf(mxa, mxb), fmaxf(mxc, mxd));
        mx = fmaxf(mx, __shfl_xor(mx, 32));
        if (!__all(mx <= THR)) {
            const float delta = fmaxf(mx, 0.f), alpha = __builtin_amdgcn_exp2f(-delta);
            st.m += delta; st.l *= alpha;
#pragma unroll
            for (int r = 0; r < 16; ++r) { p0[r] -= delta; p1[r] -= delta; st.o[0][r] *= alpha; st.o[1][r] *= alpha; }
        }
        float sa = 0.f, sb = 0.f, sc = 0.f, sd = 0.f;
#pragma unroll
        for (int r = 0; r < 16; r += 4) {
            p0[r] = __builtin_amdgcn_exp2f(p0[r]); p1[r] = __builtin_amdgcn_exp2f(p1[r]); p0[r + 1] = __builtin_amdgcn_exp2f(p0[r + 1]); p1[r + 1] = __builtin_amdgcn_exp2f(p1[r + 1]);
            p0[r + 2] = __builtin_amdgcn_exp2f(p0[r + 2]); p1[r + 2] = __builtin_amdgcn_exp2f(p1[r + 2]); p0[r + 3] = __builtin_amdgcn_exp2f(p0[r + 3]); p1[r + 3] = __builtin_amdgcn_exp2f(p1[r + 3]);
            sa += p0[r] + p1[r]; sb += p0[r + 1] + p1[r + 1]; sc += p0[r + 2] + p1[r + 2]; sd += p0[r + 3] + p1[r + 3];
        }
        st.l += (sa + sb) + (sc + sd);
    }
    if (ABL == 2) { st.o[0][0] += p0[0] + p0[5] + p1[3] + p1[9]; return; }
    const int vbase = voff + (4 * hi + ((lane & 15) >> 2)) * RPV + ((lane >> 4) & 1) * 32 + (lane & 3) * 8;
#pragma unroll
    for (int sub = 0; sub < 2; ++sub)
#pragma unroll
        for (int ks = 0; ks < 2; ++ks) {
            uint4 pw;
            if (sub == 0) { pw.x = pk2(p0[8 * ks], p0[8 * ks + 1]); pw.y = pk2(p0[8 * ks + 2], p0[8 * ks + 3]); pw.z = pk2(p0[8 * ks + 4], p0[8 * ks + 5]); pw.w = pk2(p0[8 * ks + 6], p0[8 * ks + 7]); }
            else { pw.x = pk2(p1[8 * ks], p1[8 * ks + 1]); pw.y = pk2(p1[8 * ks + 2], p1[8 * ks + 3]); pw.z = pk2(p1[8 * ks + 4], p1[8 * ks + 5]); pw.w = pk2(p1[8 * ks + 6], p1[8 * ks + 7]); }
            const bf16x8 pf = __builtin_bit_cast(bf16x8, pw);
#pragma unroll
            for (int dt = 0; dt < 2; ++dt) {
                const unsigned char* vp = lds + vbase + (32 * sub + 16 * ks) * RPV + dt * 64;
                const s16x4 lo = vtr(vp), hi4 = vtr(vp + 8 * RPV);
                const bf16x8 vf = {lo[0], lo[1], lo[2], lo[3], hi4[0], hi4[1], hi4[2], hi4[3]};
                st.o[dt] = __builtin_amdgcn_mfma_f32_32x32x16_bf16(vf, pf, st.o[dt], 0, 0, 0);
            }
        }
}
__device__ __forceinline__ uint4 ldg_tile(const bf16_t* base, long row, int ld, int tid) { return *(const uint4*)(base + row * ld + (tid & 7) * 8); }
__device__ __forceinline__ void sts_k(unsigned char* lds, int buf, const uint4& v, int tid) { *(uint4*)(lds + O_KT + buf * KTB + (tid >> 3) * RPK + (tid & 7) * 16) = v; }
__device__ __forceinline__ void sts_v(unsigned char* lds, int buf, const uint4& v, int tid) { *(uint4*)(lds + O_VT + buf * VTB + (tid >> 3) * RPV + (tid & 7) * 16) = v; }
template <class Br>
__device__ __forceinline__ void run_tiles(State& st, unsigned char* lds, const bf16x8 (&qf)[4], const Br& br, int tid, int lane) {
    const int n = br.n;
    if (n <= 0) return;
    uint4 kreg, vreg;
    br.load(0, kreg, vreg, tid);
    __syncthreads();
    sts_k(lds, 0, kreg, tid); sts_v(lds, 0, vreg, tid);
    if (n > 1) br.load(1, kreg, vreg, tid);
    __syncthreads();
    for (int idx = 0; idx < n; ++idx) {
        const int cur = idx & 1;
        if (idx + 1 < n) { sts_k(lds, cur ^ 1, kreg, tid); sts_v(lds, cur ^ 1, vreg, tid); if (idx + 2 < n) br.load(idx + 2, kreg, vreg, tid); }
        if (br.active(idx)) tile(st, lds, O_KT + cur * KTB, O_VT + cur * VTB, qf, br.cbias(idx), br.emask(idx), br.mask(idx), lane);
        __syncthreads();
    }
}
struct CmpBranch { const bf16_t* K; const bf16_t* V; int pass, nmaxq, n;
    __device__ __forceinline__ void load(int idx, uint4& k, uint4& v, int tid) const {
        const int key = tid >> 3; k = ldg_tile(K, 64 * idx + key, 64, tid);
        if (pass == 0) v = ldg_tile(V, 64 * idx + key, 64, tid);
        else { const int nn = 64 * idx + key, j0 = (tid & 7) * 8; u32 wv[4];
#pragma unroll
            for (int q = 0; q < 4; ++q) { const int ja = j0 + 2 * q, jb = ja + 1;
                wv[q] = ((nn >= 4 * ja - 1 && nn <= 4 * ja + 3) ? 0x3f80u : 0u) | ((nn >= 4 * jb - 1 && nn <= 4 * jb + 3) ? 0x3f800000u : 0u); }
            v.x = wv[0]; v.y = wv[1]; v.z = wv[2]; v.w = wv[3]; } }
    __device__ __forceinline__ float cbias(int) const { return 0.f; }
    __device__ __forceinline__ bool active(int) const { return true; }
    __device__ __forceinline__ bool emask(int) const { return true; }
    __device__ __forceinline__ RangeMask mask(int idx) const { return RangeMask{0, nmaxq - 64 * idx}; } };
struct SelBranch { const bf16_t* K; const bf16_t* V; const int* JL; unsigned long long mysel; int i, tl, n;
    __device__ __forceinline__ void load(int idx, uint4& k, uint4& v, int tid) const { const long row = 64 * JL[idx] + (tid >> 3); k = ldg_tile(K, row, EVPP, tid); v = ldg_tile(V, row, EVPP, tid); }
    __device__ __forceinline__ float cbias(int idx) const { return ((mysel >> JL[idx]) & 1ull) ? 0.f : -INFINITY; }
    __device__ __forceinline__ bool active(int idx) const { return __any((int)((mysel >> JL[idx]) & 1ull)) != 0; }
    __device__ __forceinline__ bool emask(int idx) const { return JL[idx] == i; }
    __device__ __forceinline__ RangeMask mask(int) const { return RangeMask{0, tl}; } };
template <int NB, int LD> struct WinBranch { const bf16_t* K; const bf16_t* V; int k0, i, tl, n;
    __device__ __forceinline__ void load(int idx, uint4& k, uint4& v, int tid) const { const long row = 64 * (k0 + idx) + (tid >> 3); k = ldg_tile(K, row, LD, tid); v = ldg_tile(V, row, LD, tid); }
    __device__ __forceinline__ float cbias(int) const { return 0.f; }
    __device__ __forceinline__ bool active(int) const { return true; }
    __device__ __forceinline__ bool emask(int idx) const { return (k0 + idx == i) || (k0 + idx == i - NB); }
    __device__ __forceinline__ RangeMask mask(int idx) const { RangeMask mk{0, 63}; if (k0 + idx == i) mk.hi = tl; if (k0 + idx == i - NB) mk.lo = tl + 1; return mk; } };
}

template <int ABL = 0, bool DRY = false, bool FAST = false>
__device__ __forceinline__ void nsa_unit(const Ctx& c, unsigned char* lds, int b, int i, int g) {
    using namespace fa;
    const bf16_t* P = (const bf16_t*)(c.ws + WS_PROJ);
    const bf16_t* KCB = (const bf16_t*)(c.ws + WS_KCB) + (size_t)((b * 2 + g) * 256) * 64; const bf16_t* VCB = (const bf16_t*)(c.ws + WS_VCB) + (size_t)((b * 2 + g) * 256) * 64;
    const int tid = c.tid, lane = c.lane, w = c.wave, r32 = lane & 31, hi = lane >> 5;
    const int tl = 8 * w + (r32 >> 2), hh = r32 & 3, t = 64 * i + tl, head = 4 * g + hh;
    const int key = tid >> 3;
    const size_t m = (size_t)b * SEQ + t;
    const bf16_t* prow = P + m * EVPP;
    const int nt = ((4 * i + 2) >> 6) + 1, nA = 2 * nt;
    uint4 kreg = ldg_tile(KCB, key, 64, tid), vreg = ldg_tile(VCB, key, 64, tid);
    bf16x8 qf[4];
#pragma unroll
    for (int sp = 0; sp < 4; ++sp) qf[sp] = *(const bf16x8*)(prow + 2048 + head * 64 + 16 * sp + 8 * hi);
    qnorm_rope(qf, c.nsa_qg, (const float2*)(c.ws + WS_ROPE) + (size_t)t * 8, hi);
    float* IMP = (float*)(lds + O_IMP); unsigned long long* SELM = (unsigned long long*)(lds + O_SELM); u32* UM = (u32*)(lds + O_UM); int* JL = (int*)(lds + O_JL);
    float* RES = (float*)(lds + O_RES + w * RES_W) + r32 * RES_P;
#define NSA_GATE(k) (1.f / (1.f + __expf(-bf2f(P[((size_t)b * SEQ + t) * EVPP + 3328 + head * 3 + (k)]))))
    const int nmaxq = (t >= 31) ? ((t - 31) >> 4) : -1;
    State st; init(st, 0.f, 0.f);
    float inv = 0.f;
#define NSA_LOAD_A(IDX) do { const int idx_ = (IDX); const int kt_ = idx_ >= nt ? idx_ - nt : idx_; kreg = ldg_tile(KCB, 64 * kt_ + key, 64, tid); \
        if (idx_ < nt) vreg = ldg_tile(VCB, 64 * kt_ + key, 64, tid); \
        else { const int nn = 64 * kt_ + key, j0 = (tid & 7) * 8; u32 wv[4];     \
            _Pragma("unroll") for (int q = 0; q < 4; ++q) { const int ja = j0 + 2 * q, jb = ja + 1; \
                wv[q] = ((nn >= 4 * ja - 1 && nn <= 4 * ja + 3) ? 0x3f80u : 0u) | ((nn >= 4 * jb - 1 && nn <= 4 * jb + 3) ? 0x3f800000u : 0u); } \
            vreg.x = wv[0]; vreg.y = wv[1]; vreg.z = wv[2]; vreg.w = wv[3]; } } while (0)
    __syncthreads();
    sts_k(lds, 0, kreg, tid); sts_v(lds, 0, vreg, tid);
    NSA_LOAD_A(1);
    __syncthreads();
    for (int idx = 0; idx < nA; ++idx) {
        if (idx == nt) {
            const float lt = st.l + __shfl_xor(st.l, 32);
            inv = lt > 0.f ? 1.f / lt : 0.f;
            const float gci = NSA_GATE(0) * inv;
#pragma unroll
            for (int dt = 0; dt < 2; ++dt)
#pragma unroll
                for (int r = 0; r < 16; ++r) RES[32 * dt + crow(r, hi)] = gci * st.o[dt][r];
            const float mfin = st.m; init(st, mfin, 0.f);
        }
        const int kt = idx >= nt ? idx - nt : idx, cur = idx & 1;
        tile<ABL, FAST, false>(st, lds, O_KT + cur * KTB, O_VT + cur * VTB, qf, 0.f, true, RangeMask{0, nmaxq - 64 * kt}, lane);
        if (idx + 1 < nA) { sts_k(lds, cur ^ 1, kreg, tid); sts_v(lds, cur ^ 1, vreg, tid); if (idx + 2 < nA) NSA_LOAD_A(idx + 2); }
        __syncthreads();
    }
#undef NSA_LOAD_A
#pragma unroll
    for (int dt = 0; dt < 2; ++dt)
#pragma unroll
        for (int r = 0; r < 16; ++r) {
            float v = st.o[dt][r] * inv; v += __shfl_xor(v, 1); v += __shfl_xor(v, 2);
            if (hh == 0) IMP[tl * 64 + 32 * dt + crow(r, hi)] = v;
        }
    const bf16_t* PB = P + (size_t)b * SEQ * EVPP + g * 64;
#define KW (PB + 3072)
#define VW (PB + 3200)
#define KS (PB + 2816)
#define VS (PB + 2944)
    const int k0 = (i - 8 > 0) ? i - 8 : 0, nW = i - k0 + 1;
    kreg = ldg_tile(KW, 64 * k0 + key, EVPP, tid); vreg = ldg_tile(VW, 64 * k0 + key, EVPP, tid);
    if (tid < 2) UM[tid] = 0u;
    __syncthreads();
    {
        const int tk = tid >> 3, sub = tid & 7;
        float cand[8];
#pragma unroll
        for (int q = 0; q < 8; ++q) { const int j = 8 * sub + q; const bool allowed = j <= i, forced = (j == 0) || (j == i) || (j == i - 1);
            cand[q] = allowed ? IMP[tk * 64 + j] + (forced ? 1e4f : 0.f) : -INFINITY; }
        unsigned long long msk = 0ull;
#pragma unroll 1
        for (int rnd = 0; rnd < 8; ++rnd) {
            float bv = cand[0]; int bi = 0;
#pragma unroll
            for (int q = 1; q < 8; ++q) if (cand[q] > bv) { bv = cand[q]; bi = q; }
            bi += 8 * sub;
#pragma unroll
            for (int o = 1; o < 8; o <<= 1) { const float ov = __shfl_xor(bv, o); const int oi = __shfl_xor(bi, o); if (ov > bv || (ov == bv && oi < bi)) { bv = ov; bi = oi; } }
            if (bv > -INFINITY) {
                msk |= 1ull << bi;
#pragma unroll
                for (int q = 0; q < 8; ++q) if (8 * sub + q == bi) cand[q] = -INFINITY;
            }
        }
        if (sub == 0) { SELM[tk] = msk; atomicOr(&UM[0], (u32)msk); atomicOr(&UM[1], (u32)(msk >> 32)); }
    }
    __syncthreads();
    int nsel;
    {
        const unsigned long long um = (unsigned long long)UM[0] | ((unsigned long long)UM[1] << 32);
        nsel = __popcll(um);
        if (tid < 64 && ((um >> tid) & 1ull)) JL[__popcll(um & ((1ull << tid) - 1ull))] = tid;
    }
    sts_k(lds, 0, kreg, tid); sts_v(lds, 0, vreg, tid);
    __syncthreads();
    const int nB = nW + nsel;
    const unsigned long long mysel = SELM[tl];
#define NSA_LOAD_B(IDX) do { const int lidx_ = (IDX); if (lidx_ < nW) { const long row_ = 64 * (k0 + lidx_) + key; kreg = ldg_tile(KW, row_, EVPP, tid); vreg = ldg_tile(VW, row_, EVPP, tid); } \
        else { const long row_ = 64 * JL[lidx_ - nW] + key; kreg = ldg_tile(KS, row_, EVPP, tid); vreg = ldg_tile(VS, row_, EVPP, tid); } } while (0)
    NSA_LOAD_B(1);
    init(st, 0.f, 0.f);
#define NSA_STAGE_B(IDX) do { const int idx_ = (IDX); if (idx_ + 1 < nB) { sts_k(lds, (idx_ & 1) ^ 1, kreg, tid); sts_v(lds, (idx_ & 1) ^ 1, vreg, tid); if (idx_ + 2 < nB) NSA_LOAD_B(idx_ + 2); } __syncthreads(); } while (0)
    for (int idx = 0; idx < nW; ++idx) {
        const int cur = idx & 1, kt = k0 + idx; RangeMask mk{0, 63}; if (kt == i) mk.hi = tl; if (kt == i - 8) mk.lo = tl + 1;
        tile<ABL, FAST, false>(st, lds, O_KT + cur * KTB, O_VT + cur * VTB, qf, 0.f, (kt == i) || (kt == i - 8), mk, lane);
        NSA_STAGE_B(idx);
    }
    {
        const float lt = st.l + __shfl_xor(st.l, 32);
        const float sc = NSA_GATE(2) * (lt > 0.f ? 1.f / lt : 0.f);
#pragma unroll
        for (int dt = 0; dt < 2; ++dt)
#pragma unroll
            for (int r = 0; r < 16; ++r) RES[32 * dt + crow(r, hi)] += sc * st.o[dt][r];
        init(st, 0.f, 0.f);
    }
    for (int idx = nW; idx < nB; ++idx) {
        const int cur = idx & 1, j = JL[idx - nW]; const bool mine = ((mysel >> j) & 1ull) != 0ull;
        if (__any((int)mine)) tile<ABL, FAST, true>(st, lds, O_KT + cur * KTB, O_VT + cur * VTB, qf, mine ? 0.f : -INFINITY, j == i, RangeMask{0, tl}, lane);
        NSA_STAGE_B(idx);
    }
#undef NSA_STAGE_B
#undef NSA_LOAD_B
    {
        const float lt = st.l + __shfl_xor(st.l, 32);
        const float sc = NSA_GATE(1) * (lt > 0.f ? 1.f / lt : 0.f);
        unsigned char* stg = lds + O_STG + w * STG_W;
#pragma unroll
        for (int dt = 0; dt < 2; ++dt)
#pragma unroll
            for (int r = 0; r < 16; ++r) *(bf16_t*)(stg + r32 * STG_P + (32 * dt + crow(r, hi)) * 2) = f2bf(RES[32 * dt + crow(r, hi)] + sc * st.o[dt][r]);
        LDS_FENCE();
#pragma unroll
        for (int it = 0; it < 4; ++it) {
            const int row = it * 8 + (lane >> 3), ch = lane & 7;
            const uint4 v = *(const uint4*)(stg + row * STG_P + ch * 16);
            const size_t mm = (size_t)b * SEQ + 64 * i + 8 * w + (row >> 2);
            if (!DRY) *(uint4*)((bf16_t*)(c.ws + WS_H) + mm * D + 512 + (4 * g + (row & 3)) * 64 + ch * 8) = v;
            else if (v.x == 0x12345678u && v.y == 0x9abcdef0u) *(uint4*)((bf16_t*)(c.ws + WS_H) + mm * D + 512 + (4 * g + (row & 3)) * 64 + ch * 8) = v;
        }
        LDS_FENCE();
    }
#undef KW
#undef VW
#undef KS
#undef VS
#undef NSA_GATE
}
__device__ __forceinline__ float score_bound(const float* gq, const float* gk, int nk, int lane) {
    float a = fabsf(gq[lane]), b = 0.f;
    for (int x = 0; x < nk; ++x) b = fmaxf(b, fabsf(gk[64 * x + lane]));
    return fa::SC2 * 64.f * wmax(a) * wmax(b);
}
template <int ABL = 0, bool DRY = false>
__device__ __forceinline__ void nsa_mfma(const Ctx& c, unsigned char* lds) {
    const bool fast = score_bound(c.nsa_qg, c.nsa_kg, 3, c.lane) < 60.f;
    const int G = gridDim.x;
    for (int k = 0; k * G + (int)blockIdx.x < 2048; ++k) {
        const int u = k * G + blockIdx.x;
        int rank = u >> 5; const int bg = u & 31;
        if (G == 256 && (k & 1)) rank = 8 * k + 7 - ((u >> 5) - 8 * k);
        if (fast) nsa_unit<ABL, DRY, true>(c, lds, bg >> 1, 63 - rank, bg & 1); else nsa_unit<ABL, DRY, false>(c, lds, bg >> 1, 63 - rank, bg & 1);
    }
}

__device__ __forceinline__ void swa_load(const Ctx& c, int b, int i, int g, uint4 (&kr)[3], uint4 (&vr)[3], int tid) {
    using namespace fa;
    const bf16_t* P = (const bf16_t*)(c.ws + WS_PROJ);
    const int k0 = (i - 2 > 0) ? i - 2 : 0, n = i - k0 + 1;
    const bf16_t* Kb = P + (size_t)b * SEQ * ODP + 1024 + g * 64; const bf16_t* Vb = P + (size_t)b * SEQ * ODP + 1152 + g * 64;
#pragma unroll
    for (int x = 0; x < 3; ++x) if (x < n) { const long row = 64 * (k0 + x) + (tid >> 3); kr[x] = ldg_tile(Kb, row, ODP, tid); vr[x] = ldg_tile(Vb, row, ODP, tid); }
}
template <bool FAST>
__device__ __forceinline__ void swa_unit(const Ctx& c, unsigned char* lds, int b, int i, int g, uint4 (&kr)[3], uint4 (&vr)[3], bool has_next, int nb, int ni, int ng) {
    using namespace fa;
    constexpr int SW_K = 0, SW_V = 3 * KTB, SW_STG = 3 * KTB + 3 * VTB;
    static_assert(SW_STG + 8 * STG_W <= LDS_BARST, "swa LDS");
    const bf16_t* P = (const bf16_t*)(c.ws + WS_PROJ); bf16_t* ATT = (bf16_t*)(c.ws + WS_H);
    const int tid = c.tid, lane = c.lane, w = c.wave, r32 = lane & 31, hi = lane >> 5;
    const int tl = 8 * w + (r32 >> 2), hh = r32 & 3, t = 64 * i + tl;
    const size_t m = (size_t)b * SEQ + t;
    const int k0 = (i - 2 > 0) ? i - 2 : 0, n = i - k0 + 1;
#pragma unroll
    for (int x = 0; x < 3; ++x) if (x < n) kr[x] = knorm_rope(kr[x], c.swa_kg, (const float2*)(c.ws + WS_ROPE) + (size_t)(64 * (k0 + x) + (tid >> 3)) * 8, tid & 7);
    __syncthreads();
#pragma unroll
    for (int x = 0; x < 3; ++x) if (x < n) { *(uint4*)(lds + SW_K + x * KTB + (tid >> 3) * RPK + (tid & 7) * 16) = kr[x]; *(uint4*)(lds + SW_V + x * VTB + (tid >> 3) * RPV + (tid & 7) * 16) = vr[x]; }
    __syncthreads();
    if (has_next) swa_load(c, nb, ni, ng, kr, vr, tid);
#pragma unroll 1
    for (int hq = 0; hq < 2; ++hq) {
        const int head = 8 * g + 4 * hq + hh;
        bf16x8 qf[4];
#pragma unroll
        for (int sp = 0; sp < 4; ++sp) qf[sp] = *(const bf16x8*)(P + m * ODP + head * 64 + 16 * sp + 8 * hi);
        qnorm_rope(qf, c.swa_qg, (const float2*)(c.ws + WS_ROPE) + (size_t)t * 8, hi);
        State st; const float sink2 = c.swa_sinks[head] * 1.4426950408889634f;
        if (FAST) init(st, 0.f, hi == 0 ? __builtin_amdgcn_exp2f(sink2) : 0.f); else init(st, sink2, hi == 0 ? 1.f : 0.f);
#pragma unroll 1
        for (int x = 0; x < n; ++x) {
            const int kt = k0 + x;
            RangeMask mk{0, 63}; if (kt == i) mk.hi = tl; if (kt == i - 2) mk.lo = tl + 1;
            tile<0, FAST, false>(st, lds, SW_K + x * KTB, SW_V + x * VTB, qf, 0.f, (kt == i) || (kt == i - 2), mk, lane);
        }
        unsigned char* stg = lds + SW_STG + w * STG_W;
        const float lt = st.l + __shfl_xor(st.l, 32);
        const float sc = 1.f / lt;
#pragma unroll
        for (int dt = 0; dt < 2; ++dt)
#pragma unroll
            for (int r = 0; r < 16; ++r) *(bf16_t*)(stg + r32 * STG_P + (32 * dt + crow(r, hi)) * 2) = f2bf(sc * st.o[dt][r]);
        LDS_FENCE();
#pragma unroll
        for (int it = 0; it < 4; ++it) {
            const int row = it * 8 + (lane >> 3), ch = lane & 7;
            const uint4 v = *(const uint4*)(stg + row * STG_P + ch * 16);
            const size_t mm = (size_t)b * SEQ + 64 * i + 8 * w + (row >> 2);
            *(uint4*)(ATT + mm * D + (8 * g + 4 * hq + (row & 3)) * 64 + ch * 8) = v;
        }
        LDS_FENCE();
    }
}
__device__ __forceinline__ void swa_mfma(const Ctx& c, unsigned char* lds) {
    const bool fast = score_bound(c.swa_qg, c.swa_kg, 1, c.lane) < 60.f && wmax(fabsf(c.swa_sinks[c.lane & 15])) < 40.f;
    uint4 kr[3], vr[3];
    if ((int)blockIdx.x < 2048) swa_load(c, blockIdx.x >> 7, (blockIdx.x >> 1) & 63, blockIdx.x & 1, kr, vr, c.tid);
    for (int u = blockIdx.x; u < 2048; u += gridDim.x) {
        const int g = u & 1, i = (u >> 1) & 63, b = u >> 7, un = u + gridDim.x;
        if (fast) swa_unit<true>(c, lds, b, i, g, kr, vr, un < 2048, un >> 7, (un >> 1) & 63, un & 1); else swa_unit<false>(c, lds, b, i, g, kr, vr, un < 2048, un >> 7, (un >> 1) & 63, un & 1);
    }
}

__device__ __forceinline__ void aout_fixup(const Ctx& c) {
    const bf16_t* P = (const bf16_t*)(c.ws + WS_PROJ); bf16_t* MIX = (bf16_t*)(c.ws + WS_H);
    const int lane = c.lane;
    float gn[8];
#pragma unroll
    for (int j = 0; j < 8; ++j) gn[j] = c.hg_gain[8 * (lane & 15) + j];
    for (int m0 = 4 * c.gw; m0 < M; m0 += 4 * c.ngw) {
        uint4 ow[4], gwv[4];
#pragma unroll
        for (int u = 0; u < 4; ++u) { ow[u] = *(const uint4*)(P + (size_t)(m0 + u) * EVPP + 1024 + 8 * lane); gwv[u] = *(const uint4*)(P + (size_t)(m0 + u) * EVPP + 1536 + 8 * lane); }
#pragma unroll
        for (int u = 0; u < 4; ++u) {
            float o[8], g[8]; unpack8(ow[u], o); unpack8(gwv[u], g);
            float sq = 0.f;
#pragma unroll
            for (int j = 0; j < 8; ++j) sq += o[j] * o[j];
            sq += __shfl_xor(sq, 1); sq += __shfl_xor(sq, 2); sq += __shfl_xor(sq, 4); sq += __shfl_xor(sq, 8);
            const float rstd = rsqrtf(sq * (1.f / 128.f) + EPS);
            float r[8];
#pragma unroll
            for (int j = 0; j < 8; ++j) r[j] = o[j] * rstd * gn[j] * (g[j] / (1.f + __expf(-g[j])));
            uint4 w; w.x = pk2(r[0], r[1]); w.y = pk2(r[2], r[3]); w.z = pk2(r[4], r[5]); w.w = pk2(r[6], r[7]);
            *(uint4*)(MIX + (size_t)(m0 + u) * D + 8 * lane) = w;
        }
    }
}

__device__ __forceinline__ void swa_naive(const Ctx& c, float* lds) {
    const bf16_t* P = (const bf16_t*)(c.ws + WS_PROJ); bf16_t* ATT = (bf16_t*)(c.ws + WS_H);
    float* qs = lds + c.wave * ATT_WSTRIDE; float* ps = qs + 256; int* bl = (int*)(ps + 2048);
    const int lane = c.lane;
    for (int task = c.gw; task < M * 4; task += c.ngw) {
        const int hq = task & 1, g = (task >> 1) & 1, m = task >> 2, b = m >> 12, t = m & (SEQ - 1);
        const bf16_t* prow = P + (size_t)m * ODP;
        const int head0 = g * 8 + hq * 4;
#pragma unroll
        for (int hh = 0; hh < 4; ++hh) qs[hh * 64 + lane] = bf2f(prow[(head0 + hh) * 64 + lane]);
        if (lane < 2) bl[lane] = t - 127 + 64 * lane;
        LDS_FENCE();
        const float sink[4] = {c.swa_sinks[head0], c.swa_sinks[head0 + 1], c.swa_sinks[head0 + 2], c.swa_sinks[head0 + 3]};
        float o[4], inv[4];
        attn_rounds<true>(P + (size_t)b * SEQ * ODP + 1024 + g * 64, P + (size_t)b * SEQ * ODP + 1152 + g * 64, ODP, bl, 2, 0, t, qs, ps, sink, o, inv, lane);
#pragma unroll
        for (int hh = 0; hh < 4; ++hh) ATT[(size_t)m * D + (head0 + hh) * 64 + lane] = f2bf(o[hh]);
        LDS_FENCE();
    }
}

__device__ __forceinline__ void phase_router(const Ctx& c, float* lds, int layer) {
    float* wl = lds;
    int* lcnt = (int*)(lds + 36 * 1024);
    int* lbase = lcnt + 32;
    int* tinfo = lbase + 32;
    float* twt = (float*)(tinfo + 1024);
    const float* wg = c.moe_w_grp + (size_t)layer * 1024 * 4; const float* we = c.moe_w_exp + (size_t)layer * 1024 * 32;
    const float* bg = c.moe_b_grp + layer * 4; const float* be = c.moe_b_exp + layer * 32; const float* gain = c.moe_norm + layer * D;
    int* gcnt = (int*)(c.ws + WS_CTL) + layer * 32;
    bf16_t* H = (bf16_t*)(c.ws + WS_H);
    int* TE = (int*)(c.ws + WS_TE); int* TR = (int*)(c.ws + WS_TR); float* TW = (float*)(c.ws + WS_TW);
    for (int i = c.tid; i < 36 * 1024; i += NTHREADS) { const int o = i >> 10, k = i & 1023; wl[i] = o < 4 ? wg[k * 4 + o] : we[k * 32 + (o - 4)]; }
    if (c.tid < 32) lcnt[c.tid] = 0;
    __syncthreads();
    for (int blk = blockIdx.x; blk < M / 256; blk += gridDim.x) {
        const bf16_t* XB = (const bf16_t*)(c.ws + WS_XB);
        uint2 vn[4];
        { const uint2* xr0 = (const uint2*)(XB + (size_t)(blk * 256 + c.wave * 32) * D) + c.lane;
#pragma unroll
          for (int j = 0; j < 4; ++j) vn[j] = xr0[64 * j]; }
        for (int i = 0; i < 32; ++i) {
            const int tl = c.wave * 32 + i, m = blk * 256 + tl;
            float4 v[4]; float s = 0.f;
#pragma unroll
            for (int j = 0; j < 4; ++j) { v[j] = make_float4(__uint_as_float(vn[j].x << 16), __uint_as_float(vn[j].x & 0xffff0000u), __uint_as_float(vn[j].y << 16), __uint_as_float(vn[j].y & 0xffff0000u));
                s += v[j].x * v[j].x + v[j].y * v[j].y + v[j].z * v[j].z + v[j].w * v[j].w; }
            if (i + 1 < 32) {
                const uint2* xr1 = (const uint2*)(XB + (size_t)(m + 1) * D) + c.lane;
#pragma unroll
                for (int j = 0; j < 4; ++j) vn[j] = xr1[64 * j];
            }
            const float rstd = rsqrtf(wsum(s) * (1.f / D) + EPS);
            uint2* ho = (uint2*)(H + (size_t)m * D) + c.lane;
#pragma unroll
            for (int j = 0; j < 4; ++j) {
                const float4 g = ((const float4*)gain)[c.lane + 64 * j];
                v[j].x *= rstd * g.x; v[j].y *= rstd * g.y; v[j].z *= rstd * g.z; v[j].w *= rstd * g.w;
                uint2 w; w.x = pk2(v[j].x, v[j].y); w.y = pk2(v[j].z, v[j].w); ho[64 * j] = w;
            }
            float g4[4]; int gi = 0;
#pragma unroll
            for (int o = 0; o < 4; ++o) {
                float a = 0.f;
#pragma unroll
                for (int j = 0; j < 4; ++j) { const float4 w = ((const float4*)(wl + o * 1024))[c.lane + 64 * j]; a += v[j].x * w.x + v[j].y * w.y + v[j].z * w.z + v[j].w * w.w; }
                g4[o] = wsum(a) + bg[o];
            }
            float gm = g4[0];
#pragma unroll
            for (int q = 1; q < 4; ++q) if (g4[q] > gm) { gm = g4[q]; gi = q; }
            float gs = 0.f;
#pragma unroll
            for (int q = 0; q < 4; ++q) gs += expf(g4[q] - gm);
            const float gwt = 1.f / gs;
            float w8[8];
#pragma unroll
            for (int o = 0; o < 8; ++o) {
                float a = 0.f; const float* wr = wl + (4 + gi * 8 + o) * 1024;
#pragma unroll
                for (int j = 0; j < 4; ++j) { const float4 w = ((const float4*)wr)[c.lane + 64 * j]; a += v[j].x * w.x + v[j].y * w.y + v[j].z * w.z + v[j].w * w.w; }
                w8[o] = wsum(a) + be[gi * 8 + o];
            }
            int j0 = 0; float l0 = w8[0];
#pragma unroll
            for (int j = 1; j < 8; ++j) if (w8[j] > l0) { l0 = w8[j]; j0 = j; }
            int j1 = -1; float l1 = -INFINITY;
#pragma unroll
            for (int j = 0; j < 8; ++j) if (j != j0 && w8[j] > l1) { l1 = w8[j]; j1 = j; }
            const float e1 = expf(l1 - l0); const float w0 = gwt / (1.f + e1), w1 = gwt * e1 / (1.f + e1);
            if (c.lane == 0) {
                const int ea = gi * 8 + j0, eb = gi * 8 + j1;
                const int ra = atomicAdd(&lcnt[ea], 1), rb = atomicAdd(&lcnt[eb], 1);
                tinfo[tl * 4 + 0] = ea; tinfo[tl * 4 + 1] = eb; tinfo[tl * 4 + 2] = ra; tinfo[tl * 4 + 3] = rb; twt[tl * 2] = w0; twt[tl * 2 + 1] = w1;
            }
        }
        __syncthreads();
        if (c.tid < 32) { lbase[c.tid] = atomicAdd(&gcnt[c.tid], lcnt[c.tid]); lcnt[c.tid] = 0; }
        __syncthreads();
        if (c.tid < 256) {
            const int m = blk * 256 + c.tid; const int ea = tinfo[c.tid * 4], eb = tinfo[c.tid * 4 + 1];
            TE[2 * m] = ea; TE[2 * m + 1] = eb; TR[2 * m] = lbase[ea] + tinfo[c.tid * 4 + 2]; TR[2 * m + 1] = lbase[eb] + tinfo[c.tid * 4 + 3];
            TW[2 * m] = twt[c.tid * 2]; TW[2 * m + 1] = twt[c.tid * 2 + 1];
        }
        __syncthreads();
    }
}

__device__ __forceinline__ void phase_router2(const Ctx& c, unsigned char* lds_raw, int layer) {
    typedef short bf16x8 __attribute__((ext_vector_type(8)));
    typedef float f32x4 __attribute__((ext_vector_type(4)));
    const int tid = c.tid, lane = c.lane, w = c.wave, l15 = lane & 15, g4 = lane >> 4;
    float* LG = (float*)(lds_raw + w * 5632);
    float* RS = LG + 32 * 40;
    int* lcnt = (int*)(lds_raw + 8 * 5632);
    int* lbase = lcnt + 32;
    int* tinfo = lbase + 32;
    float* twt = (float*)(tinfo + 1024);
    const bf16_t* XB = (const bf16_t*)(c.ws + WS_XB); const bf16_t* RW = (const bf16_t*)(c.ws + WS_RW) + (size_t)layer * 48 * 2048;
    const float* bg = c.moe_b_grp + layer * 4; const float* be = c.moe_b_exp + layer * 32; const float* gain = c.moe_norm + layer * D;
    int* gcnt = (int*)(c.ws + WS_CTL) + layer * 32;
    bf16_t* H = (bf16_t*)(c.ws + WS_H);
    int* TE = (int*)(c.ws + WS_TE); int* TR = (int*)(c.ws + WS_TR); float* TW = (float*)(c.ws + WS_TW);
    __syncthreads();
    if (tid < 32) lcnt[tid] = 0;
    __syncthreads();
    for (int blk = blockIdx.x; blk < M / 256; blk += gridDim.x) {
        const int tok0 = blk * 256 + w * 32;
        f32x4 acc[2][3];
#pragma unroll
        for (int mt = 0; mt < 2; ++mt)
#pragma unroll
            for (int nt = 0; nt < 3; ++nt) acc[mt][nt] = (f32x4){0.f, 0.f, 0.f, 0.f};
        float sq0 = 0.f, sq1 = 0.f;
        const bf16_t* a0 = XB + (size_t)(tok0 + l15) * D + 8 * g4; const bf16_t* a1 = a0 + (size_t)16 * D;
        const bf16_t* b0 = RW + (size_t)l15 * 2048 + 8 * g4;
#pragma unroll 2
        for (int ks = 0; ks < 32; ++ks) {
            const bf16x8 A0 = *(const bf16x8*)(a0 + 32 * ks), A1 = *(const bf16x8*)(a1 + 32 * ks);
            { float f[8]; unpack8(__builtin_bit_cast(uint4, A0), f);
#pragma unroll
              for (int j = 0; j < 8; ++j) sq0 += f[j] * f[j];
              unpack8(__builtin_bit_cast(uint4, A1), f);
#pragma unroll
              for (int j = 0; j < 8; ++j) sq1 += f[j] * f[j]; }
#pragma unroll
            for (int nt = 0; nt < 3; ++nt) {
                const bf16x8 Bh = *(const bf16x8*)(b0 + (size_t)nt * 16 * 2048 + 32 * ks), Bl = *(const bf16x8*)(b0 + (size_t)nt * 16 * 2048 + 1024 + 32 * ks);
                acc[0][nt] = __builtin_amdgcn_mfma_f32_16x16x32_bf16(A0, Bh, acc[0][nt], 0, 0, 0); acc[0][nt] = __builtin_amdgcn_mfma_f32_16x16x32_bf16(A0, Bl, acc[0][nt], 0, 0, 0);
                acc[1][nt] = __builtin_amdgcn_mfma_f32_16x16x32_bf16(A1, Bh, acc[1][nt], 0, 0, 0); acc[1][nt] = __builtin_amdgcn_mfma_f32_16x16x32_bf16(A1, Bl, acc[1][nt], 0, 0, 0);
            }
        }
        sq0 += __shfl_xor(sq0, 16); sq0 += __shfl_xor(sq0, 32); sq1 += __shfl_xor(sq1, 16); sq1 += __shfl_xor(sq1, 32);
        if (g4 == 0) { RS[l15] = rsqrtf(sq0 * (1.f / D) + EPS); RS[16 + l15] = rsqrtf(sq1 * (1.f / D) + EPS); }
        LDS_FENCE();
#pragma unroll
        for (int nt = 0; nt < 3; ++nt) {
            const int o = 16 * nt + l15;
            if (o < 36) {
                const float bias = o < 4 ? bg[o] : be[o - 4];
#pragma unroll
                for (int mt = 0; mt < 2; ++mt)
#pragma unroll
                    for (int r = 0; r < 4; ++r) { const int tk = 16 * mt + 4 * g4 + r; LG[tk * 40 + o] = acc[mt][nt][r] * RS[tk] + bias; }
            }
        }
        LDS_FENCE();
        if (lane < 32) {
            const float* lg = LG + lane * 40;
            int gi = 0; float gm = lg[0];
#pragma unroll
            for (int q = 1; q < 4; ++q) if (lg[q] > gm) { gm = lg[q]; gi = q; }
            float gs = 0.f;
#pragma unroll
            for (int q = 0; q < 4; ++q) gs += expf(lg[q] - gm);
            const float gwt = 1.f / gs;
            float w8[8];
#pragma unroll
            for (int j = 0; j < 8; ++j) w8[j] = lg[4 + gi * 8 + j];
            int j0 = 0; float l0 = w8[0];
#pragma unroll
            for (int j = 1; j < 8; ++j) if (w8[j] > l0) { l0 = w8[j]; j0 = j; }
            int j1 = -1; float l1 = -INFINITY;
#pragma unroll
            for (int j = 0; j < 8; ++j) if (j != j0 && w8[j] > l1) { l1 = w8[j]; j1 = j; }
            const float e1 = expf(l1 - l0); const float w0 = gwt / (1.f + e1), w1 = gwt * e1 / (1.f + e1);
            const int tl = w * 32 + lane, ea = gi * 8 + j0, eb = gi * 8 + j1;
            const int ra = atomicAdd(&lcnt[ea], 1), rb = atomicAdd(&lcnt[eb], 1);
            tinfo[tl * 4 + 0] = ea; tinfo[tl * 4 + 1] = eb; tinfo[tl * 4 + 2] = ra; tinfo[tl * 4 + 3] = rb; twt[tl * 2] = w0; twt[tl * 2 + 1] = w1;
        }
        __syncthreads();
        if (tid < 32) { lbase[tid] = atomicAdd(&gcnt[tid], lcnt[tid]); lcnt[tid] = 0; }
        __syncthreads();
        if (tid < 256) {
            const int m = blk * 256 + tid; const int ea = tinfo[tid * 4], eb = tinfo[tid * 4 + 1];
            TE[2 * m] = ea; TE[2 * m + 1] = eb; TR[2 * m] = lbase[ea] + tinfo[tid * 4 + 2]; TR[2 * m + 1] = lbase[eb] + tinfo[tid * 4 + 3];
            TW[2 * m] = twt[tid * 2]; TW[2 * m + 1] = twt[tid * 2 + 1];
            int* LIST = (int*)(c.ws + WS_LIST);
            LIST[(size_t)ea * 65536 + lbase[ea] + tinfo[tid * 4 + 2]] = m; LIST[(size_t)eb * 65536 + lbase[eb] + tinfo[tid * 4 + 3]] = m;
            float* RSL = (float*)(c.ws + WS_RSL); const float rsv = ((const float*)(lds_raw + (tid >> 5) * 5632))[32 * 40 + (tid & 31)];
            RSL[(size_t)ea * 65536 + lbase[ea] + tinfo[tid * 4 + 2]] = rsv; RSL[(size_t)eb * 65536 + lbase[eb] + tinfo[tid * 4 + 3]] = rsv;
        }
        __syncthreads();
    }
}

__device__ __forceinline__ void phase_scatter(const Ctx& c, float* lds, int layer) {
    int* ps = (int*)lds;
    const int* gcnt = (const int*)(c.ws + WS_CTL) + layer * 32;
    if (c.tid == 0) { int a = 0; for (int e = 0; e < 32; ++e) { ps[e] = a; a += (gcnt[e] + 255) / 256 * 256; } ps[32] = a; }
    __syncthreads();
    const int* TE = (const int*)(c.ws + WS_TE); const int* TR = (const int*)(c.ws + WS_TR); const float* TW = (const float*)(c.ws + WS_TW);
    int* TSLOT = (int*)(c.ws + WS_TSLOT); int* ROWTOK = (int*)(c.ws + WS_ROWTOK); float* ROWW = (float*)(c.ws + WS_ROWW); int* TILEE = (int*)(c.ws + WS_TILEE);
    const int gt = blockIdx.x * NTHREADS + c.tid, ngt = gridDim.x * NTHREADS;
    for (int a = gt; a < 2 * M; a += ngt) { const int e = TE[a], slot = ps[e] + TR[a]; TSLOT[a] = slot; ROWTOK[slot] = a >> 1; ROWW[slot] = TW[a]; }
    for (int i = gt; i < 32 * 256; i += ngt) { const int e = i >> 8, r = i & 255; const int cnt = gcnt[e], pc = (cnt + 255) / 256 * 256; if (cnt + r < pc) { ROWTOK[ps[e] + cnt + r] = 0; ROWW[ps[e] + cnt + r] = 0.f; } }
    for (int st = gt; st < MAXTILES; st += ngt) { int e = -1; for (int q = 0; q < 32; ++q) if (st * 256 >= ps[q] && st * 256 < ps[q + 1]) e = q; TILEE[st] = e; }
    if (gt == 0) TILEE[600] = ps[32] / 256;
}

__device__ __forceinline__ void phase_moe1_naive(const Ctx& c, float* lds, int layer) {
    const int* TILEE = (const int*)(c.ws + WS_TILEE); const int nt = TILEE[600];
    const bf16_t* H = (const bf16_t*)(c.ws + WS_H); bf16_t* HID = (bf16_t*)(c.ws + WS_HID);
    ARowGather ar{H, D, (const int*)(c.ws + WS_ROWTOK)}; EpiGU epi{HID};
    const int total = nt * 2 * 16;
    for (int u = blockIdx.x; u < total; u += gridDim.x) {
        const int st128 = u / 16, nvt = u % 16, e = TILEE[st128 >> 1];
        BRowGU br{(const bf16_t*)(c.ws + WS_WGU) + (size_t)(layer * 32 + e) * 1024 * 1024, D};
        gemm_naive_tile(lds, st128 * 128, nvt * 64, D, ar, br, epi);
    }
}
__device__ __forceinline__ void phase_moe2_naive(const Ctx& c, float* lds, int layer) {
    const int* TILEE = (const int*)(c.ws + WS_TILEE); const int nt = TILEE[600];
    const bf16_t* HID = (const bf16_t*)(c.ws + WS_HID); bf16_t* YS = (bf16_t*)(c.ws + WS_YS);
    ARowPlain ar{HID, FF}; EpiDown epi{YS, (const float*)(c.ws + WS_ROWW)};
    const int total = nt * 2 * 16;
    for (int u = blockIdx.x; u < total; u += gridDim.x) {
        const int st128 = u / 16, nt64 = u % 16, e = TILEE[st128 >> 1];
        BRowPlain br{(const bf16_t*)(c.ws + WS_WD) + (size_t)(layer * 32 + e) * 1024 * 512, FF};
        gemm_naive_tile(lds, st128 * 128, nt64 * 64, FF, ar, br, epi);
    }
}


__device__ __forceinline__ int build_tile_table(const Ctx& c, unsigned char* lds_raw, int layer) {
    const int* gcnt = (const int*)(c.ws + WS_CTL) + layer * 32;
    int* pst = (int*)(lds_raw + pg8::STAGE_BYTES); int* te = pst + 64; int* tv = te + MAXTILES; int* tg = tv + MAXTILES;
    __syncthreads();
    if (c.tid == 0) { int a = 0; for (int e = 0; e < 32; ++e) { pst[e] = a; a += (gcnt[e] + 255) >> 8; } pst[32] = a; }
    __syncthreads();
    for (int st = c.tid; st < MAXTILES; st += NTHREADS) {
        int e = 31;
        for (int q = 0; q < 32; ++q) if (st >= pst[q] && st < pst[q + 1]) e = q;
        const int ti = st - pst[e], rem = gcnt[e] - 256 * ti;
        te[st] = e; tv[st] = rem < 256 ? (rem > 0 ? rem : 0) : 256; tg[st] = e * 65536 + 256 * ti;
    }
    __syncthreads();
    return pst[32];
}
__device__ __forceinline__ void phase_moe1_mfma(const Ctx& c, unsigned char* lds_raw, int layer) {
    const int nt = build_tile_table(c, lds_raw, layer);
    const int* te = (const int*)(lds_raw + pg8::STAGE_BYTES) + 64;
    pg8::Gemm g{(const bf16_t*)(c.ws + WS_XB), (const bf16_t*)(c.ws + WS_WGU) + (size_t)layer * 32 * 1024 * 1024, D, (const int*)(c.ws + WS_LIST), (size_t)1024 * 1024};
    pg8::MoeOrder S{te, te + MAXTILES, te + 2 * MAXTILES, nt * 4, (int)gridDim.x, (int)blockIdx.x};
    pg8::EpiGUT E{(bf16_t*)(c.ws + WS_HID), (const float*)(c.ws + WS_RSL)};
    pg8::gemm_phase<pg8::EpiGUT, pg8::MoeOrder, true>((PG8_LAS unsigned char*)lds_raw, g, S, E);
}
__device__ __forceinline__ void phase_moe2_mfma(const Ctx& c, unsigned char* lds_raw, int layer) {
    const int nt = build_tile_table(c, lds_raw, layer);
    const int* te = (const int*)(lds_raw + pg8::STAGE_BYTES) + 64;
    pg8::Gemm g{(const bf16_t*)(c.ws + WS_HID), (const bf16_t*)(c.ws + WS_WD) + (size_t)layer * 32 * 1024 * 512, FF, nullptr, (size_t)1024 * 512};
    pg8::MoeOrder S{te, te + MAXTILES, te + 2 * MAXTILES, nt * 4, (int)gridDim.x, (int)blockIdx.x};
    pg8::EpiDownT E{(bf16_t*)(c.ws + WS_YS)};
    pg8::gemm_phase<pg8::EpiDownT, pg8::MoeOrder, false>((PG8_LAS unsigned char*)lds_raw, g, S, E);
}
template <class Epi>
__device__ __forceinline__ void phase_gemm_mfma(unsigned char* lds_raw, const bf16_t* A, const bf16_t* Bt, int Npad, int K, const Epi& E) {
    pg8::Gemm g{A, Bt, K, nullptr, 0}; pg8::StaticOrder S; S.init(M, Npad, (int)gridDim.x, (int)blockIdx.x);
    pg8::gemm_phase<Epi, pg8::StaticOrder, false>((PG8_LAS unsigned char*)lds_raw, g, S, E);
}

typedef const __attribute__((address_space(4))) Args CArgs;
__device__ __forceinline__ void make_ctx(Ctx& c, CArgs& a, int tid_) {
    c.x = a.in[0]; c.ev_norm = a.in[1]; c.ev_w_in = a.in[2]; c.hg_lb = a.in[3]; c.hg_gain = a.in[4]; c.nsa_qg = a.in[5]; c.nsa_kg = a.in[6]; c.cmp_pe = a.in[7];
    c.cmp_w1 = a.in[8]; c.cmp_w2 = a.in[9]; c.ev_w_out = a.in[10]; c.od_norm = a.in[11]; c.od_w_in = a.in[12]; c.swa_qg = a.in[13]; c.swa_kg = a.in[14]; c.swa_sinks = a.in[15];
    c.od_w_out = a.in[16]; c.moe_norm = a.in[17]; c.moe_w_grp = a.in[18]; c.moe_b_grp = a.in[19]; c.moe_w_exp = a.in[20]; c.moe_b_exp = a.in[21];
    c.moe_w_gate = a.in[22]; c.moe_w_up = a.in[23]; c.moe_w_down = a.in[24];
    c.xr = a.out; c.ws = a.ws;
    c.tid = tid_; c.lane = c.tid & 63; c.wave = c.tid >> 6; c.gw = blockIdx.x * NWAVES + c.wave; c.ngw = gridDim.x * NWAVES;
}

#ifndef PSTAMP
#define PSTAMP(k) do {} while (0)
#endif
#define PHASE_BEGIN() Ctx c; { CArgs* ap_ = (CArgs*)__builtin_amdgcn_kernarg_segment_ptr(); asm volatile("" : "+s"(ap_)); int tid_ = threadIdx.x; asm volatile("" : "+v"(tid_)); make_ctx(c, *ap_, tid_); } \
    unsigned char* ws = c.ws; bf16_t* H = (bf16_t*)(ws + WS_H); bf16_t* PROJ = (bf16_t*)(ws + WS_PROJ); (void)H; (void)PROJ;
__global__ void __launch_bounds__(NTHREADS, 2) mega(Args a) {
    extern __shared__ __attribute__((aligned(16))) unsigned char lds_raw[];
    float* lds = (float*)lds_raw;
    if (threadIdx.x < 4) ((volatile XLAS unsigned*)(XLAS unsigned char*)lds_raw)[(LDS_BARST >> 2) + threadIdx.x] = 0u;
    __syncthreads();
    const XcdBarrier xbar = xcd_barrier_post((unsigned*)(a.ws + WS_CTL + CTL_BAR), (volatile XLAS unsigned*)((XLAS unsigned char*)lds_raw + LDS_BARST));
    PSTAMP(0); { PHASE_BEGIN(); phase_prologue(c, lds); PSTAMP(23); phase_norm_x(c, c.x, c.ev_norm, H); }
    xcd_barrier(xbar);
    PSTAMP(1); { PHASE_BEGIN(); pg8::EpiProj0T epi{PROJ, (float*)(ws + WS_LOGF), (const float*)(ws + WS_LB)}; phase_gemm_mfma(lds_raw, H, (const bf16_t*)(ws + WS_W0T), EVPP, D, epi); }
    xcd_barrier(xbar);
    PSTAMP(2); { PHASE_BEGIN();
      post_even(c, blockIdx.x, gridDim.x); PSTAMP(20);
      for (int u = blockIdx.x; u < 256; u += gridDim.x) compress_mfma(c, lds_raw, u);
      PSTAMP(21);
      for (int su = blockIdx.x; su < 256; su += gridDim.x) hgrn2_passA(c, lds_raw, su); }
    xcd_barrier(xbar);
    PSTAMP(24); { PHASE_BEGIN();
      for (int u = blockIdx.x; u < 256; u += gridDim.x) hgrn2_seq(c, lds_raw, u); }
    xcd_barrier(xbar);
    PSTAMP(3); { PHASE_BEGIN(); nsa_mfma(c, lds_raw); PSTAMP(22);
#ifdef PROBE_NSA_ABL
      nsa_mfma<PROBE_NSA_ABL, true>(c, lds_raw);
#endif
      aout_fixup(c); }
    xcd_barrier(xbar);
    PSTAMP(4); { PHASE_BEGIN(); pg8::EpiResidF2B epi{c.x, (bf16_t*)(ws + WS_XB)}; phase_gemm_mfma(lds_raw, H, (const bf16_t*)(ws + WS_WO0T), D, D, epi); }
    xcd_barrier(xbar);
    PSTAMP(5); { PHASE_BEGIN(); phase_router2(c, lds_raw, 0); }
    xcd_barrier(xbar);
    PSTAMP(7); { PHASE_BEGIN(); phase_moe1_mfma(c, lds_raw, 0); }
    xcd_barrier(xbar);
    PSTAMP(8); { PHASE_BEGIN(); phase_moe2_mfma(c, lds_raw, 0); }
    xcd_barrier(xbar);
    PSTAMP(9); { PHASE_BEGIN(); phase_combine<false>(c, (bf16_t*)(ws + WS_XB), nullptr, c.od_norm, H, (const bf16_t*)(ws + WS_YS), 0); }
    xcd_barrier(xbar);
    PSTAMP(10); { PHASE_BEGIN(); pg8::EpiRawScaleT epi{PROJ, ODP, (const float*)(ws + WS_RSTD)}; phase_gemm_mfma(lds_raw, (const bf16_t*)(ws + WS_XB), (const bf16_t*)(ws + WS_W1T), ODP, D, epi); }
    xcd_barrier(xbar);
    PSTAMP(12); { PHASE_BEGIN(); swa_mfma(c, lds_raw); }
    xcd_barrier(xbar);
    PSTAMP(13); { PHASE_BEGIN(); pg8::EpiResidB2B epi{(bf16_t*)(ws + WS_XB)}; phase_gemm_mfma(lds_raw, H, (const bf16_t*)(ws + WS_WO1T), D, D, epi); }
    xcd_barrier(xbar);
    PSTAMP(14); { PHASE_BEGIN(); phase_router2(c, lds_raw, 1); }
    xcd_barrier(xbar);
    PSTAMP(16); { PHASE_BEGIN(); phase_moe1_mfma(c, lds_raw, 1); }
    xcd_barrier(xbar);
    PSTAMP(17); { PHASE_BEGIN(); phase_moe2_mfma(c, lds_raw, 1); }
    xcd_barrier(xbar);
    PSTAMP(18); { PHASE_BEGIN(); phase_combine<true>(c, (bf16_t*)(ws + WS_XB), c.xr, nullptr, nullptr, (const bf16_t*)(ws + WS_YS), 1); }
    PSTAMP(19);
#ifdef PROBE_TAIL
    PROBE_TAIL
#endif
}

extern "C" void kernel_launch(void* const* d_in, const int* in_sizes, int n_in, void* d_out, int out_size, void* d_ws, size_t ws_size, hipStream_t stream) {
    static int grid = 0;
    if (grid == 0) {
        if (n_in != 25 || ws_size < WS_END) { fprintf(stderr, "kernel_launch: unexpected n_in %d / ws %zu\n", n_in, ws_size); grid = -1; return; }
        int dev = 0, cus = 0, per_cu = 0;
        hipGetDevice(&dev);
        hipDeviceGetAttribute(&cus, hipDeviceAttributeMultiprocessorCount, dev);
        hipFuncSetAttribute((const void*)mega, hipFuncAttributeMaxDynamicSharedMemorySize, LDS_BYTES);
        hipOccupancyMaxActiveBlocksPerMultiprocessor(&per_cu, (const void*)mega, NTHREADS, LDS_BYTES);
        if (per_cu < 1) { fprintf(stderr, "kernel_launch: occupancy query says %d blocks/CU\n", per_cu); per_cu = 1; }
        (void)hipGetLastError();
        grid = cus;
    }
    if (grid < 0) return;
    hipMemsetAsync((char*)d_ws + WS_CTL, 0, CTL_BYTES, stream);
    Args a{};
    for (int i = 0; i < 25; ++i) a.in[i] = (const float*)d_in[i];
    a.out = (float*)d_out; a.ws = (unsigned char*)d_ws;
    void* args[] = {&a};
    hipError_t e = hipLaunchCooperativeKernel((const void*)mega, dim3(grid), dim3(NTHREADS), args, LDS_BYTES, stream);
    if (e != hipSuccess) fprintf(stderr, "cooperative launch failed: %s (grid %d)\n", hipGetErrorString(e), grid);
}
```

```cpp
#include <hip/hip_runtime.h>
#include <hip/hip_cooperative_groups.h>
#include <cstdio>
#include <cstdint>
namespace cg = cooperative_groups;

constexpr int D = 1024, BATCH = 16, SEQ = 4096, M = BATCH * SEQ;
constexpr int EVP = 3352, EVPP = 3584, ODP = 1280;
constexpr int NEXP = 32, FF = 512;
constexpr int NTHREADS = 512, NWAVES = 8;
constexpr int MAXTILES = 544;
constexpr int NSLOTS = MAXTILES * 256;
constexpr float EPS = 1e-6f;

typedef unsigned short bf16_t;
typedef unsigned int u32;

constexpr size_t MiB = 1u << 20;
constexpr size_t WS_CTL = 0;
constexpr size_t CTL_BYTES = 64 * 1024;
constexpr size_t WS_LB = 1 * MiB;
constexpr size_t WS_CBIAS = WS_LB + 4096;
constexpr size_t WS_ROPE = WS_LB + 8192;
constexpr size_t WS_KCB = 2 * MiB;
constexpr size_t WS_VCB = 3 * MiB;
constexpr size_t WS_TE = 4 * MiB;
constexpr size_t WS_TR = 4 * MiB + 512 * 1024;
constexpr size_t WS_TW = 5 * MiB;
constexpr size_t WS_TSLOT = 5 * MiB + 512 * 1024;
constexpr size_t WS_ROWTOK = 6 * MiB;
constexpr size_t WS_ROWW = 7 * MiB;
constexpr size_t WS_TILEE = 8 * MiB;
constexpr size_t WS_W0T = 16 * MiB;
constexpr size_t WS_WO0T = 23 * MiB;
constexpr size_t WS_W1T = 25 * MiB;
constexpr size_t WS_WO1T = 28 * MiB;
constexpr size_t WS_CW1T = 30 * MiB;
constexpr size_t WS_CW2T = 32 * MiB;
constexpr size_t WS_RW = 33 * MiB;
constexpr size_t WS_WGU = 40 * MiB;
constexpr size_t WS_WD = 168 * MiB;
constexpr size_t WS_H = 232 * MiB;
constexpr size_t WS_PROJ = 360 * MiB;
constexpr size_t WS_HID = WS_PROJ;
constexpr size_t WS_YS = WS_PROJ + 136 * MiB;
constexpr size_t WS_LOGF = 808 * MiB;
constexpr size_t WS_XB = WS_LOGF;
constexpr size_t WS_LIST = 936 * MiB;
constexpr size_t WS_RSL = 944 * MiB;
constexpr size_t WS_RSTD = 952 * MiB;
constexpr size_t WS_END = 953 * MiB;

constexpr int LDS_BYTES = 160 * 1024;
constexpr int LDS_BARST = LDS_BYTES - 16;
constexpr size_t CTL_BAR = 16 * 1024;
constexpr int CTL_MOEDONE = 2048;
constexpr int CTL_QUEUE = 1024;

__device__ __forceinline__ float bf2f(bf16_t v) { return __uint_as_float(((u32)v) << 16); }
typedef float f32x2_t __attribute__((ext_vector_type(2))); typedef __bf16 bf16x2_t __attribute__((ext_vector_type(2)));
__device__ __forceinline__ u32 pk2(float lo, float hi) { f32x2_t v = {lo, hi}; bf16x2_t b = __builtin_convertvector(v, bf16x2_t); return __builtin_bit_cast(u32, b); }
__device__ __forceinline__ bf16_t f2bf(float f) { return (bf16_t)(pk2(f, 0.f) & 0xffffu); }
__device__ __forceinline__ float wsum(float v) {
#pragma unroll
    for (int o = 32; o; o >>= 1) v += __shfl_xor(v, o);
    return v;
}
__device__ __forceinline__ float wmax(float v) {
#pragma unroll
    for (int o = 32; o; o >>= 1) v = fmaxf(v, __shfl_xor(v, o));
    return v;
}
__device__ __forceinline__ void unpack8(const uint4& w, float* f) {
    f[0] = __uint_as_float(w.x << 16); f[1] = __uint_as_float(w.x & 0xffff0000u);
    f[2] = __uint_as_float(w.y << 16); f[3] = __uint_as_float(w.y & 0xffff0000u);
    f[4] = __uint_as_float(w.z << 16); f[5] = __uint_as_float(w.z & 0xffff0000u);
    f[6] = __uint_as_float(w.w << 16); f[7] = __uint_as_float(w.w & 0xffff0000u);
}
#define LDS_FENCE() asm volatile("s_waitcnt lgkmcnt(0)" ::: "memory")

#define XB_TMO      128
#define XB_XCNT(j)  (256  + 64 * (j))
#define XB_XSUB(j)  (1280 + 64 * (j))
#define XB_XGEN(j)  (2304 + 64 * (j))
#define XB_TOP      3328
#define XB_TOPGEN   3392
#define XCD_BAR_WORDS 3456
#define XB_SPIN_CAP (1u << 18)
#define XLAS __attribute__((address_space(3)))
__device__ __forceinline__ unsigned xb_ld(unsigned* p)              { return __hip_atomic_load(p, __ATOMIC_RELAXED, __HIP_MEMORY_SCOPE_AGENT); }
__device__ __forceinline__ unsigned xb_add(unsigned* p, unsigned v) { return __hip_atomic_fetch_add(p, v, __ATOMIC_RELAXED, __HIP_MEMORY_SCOPE_AGENT); }
__device__ __forceinline__ unsigned xb_xcc_id() { return (unsigned)__builtin_amdgcn_s_getreg((3 << 11) | 20) & 0xFu; }
#define XB_SPIN(cond, bar) do { unsigned _sp = 0; while (cond) { __builtin_amdgcn_s_sleep(1); \
    if ((++_sp & 255u) == 0u) { if (xb_ld(&(bar)[XB_TMO])) break; if (_sp > XB_SPIN_CAP) { atomicAdd(&(bar)[XB_TMO], 1u); break; } } } } while (0)
struct XcdBarrier { unsigned* bar; unsigned x; volatile XLAS unsigned* st; };
__device__ __forceinline__ XcdBarrier xcd_barrier_post(unsigned* bar, volatile XLAS unsigned* st) {
    XcdBarrier b; b.bar = bar; b.x = xb_xcc_id(); b.st = st;
    if (threadIdx.x == 0) (void)xb_add(&bar[XB_XCNT(b.x)], 1u);
    return b;
}
__device__ __forceinline__ void xcd_barrier_complete(unsigned* bar, unsigned x, unsigned& nloc, unsigned& nx) {
    const unsigned G = gridDim.x * gridDim.y * gridDim.z;
    unsigned sum, cnt, mine, sp = 0u;
    for (;;) {
        sum = 0u; cnt = 0u; mine = 0u;
#pragma unroll
        for (unsigned j = 0; j < 16; ++j) { const unsigned c = xb_ld(&bar[XB_XCNT(j)]); sum += c; cnt += (c > 0u) ? 1u : 0u; mine = (j == x) ? c : mine; }
        if (sum == G) break;
        __builtin_amdgcn_s_sleep(1);
        if ((++sp & 255u) == 0u) { if (xb_ld(&bar[XB_TMO])) break; if (sp > XB_SPIN_CAP) { atomicAdd(&bar[XB_TMO], 1u); break; } }
    }
    nloc = mine > 0u ? mine : 1u; nx = cnt > 0u ? cnt : 1u;
}
__device__ __forceinline__ void xcd_barrier(const XcdBarrier& b) {
    asm volatile("s_waitcnt vmcnt(0)" ::: "memory");
    __syncthreads();
    if (threadIdx.x == 0) {
        unsigned* bar = b.bar;
        __builtin_amdgcn_s_waitcnt(0);
        unsigned nloc = b.st[0], nx = b.st[1];
        if (nloc == 0u) { xcd_barrier_complete(bar, b.x, nloc, nx); b.st[0] = nloc; b.st[1] = nx; }
        const unsigned old = xb_add(&bar[XB_XSUB(b.x)], 1u);
        const unsigned gen = old / nloc;
        if (old + 1u == (gen + 1u) * nloc) {
            __builtin_amdgcn_fence(__ATOMIC_RELEASE, "agent");
            asm volatile("s_waitcnt vmcnt(0)" ::: "memory");
            const unsigned og = xb_add(&bar[XB_TOP], 1u);
            const unsigned tg = og / nx;
            if (og + 1u == (tg + 1u) * nx) xb_add(&bar[XB_TOPGEN], 1u);
            else XB_SPIN(xb_ld(&bar[XB_TOPGEN]) == tg, bar);
            __builtin_amdgcn_fence(__ATOMIC_ACQUIRE, "agent");
            xb_add(&bar[XB_XGEN(b.x)], 1u);
            asm volatile("s_waitcnt vmcnt(0)" ::: "memory");
        } else {
            XB_SPIN(xb_ld(&bar[XB_XGEN(b.x)]) == gen, bar);
            __builtin_amdgcn_fence(__ATOMIC_ACQUIRE, "agent");
            asm volatile("s_waitcnt vmcnt(0)" ::: "memory");
        }
    }
    __syncthreads();
}

struct Args {
    const float* in[25];
    float* out;
    unsigned char* ws;
};

struct Ctx {
    const float *x, *ev_norm, *ev_w_in, *hg_lb, *hg_gain, *nsa_qg, *nsa_kg, *cmp_pe, *cmp_w1, *cmp_w2, *ev_w_out;
    const float *od_norm, *od_w_in, *swa_qg, *swa_kg, *swa_sinks, *od_w_out;
    const float *moe_norm, *moe_w_grp, *moe_b_grp, *moe_w_exp, *moe_b_exp, *moe_w_gate, *moe_w_up, *moe_w_down;
    float* xr;
    unsigned char* ws;
    int tid, lane, wave, gw, ngw;
};

typedef const __attribute__((address_space(4))) Args CArgs;
__device__ __forceinline__ void make_ctx(Ctx& c, CArgs& a, int tid_) {
    c.x = a.in[0]; c.ev_norm = a.in[1]; c.ev_w_in = a.in[2]; c.hg_lb = a.in[3]; c.hg_gain = a.in[4]; c.nsa_qg = a.in[5]; c.nsa_kg = a.in[6]; c.cmp_pe = a.in[7];
    c.cmp_w1 = a.in[8]; c.cmp_w2 = a.in[9]; c.ev_w_out = a.in[10]; c.od_norm = a.in[11]; c.od_w_in = a.in[12]; c.swa_qg = a.in[13]; c.swa_kg = a.in[14]; c.swa_sinks = a.in[15];
    c.od_w_out = a.in[16]; c.moe_norm = a.in[17]; c.moe_w_grp = a.in[18]; c.moe_b_grp = a.in[19]; c.moe_w_exp = a.in[20]; c.moe_b_exp = a.in[21];
    c.moe_w_gate = a.in[22]; c.moe_w_up = a.in[23]; c.moe_w_down = a.in[24];
    c.xr = a.out; c.ws = a.ws;
    c.tid = tid_; c.lane = c.tid & 63; c.wave = c.tid >> 6; c.gw = blockIdx.x * NWAVES + c.wave; c.ngw = gridDim.x * NWAVES;
}

__device__ __forceinline__ void transpose_item(const float* W, int K, int Nsrc, bf16_t* WT, int drow0, int k0, int n0, float* scr, int lane, const float* gain = nullptr) {
    const int rk = lane >> 3, c4 = 4 * (lane & 7);
    float4 v[8];
#pragma unroll
    for (int i = 0; i < 8; ++i) v[i] = (n0 + c4 < Nsrc) ? *(const float4*)(W + (size_t)(k0 + 8 * i + rk) * Nsrc + n0 + c4) : make_float4(0.f, 0.f, 0.f, 0.f);
#pragma unroll
    for (int i = 0; i < 8; ++i) { float* d = scr + (8 * i + rk) * 33 + c4; d[0] = v[i].x; d[1] = v[i].y; d[2] = v[i].z; d[3] = v[i].w; }
    LDS_FENCE();
    const int c = lane & 7;
#pragma unroll
    for (int j = 0; j < 4; ++j) {
        const int n = (lane >> 3) + 8 * j;
        const float* s = scr + (8 * c) * 33 + n;
        uint4 o;
        float4 ga = make_float4(1.f, 1.f, 1.f, 1.f), gb = ga;
        if (gain) { ga = *(const float4*)(gain + k0 + 8 * c); gb = *(const float4*)(gain + k0 + 8 * c + 4); }
        o.x = pk2(s[0 * 33] * ga.x, s[1 * 33] * ga.y); o.y = pk2(s[2 * 33] * ga.z, s[3 * 33] * ga.w); o.z = pk2(s[4 * 33] * gb.x, s[5 * 33] * gb.y); o.w = pk2(s[6 * 33] * gb.z, s[7 * 33] * gb.w);
        *(uint4*)(WT + (size_t)(drow0 + n0 + n) * K + k0 + 8 * c) = o;
    }
    LDS_FENCE();
}

struct MoeItem { const float* W; bf16_t* WT; const float* gain; int K, N, drow0, k0, n0; };
constexpr int MOE_ITEMS = 3 * 64 * 512;
__device__ __forceinline__ void moe_item_decode(const Ctx& c, int r, MoeItem& it) {
    constexpr int IG = 64 * 512;
    bf16_t* WGU = (bf16_t*)(c.ws + WS_WGU); bf16_t* WDt = (bf16_t*)(c.ws + WS_WD);
    if (r < 2 * IG) {
        const bool up = r >= IG; if (up) r -= IG;
        const int le = r >> 9, q = r & 511, kb = q >> 4, nb = q & 15, n0 = 32 * nb;
        it.W = (up ? c.moe_w_up : c.moe_w_gate) + (size_t)le * 1024 * 512; it.WT = WGU + (size_t)le * 1024 * 1024; it.K = 1024; it.N = 512; it.gain = c.moe_norm + (le >> 5) * D;
        it.drow0 = (n0 >> 7) * 256 + (up ? 128 : 0) + (n0 & 127) - n0; it.k0 = 32 * kb; it.n0 = n0;
    } else {
        r -= 2 * IG; const int le = r >> 9, q = r & 511;
        it.W = c.moe_w_down + (size_t)le * 512 * 1024; it.WT = WDt + (size_t)le * 1024 * 512; it.K = 512; it.N = 1024; it.drow0 = 0; it.k0 = 32 * (q >> 5); it.n0 = 32 * (q & 31); it.gain = nullptr;
    }
}
struct MoeRegs { float4 a, b, c, d; };
__device__ __forceinline__ void moe_item_issue(const MoeItem& it, MoeRegs& v, int lane) {
    const float* p = it.W + (size_t)(it.k0 + 4 * (lane >> 3)) * it.N + it.n0 + 4 * (lane & 7); const size_t N = it.N;
    v.a = *(const float4*)(p); v.b = *(const float4*)(p + N); v.c = *(const float4*)(p + 2 * N); v.d = *(const float4*)(p + 3 * N);
}
__device__ __forceinline__ void moe_item_finish(const MoeItem& it, const MoeRegs& v, int lane) {
    bf16_t* o = it.WT + (size_t)(it.drow0 + it.n0 + 4 * (lane & 7)) * it.K + it.k0 + 4 * (lane >> 3);
    uint2 w;
    w.x = pk2(v.a.x, v.b.x); w.y = pk2(v.c.x, v.d.x); *(uint2*)(o) = w;
    w.x = pk2(v.a.y, v.b.y); w.y = pk2(v.c.y, v.d.y); *(uint2*)(o + it.K) = w;
    w.x = pk2(v.a.z, v.b.z); w.y = pk2(v.c.z, v.d.z); *(uint2*)(o + 2 * (size_t)it.K) = w;
    w.x = pk2(v.a.w, v.b.w); w.y = pk2(v.c.w, v.d.w); *(uint2*)(o + 3 * (size_t)it.K) = w;
}

__device__ __forceinline__ void phase_prologue(const Ctx& c, float* lds) {
    float* scr = lds + c.wave * (64 * 33);
    unsigned char* ws = c.ws;
    bf16_t* W0T = (bf16_t*)(ws + WS_W0T); bf16_t* WO0T = (bf16_t*)(ws + WS_WO0T); bf16_t* W1T = (bf16_t*)(ws + WS_W1T); bf16_t* WO1T = (bf16_t*)(ws + WS_WO1T);
    bf16_t* CW1T = (bf16_t*)(ws + WS_CW1T); bf16_t* CW2T = (bf16_t*)(ws + WS_CW2T);
    constexpr int I0 = 16 * 112, I1 = 16 * 32, I2 = 16 * 40, I3 = 16 * 32, I4 = 2 * 32 * 8, I5 = 2 * 4 * 2;
    constexpr int NITEMS = I0 + I1 + I2 + I3 + I4 + I5;
    for (int it = c.gw; it < NITEMS; it += c.ngw) {
        int r = it;
        if (r < I0) { transpose_item(c.ev_w_in, 1024, EVP, W0T, 0, 64 * (r / 112), 32 * (r % 112), scr, c.lane); continue; } r -= I0;
        if (r < I1) { transpose_item(c.ev_w_out, 1024, 1024, WO0T, 0, 64 * (r / 32), 32 * (r % 32), scr, c.lane); continue; } r -= I1;
        if (r < I2) { transpose_item(c.od_w_in, 1024, ODP, W1T, 0, 64 * (r / 40), 32 * (r % 40), scr, c.lane, c.od_norm); continue; } r -= I2;
        if (r < I3) { transpose_item(c.od_w_out, 1024, 1024, WO1T, 0, 64 * (r / 32), 32 * (r % 32), scr, c.lane); continue; } r -= I3;
        if (r < I4) { const int kind = r / 256, q = r % 256; transpose_item(c.cmp_w1 + (size_t)kind * 2048 * 256, 2048, 256, CW1T + (size_t)kind * 256 * 2048, 0, 64 * (q / 8), 32 * (q % 8), scr, c.lane); continue; } r -= I4;
        if (r < I5) { const int kind = r / 8, q = r % 8; transpose_item(c.cmp_w2 + (size_t)kind * 256 * 64, 256, 64, CW2T + (size_t)kind * 64 * 256, 0, 64 * (q / 2), 32 * (q % 2), scr, c.lane); continue; }
    }
    const int gt = blockIdx.x * NTHREADS + c.tid, ngt = gridDim.x * NTHREADS;
    float* LB = (float*)(ws + WS_LB);
    for (int i = gt; i < 512; i += ngt) { const float l0 = c.hg_lb[i], l1 = c.hg_lb[512 + i]; LB[i] = 1.f / (1.f + expf(l1 - l0)); }
    float* CB = (float*)(ws + WS_CBIAS);
    for (int i = c.gw; i < 512; i += c.ngw) {
        const int kind = i >> 8, cc = i & 255; float sacc = 0.f;
        for (int k = c.lane; k < 2048; k += 64) sacc += c.cmp_pe[kind * 2048 + k] * c.cmp_w1[((size_t)kind * 2048 + k) * 256 + cc];
        sacc = wsum(sacc);
        if (c.lane == 0) CB[i] = sacc;
    }
    bf16_t* RW = (bf16_t*)(ws + WS_RW);
    for (int i = gt; i < 2 * 48 * 1024; i += ngt) {
        const int k = i & 1023, o = (i >> 10) % 48, layer = i / (48 * 1024);
        float wv = 0.f;
        if (o < 36) wv = c.moe_norm[layer * D + k] * (o < 4 ? c.moe_w_grp[(size_t)layer * 1024 * 4 + k * 4 + o] : c.moe_w_exp[(size_t)layer * 1024 * 32 + k * 32 + (o - 4)]);
        const bf16_t hi = f2bf(wv); const bf16_t lo = f2bf(wv - bf2f(hi));
        RW[((size_t)layer * 48 + o) * 2048 + k] = hi; RW[((size_t)layer * 48 + o) * 2048 + 1024 + k] = lo;
    }
    float2* RT = (float2*)(ws + WS_ROPE);
    for (int i = gt; i < 4096 * 8; i += ngt) {
        const int pos = i >> 3, f = i & 7;
        const double inv = exp(-(double)f * 0.125 * 13.122363377404328);
        const double a = (double)pos * inv;
        const double r = a - 6.283185307179586476925 * rint(a / 6.283185307179586476925);
        const float rf = (float)r;
        RT[i] = make_float2(cosf(rf), sinf(rf));
    }
}

__device__ __forceinline__ void phase_norm_x(const Ctx& c, const float* src, const float* gain, bf16_t* H) {
    for (int m0 = 2 * c.gw; m0 < M; m0 += 2 * c.ngw) {
        float4 v[2][4];
#pragma unroll
        for (int u = 0; u < 2; ++u) { const float4* xr = (const float4*)(src + (size_t)(m0 + u) * D) + c.lane;
#pragma unroll
            for (int j = 0; j < 4; ++j) v[u][j] = xr[64 * j]; }
#pragma unroll
        for (int u = 0; u < 2; ++u) {
            float s = 0.f;
#pragma unroll
            for (int j = 0; j < 4; ++j) s += v[u][j].x * v[u][j].x + v[u][j].y * v[u][j].y + v[u][j].z * v[u][j].z + v[u][j].w * v[u][j].w;
            const float rstd = rsqrtf(wsum(s) * (1.f / D) + EPS);
            uint2* o = (uint2*)(H + (size_t)(m0 + u) * D) + c.lane;
#pragma unroll
            for (int j = 0; j < 4; ++j) {
                const float4 g = ((const float4*)gain)[c.lane + 64 * j];
                uint2 w; w.x = pk2(v[u][j].x * rstd * g.x, v[u][j].y * rstd * g.y); w.y = pk2(v[u][j].z * rstd * g.z, v[u][j].w * rstd * g.w);
                o[64 * j] = w;
            }
        }
    }
}
template <bool FINAL>
__device__ __forceinline__ void phase_combine(const Ctx& c, bf16_t* XB, float* out, const float* gain, bf16_t* H, const bf16_t* YS, int layer) {
    const float* TWp = (const float*)(c.ws + WS_TW); const int* TEp = (const int*)(c.ws + WS_TE); const int* TRp = (const int*)(c.ws + WS_TR);
    int psrow;
    { const int cnt = ((const int*)(c.ws + WS_CTL))[layer * 32 + (c.lane & 31)]; const int pc = (cnt + 255) & ~255; int incl = pc;
#pragma unroll
      for (int o = 1; o < 32; o <<= 1) { const int t_ = __shfl_up(incl, o, 32); if ((c.lane & 31) >= o) incl += t_; }
      psrow = incl - pc; }
    for (int m0 = 2 * c.gw; m0 < M; m0 += 2 * c.ngw) {
        uint2 xw[2][4], ya[2][4], yb[2][4]; float wa[2], wb[2];
#pragma unroll
        for (int u = 0; u < 2; ++u) {
            const int m = m0 + u; const int s0 = __shfl(psrow, TEp[2 * m]) + TRp[2 * m], s1 = __shfl(psrow, TEp[2 * m + 1]) + TRp[2 * m + 1]; wa[u] = TWp[2 * m]; wb[u] = TWp[2 * m + 1];
            const uint2* xr = (const uint2*)(XB + (size_t)m * D) + c.lane; const uint2* y0 = (const uint2*)(YS + (size_t)s0 * D) + c.lane; const uint2* y1 = (const uint2*)(YS + (size_t)s1 * D) + c.lane;
#pragma unroll
            for (int j = 0; j < 4; ++j) { xw[u][j] = xr[64 * j]; ya[u][j] = y0[64 * j]; yb[u][j] = y1[64 * j]; }
        }
#pragma unroll
        for (int u = 0; u < 2; ++u) {
            const int m = m0 + u;
            float4 v[4]; float s = 0.f;
#pragma unroll
            for (int j = 0; j < 4; ++j) {
                v[j].x = __uint_as_float(xw[u][j].x << 16) + wa[u] * __uint_as_float(ya[u][j].x << 16) + wb[u] * __uint_as_float(yb[u][j].x << 16);
                v[j].y = __uint_as_float(xw[u][j].x & 0xffff0000u) + wa[u] * __uint_as_float(ya[u][j].x & 0xffff0000u) + wb[u] * __uint_as_float(yb[u][j].x & 0xffff0000u);
                v[j].z = __uint_as_float(xw[u][j].y << 16) + wa[u] * __uint_as_float(ya[u][j].y << 16) + wb[u] * __uint_as_float(yb[u][j].y << 16);
                v[j].w = __uint_as_float(xw[u][j].y & 0xffff0000u) + wa[u] * __uint_as_float(ya[u][j].y & 0xffff0000u) + wb[u] * __uint_as_float(yb[u][j].y & 0xffff0000u);
                s += v[j].x * v[j].x + v[j].y * v[j].y + v[j].z * v[j].z + v[j].w * v[j].w;
            }
            if (FINAL) {
                float4* xo = (float4*)(out + (size_t)m * D) + c.lane;
#pragma unroll
                for (int j = 0; j < 4; ++j) xo[64 * j] = v[j];
            } else {
                uint2* xo = (uint2*)(XB + (size_t)m * D) + c.lane;
#pragma unroll
                for (int j = 0; j < 4; ++j) { uint2 w; w.x = pk2(v[j].x, v[j].y); w.y = pk2(v[j].z, v[j].w); xo[64 * j] = w; }
                float s2 = 0.f;
#pragma unroll
                for (int j = 0; j < 4; ++j) { const float a0 = bf2f(f2bf(v[j].x)), a1 = bf2f(f2bf(v[j].y)), a2 = bf2f(f2bf(v[j].z)), a3 = bf2f(f2bf(v[j].w)); s2 += a0 * a0 + a1 * a1 + a2 * a2 + a3 * a3; }
                const float rstd = rsqrtf(wsum(s2) * (1.f / D) + EPS);
                if (c.lane == 0) ((float*)(c.ws + WS_RSTD))[m] = rstd;
            }
        }
    }
}

namespace pg8 {
#define PG8_LAS __attribute__((address_space(3)))
typedef short bf16x8 __attribute__((ext_vector_type(8)));
typedef float f32x4 __attribute__((ext_vector_type(4)));
typedef unsigned u32x4 __attribute__((ext_vector_type(4)));
constexpr int BM = 256, BK = 64, HALF = 128, HTB = HALF * BK * 2, STAGE_BYTES = 8 * HTB, NXCD = 8, WGM = 8;
__device__ __forceinline__ int lds_byte(int r, int c) { const int st = (r >> 4) * 2 + (c >> 5), rr = r & 15, cc = c & 31, ob = rr * 64 + cc * 2; return st * 1024 + (ob ^ (((ob >> 9) & 1) << 5)); }
__device__ __forceinline__ void stage_rc(int b, int& R, int& C) { const int st = b / 1024, sb = b % 1024, swz = sb ^ (((sb >> 9) & 1) << 5); R = (st >> 1) * 16 + swz / 64; C = (st & 1) * 32 + (swz % 64) / 2; }
__device__ __forceinline__ int perm32(int rho) { const int n = rho >> 4, i = rho & 15; return 8 * (i >> 2) + 4 * n + (i & 3); }
struct Unit { int pm, pn, e, nvalid, gbase; };
struct Gemm { const bf16_t* A; const bf16_t* Bt; int K; const int* gather; size_t bstride; };
struct StaticOrder {
    int nM, nN, nwg, G, c;
    __device__ __forceinline__ void init(int Mr, int N, int G_, int c_) { nM = Mr / BM; nN = N / BM; nwg = nM * nN; G = G_; c = c_; }
    __device__ __forceinline__ bool next(int i, Unit& u) const {
        const long L = (long)i * G + c; if (L >= nwg) return false;
        int wgid = (int)L; { const int q = nwg / NXCD, r = nwg % NXCD, xcd = wgid % NXCD, off = wgid / NXCD; wgid = (xcd < r ? xcd * (q + 1) : r * (q + 1) + (xcd - r) * q) + off; }
        const int nig = WGM * nN, gid = wgid / nig, fm = gid * WGM, gsz = (nM - fm) < WGM ? (nM - fm) : WGM;
        u.pm = fm + ((wgid % nig) % gsz); u.pn = (wgid % nig) / gsz; u.e = 0; u.nvalid = BM; u.gbase = 0; return true;
    }
    __device__ __forceinline__ void wait(const Unit&) const {}
};
struct MoeOrder {
    const int* te; const int* tv; const int* tg; int nwg, G, c; const int* ready;
    __device__ __forceinline__ void wait(const Unit& u) const {
        if (ready) {
            const __attribute__((address_space(1))) int* w_ = (const __attribute__((address_space(1))) int*)(ready + u.pm);
            while (__builtin_amdgcn_readfirstlane(__hip_atomic_load(w_, __ATOMIC_RELAXED, __HIP_MEMORY_SCOPE_AGENT)) < 32) __builtin_amdgcn_s_sleep(1);
            asm volatile("" ::: "memory");
        }
    }
    __device__ __forceinline__ bool next(int i, Unit& u) const {
        const long L = (long)i * G + c; if (L >= nwg) return false;
        int wgid = (int)L; { const int q = nwg / NXCD, r = nwg % NXCD, xcd = wgid % NXCD, off = wgid / NXCD; wgid = (xcd < r ? xcd * (q + 1) : r * (q + 1) + (xcd - r) * q) + off; }
        u.pm = wgid >> 2; u.pn = wgid & 3; u.e = te[u.pm]; u.nvalid = tv[u.pm]; u.gbase = tg[u.pm]; return true;
    }
};
__device__ __forceinline__ unsigned cvt_pk_bf16(float lo, float hi) { unsigned r; asm volatile("v_cvt_pk_bf16_f32 %0, %1, %2" : "=v"(r) : "v"(lo), "v"(hi)); return r; }

struct EpiRawScaleT { static constexpr bool PERM = true; bf16_t* O; int ldc; const float* RS;
    __device__ __forceinline__ void operator()(const f32x4 (&acc)[2][2][4][2], const Unit& u, int wr, int wc, int fr, int fq) const {
        const int row0 = u.pm * BM + wr * 64 + fr, col0 = u.pn * BM + wc * 32 + 8 * fq;
#pragma unroll
        for (int ai = 0; ai < 2; ++ai)
#pragma unroll
            for (int m = 0; m < 4; ++m) { const int r = row0 + ai * HALF + m * 16; const float sc = RS[r]; bf16_t* rowp = O + (size_t)r * ldc + col0;
#pragma unroll
                for (int bj = 0; bj < 2; ++bj) { const f32x4 v0 = acc[ai][bj][m][0] * sc, v1 = acc[ai][bj][m][1] * sc; u32x4 w;
                    w.x = cvt_pk_bf16(v0[0], v0[1]); w.y = cvt_pk_bf16(v0[2], v0[3]); w.z = cvt_pk_bf16(v1[0], v1[1]); w.w = cvt_pk_bf16(v1[2], v1[3]);
                    *(u32x4*)(rowp + bj * HALF) = w; } }
    } };
struct EpiProj0T { static constexpr bool PERM = true; bf16_t* O; float* LOGF; const float* LB;
    __device__ __forceinline__ void operator()(const f32x4 (&acc)[2][2][4][2], const Unit& u, int wr, int wc, int fr, int fq) const {
        const int row0 = u.pm * BM + wr * 64 + fr, col0 = u.pn * BM + wc * 32 + 8 * fq;
        const bool isf = (u.pn == 2 || u.pn == 3);
#pragma unroll
        for (int ai = 0; ai < 2; ++ai)
#pragma unroll
            for (int m = 0; m < 4; ++m) { const size_t r = (size_t)(row0 + ai * HALF + m * 16); bf16_t* rowp = O + r * EVPP + col0;
#pragma unroll
                for (int bj = 0; bj < 2; ++bj) { f32x4 v0 = acc[ai][bj][m][0], v1 = acc[ai][bj][m][1];
                    if (isf) {
                        const int cc = col0 + bj * HALF - 512; const f32x4 lb0 = *(const f32x4*)(LB + cc), lb1 = *(const f32x4*)(LB + cc + 4);
                        f32x4 lf0, lf1;
#pragma unroll
                        for (int j = 0; j < 4; ++j) {
                            { const float z = v0[j], lb = lb0[j], sg = 1.f / (1.f + __expf(-z)), sn = 1.f / (1.f + __expf(z)); lf0[j] = __logf(lb + (1.f - lb) * sg); v0[j] = (1.f - lb) * sn; }
                            { const float z = v1[j], lb = lb1[j], sg = 1.f / (1.f + __expf(-z)), sn = 1.f / (1.f + __expf(z)); lf1[j] = __logf(lb + (1.f - lb) * sg); v1[j] = (1.f - lb) * sn; }
                        }
                        *(f32x4*)(LOGF + r * 512 + cc) = lf0; *(f32x4*)(LOGF + r * 512 + cc + 4) = lf1;
                    }
                    u32x4 w; w.x = cvt_pk_bf16(v0[0], v0[1]); w.y = cvt_pk_bf16(v0[2], v0[3]); w.z = cvt_pk_bf16(v1[0], v1[1]); w.w = cvt_pk_bf16(v1[2], v1[3]);
                    *(u32x4*)(rowp + bj * HALF) = w; } }
    } };
struct EpiResidF2B { static constexpr bool PERM = true; const float* X; bf16_t* O;
    __device__ __forceinline__ void operator()(const f32x4 (&acc)[2][2][4][2], const Unit& u, int wr, int wc, int fr, int fq) const {
        const int row0 = u.pm * BM + wr * 64 + fr, col0 = u.pn * BM + wc * 32 + 8 * fq;
#pragma unroll
        for (int ai = 0; ai < 2; ++ai)
#pragma unroll
            for (int m = 0; m < 4; ++m) { const size_t off = (size_t)(row0 + ai * HALF + m * 16) * D + col0;
#pragma unroll
                for (int bj = 0; bj < 2; ++bj) { const f32x4 x0 = *(const f32x4*)(X + off + bj * HALF), x1 = *(const f32x4*)(X + off + bj * HALF + 4);
                    const f32x4 v0 = x0 + acc[ai][bj][m][0], v1 = x1 + acc[ai][bj][m][1]; u32x4 w;
                    w.x = cvt_pk_bf16(v0[0], v0[1]); w.y = cvt_pk_bf16(v0[2], v0[3]); w.z = cvt_pk_bf16(v1[0], v1[1]); w.w = cvt_pk_bf16(v1[2], v1[3]);
                    *(u32x4*)(O + off + bj * HALF) = w; } }
    } };
struct EpiResidB2B { static constexpr bool PERM = true; bf16_t* XO;
    __device__ __forceinline__ void operator()(const f32x4 (&acc)[2][2][4][2], const Unit& u, int wr, int wc, int fr, int fq) const {
        const int row0 = u.pm * BM + wr * 64 + fr, col0 = u.pn * BM + wc * 32 + 8 * fq;
#pragma unroll
        for (int ai = 0; ai < 2; ++ai)
#pragma unroll
            for (int m = 0; m < 4; ++m) { const size_t off = (size_t)(row0 + ai * HALF + m * 16) * D + col0;
#pragma unroll
                for (int bj = 0; bj < 2; ++bj) { const u32x4 xw = *(const u32x4*)(XO + off + bj * HALF);
                    const f32x4 a0 = acc[ai][bj][m][0], a1 = acc[ai][bj][m][1]; u32x4 w;
                    w.x = cvt_pk_bf16(__uint_as_float(xw.x << 16) + a0[0], __uint_as_float(xw.x & 0xffff0000u) + a0[1]); w.y = cvt_pk_bf16(__uint_as_float(xw.y << 16) + a0[2], __uint_as_float(xw.y & 0xffff0000u) + a0[3]);
                    w.z = cvt_pk_bf16(__uint_as_float(xw.z << 16) + a1[0], __uint_as_float(xw.z & 0xffff0000u) + a1[1]); w.w = cvt_pk_bf16(__uint_as_float(xw.w << 16) + a1[2], __uint_as_float(xw.w & 0xffff0000u) + a1[3]);
                    *(u32x4*)(XO + off + bj * HALF) = w; } }
    } };
struct EpiGUT { static constexpr bool PERM = true; bf16_t* HID; const float* RSL; int* done;
    __device__ __forceinline__ void operator()(const f32x4 (&acc)[2][2][4][2], const Unit& u, int wr, int wc, int fr, int fq) const {
        const int lr0 = wr * 64 + fr, row0 = u.pm * BM + lr0, col0 = u.pn * HALF + wc * 32 + 8 * fq;
        float rs[2][4];
#pragma unroll
        for (int ai = 0; ai < 2; ++ai)
#pragma unroll
            for (int m = 0; m < 4; ++m) { const int lr = lr0 + ai * HALF + m * 16; rs[ai][m] = RSL[u.gbase + (lr < u.nvalid ? lr : 0)]; }
#pragma unroll
        for (int ai = 0; ai < 2; ++ai)
#pragma unroll
            for (int m = 0; m < 4; ++m) { bf16_t* rowp = HID + (size_t)(row0 + ai * HALF + m * 16) * FF + col0; float h[8]; const float r_ = rs[ai][m];
#pragma unroll
                for (int n = 0; n < 2; ++n)
#pragma unroll
                    for (int j = 0; j < 4; ++j) { const float g = acc[ai][0][m][n][j] * r_, uu = acc[ai][1][m][n][j] * r_; h[4 * n + j] = g / (1.f + __expf(-g)) * uu; }
                u32x4 w; w.x = cvt_pk_bf16(h[0], h[1]); w.y = cvt_pk_bf16(h[2], h[3]); w.z = cvt_pk_bf16(h[4], h[5]); w.w = cvt_pk_bf16(h[6], h[7]);
                asm volatile("global_store_dwordx4 %0, %1, off sc1\n\ts_nop 1" : : "v"(rowp), "v"(w) : "memory"); }
        asm volatile("s_waitcnt vmcnt(0)" ::: "memory");
        if (fr == 0 && fq == 0) __hip_atomic_fetch_add((__attribute__((address_space(1))) int*)(done + u.pm), 1, __ATOMIC_RELAXED, __HIP_MEMORY_SCOPE_AGENT);
    } };
struct EpiDownT { static constexpr bool PERM = true; bf16_t* YS;
    __device__ __forceinline__ void operator()(const f32x4 (&acc)[2][2][4][2], const Unit& u, int wr, int wc, int fr, int fq) const {
        const int row0 = u.pm * BM + wr * 64 + fr, col0 = u.pn * BM + wc * 32 + 8 * fq;
#pragma unroll
        for (int ai = 0; ai < 2; ++ai)
#pragma unroll
            for (int m = 0; m < 4; ++m) { bf16_t* rowp = YS + (size_t)(row0 + ai * HALF + m * 16) * D + col0;
#pragma unroll
                for (int bj = 0; bj < 2; ++bj) { const f32x4 v0 = acc[ai][bj][m][0], v1 = acc[ai][bj][m][1]; u32x4 w;
                    w.x = cvt_pk_bf16(v0[0], v0[1]); w.y = cvt_pk_bf16(v0[2], v0[3]); w.z = cvt_pk_bf16(v1[0], v1[1]); w.w = cvt_pk_bf16(v1[2], v1[3]);
                    *(u32x4*)(rowp + bj * HALF) = w; } }
    } };

template <class Epi, class Sched, bool GATHER, int AUXA = 0>
__device__ __forceinline__ void gemm_phase(PG8_LAS unsigned char* lds, const Gemm g, const Sched& S, const Epi& E) {
    int tid_o = threadIdx.x; asm volatile("" : "+v"(tid_o));
    const int tid = tid_o, wid = __builtin_amdgcn_readfirstlane(tid >> 6), lane = tid & 63, wr = wid >> 2, wc = wid & 3, fr = lane & 15, fq = lane >> 4;
    const int K = g.K, nt = K / BK;
    int stR[2], stC[2]; unsigned voffB[2];
#pragma unroll
    for (int i = 0; i < 2; ++i) { int R, C; stage_rc(tid * 16 + i * 8192, R, C); const int Rb = Epi::PERM ? ((R & ~31) + perm32(R & 31)) : R; stR[i] = R; stC[i] = C; voffB[i] = (unsigned)(Rb * K + C) * 2u; }
    const size_t kstep = (size_t)(BK * 2);
    const size_t hstep = (size_t)HALF * K * 2;
    const size_t tstep = 2 * hstep;
    const unsigned ldsw = (unsigned)wid * 1024u;
    const int aoff = lds_byte(wr * 64 + fr, fq * 8), boff = lds_byte(wc * 32 + fr, fq * 8);
#define PG8_SA(b, h) (((b) * 2 + (h)) * HTB)
#define PG8_SB(b, h) ((4 + (b) * 2 + (h)) * HTB)
#define PG8_STAGE(bufoff, gbase, voff) do { _Pragma("unroll") for (int _i = 0; _i < 2; ++_i) \
        __builtin_amdgcn_global_load_lds((const unsigned*)((const char*)(gbase) + (voff)[_i]), (PG8_LAS unsigned*)(lds + (bufoff) + ldsw + _i * 8192), 16, 0, 0); } while (0)
#define PG8_STAGEA(bufoff, gbase, voff) do { _Pragma("unroll") for (int _i = 0; _i < 2; ++_i) \
        __builtin_amdgcn_global_load_lds((const unsigned*)((const char*)(gbase) + (voff)[_i]), (PG8_LAS unsigned*)(lds + (bufoff) + ldsw + _i * 8192), 16, 0, AUXA); } while (0)
#define PG8_LDA(dst, b, h) do { _Pragma("unroll") for (int m = 0; m < 4; ++m) _Pragma("unroll") for (int k = 0; k < 2; ++k) dst[m][k] = *(const PG8_LAS bf16x8*)(lds + PG8_SA(b, h) + aoff + m * 2048 + k * 1024); } while (0)
#define PG8_LDB(dst, b, h) do { _Pragma("unroll") for (int n = 0; n < 2; ++n) _Pragma("unroll") for (int k = 0; k < 2; ++k) dst[n][k] = *(const PG8_LAS bf16x8*)(lds + PG8_SB(b, h) + boff + n * 2048 + k * 1024); } while (0)
#define PG8_MMA(ai, bj, At, Bt) do { __builtin_amdgcn_s_setprio(1); _Pragma("unroll") for (int m = 0; m < 4; ++m) _Pragma("unroll") for (int n = 0; n < 2; ++n) _Pragma("unroll") for (int k = 0; k < 2; ++k) \
        acc[ai][bj][m][n] = __builtin_amdgcn_mfma_f32_16x16x32_bf16(Bt[n][k], At[m][k], acc[ai][bj][m][n], 0, 0, 0); __builtin_amdgcn_s_setprio(0); } while (0)
#define PG8_WAIT_V(n) asm volatile("s_waitcnt vmcnt(" #n ")" ::: "memory")
#define PG8_WAIT_L(n) asm volatile("s_waitcnt lgkmcnt(" #n ")" ::: "memory")
#define PG8_BAR __builtin_amdgcn_s_barrier()
#define PG8_SCHED __builtin_amdgcn_sched_barrier(0)
#define PG8_OFFS(dst, u) do { _Pragma("unroll") for (int _h = 0; _h < 2; ++_h) _Pragma("unroll") for (int _i = 0; _i < 2; ++_i) { \
        int _row = (u).pm * BM + _h * HALF + stR[_i]; if (GATHER) { const int _lr = _h * HALF + stR[_i]; _row = _lr < (u).nvalid ? g.gather[(u).gbase + _lr] : 0; } dst[_h][_i] = (unsigned)(_row * K + stC[_i]) * 2u; } } while (0)
    Unit cur, nxt; int ui = 0;
    if (!S.next(0, cur)) return;
    f32x4 acc[2][2][4][2];
#pragma unroll
    for (int a = 0; a < 2; ++a)
#pragma unroll
        for (int b = 0; b < 2; ++b)
#pragma unroll
            for (int m = 0; m < 4; ++m)
#pragma unroll
                for (int n = 0; n < 2; ++n) acc[a][b][m][n] = (f32x4){0.f, 0.f, 0.f, 0.f};
    bf16x8 At[4][2], B0[2][2], B1[2][2];
    unsigned offC[2][2], offN[2][2];
    PG8_OFFS(offC, cur);
    S.wait(cur);
    const char* const A0 = (const char*)g.A;
    const char* cB = (const char*)g.Bt + ((size_t)cur.e * g.bstride) * 2 + (size_t)cur.pn * tstep;
    PG8_STAGE(PG8_SB(0, 0), cB, voffB); PG8_STAGE(PG8_SB(0, 1), cB + hstep, voffB); PG8_STAGEA(PG8_SA(0, 0), A0, offC[0]); PG8_STAGEA(PG8_SA(0, 1), A0, offC[1]);
    if (wr == 1) PG8_BAR;
    PG8_WAIT_V(2); PG8_BAR;
    PG8_STAGE(PG8_SB(1, 0), cB + kstep, voffB); PG8_STAGEA(PG8_SA(1, 0), A0 + kstep, offC[0]); PG8_STAGE(PG8_SB(1, 1), cB + hstep + kstep, voffB);
    PG8_WAIT_V(6); PG8_BAR;
    for (;;) {
        const bool has_next = S.next(ui + 1, nxt);
        if (has_next) S.wait(nxt);
        const char* nB = cB;
        if (has_next) { PG8_OFFS(offN, nxt); nB = (const char*)g.Bt + ((size_t)nxt.e * g.bstride) * 2 + (size_t)nxt.pn * tstep; }
        else {
#pragma unroll
            for (int _h = 0; _h < 2; ++_h)
#pragma unroll
                for (int _i = 0; _i < 2; ++_i) offN[_h][_i] = offC[_h][_i];
        }
        for (int t = 0; t < nt; t += 2) {
            const bool last = (t == nt - 2);
            const char* a1 = A0 + (size_t)(t + 1) * kstep;
            const char* a2 = A0 + (last ? (size_t)0 : (size_t)(t + 2) * kstep); const char* b2 = last ? nB : cB + (size_t)(t + 2) * kstep;
            const char* a3 = a2 + kstep; const char* b3 = b2 + kstep;
            unsigned off2[2][2];
            if (last) {
#pragma unroll
                for (int _h = 0; _h < 2; ++_h)
#pragma unroll
                    for (int _i = 0; _i < 2; ++_i) off2[_h][_i] = offN[_h][_i];
            } else {
#pragma unroll
                for (int _h = 0; _h < 2; ++_h)
#pragma unroll
                    for (int _i = 0; _i < 2; ++_i) off2[_h][_i] = offC[_h][_i];
            }
            PG8_LDB(B0, 0, 0); PG8_LDB(B1, 0, 1); PG8_SCHED; PG8_LDA(At, 0, 0); PG8_STAGEA(PG8_SA(1, 1), a1, offC[1]);
            PG8_WAIT_V(8); PG8_WAIT_L(0); PG8_BAR; PG8_MMA(0, 0, At, B0); PG8_MMA(0, 1, At, B1); PG8_BAR; PG8_SCHED;
            PG8_LDA(At, 0, 1); PG8_STAGE(PG8_SB(0, 0), b2, voffB); PG8_STAGE(PG8_SB(0, 1), b2 + hstep, voffB); PG8_STAGEA(PG8_SA(0, 0), a2, off2[0]);
            PG8_WAIT_V(8); PG8_WAIT_L(0); PG8_BAR; PG8_MMA(1, 0, At, B0); PG8_MMA(1, 1, At, B1); PG8_BAR; PG8_SCHED;
            PG8_LDB(B0, 1, 0); PG8_LDB(B1, 1, 1); PG8_SCHED; PG8_LDA(At, 1, 0); PG8_STAGEA(PG8_SA(0, 1), a2, off2[1]);
            PG8_WAIT_V(8); PG8_WAIT_L(0); PG8_BAR; PG8_MMA(0, 0, At, B0); PG8_MMA(0, 1, At, B1); PG8_BAR; PG8_SCHED;
            PG8_LDA(At, 1, 1); PG8_STAGE(PG8_SB(1, 0), b3, voffB); PG8_STAGE(PG8_SB(1, 1), b3 + hstep, voffB); PG8_STAGEA(PG8_SA(1, 0), a3, off2[0]);
            PG8_WAIT_V(8); PG8_WAIT_L(0); PG8_BAR; PG8_MMA(1, 0, At, B0); PG8_MMA(1, 1, At, B1); PG8_BAR; PG8_SCHED;
        }
        if (wr == 0) PG8_BAR;
        E(acc, cur, wr, wc, fr, fq);
        if (!has_next) break;
#pragma unroll
        for (int a = 0; a < 2; ++a)
#pragma unroll
            for (int b = 0; b < 2; ++b)
#pragma unroll
                for (int m = 0; m < 4; ++m)
#pragma unroll
                    for (int n = 0; n < 2; ++n) acc[a][b][m][n] = (f32x4){0.f, 0.f, 0.f, 0.f};
        cur = nxt; cB = nB; ++ui;
#pragma unroll
        for (int _h = 0; _h < 2; ++_h)
#pragma unroll
            for (int _i = 0; _i < 2; ++_i) offC[_h][_i] = offN[_h][_i];
        if (wr == 1) PG8_BAR;
    }
    PG8_WAIT_V(0);
    PG8_BAR;
#undef PG8_SA
#undef PG8_SB
#undef PG8_STAGE
#undef PG8_STAGEA
#undef PG8_LDA
#undef PG8_LDB
#undef PG8_MMA
#undef PG8_WAIT_V
#undef PG8_WAIT_L
#undef PG8_BAR
#undef PG8_SCHED
#undef PG8_OFFS
}
}

__device__ __forceinline__ void normrope64(bf16_t* p, const float* gain, const float2* rt  ) {
    uint4 w[8]; float f[64];
#pragma unroll
    for (int i = 0; i < 8; ++i) { w[i] = ((const uint4*)p)[i]; unpack8(w[i], f + 8 * i); }
    float s = 0.f;
#pragma unroll
    for (int i = 0; i < 64; ++i) s += f[i] * f[i];
    const float rstd = rsqrtf(s * (1.f / 64.f) + EPS);
#pragma unroll
    for (int i = 0; i < 64; ++i) f[i] = f[i] * rstd * gain[i];
#pragma unroll
    for (int i = 0; i < 8; ++i) { const float2 cs = rt[i]; const float x1 = f[i], x2 = f[8 + i]; f[i] = x1 * cs.x - x2 * cs.y; f[8 + i] = x2 * cs.x + x1 * cs.y; }
#pragma unroll
    for (int i = 0; i < 8; ++i) { uint4 o; o.x = pk2(f[8 * i], f[8 * i + 1]); o.y = pk2(f[8 * i + 2], f[8 * i + 3]); o.z = pk2(f[8 * i + 4], f[8 * i + 5]); o.w = pk2(f[8 * i + 6], f[8 * i + 7]); ((uint4*)p)[i] = o; }
}

__device__ __forceinline__ void post_even(const Ctx& c, int vb, int nvb) {
    bf16_t* P = (bf16_t*)(c.ws + WS_PROJ); const float2* RT = (const float2*)(c.ws + WS_ROPE);
    const long total = (long)M * 4;
    for (long it = (long)vb * NTHREADS + c.tid; it < total; it += (long)nvb * NTHREADS) {
        const int m = (int)(it >> 2), s = (int)(it & 3); const int pos = m & (SEQ - 1);
        int col; const float* gain;
        if (s < 2) { col = 2816 + 64 * s; gain = c.nsa_kg + 64; }
        else { col = 3072 + 64 * (s - 2); gain = c.nsa_kg + 128; }
        normrope64(P + (size_t)m * EVPP + col, gain, RT + pos * 8);
    }
}
__device__ __forceinline__ float gelu_tanh(float x) { const float u = 0.7978845608028654f * (x + 0.044715f * x * x * x); return 0.5f * x * (1.f + tanhf(u)); }

__device__ __forceinline__ void compress_mfma(const Ctx& c, unsigned char* lds, int unit) {
    typedef short bf16x8 __attribute__((ext_vector_type(8)));
    typedef float f32x4 __attribute__((ext_vector_type(4)));
    const int kind = unit >> 7, b = (unit >> 3) & 15, g = (unit >> 2) & 1, n0 = (unit & 3) * 64;
    const bf16_t* P = (const bf16_t*)(c.ws + WS_PROJ);
    const bf16_t* W1 = (const bf16_t*)(c.ws + WS_CW1T) + (size_t)kind * 256 * 2048; const bf16_t* W2 = (const bf16_t*)(c.ws + WS_CW2T) + (size_t)kind * 64 * 256;
    const float* CB = (const float*)(c.ws + WS_CBIAS) + kind * 256; const float2* RT = (const float2*)(c.ws + WS_ROPE);
    bf16_t* OUTB = (bf16_t*)(c.ws + (kind == 0 ? WS_KCB : WS_VCB)) + (size_t)((b * 2 + g) * 256) * 64;
    const int tid = c.tid, lane = c.lane, w = c.wave, l15 = lane & 15, g4 = lane >> 4;
    constexpr int HP = 264;
    bf16_t* HS = (bf16_t*)lds; float* OS = (float*)(lds + 64 * HP * 2);
    __syncthreads();
    f32x4 acc[4][2];
#pragma unroll
    for (int mt = 0; mt < 4; ++mt) { acc[mt][0] = (f32x4){0.f, 0.f, 0.f, 0.f}; acc[mt][1] = (f32x4){0.f, 0.f, 0.f, 0.f}; }
    const bf16_t* xb[4];
#pragma unroll
    for (int mt = 0; mt < 4; ++mt) { int n = n0 + 16 * mt + l15; if (n > 254) n = 254; xb[mt] = P + ((size_t)b * SEQ + 16 * n) * EVPP + 2560 + kind * 128 + g * 64 + 8 * (g4 & 1); }
    const bf16_t* wb0 = W1 + (size_t)(32 * w + l15) * 2048 + 8 * g4; const bf16_t* wb1 = wb0 + (size_t)16 * 2048;
#pragma unroll 4
    for (int ks = 0; ks < 64; ++ks) {
        const size_t xo = (size_t)(ks >> 1) * EVPP + 32 * (ks & 1) + 16 * (g4 >> 1);
        const bf16x8 b0 = *(const bf16x8*)(wb0 + 32 * ks), b1 = *(const bf16x8*)(wb1 + 32 * ks);
#pragma unroll
        for (int mt = 0; mt < 4; ++mt) {
            const bf16x8 af = *(const bf16x8*)(xb[mt] + xo);
            acc[mt][0] = __builtin_amdgcn_mfma_f32_16x16x32_bf16(af, b0, acc[mt][0], 0, 0, 0);
            acc[mt][1] = __builtin_amdgcn_mfma_f32_16x16x32_bf16(af, b1, acc[mt][1], 0, 0, 0);
        }
    }
#pragma unroll
    for (int mt = 0; mt < 4; ++mt)
#pragma unroll
        for (int nt = 0; nt < 2; ++nt) { const int cc = 32 * w + 16 * nt + l15; const float bias = CB[cc];
#pragma unroll
            for (int r = 0; r < 4; ++r) HS[(16 * mt + 4 * g4 + r) * HP + cc] = f2bf(gelu_tanh(acc[mt][nt][r] + bias)); }
    __syncthreads();
    {
        const int mt = w >> 1, nt0 = 2 * (w & 1);
        f32x4 o0 = {0.f, 0.f, 0.f, 0.f}, o1 = {0.f, 0.f, 0.f, 0.f};
        const bf16_t* ar = HS + (16 * mt + l15) * HP + 8 * g4;
        const bf16_t* br0 = W2 + (size_t)(16 * nt0 + l15) * 256 + 8 * g4; const bf16_t* br1 = br0 + 16 * 256;
#pragma unroll
        for (int ks = 0; ks < 8; ++ks) {
            const bf16x8 af = *(const bf16x8*)(ar + 32 * ks);
            o0 = __builtin_amdgcn_mfma_f32_16x16x32_bf16(af, *(const bf16x8*)(br0 + 32 * ks), o0, 0, 0, 0);
            o1 = __builtin_amdgcn_mfma_f32_16x16x32_bf16(af, *(const bf16x8*)(br1 + 32 * ks), o1, 0, 0, 0);
        }
#pragma unroll
        for (int r = 0; r < 4; ++r) { OS[(16 * mt + 4 * g4 + r) * 68 + 16 * nt0 + l15] = o0[r]; OS[(16 * mt + 4 * g4 + r) * 68 + 16 * nt0 + 16 + l15] = o1[r]; }
    }
    __syncthreads();
    {
        const int row = tid >> 3, sub = tid & 7, n = n0 + row;
        float v[8];
#pragma unroll
        for (int j = 0; j < 8; ++j) v[j] = OS[row * 68 + 8 * sub + j];
        if (kind == 0) {
            float sq = 0.f;
#pragma unroll
            for (int j = 0; j < 8; ++j) sq += v[j] * v[j];
            sq += __shfl_xor(sq, 1); sq += __shfl_xor(sq, 2); sq += __shfl_xor(sq, 4);
            const float rstd = rsqrtf(sq * (1.f / 64.f) + EPS);
#pragma unroll
            for (int j = 0; j < 8; ++j) v[j] = v[j] * rstd * c.nsa_kg[8 * sub + j];
            const int pos = (16 * n + 31) & (SEQ - 1);
#pragma unroll
            for (int j = 0; j < 8; ++j) {
                const float other = __shfl_xor(v[j], 1);
                const float2 cs = RT[pos * 8 + j];
                if (sub == 0) v[j] = v[j] * cs.x - other * cs.y; else if (sub == 1) v[j] = v[j] * cs.x + other * cs.y;
            }
        }
        uint4 o; o.x = pk2(v[0], v[1]); o.y = pk2(v[2], v[3]); o.z = pk2(v[4], v[5]); o.w = pk2(v[6], v[7]);
        if (n > 254) { o.x = 0u; o.y = 0u; o.z = 0u; o.w = 0u; }
        *(uint4*)(OUTB + (size_t)n * 64 + 8 * sub) = o;
    }
}

namespace hg {
typedef short bf16x8 __attribute__((ext_vector_type(8)));
typedef float f32x4 __attribute__((ext_vector_type(4)));
constexpr int PQ = 136, PS = 72;
constexpr int O_QS = 0, O_QD = O_QS + 64 * PQ * 2, O_KD = O_QD + 64 * PQ * 2, O_KK = O_KD + 64 * PQ * 2, O_QO = O_KK + 48 * PQ * 2, O_KST = O_QO + 96 * PQ * 2,
              O_VT = O_KST + 128 * PS * 2, O_STT = O_VT + 32 * PS * 2, O_TSH = O_STT + 32 * PQ * 2, O_END = O_TSH + 4 * 128 * 4;
static_assert(O_END <= 160 * 1024, "hgrn2 LDS");
__device__ __forceinline__ bf16x8 pack8(float a0, float a1, float a2, float a3, float a4, float a5, float a6, float a7) {
    uint4 w; w.x = pk2(a0, a1); w.y = pk2(a2, a3); w.z = pk2(a4, a5); w.w = pk2(a6, a7); return __builtin_bit_cast(bf16x8, w); }
__device__ __forceinline__ float cexp(float x) { return __expf(fminf(fmaxf(x, -80.f), 80.f)); }
}
namespace hg {
constexpr int A_VT = O_KST + 128 * PS * 2, A_TSH = A_VT + 128 * PS * 2, A_END = A_TSH + 4 * 128 * 4;
static_assert(A_END <= 160 * 1024 - 16, "hgrn2 pass A LDS");
constexpr int S_QS = 0, S_STT = 2 * 64 * PQ * 2, S_OS = S_STT + 2 * 128 * PQ * 2, OSP = 132, S_END = S_OS + 64 * OSP * 4;
static_assert(S_END <= 160 * 1024 - 16, "hgrn2 sequential pass LDS");
constexpr size_t HG_U = 0, HG_QG = (size_t)128 << 20, HG_OI = (size_t)192 << 20;
}
__device__ __forceinline__ void hgrn2_passA(const Ctx& c, unsigned char* lds_raw, int su) {
    using namespace hg;
    const int cq = su & 3, h = (su >> 2) & 3, b = su >> 4;
    const bf16_t* P = (const bf16_t*)(c.ws + WS_PROJ); const float* LOGF = (const float*)(c.ws + WS_LOGF);
    unsigned char* scr = (unsigned char*)c.xr; float* GD = (float*)(c.ws + WS_LIST);
    bf16_t* QS = (bf16_t*)(lds_raw + O_QS); bf16_t* QD = (bf16_t*)(lds_raw + O_QD); bf16_t* KD = (bf16_t*)(lds_raw + O_KD); bf16_t* KK = (bf16_t*)(lds_raw + O_KK);
    bf16_t* QO = (bf16_t*)(lds_raw + O_QO); bf16_t* KST = (bf16_t*)(lds_raw + O_KST); bf16_t* VT = (bf16_t*)(lds_raw + A_VT);
    float* TSH = (float*)(lds_raw + A_TSH);
    const int tid = c.tid, lane = c.lane, w = c.wave;
    const int i = w >> 1, hf = w & 1, d = 2 * lane;
    const int tt = w >> 1, vh = w & 1, g4 = lane >> 4, l15 = lane & 15;
    const size_t rowbase = (size_t)b * SEQ + (size_t)cq * 1024;
    const bf16_t* qp = P + (rowbase + 16 * i + 8 * hf) * EVPP + h * 128 + d;
    const float* lp = LOGF + (rowbase + 16 * i + 8 * hf) * 512 + h * 128 + d;
    const int vrow = tid >> 3, vc = (tid & 7) * 16;
    const bf16_t* vp = P + (rowbase + vrow) * EVPP + 1024 + h * 128 + vc;
    u32 qraw[8], kraw[8]; float2 lfr[8], pre[8]; uint4 vr0, vr1;
#pragma unroll
    for (int r = 0; r < 8; ++r) { qraw[r] = *(const u32*)(qp + (size_t)r * EVPP); kraw[r] = *(const u32*)(qp + (size_t)r * EVPP + 512); lfr[r] = *(const float2*)(lp + (size_t)r * 512);
        pre[r] = *(const float2*)(lp + (size_t)r * 512 - (size_t)(8 * hf) * 512); }
    vr0 = *(const uint4*)vp; vr1 = *(const uint4*)(vp + 8);
    __syncthreads();
    for (int k = 0; k < 16; ++k) {
        const int u = ((b * 4 + h) * 64) + cq * 16 + k;
        float2 lb[8]; float2 run = make_float2(0.f, 0.f);
#pragma unroll
        for (int r = 0; r < 8; ++r) { run.x += pre[r].x; run.y += pre[r].y; }
        run.x *= (float)hf; run.y *= (float)hf;
        const float2 rmid = run;
#pragma unroll
        for (int r = 0; r < 8; ++r) { run.x += lfr[r].x; run.y += lfr[r].y; lb[r] = run; }
        if (hf) *(float2*)(TSH + i * 128 + d) = lb[7];
        if (k < 15) {
            const size_t adv = (size_t)(k + 1) * 64;
#pragma unroll
            for (int r = 0; r < 8; ++r) { lfr[r] = *(const float2*)(lp + (adv + r) * 512); pre[r] = *(const float2*)(lp + (adv + r) * 512 - (size_t)(8 * hf) * 512); }
        }
        __syncthreads();
        {
            const float2 T0 = *(const float2*)(TSH + d), T1 = *(const float2*)(TSH + 128 + d), T2 = *(const float2*)(TSH + 256 + d), T3 = *(const float2*)(TSH + 384 + d);
            const float2 Ti = i == 0 ? T0 : (i == 1 ? T1 : (i == 2 ? T2 : T3));
            const float2 rm = hf ? rmid : lb[7];
            float cQS[2], cQD[2], cKD[2], cKK[2], cKS[2], cQ0[2], cQ1[2], cQ2[2];
#pragma unroll
            for (int x = 0; x < 2; ++x) {
                const float t0x = x ? T0.y : T0.x, t1x = x ? T1.y : T1.x, t2x = x ? T2.y : T2.x, t3x = x ? T3.y : T3.x, tix = x ? Ti.y : Ti.x, rmx = x ? rm.y : rm.x;
                const float Bi = (i > 0 ? t0x : 0.f) + (i > 1 ? t1x : 0.f) + (i > 2 ? t2x : 0.f), B4 = (t0x + t1x) + (t2x + t3x);
                cQS[x] = cexp(Bi); cQD[x] = cexp(-rmx); cKD[x] = cexp(rmx); cKK[x] = cexp(tix); cKS[x] = cKK[x] * cexp(B4 - (Bi + tix));
                cQ0[x] = cexp(Bi - t0x); cQ1[x] = cexp(Bi - (t0x + t1x)); cQ2[x] = cexp(Bi - (t0x + t1x + t2x));
            }
            if (tid < 128) GD[(size_t)u * 128 + tid] = cexp((TSH[tid] + TSH[128 + tid]) + (TSH[256 + tid] + TSH[384 + tid]));
            float ks0[8], ks1[8];
#pragma unroll
            for (int r = 0; r < 8; ++r) {
                const int t = 16 * i + 8 * hf + r;
                const float q0 = __uint_as_float(qraw[r] << 16), q1 = __uint_as_float(qraw[r] & 0xffff0000u), k0 = __uint_as_float(kraw[r] << 16), k1 = __uint_as_float(kraw[r] & 0xffff0000u);
                const float e0 = __expf(fmaxf(lb[r].x, -80.f)), e1 = __expf(fmaxf(lb[r].y, -80.f));
                const float qe0 = q0 * e0, qe1 = q1 * e1, ke0 = k0 * __builtin_amdgcn_rcpf(e0), ke1 = k1 * __builtin_amdgcn_rcpf(e1);
                *(u32*)(QS + t * PQ + d) = pk2(qe0 * cQS[0], qe1 * cQS[1]);
                *(u32*)(QD + t * PQ + d) = pk2(qe0 * cQD[0], qe1 * cQD[1]); *(u32*)(KD + t * PQ + d) = pk2(ke0 * cKD[0], ke1 * cKD[1]);
                if (i < 3) *(u32*)(KK + t * PQ + d) = pk2(ke0 * cKK[0], ke1 * cKK[1]);
                ks0[r] = ke0 * cKS[0]; ks1[r] = ke1 * cKS[1];
                if (i >= 1) *(u32*)(QO + (t - 16) * PQ + d) = pk2(qe0 * cQ0[0], qe1 * cQ0[1]);
                if (i >= 2) *(u32*)(QO + (48 + t - 32) * PQ + d) = pk2(qe0 * cQ1[0], qe1 * cQ1[1]);
                if (i >= 3) *(u32*)(QO + (80 + t - 48) * PQ + d) = pk2(qe0 * cQ2[0], qe1 * cQ2[1]);
            }
            uint4 w0, w1;
            w0.x = pk2(ks0[0], ks0[1]); w0.y = pk2(ks0[2], ks0[3]); w0.z = pk2(ks0[4], ks0[5]); w0.w = pk2(ks0[6], ks0[7]);
            w1.x = pk2(ks1[0], ks1[1]); w1.y = pk2(ks1[2], ks1[3]); w1.z = pk2(ks1[4], ks1[5]); w1.w = pk2(ks1[6], ks1[7]);
            *(uint4*)(KST + d * PS + 16 * i + 8 * hf) = w0; *(uint4*)(KST + (d + 1) * PS + 16 * i + 8 * hf) = w1;
        }
        {
            const u32 vw[8] = {vr0.x, vr0.y, vr0.z, vr0.w, vr1.x, vr1.y, vr1.z, vr1.w};
#pragma unroll
            for (int j = 0; j < 8; ++j) { VT[(vc + 2 * j) * PS + vrow] = (bf16_t)(vw[j] & 0xffffu); VT[(vc + 2 * j + 1) * PS + vrow] = (bf16_t)(vw[j] >> 16); }
        }
        if (k < 15) {
            const size_t adv = (size_t)(k + 1) * 64;
#pragma unroll
            for (int r = 0; r < 8; ++r) { qraw[r] = *(const u32*)(qp + (adv + r) * EVPP); kraw[r] = *(const u32*)(qp + (adv + r) * EVPP + 512); }
            vr0 = *(const uint4*)(vp + adv * EVPP); vr1 = *(const uint4*)(vp + adv * EVPP + 8);
        }
        __syncthreads();
        {
            f32x4 Pj[4];
#pragma unroll
            for (int j = 0; j < 4; ++j) {
                Pj[j] = (f32x4){0.f, 0.f, 0.f, 0.f};
                if (j <= tt) {
                    const bf16_t* Ar; const bf16_t* Br;
                    if (j < tt) { Ar = KK + (16 * j + l15) * PQ; Br = QO + ((j == 0 ? 0 : (j == 1 ? 48 : 80)) + 16 * (tt - j - 1) + l15) * PQ; }
                    else { Ar = KD + (16 * tt + l15) * PQ; Br = QD + (16 * tt + l15) * PQ; }
                    f32x4 acc = {0.f, 0.f, 0.f, 0.f};
#pragma unroll
                    for (int ks = 0; ks < 4; ++ks) acc = __builtin_amdgcn_mfma_f32_16x16x32_bf16(*(const bf16x8*)(Ar + 32 * ks + 8 * g4), *(const bf16x8*)(Br + 32 * ks + 8 * g4), acc, 0, 0, 0);
                    __builtin_amdgcn_sched_group_barrier(0x100, 8, 0); __builtin_amdgcn_sched_group_barrier(0x008, 4, 0);
                    if (j == tt) {
#pragma unroll
                        for (int r = 0; r < 4; ++r) if (4 * g4 + r > l15) acc[r] = 0.f;
                    }
                    Pj[j] = acc;
                }
            }
            const bf16x8 af0 = pack8(Pj[0][0], Pj[0][1], Pj[0][2], Pj[0][3], Pj[1][0], Pj[1][1], Pj[1][2], Pj[1][3]);
            const bf16x8 af1 = pack8(Pj[2][0], Pj[2][1], Pj[2][2], Pj[2][3], Pj[3][0], Pj[3][1], Pj[3][2], Pj[3][3]);
            uint2* OI = (uint2*)(scr + HG_OI) + ((size_t)u * 32 + tt * 8) * 64 + lane;
#pragma unroll
            for (int q = 0; q < 4; ++q) {
                const int vt = 4 * vh + q;
                const bf16_t* vrw = VT + (16 * vt + l15) * PS;
                f32x4 o = {0.f, 0.f, 0.f, 0.f};
                { const uint2 lo = *(const uint2*)(vrw + 4 * g4), hi = *(const uint2*)(vrw + 16 + 4 * g4); uint4 bw; bw.x = lo.x; bw.y = lo.y; bw.z = hi.x; bw.w = hi.y;
                  o = __builtin_amdgcn_mfma_f32_16x16x32_bf16(af0, __builtin_bit_cast(bf16x8, bw), o, 0, 0, 0); }
                if (tt >= 2) { const uint2 lo = *(const uint2*)(vrw + 32 + 4 * g4), hi = *(const uint2*)(vrw + 48 + 4 * g4); uint4 bw; bw.x = lo.x; bw.y = lo.y; bw.z = hi.x; bw.w = hi.y;
                  o = __builtin_amdgcn_mfma_f32_16x16x32_bf16(af1, __builtin_bit_cast(bf16x8, bw), o, 0, 0, 0); }
                uint2 ow; ow.x = pk2(o[0], o[1]); ow.y = pk2(o[2], o[3]);
                OI[(size_t)vt * 64] = ow;
            }
            {
                uint2* U = (uint2*)(scr + HG_U) + ((size_t)u * 64 + w * 8) * 64 + lane;
                const bf16_t* vrw = VT + (16 * w + l15) * PS;
                const bf16x8 av0 = *(const bf16x8*)(vrw + 8 * g4), av1 = *(const bf16x8*)(vrw + 32 + 8 * g4);
#pragma unroll
                for (int dt = 0; dt < 8; ++dt) {
                    const bf16_t* kr = KST + (16 * dt + l15) * PS + 8 * g4;
                    f32x4 a = {0.f, 0.f, 0.f, 0.f};
                    a = __builtin_amdgcn_mfma_f32_16x16x32_bf16(av0, *(const bf16x8*)(kr), a, 0, 0, 0);
                    a = __builtin_amdgcn_mfma_f32_16x16x32_bf16(av1, *(const bf16x8*)(kr + 32), a, 0, 0, 0);
                    uint2 uw; uw.x = pk2(a[0], a[1]); uw.y = pk2(a[2], a[3]);
                    U[(size_t)dt * 64] = uw;
                }
            }
            {
                const int row = tid >> 3, ch16 = (tid & 7) * 16;
                const uint4 a0 = *(const uint4*)(QS + row * PQ + ch16), a1 = *(const uint4*)(QS + row * PQ + ch16 + 8);
                uint4* QG = (uint4*)(scr + HG_QG + ((size_t)u * 64 + row) * 256 + ch16 * 2);
                QG[0] = a0; QG[1] = a1;
            }
        }
        __syncthreads();
    }
}

static_assert(MOE_ITEMS == 2048 * 8 * 4 + 64 * 64 * 8, "four MoE conversion items per (NSA unit, wave) + one per (scan chunk, unit, wave)");
#define MB_DECL(SET) float4 SET##a, SET##b, SET##c, SET##d, SET##g; bf16_t* SET##o; size_t SET##k;
#define MB_ISSUE(SET, CM, MS) { MoeItem mi_; moe_item_decode(CM, (MS), mi_); \
          const float* p_ = mi_.W + (size_t)(mi_.k0 + 4 * (lane >> 3)) * mi_.N + mi_.n0 + 4 * (lane & 7); const size_t N_ = mi_.N; \
          SET##a = *(const float4*)(p_); SET##b = *(const float4*)(p_ + N_); SET##c = *(const float4*)(p_ + 2 * N_); SET##d = *(const float4*)(p_ + 3 * N_); \
          SET##g = mi_.gain ? *(const float4*)(mi_.gain + mi_.k0 + 4 * (lane >> 3)) : make_float4(1.f, 1.f, 1.f, 1.f); \
          SET##o = mi_.WT + (size_t)(mi_.drow0 + mi_.n0 + 4 * (lane & 7)) * mi_.K + mi_.k0 + 4 * (lane >> 3); SET##k = mi_.K; }
#define MB_FINISH(SET) { uint2 w_; \
          w_.x = pk2(SET##a.x * SET##g.x, SET##b.x * SET##g.y); w_.y = pk2(SET##c.x * SET##g.z, SET##d.x * SET##g.w); *(uint2*)(SET##o) = w_; \
          w_.x = pk2(SET##a.y * SET##g.x, SET##b.y * SET##g.y); w_.y = pk2(SET##c.y * SET##g.z, SET##d.y * SET##g.w); *(uint2*)(SET##o + SET##k) = w_; \
          w_.x = pk2(SET##a.z * SET##g.x, SET##b.z * SET##g.y); w_.y = pk2(SET##c.z * SET##g.z, SET##d.z * SET##g.w); *(uint2*)(SET##o + 2 * SET##k) = w_; \
          w_.x = pk2(SET##a.w * SET##g.x, SET##b.w * SET##g.y); w_.y = pk2(SET##c.w * SET##g.z, SET##d.w * SET##g.w); *(uint2*)(SET##o + 3 * SET##k) = w_; }
#define MB_CTX() Ctx cm_; { CArgs* ap_ = (CArgs*)__builtin_amdgcn_kernarg_segment_ptr(); asm volatile("" : "+s"(ap_)); int tid_ = threadIdx.x; asm volatile("" : "+v"(tid_)); make_ctx(cm_, *ap_, tid_); } \
          const int ms_ = (((63 - i) * 32 + b * 2 + g) * 8 + w) * 4
#define MB_ISSUE_A() if (!DRY) { MB_CTX();  }
#define MB_FINISH_A() if (!DRY) {  }
#define MB_ISSUE_B() if (!DRY) { MB_CTX() + 0; MB_ISSUE(m0, cm_, ms_ + 0) MB_ISSUE(m1, cm_, ms_ + 1) MB_ISSUE(m2, cm_, ms_ + 2) MB_ISSUE(m3, cm_, ms_ + 3) }
#define MB_FINISH_B() if (!DRY) { MB_FINISH(m0) MB_FINISH(m1) MB_FINISH(m2) MB_FINISH(m3) }
__device__ __forceinline__ void hgrn2_seq_full(const Ctx& c, unsigned char* lds_raw, int unit) {
    using namespace hg;
    const int h = unit & 3, b = unit >> 2;
    const bf16_t* P = (const bf16_t*)(c.ws + WS_PROJ); bf16_t* MIX = (bf16_t*)(c.ws + WS_H);
    const unsigned char* scr = (const unsigned char*)c.xr; const float* GD = (const float*)(c.ws + WS_LIST);
    const int tid = c.tid, lane = c.lane, w = c.wave;
    const int tt = w >> 1, vh = w & 1, g4 = lane >> 4, l15 = lane & 15;
    const size_t rowbase = (size_t)b * SEQ;
    const int u0 = unit * 64;
    f32x4 st[8];
#pragma unroll
    for (int dt = 0; dt < 8; ++dt) st[dt] = (f32x4){0.f, 0.f, 0.f, 0.f};
    const int qrow = tid >> 3, qc16 = (tid & 7) * 16;
    float* OS = (float*)(lds_raw + S_OS);
    uint4 q0, q1, gt0, gt1; uint2 uu[8], oi[4]; float gg[8]; MB_DECL(mx)
#define HGF_LDQ(CH) do { const uint4* qg_ = (const uint4*)(scr + HG_QG + (((size_t)(u0 + (CH))) * 64 + qrow) * 256 + qc16 * 2); q0 = qg_[0]; q1 = qg_[1]; } while (0)
#define HGF_LDOI(CH) do { const uint2* op_ = (const uint2*)(scr + HG_OI) + (((size_t)(u0 + (CH))) * 32 + tt * 8 + 4 * vh) * 64 + lane; \
        _Pragma("unroll") for (int q = 0; q < 4; ++q) oi[q] = op_[(size_t)q * 64]; } while (0)
#define HGF_LDU(CH) do { const uint2* up_ = (const uint2*)(scr + HG_U) + (((size_t)(u0 + (CH))) * 64 + w * 8) * 64 + lane; const float* gp_ = GD + ((size_t)(u0 + (CH))) * 128 + l15; \
        _Pragma("unroll") for (int dt = 0; dt < 8; ++dt) { uu[dt] = up_[(size_t)dt * 64]; gg[dt] = gp_[16 * dt]; } } while (0)
#define HGF_LDG(CH) do { const uint4* gp_ = (const uint4*)(P + (rowbase + (size_t)(CH) * 64 + qrow) * EVPP + 1536 + h * 128 + qc16); gt0 = gp_[0]; gt1 = gp_[1]; } while (0)
    HGF_LDQ(0); HGF_LDOI(0); HGF_LDU(0); HGF_LDG(0);
    __syncthreads();
    for (int ch = 0; ch < 64; ++ch) {
        bf16_t* QSL = (bf16_t*)(lds_raw + S_QS) + (ch & 1) * 64 * PQ; bf16_t* STT = (bf16_t*)(lds_raw + S_STT) + (ch & 1) * 128 * PQ;
        MB_ISSUE(mx, c, 2048 * 8 * 4 + (ch * 64 + unit) * 8 + w)
        *(uint4*)(QSL + qrow * PQ + qc16) = q0; *(uint4*)(QSL + qrow * PQ + qc16 + 8) = q1;
#pragma unroll
        for (int dt = 0; dt < 8; ++dt)
#pragma unroll
            for (int r = 0; r < 4; ++r) STT[(16 * w + 4 * g4 + r) * PQ + 16 * dt + l15] = f2bf(st[dt][r]);
        if (ch + 1 < 64) HGF_LDQ(ch + 1);
        __syncthreads();
#pragma unroll
        for (int q = 0; q < 4; ++q) {
            const int vt = 4 * vh + q;
            f32x4 o = {__uint_as_float(oi[q].x << 16), __uint_as_float(oi[q].x & 0xffff0000u), __uint_as_float(oi[q].y << 16), __uint_as_float(oi[q].y & 0xffff0000u)};
            const bf16_t* Ar = QSL + (16 * tt + l15) * PQ; const bf16_t* Br = STT + (16 * vt + l15) * PQ;
#pragma unroll
            for (int ks = 0; ks < 4; ++ks) o = __builtin_amdgcn_mfma_f32_16x16x32_bf16(*(const bf16x8*)(Ar + 32 * ks + 8 * g4), *(const bf16x8*)(Br + 32 * ks + 8 * g4), o, 0, 0, 0);
#pragma unroll
            for (int r = 0; r < 4; ++r) OS[(16 * tt + 4 * g4 + r) * OSP + 16 * vt + l15] = o[r];
        }
        if (ch + 1 < 64) HGF_LDOI(ch + 1);
#pragma unroll
        for (int dt = 0; dt < 8; ++dt) {
            st[dt][0] = st[dt][0] * gg[dt] + __uint_as_float(uu[dt].x << 16); st[dt][1] = st[dt][1] * gg[dt] + __uint_as_float(uu[dt].x & 0xffff0000u);
            st[dt][2] = st[dt][2] * gg[dt] + __uint_as_float(uu[dt].y << 16); st[dt][3] = st[dt][3] * gg[dt] + __uint_as_float(uu[dt].y & 0xffff0000u);
        }
        if (ch + 1 < 64) HGF_LDU(ch + 1);
        __syncthreads();
        MB_FINISH(mx)
        {
            const float* orow = OS + qrow * OSP + qc16;
            const float4 o0 = *(const float4*)(orow), o1 = *(const float4*)(orow + 4), o2 = *(const float4*)(orow + 8), o3 = *(const float4*)(orow + 12);
            float sq = (o0.x * o0.x + o0.y * o0.y) + (o0.z * o0.z + o0.w * o0.w) + (o1.x * o1.x + o1.y * o1.y) + (o1.z * o1.z + o1.w * o1.w)
                     + (o2.x * o2.x + o2.y * o2.y) + (o2.z * o2.z + o2.w * o2.w) + (o3.x * o3.x + o3.y * o3.y) + (o3.z * o3.z + o3.w * o3.w);
            sq += __shfl_xor(sq, 1); sq += __shfl_xor(sq, 2); sq += __shfl_xor(sq, 4);
            const float rstd = rsqrtf(sq * (1.f / 128.f) + EPS);
            const float4 n0 = *(const float4*)(c.hg_gain + qc16), n1 = *(const float4*)(c.hg_gain + qc16 + 4), n2 = *(const float4*)(c.hg_gain + qc16 + 8), n3 = *(const float4*)(c.hg_gain + qc16 + 12);
            float ga[8], gb[8]; unpack8(gt0, ga); unpack8(gt1, gb);
#define HGF_SG(G) ((G) / (1.f + __expf(-(G))))
            uint4 w0, w1;
            w0.x = pk2(o0.x * rstd * n0.x * HGF_SG(ga[0]), o0.y * rstd * n0.y * HGF_SG(ga[1])); w0.y = pk2(o0.z * rstd * n0.z * HGF_SG(ga[2]), o0.w * rstd * n0.w * HGF_SG(ga[3]));
            w0.z = pk2(o1.x * rstd * n1.x * HGF_SG(ga[4]), o1.y * rstd * n1.y * HGF_SG(ga[5])); w0.w = pk2(o1.z * rstd * n1.z * HGF_SG(ga[6]), o1.w * rstd * n1.w * HGF_SG(ga[7]));
            w1.x = pk2(o2.x * rstd * n2.x * HGF_SG(gb[0]), o2.y * rstd * n2.y * HGF_SG(gb[1])); w1.y = pk2(o2.z * rstd * n2.z * HGF_SG(gb[2]), o2.w * rstd * n2.w * HGF_SG(gb[3]));
            w1.z = pk2(o3.x * rstd * n3.x * HGF_SG(gb[4]), o3.y * rstd * n3.y * HGF_SG(gb[5])); w1.w = pk2(o3.z * rstd * n3.z * HGF_SG(gb[6]), o3.w * rstd * n3.w * HGF_SG(gb[7]));
#undef HGF_SG
            uint4* mp = (uint4*)(MIX + (rowbase + (size_t)ch * 64 + qrow) * D + h * 128 + qc16);
            mp[0] = w0; mp[1] = w1;
        }
        if (ch + 1 < 64) HGF_LDG(ch + 1);
    }
#undef HGF_LDQ
#undef HGF_LDOI
#undef HGF_LDU
#undef HGF_LDG
    __syncthreads();
}

namespace fa {
typedef short bf16x8 __attribute__((ext_vector_type(8)));
typedef short s16x4 __attribute__((ext_vector_type(4)));
typedef float f32x16 __attribute__((ext_vector_type(16)));
#define FA_LAS __attribute__((address_space(3)))
constexpr int RPK = 144, RPV = 192;
constexpr int KTB = 64 * RPK, VTB = 64 * RPV;
constexpr int O_KT = 0, O_VT = 2 * KTB, O_IMP = O_VT + 2 * VTB, O_SELM = O_IMP + 64 * 64 * 4, O_JL = O_SELM + 512, O_UM = O_JL + 64 * 4, O_STG = 0  , STG_P = 144, STG_W = 32 * STG_P,
              O_RES = O_UM + 32, RES_P = 68, RES_W = 32 * RES_P * 4, O_END = O_RES + 8 * RES_W;
static_assert(O_END + 16 <= LDS_BARST && (O_STG % 16) == 0 && (O_RES % 16) == 0 && 8 * STG_W <= 2 * KTB + 2 * VTB, "attention LDS");
constexpr float SC2 = 0.125f * 1.4426950408889634f;
constexpr float THR = 8.f;
__device__ __forceinline__ int crow(int r, int hi) { return (r & 3) + 8 * (r >> 2) + 4 * hi; }
struct RangeMask { int lo, hi; __device__ __forceinline__ bool operator()(int kl) const { return kl >= lo && kl <= hi; } };
__device__ __forceinline__ s16x4 vtr(const unsigned char* p) {
    typedef short v4i16_t __attribute__((ext_vector_type(4)));
    return __builtin_bit_cast(s16x4, __builtin_amdgcn_ds_read_tr16_b64_v4i16((FA_LAS v4i16_t*)(p))); }
struct State { f32x16 o[2]; float m, l; };
__device__ __forceinline__ void init(State& st, float m0, float l0) {
#pragma unroll
    for (int t = 0; t < 2; ++t)
#pragma unroll
        for (int r = 0; r < 16; ++r) st.o[t][r] = 0.f;
    st.m = m0; st.l = l0; }
__device__ __forceinline__ void qnorm_rope(bf16x8 (&qf)[4], const float* gain, const float2* rt  , int hi) {
    float f[4][8]; float ss = 0.f;
#pragma unroll
    for (int sp = 0; sp < 4; ++sp) { unpack8(__builtin_bit_cast(uint4, qf[sp]), f[sp]);
#pragma unroll
        for (int j = 0; j < 8; ++j) ss += f[sp][j] * f[sp][j]; }
    ss += __shfl_xor(ss, 32);
    const float rstd = rsqrtf(ss * (1.f / 64.f) + EPS);
#pragma unroll
    for (int sp = 0; sp < 4; ++sp) { const float4 g0 = *(const float4*)(gain + 16 * sp + 8 * hi), g1 = *(const float4*)(gain + 16 * sp + 8 * hi + 4);
        f[sp][0] *= rstd * g0.x; f[sp][1] *= rstd * g0.y; f[sp][2] *= rstd * g0.z; f[sp][3] *= rstd * g0.w; f[sp][4] *= rstd * g1.x; f[sp][5] *= rstd * g1.y; f[sp][6] *= rstd * g1.z; f[sp][7] *= rstd * g1.w; }
#pragma unroll
    for (int j = 0; j < 8; ++j) { const float other = __shfl_xor(f[0][j], 32); const float2 cs = rt[j];
        f[0][j] = hi ? (f[0][j] * cs.x + other * cs.y) : (f[0][j] * cs.x - other * cs.y); }
#pragma unroll
    for (int sp = 0; sp < 4; ++sp) { uint4 o; o.x = pk2(f[sp][0] * SC2, f[sp][1] * SC2); o.y = pk2(f[sp][2] * SC2, f[sp][3] * SC2); o.z = pk2(f[sp][4] * SC2, f[sp][5] * SC2); o.w = pk2(f[sp][6] * SC2, f[sp][7] * SC2);
        qf[sp] = __builtin_bit_cast(bf16x8, o); }
}
__device__ __forceinline__ uint4 knorm_rope(const uint4 kv, const float* gain, const float2* rt  , int chunk) {
    float f[8]; unpack8(kv, f); float ss = 0.f;
#pragma unroll
    for (int j = 0; j < 8; ++j) ss += f[j] * f[j];
    ss += __shfl_xor(ss, 1); ss += __shfl_xor(ss, 2); ss += __shfl_xor(ss, 4);
    const float rstd = rsqrtf(ss * (1.f / 64.f) + EPS);
    const float4 g0 = *(const float4*)(gain + 8 * chunk), g1 = *(const float4*)(gain + 8 * chunk + 4);
    f[0] *= rstd * g0.x; f[1] *= rstd * g0.y; f[2] *= rstd * g0.z; f[3] *= rstd * g0.w; f[4] *= rstd * g1.x; f[5] *= rstd * g1.y; f[6] *= rstd * g1.z; f[7] *= rstd * g1.w;
#pragma unroll
    for (int j = 0; j < 8; ++j) { const float other = __shfl_xor(f[j], 1);
        if (chunk < 2) { const float2 cs = rt[j]; f[j] = chunk ? (f[j] * cs.x + other * cs.y) : (f[j] * cs.x - other * cs.y); } }
    uint4 o; o.x = pk2(f[0], f[1]); o.y = pk2(f[2], f[3]); o.z = pk2(f[4], f[5]); o.w = pk2(f[6], f[7]); return o;
}
template <int ABL = 0, bool FAST = false, bool ROWM = true, bool IMPC = false>
__device__ __forceinline__ void tile(State& st, const unsigned char* lds, int koff, int voff, const bf16x8 (&qf)[4], float cbias, bool emask, const RangeMask mk, int lane, float* impr = nullptr, float* carry = nullptr) {
    const int r32 = lane & 31, hi = lane >> 5;
    const float negm = FAST ? (ROWM ? cbias : 0.f) : cbias - st.m;
    f32x16 p0, p1;
#pragma unroll
    for (int r = 0; r < 16; ++r) { p0[r] = negm; p1[r] = negm; }
    const unsigned char* kb = lds + koff + r32 * RPK + hi * 16;
#pragma unroll
    for (int sp = 0; sp < 4; ++sp) {
        const bf16x8 a0 = *(const bf16x8*)(kb + 32 * sp), a1 = *(const bf16x8*)(kb + 32 * RPK + 32 * sp);
        p0 = __builtin_amdgcn_mfma_f32_32x32x16_bf16(a0, qf[sp], p0, 0, 0, 0);
        p1 = __builtin_amdgcn_mfma_f32_32x32x16_bf16(a1, qf[sp], p1, 0, 0, 0);
    }
    __builtin_amdgcn_sched_group_barrier(0x100, 8, 0);
    __builtin_amdgcn_sched_group_barrier(0x008, 8, 0);
    if (emask) {
#pragma unroll
        for (int r = 0; r < 16; ++r) { const int kl = crow(r, hi); if (!mk(kl)) p0[r] = -INFINITY; if (!mk(kl + 32)) p1[r] = -INFINITY; }
    }
    if (ABL == 1) {
#pragma unroll
        for (int r = 0; r < 16; ++r) { p0[r] *= 0.001f; p1[r] *= 0.001f; }
        st.l += p0[0];
    } else if (FAST) {
        float sa = 0.f, sb = 0.f, sc = 0.f, sd = 0.f;
#pragma unroll
        for (int r = 0; r < 16; r += 4) {
            p0[r] = __builtin_amdgcn_exp2f(p0[r]); p1[r] = __builtin_amdgcn_exp2f(p1[r]); p0[r + 1] = __builtin_amdgcn_exp2f(p0[r + 1]); p1[r + 1] = __builtin_amdgcn_exp2f(p1[r + 1]);
            p0[r + 2] = __builtin_amdgcn_exp2f(p0[r + 2]); p1[r + 2] = __builtin_amdgcn_exp2f(p1[r + 2]); p0[r + 3] = __builtin_amdgcn_exp2f(p0[r + 3]); p1[r + 3] = __builtin_amdgcn_exp2f(p1[r + 3]);
            sa += p0[r] + p1[r]; sb += p0[r + 1] + p1[r + 1]; sc += p0[r + 2] + p1[r + 2]; sd += p0[r + 3] + p1[r + 3];
        }
        st.l += (sa + sb) + (sc + sd);
        if (IMPC) {
            float x0[4], x1[4];
#pragma unroll
            for (int q = 0; q < 4; ++q) { x0[q] = __shfl_xor(p0[4 * q + 3], 32); x1[q] = __shfl_xor(p1[4 * q + 3], 32); }
#pragma unroll
            for (int q = 0; q < 4; ++q) {
                const float g0 = (p0[4 * q] + p0[4 * q + 1]) + (p0[4 * q + 2] + p0[4 * q + 3]), g1 = (p1[4 * q] + p1[4 * q + 1]) + (p1[4 * q + 2] + p1[4 * q + 3]);
                const float e0 = hi ? x0[q] : (q ? x0[q ? q - 1 : 0] : *carry), e1 = hi ? x1[q] : (q ? x1[q ? q - 1 : 0] : x0[3]);
                impr[2 * q + hi] = g0 + e0; impr[8 + 2 * q + hi] = g1 + e1;
            }
            *carry = x1[3];
        }
    } else {
        float mxa = fmaxf(p0[0], p1[0]), mxb = fmaxf(p0[1], p1[1]), mxc = fmaxf(p0[2], p1[2]), mxd = fmaxf(p0[3], p1[3]);
#pragma unroll
        for (int r = 4; r < 16; r += 4) { mxa = fmaxf(mxa, fmaxf(p0[r], p1[r])); mxb = fmaxf(mxb, fmaxf(p0[r + 1], p1[r + 1])); mxc = fmaxf(mxc, fmaxf(p0[r + 2], p1[r + 2])); mxd = fmaxf(mxd, fmaxf(p0[r + 3], p1[r + 3])); }
        float mx = fmaxf(fmaxf(mxa, mxb), fmaxf(mxc, mxd));
        mx = fmaxf(mx, __shfl_xor(mx, 32));
        if (!__all(mx <= THR)) {
            const float delta = fmaxf(mx, 0.f), alpha = __builtin_amdgcn_exp2f(-delta);
            st.m += delta; st.l *= alpha;
#pragma unroll
            for (int r = 0; r < 16; ++r) { p0[r] -= delta; p1[r] -= delta; st.o[0][r] *= alpha; st.o[1][r] *= alpha; }
        }
        float sa = 0.f, sb = 0.f, sc = 0.f, sd = 0.f;
#pragma unroll
        for (int r = 0; r < 16; r += 4) {
            p0[r] = __builtin_amdgcn_exp2f(p0[r]); p1[r] = __builtin_amdgcn_exp2f(p1[r]); p0[r + 1] = __builtin_amdgcn_exp2f(p0[r + 1]); p1[r + 1] = __builtin_amdgcn_exp2f(p1[r + 1]);
            p0[r + 2] = __builtin_amdgcn_exp2f(p0[r + 2]); p1[r + 2] = __builtin_amdgcn_exp2f(p1[r + 2]); p0[r + 3] = __builtin_amdgcn_exp2f(p0[r + 3]); p1[r + 3] = __builtin_amdgcn_exp2f(p1[r + 3]);
            sa += p0[r] + p1[r]; sb += p0[r + 1] + p1[r + 1]; sc += p0[r + 2] + p1[r + 2]; sd += p0[r + 3] + p1[r + 3];
        }
        st.l += (sa + sb) + (sc + sd);
    }
    if (ABL == 2) { st.o[0][0] += p0[0] + p0[5] + p1[3] + p1[9]; return; }
    const int vbase = voff + (4 * hi + ((lane & 15) >> 2)) * RPV + ((lane >> 4) & 1) * 32 + (lane & 3) * 8;
#pragma unroll
    for (int sub = 0; sub < 2; ++sub)
#pragma unroll
        for (int ks = 0; ks < 2; ++ks) {
            uint4 pw;
            if (sub == 0) { pw.x = pk2(p0[8 * ks], p0[8 * ks + 1]); pw.y = pk2(p0[8 * ks + 2], p0[8 * ks + 3]); pw.z = pk2(p0[8 * ks + 4], p0[8 * ks + 5]); pw.w = pk2(p0[8 * ks + 6], p0[8 * ks + 7]); }
            else { pw.x = pk2(p1[8 * ks], p1[8 * ks + 1]); pw.y = pk2(p1[8 * ks + 2], p1[8 * ks + 3]); pw.z = pk2(p1[8 * ks + 4], p1[8 * ks + 5]); pw.w = pk2(p1[8 * ks + 6], p1[8 * ks + 7]); }
            const bf16x8 pf = __builtin_bit_cast(bf16x8, pw);
#pragma unroll
            for (int dt = 0; dt < 2; ++dt) {
                const unsigned char* vp = lds + vbase + (32 * sub + 16 * ks) * RPV + dt * 64;
                const s16x4 lo = vtr(vp), hi4 = vtr(vp + 8 * RPV);
                const bf16x8 vf = {lo[0], lo[1], lo[2], lo[3], hi4[0], hi4[1], hi4[2], hi4[3]};
                st.o[dt] = __builtin_amdgcn_mfma_f32_32x32x16_bf16(vf, pf, st.o[dt], 0, 0, 0);
            }
        }
}
__device__ __forceinline__ uint4 ldg_tile(const bf16_t* base, long row, int ld, int tid) { return *(const uint4*)(base + row * ld + (tid & 7) * 8); }
__device__ __forceinline__ void sts_k(unsigned char* lds, int buf, const uint4& v, int tid) { *(uint4*)(lds + O_KT + buf * KTB + (tid >> 3) * RPK + (tid & 7) * 16) = v; }
__device__ __forceinline__ void sts_v(unsigned char* lds, int buf, const uint4& v, int tid) { *(uint4*)(lds + O_VT + buf * VTB + (tid >> 3) * RPV + (tid & 7) * 16) = v; }
}

template <int ABL = 0, bool DRY = false, bool FAST = false>
__device__ __forceinline__ void nsa_unit(const Ctx& c, unsigned char* lds, int b, int i, int g) {
    using namespace fa;
    const bf16_t* P = (const bf16_t*)(c.ws + WS_PROJ);
    const bf16_t* KCB = (const bf16_t*)(c.ws + WS_KCB) + (size_t)((b * 2 + g) * 256) * 64; const bf16_t* VCB = (const bf16_t*)(c.ws + WS_VCB) + (size_t)((b * 2 + g) * 256) * 64;
    const int tid = c.tid, lane = c.lane, w = c.wave, r32 = lane & 31, hi = lane >> 5;
    const int tl = 8 * w + (r32 >> 2), hh = r32 & 3, t = 64 * i + tl, head = 4 * g + hh;
    const int key = tid >> 3;
    const size_t m = (size_t)b * SEQ + t;
    const bf16_t* prow = P + m * EVPP;
    const int nt = ((4 * i + 2) >> 6) + 1, nA = FAST ? nt : 2 * nt;
    uint4 kreg = ldg_tile(KCB, key, 64, tid), vreg = ldg_tile(VCB, key, 64, tid);
    bf16x8 qf[4];
#pragma unroll
    for (int sp = 0; sp < 4; ++sp) qf[sp] = *(const bf16x8*)(prow + 2048 + head * 64 + 16 * sp + 8 * hi);
    MB_DECL(m0) MB_DECL(m1) MB_DECL(m2) MB_DECL(m3)
    MB_ISSUE_A()
    qnorm_rope(qf, c.nsa_qg, (const float2*)(c.ws + WS_ROPE) + (size_t)t * 8, hi);
    float* IMP = (float*)(lds + O_IMP); unsigned long long* SELM = (unsigned long long*)(lds + O_SELM); u32* UM = (u32*)(lds + O_UM); int* JL = (int*)(lds + O_JL);
    float* RES = (float*)(lds + O_RES + w * RES_W) + r32 * RES_P;
#define NSA_GATE(k) (1.f / (1.f + __expf(-bf2f(P[((size_t)b * SEQ + t) * EVPP + 3328 + head * 3 + (k)]))))
    const int nmaxq = (t >= 31) ? ((t - 31) >> 4) : -1;
    State st; init(st, 0.f, 0.f);
    float inv = 0.f;
#define NSA_LOAD_A(IDX) do { const int idx_ = (IDX); const int kt_ = idx_ >= nt ? idx_ - nt : idx_; kreg = ldg_tile(KCB, 64 * kt_ + key, 64, tid); \
        if (idx_ < nt) vreg = ldg_tile(VCB, 64 * kt_ + key, 64, tid); \
        else { const int nn = 64 * kt_ + key, j0 = (tid & 7) * 8; u32 wv[4];     \
            _Pragma("unroll") for (int q = 0; q < 4; ++q) { const int ja = j0 + 2 * q, jb = ja + 1; \
                wv[q] = ((nn >= 4 * ja - 1 && nn <= 4 * ja + 3) ? 0x3f80u : 0u) | ((nn >= 4 * jb - 1 && nn <= 4 * jb + 3) ? 0x3f800000u : 0u); } \
            vreg.x = wv[0]; vreg.y = wv[1]; vreg.z = wv[2]; vreg.w = wv[3]; } } while (0)
    __syncthreads();
    sts_k(lds, 0, kreg, tid); sts_v(lds, 0, vreg, tid);
    NSA_LOAD_A(1);
    __syncthreads();
    MB_FINISH_A()
    float carry = 0.f;
    for (int idx = 0; idx < nA; ++idx) {
        if (!FAST && idx == nt) {
            const float lt = st.l + __shfl_xor(st.l, 32);
            inv = lt > 0.f ? 1.f / lt : 0.f;
            const float gci = NSA_GATE(0) * inv;
#pragma unroll
            for (int dt = 0; dt < 2; ++dt)
#pragma unroll
                for (int r = 0; r < 16; ++r) RES[32 * dt + crow(r, hi)] = gci * st.o[dt][r];
            const float mfin = st.m; init(st, mfin, 0.f);
        }
        const int kt = idx >= nt ? idx - nt : idx, cur = idx & 1;
        if (FAST) tile<ABL, true, false, true>(st, lds, O_KT + cur * KTB, O_VT + cur * VTB, qf, 0.f, true, RangeMask{0, nmaxq - 64 * kt}, lane, RES + 16 * kt, &carry);
        else tile<ABL, false, false>(st, lds, O_KT + cur * KTB, O_VT + cur * VTB, qf, 0.f, true, RangeMask{0, nmaxq - 64 * kt}, lane);
        if (idx + 1 < nA) { sts_k(lds, cur ^ 1, kreg, tid); sts_v(lds, cur ^ 1, vreg, tid); if (idx + 2 < nA) NSA_LOAD_A(idx + 2); }
        __syncthreads();
    }
#undef NSA_LOAD_A
    if (FAST) {
        const float lt = st.l + __shfl_xor(st.l, 32);
        inv = lt > 0.f ? 1.f / lt : 0.f;
        for (int jj = 0; jj < 8 * nt; ++jj) {
            float v = RES[2 * jj + hi] * inv; v += __shfl_xor(v, 1); v += __shfl_xor(v, 2);
            if (hh == 0) IMP[tl * 64 + 2 * jj + hi] = v;
        }
        const float gci = NSA_GATE(0) * inv;
#pragma unroll
        for (int dt = 0; dt < 2; ++dt)
#pragma unroll
            for (int r = 0; r < 16; ++r) RES[32 * dt + crow(r, hi)] = gci * st.o[dt][r];
    } else {
#pragma unroll
        for (int dt = 0; dt < 2; ++dt)
#pragma unroll
            for (int r = 0; r < 16; ++r) {
                float v = st.o[dt][r] * inv; v += __shfl_xor(v, 1); v += __shfl_xor(v, 2);
                if (hh == 0) IMP[tl * 64 + 32 * dt + crow(r, hi)] = v;
            }
    }
    const bf16_t* PB = P + (size_t)b * SEQ * EVPP + g * 64;
#define KW (PB + 3072)
#define VW (PB + 3200)
#define KS (PB + 2816)
#define VS (PB + 2944)
    const int k0 = (i - 8 > 0) ? i - 8 : 0, nW = i - k0 + 1;
    kreg = ldg_tile(KW, 64 * k0 + key, EVPP, tid); vreg = ldg_tile(VW, 64 * k0 + key, EVPP, tid);
    if (tid < 2) UM[tid] = 0u;
    MB_ISSUE_B()
    __syncthreads();
    {
        const int tk = tid >> 3, sub = tid & 7;
        float cand[8];
#pragma unroll
        for (int q = 0; q < 8; ++q) { const int j = 8 * sub + q; const bool allowed = j <= i, forced = (j == 0) || (j == i) || (j == i - 1);
            cand[q] = allowed ? IMP[tk * 64 + j] + (forced ? 1e4f : 0.f) : -INFINITY; }
        unsigned long long msk = 0ull;
#pragma unroll 1
        for (int rnd = 0; rnd < 8; ++rnd) {
            float bv = cand[0]; int bi = 0;
#pragma unroll
            for (int q = 1; q < 8; ++q) if (cand[q] > bv) { bv = cand[q]; bi = q; }
            bi += 8 * sub;
#pragma unroll
            for (int o = 1; o < 8; o <<= 1) { const float ov = __shfl_xor(bv, o); const int oi = __shfl_xor(bi, o); if (ov > bv || (ov == bv && oi < bi)) { bv = ov; bi = oi; } }
            if (bv > -INFINITY) {
                msk |= 1ull << bi;
#pragma unroll
                for (int q = 0; q < 8; ++q) if (8 * sub + q == bi) cand[q] = -INFINITY;
            }
        }
        if (sub == 0) { SELM[tk] = msk; atomicOr(&UM[0], (u32)msk); atomicOr(&UM[1], (u32)(msk >> 32)); }
    }
    __syncthreads();
    int nsel;
    {
        const unsigned long long um = (unsigned long long)UM[0] | ((unsigned long long)UM[1] << 32);
        nsel = __popcll(um);
        if (tid < 64 && ((um >> tid) & 1ull)) JL[__popcll(um & ((1ull << tid) - 1ull))] = tid;
    }
    sts_k(lds, 0, kreg, tid); sts_v(lds, 0, vreg, tid);
    __syncthreads();
    MB_FINISH_B()
    const int nB = nW + nsel;
    const unsigned long long mysel = SELM[tl];
#define NSA_LOAD_B(IDX) do { const int lidx_ = (IDX); if (lidx_ < nW) { const long row_ = 64 * (k0 + lidx_) + key; kreg = ldg_tile(KW, row_, EVPP, tid); vreg = ldg_tile(VW, row_, EVPP, tid); } \
        else { const long row_ = 64 * JL[lidx_ - nW] + key; kreg = ldg_tile(KS, row_, EVPP, tid); vreg = ldg_tile(VS, row_, EVPP, tid); } } while (0)
    NSA_LOAD_B(1);
    init(st, 0.f, 0.f);
#define NSA_STAGE_B(IDX) do { const int idx_ = (IDX); if (idx_ + 1 < nB) { sts_k(lds, (idx_ & 1) ^ 1, kreg, tid); sts_v(lds, (idx_ & 1) ^ 1, vreg, tid); if (idx_ + 2 < nB) NSA_LOAD_B(idx_ + 2); } __syncthreads(); } while (0)
    for (int idx = 0; idx < nW; ++idx) {
        const int cur = idx & 1, kt = k0 + idx; RangeMask mk{0, 63}; if (kt == i) mk.hi = tl; if (kt == i - 8) mk.lo = tl + 1;
        tile<ABL, FAST, false>(st, lds, O_KT + cur * KTB, O_VT + cur * VTB, qf, 0.f, (kt == i) || (kt == i - 8), mk, lane);
        NSA_STAGE_B(idx);
    }
    {
        const float lt = st.l + __shfl_xor(st.l, 32);
        const float sc = NSA_GATE(2) * (lt > 0.f ? 1.f / lt : 0.f);
#pragma unroll
        for (int dt = 0; dt < 2; ++dt)
#pragma unroll
            for (int r = 0; r < 16; ++r) RES[32 * dt + crow(r, hi)] += sc * st.o[dt][r];
        init(st, 0.f, 0.f);
    }
    for (int idx = nW; idx < nB; ++idx) {
        const int cur = idx & 1, j = JL[idx - nW]; const bool mine = ((mysel >> j) & 1ull) != 0ull;
        if (__any((int)mine)) tile<ABL, FAST, true>(st, lds, O_KT + cur * KTB, O_VT + cur * VTB, qf, mine ? 0.f : -INFINITY, j == i, RangeMask{0, tl}, lane);
        NSA_STAGE_B(idx);
    }
#undef NSA_STAGE_B
#undef NSA_LOAD_B
    {
        const float lt = st.l + __shfl_xor(st.l, 32);
        const float sc = NSA_GATE(1) * (lt > 0.f ? 1.f / lt : 0.f);
        unsigned char* stg = lds + O_STG + w * STG_W;
#pragma unroll
        for (int dt = 0; dt < 2; ++dt)
#pragma unroll
            for (int r = 0; r < 16; ++r) *(bf16_t*)(stg + r32 * STG_P + (32 * dt + crow(r, hi)) * 2) = f2bf(RES[32 * dt + crow(r, hi)] + sc * st.o[dt][r]);
        LDS_FENCE();
#pragma unroll
        for (int it = 0; it < 4; ++it) {
            const int row = it * 8 + (lane >> 3), ch = lane & 7;
            const uint4 v = *(const uint4*)(stg + row * STG_P + ch * 16);
            const size_t mm = (size_t)b * SEQ + 64 * i + 8 * w + (row >> 2);
            if (!DRY) *(uint4*)((bf16_t*)(c.ws + WS_H) + mm * D + 512 + (4 * g + (row & 3)) * 64 + ch * 8) = v;
            else if (v.x == 0x12345678u && v.y == 0x9abcdef0u) *(uint4*)((bf16_t*)(c.ws + WS_H) + mm * D + 512 + (4 * g + (row & 3)) * 64 + ch * 8) = v;
        }
        LDS_FENCE();
    }
#undef KW
#undef VW
#undef KS
#undef VS
#undef NSA_GATE
}
__device__ __forceinline__ float score_bound(const float* gq, const float* gk, int nk, int lane) {
    float a = fabsf(gq[lane]), b = 0.f;
    for (int x = 0; x < nk; ++x) b = fmaxf(b, fabsf(gk[64 * x + lane]));
    return fa::SC2 * 64.f * wmax(a) * wmax(b);
}
template <int ABL = 0, bool DRY = false>
__device__ __forceinline__ void nsa_mfma(const Ctx& c, unsigned char* lds) {
    const bool fast = score_bound(c.nsa_qg, c.nsa_kg, 3, c.lane) < 60.f;
    int* qc = (int*)(c.ws + WS_CTL) + CTL_QUEUE + (DRY ? 1 : 0);
    volatile int* slot = (volatile int*)(lds + fa::O_END);
    __syncthreads();
    if (c.tid == 0) *slot = atomicAdd(qc, 1);
    __syncthreads();
    int u = __builtin_amdgcn_readfirstlane(*slot);
    while (u < 2048) {
        __syncthreads();
        if (c.tid == 0) *slot = atomicAdd(qc, 1);
        const int rank = u >> 5, bg = u & 31;
        if (fast) nsa_unit<ABL, DRY, true>(c, lds, bg >> 1, 63 - rank, bg & 1); else nsa_unit<ABL, DRY, false>(c, lds, bg >> 1, 63 - rank, bg & 1);
        __syncthreads();
        u = __builtin_amdgcn_readfirstlane(*slot);
    }
}

__device__ __forceinline__ void swa_load(const Ctx& c, int b, int i, int g, uint4 (&kr)[3], uint4 (&vr)[3], int tid) {
    using namespace fa;
    const bf16_t* P = (const bf16_t*)(c.ws + WS_PROJ);
    const int k0 = (i - 2 > 0) ? i - 2 : 0, n = i - k0 + 1;
    const bf16_t* Kb = P + (size_t)b * SEQ * ODP + 1024 + g * 64; const bf16_t* Vb = P + (size_t)b * SEQ * ODP + 1152 + g * 64;
#pragma unroll
    for (int x = 0; x < 3; ++x) if (x < n) { const long row = 64 * (k0 + x) + (tid >> 3); kr[x] = ldg_tile(Kb, row, ODP, tid); vr[x] = ldg_tile(Vb, row, ODP, tid); }
}
template <bool FAST>
__device__ __forceinline__ void swa_unit(const Ctx& c, unsigned char* lds, int b, int i, int g, uint4 (&kr)[3], uint4 (&vr)[3], bool has_next, int nb, int ni, int ng) {
    using namespace fa;
    constexpr int SW_K = 0, SW_V = 3 * KTB, SW_STG = 3 * KTB + 3 * VTB;
    static_assert(SW_STG + 8 * STG_W <= LDS_BARST, "swa LDS");
    const bf16_t* P = (const bf16_t*)(c.ws + WS_PROJ); bf16_t* ATT = (bf16_t*)(c.ws + WS_H);
    const int tid = c.tid, lane = c.lane, w = c.wave, r32 = lane & 31, hi = lane >> 5;
    const int tl = 8 * w + (r32 >> 2), hh = r32 & 3, t = 64 * i + tl;
    const size_t m = (size_t)b * SEQ + t;
    const int k0 = (i - 2 > 0) ? i - 2 : 0, n = i - k0 + 1;
#pragma unroll
    for (int x = 0; x < 3; ++x) if (x < n) kr[x] = knorm_rope(kr[x], c.swa_kg, (const float2*)(c.ws + WS_ROPE) + (size_t)(64 * (k0 + x) + (tid >> 3)) * 8, tid & 7);
    __syncthreads();
#pragma unroll
    for (int x = 0; x < 3; ++x) if (x < n) { *(uint4*)(lds + SW_K + x * KTB + (tid >> 3) * RPK + (tid & 7) * 16) = kr[x]; *(uint4*)(lds + SW_V + x * VTB + (tid >> 3) * RPV + (tid & 7) * 16) = vr[x]; }
    __syncthreads();
    if (has_next) swa_load(c, nb, ni, ng, kr, vr, tid);
#pragma unroll 1
    for (int hq = 0; hq < 2; ++hq) {
        const int head = 8 * g + 4 * hq + hh;
        bf16x8 qf[4];
#pragma unroll
        for (int sp = 0; sp < 4; ++sp) qf[sp] = *(const bf16x8*)(P + m * ODP + head * 64 + 16 * sp + 8 * hi);
        qnorm_rope(qf, c.swa_qg, (const float2*)(c.ws + WS_ROPE) + (size_t)t * 8, hi);
        State st; const float sink2 = c.swa_sinks[head] * 1.4426950408889634f;
        if (FAST) init(st, 0.f, hi == 0 ? __builtin_amdgcn_exp2f(sink2) : 0.f); else init(st, sink2, hi == 0 ? 1.f : 0.f);
#pragma unroll 1
        for (int x = 0; x < n; ++x) {
            const int kt = k0 + x;
            RangeMask mk{0, 63}; if (kt == i) mk.hi = tl; if (kt == i - 2) mk.lo = tl + 1;
            tile<0, FAST, false>(st, lds, SW_K + x * KTB, SW_V + x * VTB, qf, 0.f, (kt == i) || (kt == i - 2), mk, lane);
        }
        unsigned char* stg = lds + SW_STG + w * STG_W;
        const float lt = st.l + __shfl_xor(st.l, 32);
        const float sc = 1.f / lt;
#pragma unroll
        for (int dt = 0; dt < 2; ++dt)
#pragma unroll
            for (int r = 0; r < 16; ++r) *(bf16_t*)(stg + r32 * STG_P + (32 * dt + crow(r, hi)) * 2) = f2bf(sc * st.o[dt][r]);
        LDS_FENCE();
#pragma unroll
        for (int it = 0; it < 4; ++it) {
            const int row = it * 8 + (lane >> 3), ch = lane & 7;
            const uint4 v = *(const uint4*)(stg + row * STG_P + ch * 16);
            const size_t mm = (size_t)b * SEQ + 64 * i + 8 * w + (row >> 2);
            *(uint4*)(ATT + mm * D + (8 * g + 4 * hq + (row & 3)) * 64 + ch * 8) = v;
        }
        LDS_FENCE();
    }
}
__device__ __forceinline__ void swa_mfma(const Ctx& c, unsigned char* lds) {
    const bool fast = score_bound(c.swa_qg, c.swa_kg, 1, c.lane) < 60.f && wmax(fabsf(c.swa_sinks[c.lane & 15])) < 40.f;
    uint4 kr[3], vr[3];
    if ((int)blockIdx.x < 2048) swa_load(c, blockIdx.x >> 7, (blockIdx.x >> 1) & 63, blockIdx.x & 1, kr, vr, c.tid);
    for (int u = blockIdx.x; u < 2048; u += gridDim.x) {
        const int g = u & 1, i = (u >> 1) & 63, b = u >> 7, un = u + gridDim.x;
        if (fast) swa_unit<true>(c, lds, b, i, g, kr, vr, un < 2048, un >> 7, (un >> 1) & 63, un & 1); else swa_unit<false>(c, lds, b, i, g, kr, vr, un < 2048, un >> 7, (un >> 1) & 63, un & 1);
    }
}

__device__ __forceinline__ void phase_router2(const Ctx& c, unsigned char* lds_raw, int layer) {
    typedef short bf16x8 __attribute__((ext_vector_type(8)));
    typedef float f32x4 __attribute__((ext_vector_type(4)));
    const int tid = c.tid, lane = c.lane, w = c.wave, l15 = lane & 15, g4 = lane >> 4;
    float* LG = (float*)(lds_raw + w * 5632);
    float* RS = LG + 32 * 40;
    int* lcnt = (int*)(lds_raw + 8 * 5632);
    int* lbase = lcnt + 32;
    int* tinfo = lbase + 32;
    float* twt = (float*)(tinfo + 1024);
    const bf16_t* XB = (const bf16_t*)(c.ws + WS_XB); const bf16_t* RW = (const bf16_t*)(c.ws + WS_RW) + (size_t)layer * 48 * 2048;
    const float* bg = c.moe_b_grp + layer * 4; const float* be = c.moe_b_exp + layer * 32; const float* gain = c.moe_norm + layer * D;
    int* gcnt = (int*)(c.ws + WS_CTL) + layer * 32;
    bf16_t* H = (bf16_t*)(c.ws + WS_H);
    int* TE = (int*)(c.ws + WS_TE); int* TR = (int*)(c.ws + WS_TR); float* TW = (float*)(c.ws + WS_TW);
    __syncthreads();
    if (tid < 32) lcnt[tid] = 0;
    __syncthreads();
    for (int blk = blockIdx.x; blk < M / 256; blk += gridDim.x) {
        const int tok0 = blk * 256 + w * 32;
        f32x4 acc[2][3];
#pragma unroll
        for (int mt = 0; mt < 2; ++mt)
#pragma unroll
            for (int nt = 0; nt < 3; ++nt) acc[mt][nt] = (f32x4){0.f, 0.f, 0.f, 0.f};
        float sq0 = 0.f, sq1 = 0.f;
        const bf16_t* a0 = XB + (size_t)(tok0 + l15) * D + 8 * g4; const bf16_t* a1 = a0 + (size_t)16 * D;
        const bf16_t* b0 = RW + (size_t)l15 * 2048 + 8 * g4;
#pragma unroll 2
        for (int ks = 0; ks < 32; ++ks) {
            const bf16x8 A0 = *(const bf16x8*)(a0 + 32 * ks), A1 = *(const bf16x8*)(a1 + 32 * ks);
            { float f[8]; unpack8(__builtin_bit_cast(uint4, A0), f);
#pragma unroll
              for (int j = 0; j < 8; ++j) sq0 += f[j] * f[j];
              unpack8(__builtin_bit_cast(uint4, A1), f);
#pragma unroll
              for (int j = 0; j < 8; ++j) sq1 += f[j] * f[j]; }
#pragma unroll
            for (int nt = 0; nt < 3; ++nt) {
                const bf16x8 Bh = *(const bf16x8*)(b0 + (size_t)nt * 16 * 2048 + 32 * ks), Bl = *(const bf16x8*)(b0 + (size_t)nt * 16 * 2048 + 1024 + 32 * ks);
                acc[0][nt] = __builtin_amdgcn_mfma_f32_16x16x32_bf16(A0, Bh, acc[0][nt], 0, 0, 0); acc[0][nt] = __builtin_amdgcn_mfma_f32_16x16x32_bf16(A0, Bl, acc[0][nt], 0, 0, 0);
                acc[1][nt] = __builtin_amdgcn_mfma_f32_16x16x32_bf16(A1, Bh, acc[1][nt], 0, 0, 0); acc[1][nt] = __builtin_amdgcn_mfma_f32_16x16x32_bf16(A1, Bl, acc[1][nt], 0, 0, 0);
            }
        }
        sq0 += __shfl_xor(sq0, 16); sq0 += __shfl_xor(sq0, 32); sq1 += __shfl_xor(sq1, 16); sq1 += __shfl_xor(sq1, 32);
        if (g4 == 0) { RS[l15] = rsqrtf(sq0 * (1.f / D) + EPS); RS[16 + l15] = rsqrtf(sq1 * (1.f / D) + EPS); }
        LDS_FENCE();
#pragma unroll
        for (int nt = 0; nt < 3; ++nt) {
            const int o = 16 * nt + l15;
            if (o < 36) {
                const float bias = o < 4 ? bg[o] : be[o - 4];
#pragma unroll
                for (int mt = 0; mt < 2; ++mt)
#pragma unroll
                    for (int r = 0; r < 4; ++r) { const int tk = 16 * mt + 4 * g4 + r; LG[tk * 40 + o] = acc[mt][nt][r] * RS[tk] + bias; }
            }
        }
        LDS_FENCE();
        if (lane < 32) {
            const float* lg = LG + lane * 40;
            int gi = 0; float gm = lg[0];
#pragma unroll
            for (int q = 1; q < 4; ++q) if (lg[q] > gm) { gm = lg[q]; gi = q; }
            float gs = 0.f;
#pragma unroll
            for (int q = 0; q < 4; ++q) gs += expf(lg[q] - gm);
            const float gwt = 1.f / gs;
            float w8[8];
#pragma unroll
            for (int j = 0; j < 8; ++j) w8[j] = lg[4 + gi * 8 + j];
            int j0 = 0; float l0 = w8[0];
#pragma unroll
            for (int j = 1; j < 8; ++j) if (w8[j] > l0) { l0 = w8[j]; j0 = j; }
            int j1 = -1; float l1 = -INFINITY;
#pragma unroll
            for (int j = 0; j < 8; ++j) if (j != j0 && w8[j] > l1) { l1 = w8[j]; j1 = j; }
            const float e1 = expf(l1 - l0); const float w0 = gwt / (1.f + e1), w1 = gwt * e1 / (1.f + e1);
            const int tl = w * 32 + lane, ea = gi * 8 + j0, eb = gi * 8 + j1;
            const int ra = atomicAdd(&lcnt[ea], 1), rb = atomicAdd(&lcnt[eb], 1);
            tinfo[tl * 4 + 0] = ea; tinfo[tl * 4 + 1] = eb; tinfo[tl * 4 + 2] = ra; tinfo[tl * 4 + 3] = rb; twt[tl * 2] = w0; twt[tl * 2 + 1] = w1;
        }
        __syncthreads();
        if (tid < 32) { lbase[tid] = atomicAdd(&gcnt[tid], lcnt[tid]); lcnt[tid] = 0; }
        __syncthreads();
        if (tid < 256) {
            const int m = blk * 256 + tid; const int ea = tinfo[tid * 4], eb = tinfo[tid * 4 + 1];
            TE[2 * m] = ea; TE[2 * m + 1] = eb; TR[2 * m] = lbase[ea] + tinfo[tid * 4 + 2]; TR[2 * m + 1] = lbase[eb] + tinfo[tid * 4 + 3];
            TW[2 * m] = twt[tid * 2]; TW[2 * m + 1] = twt[tid * 2 + 1];
            int* LIST = (int*)(c.ws + WS_LIST);
            LIST[(size_t)ea * 65536 + lbase[ea] + tinfo[tid * 4 + 2]] = m; LIST[(size_t)eb * 65536 + lbase[eb] + tinfo[tid * 4 + 3]] = m;
            float* RSL = (float*)(c.ws + WS_RSL); const float rsv = ((const float*)(lds_raw + (tid >> 5) * 5632))[32 * 40 + (tid & 31)];
            RSL[(size_t)ea * 65536 + lbase[ea] + tinfo[tid * 4 + 2]] = rsv; RSL[(size_t)eb * 65536 + lbase[eb] + tinfo[tid * 4 + 3]] = rsv;
        }
        __syncthreads();
    }
}

__device__ __forceinline__ int build_tile_table(const Ctx& c, unsigned char* lds_raw, int layer) {
    const int* gcnt = (const int*)(c.ws + WS_CTL) + layer * 32;
    int* pst = (int*)(lds_raw + pg8::STAGE_BYTES); int* te = pst + 64; int* tv = te + MAXTILES; int* tg = tv + MAXTILES;
    __syncthreads();
    if (c.tid == 0) { int a = 0; for (int e = 0; e < 32; ++e) { pst[e] = a; a += (gcnt[e] + 255) >> 8; } pst[32] = a; }
    __syncthreads();
    for (int st = c.tid; st < MAXTILES; st += NTHREADS) {
        int e = 31;
        for (int q = 0; q < 32; ++q) if (st >= pst[q] && st < pst[q + 1]) e = q;
        const int ti = st - pst[e], rem = gcnt[e] - 256 * ti;
        te[st] = e; tv[st] = rem < 256 ? (rem > 0 ? rem : 0) : 256; tg[st] = e * 65536 + 256 * ti;
    }
    __syncthreads();
    return pst[32];
}
__device__ __forceinline__ void phase_moe1_mfma(const Ctx& c, unsigned char* lds_raw, int layer) {
    const int nt = build_tile_table(c, lds_raw, layer);
    const int* te = (const int*)(lds_raw + pg8::STAGE_BYTES) + 64;
    pg8::Gemm g{(const bf16_t*)(c.ws + WS_XB), (const bf16_t*)(c.ws + WS_WGU) + (size_t)layer * 32 * 1024 * 1024, D, (const int*)(c.ws + WS_LIST), (size_t)1024 * 1024};
    pg8::MoeOrder S{te, te + MAXTILES, te + 2 * MAXTILES, nt * 4, (int)gridDim.x, (int)blockIdx.x, nullptr};
    pg8::EpiGUT E{(bf16_t*)(c.ws + WS_HID), (const float*)(c.ws + WS_RSL), (int*)(c.ws + WS_CTL) + CTL_MOEDONE + layer * MAXTILES};
    pg8::gemm_phase<pg8::EpiGUT, pg8::MoeOrder, true>((PG8_LAS unsigned char*)lds_raw, g, S, E);
}
__device__ __forceinline__ void phase_moe2_mfma(const Ctx& c, unsigned char* lds_raw, int layer) {
    const int nt = build_tile_table(c, lds_raw, layer);
    const int* te = (const int*)(lds_raw + pg8::STAGE_BYTES) + 64;
    pg8::Gemm g{(const bf16_t*)(c.ws + WS_HID), (const bf16_t*)(c.ws + WS_WD) + (size_t)layer * 32 * 1024 * 512, FF, nullptr, (size_t)1024 * 512};
    pg8::MoeOrder S{te, te + MAXTILES, te + 2 * MAXTILES, nt * 4, (int)gridDim.x, (int)gridDim.x - 1 - (int)blockIdx.x, (const int*)(c.ws + WS_CTL) + CTL_MOEDONE + layer * MAXTILES};
    pg8::EpiDownT E{(bf16_t*)(c.ws + WS_YS)};
    pg8::gemm_phase<pg8::EpiDownT, pg8::MoeOrder, false, 16>((PG8_LAS unsigned char*)lds_raw, g, S, E);
}
template <class Epi>
__device__ __forceinline__ void phase_gemm_mfma(unsigned char* lds_raw, const bf16_t* A, const bf16_t* Bt, int Npad, int K, const Epi& E) {
    pg8::Gemm g{A, Bt, K, nullptr, 0}; pg8::StaticOrder S; S.init(M, Npad, (int)gridDim.x, (int)blockIdx.x);
    pg8::gemm_phase<Epi, pg8::StaticOrder, false>((PG8_LAS unsigned char*)lds_raw, g, S, E);
}

#ifndef PSTAMP
#define PSTAMP(k) do {} while (0)
#endif
#define PHASE_BEGIN() Ctx c; { CArgs* ap_ = (CArgs*)__builtin_amdgcn_kernarg_segment_ptr(); asm volatile("" : "+s"(ap_)); int tid_ = threadIdx.x; asm volatile("" : "+v"(tid_)); make_ctx(c, *ap_, tid_); } \
    unsigned char* ws = c.ws; bf16_t* H = (bf16_t*)(ws + WS_H); bf16_t* PROJ = (bf16_t*)(ws + WS_PROJ); (void)H; (void)PROJ;
__global__ void __launch_bounds__(NTHREADS, 2) mega(Args a) {
    extern __shared__ __attribute__((aligned(16))) unsigned char lds_raw[];
    float* lds = (float*)lds_raw;
    if (threadIdx.x < 4) ((volatile XLAS unsigned*)(XLAS unsigned char*)lds_raw)[(LDS_BARST >> 2) + threadIdx.x] = 0u;
    __syncthreads();
    const XcdBarrier xbar = xcd_barrier_post((unsigned*)(a.ws + WS_CTL + CTL_BAR), (volatile XLAS unsigned*)((XLAS unsigned char*)lds_raw + LDS_BARST));
    PSTAMP(0); { PHASE_BEGIN(); phase_prologue(c, lds); PSTAMP(23); phase_norm_x(c, c.x, c.ev_norm, H); }
    xcd_barrier(xbar);
    PSTAMP(1); { PHASE_BEGIN(); pg8::EpiProj0T epi{PROJ, (float*)(ws + WS_LOGF), (const float*)(ws + WS_LB)}; phase_gemm_mfma(lds_raw, H, (const bf16_t*)(ws + WS_W0T), EVPP, D, epi); }
    xcd_barrier(xbar);
    PSTAMP(2); { PHASE_BEGIN();
      post_even(c, blockIdx.x, gridDim.x); PSTAMP(20);
      for (int u = blockIdx.x; u < 256; u += gridDim.x) compress_mfma(c, lds_raw, u);
      PSTAMP(21);
      for (int su = blockIdx.x; su < 256; su += gridDim.x) hgrn2_passA(c, lds_raw, su); }
    xcd_barrier(xbar);
    PSTAMP(24); { PHASE_BEGIN();
      for (int u = blockIdx.x; u < 64; u += gridDim.x) hgrn2_seq_full(c, lds_raw, u);
      PSTAMP(3); nsa_mfma(c, lds_raw); PSTAMP(22);
#ifdef PROBE_NSA_ABL
      nsa_mfma<PROBE_NSA_ABL, true>(c, lds_raw);
#endif
    }
    xcd_barrier(xbar);
    PSTAMP(4); { PHASE_BEGIN(); pg8::EpiResidF2B epi{c.x, (bf16_t*)(ws + WS_XB)}; phase_gemm_mfma(lds_raw, H, (const bf16_t*)(ws + WS_WO0T), D, D, epi); }
    xcd_barrier(xbar);
    PSTAMP(5); { PHASE_BEGIN(); phase_router2(c, lds_raw, 0); }
    xcd_barrier(xbar);
    PSTAMP(7); { PHASE_BEGIN(); phase_moe1_mfma(c, lds_raw, 0); }
    PSTAMP(8); { PHASE_BEGIN(); phase_moe2_mfma(c, lds_raw, 0); }
    xcd_barrier(xbar);
    PSTAMP(9); { PHASE_BEGIN(); phase_combine<false>(c, (bf16_t*)(ws + WS_XB), nullptr, c.od_norm, H, (const bf16_t*)(ws + WS_YS), 0); }
    xcd_barrier(xbar);
    PSTAMP(10); { PHASE_BEGIN(); pg8::EpiRawScaleT epi{PROJ, ODP, (const float*)(ws + WS_RSTD)}; phase_gemm_mfma(lds_raw, (const bf16_t*)(ws + WS_XB), (const bf16_t*)(ws + WS_W1T), ODP, D, epi); }
    xcd_barrier(xbar);
    PSTAMP(12); { PHASE_BEGIN(); swa_mfma(c, lds_raw); }
    xcd_barrier(xbar);
    PSTAMP(13); { PHASE_BEGIN(); pg8::EpiResidB2B epi{(bf16_t*)(ws + WS_XB)}; phase_gemm_mfma(lds_raw, H, (const bf16_t*)(ws + WS_WO1T), D, D, epi); }
    xcd_barrier(xbar);
    PSTAMP(14); { PHASE_BEGIN(); phase_router2(c, lds_raw, 1); }
    xcd_barrier(xbar);
    PSTAMP(16); { PHASE_BEGIN(); phase_moe1_mfma(c, lds_raw, 1); }
    PSTAMP(17); { PHASE_BEGIN(); phase_moe2_mfma(c, lds_raw, 1); }
    xcd_barrier(xbar);
    PSTAMP(18); { PHASE_BEGIN(); phase_combine<true>(c, (bf16_t*)(ws + WS_XB), c.xr, nullptr, nullptr, (const bf16_t*)(ws + WS_YS), 1); }
    PSTAMP(19);
#ifdef PROBE_TAIL
    PROBE_TAIL
#endif
}

extern "C" void kernel_launch(void* const* d_in, const int* in_sizes, int n_in, void* d_out, int out_size, void* d_ws, size_t ws_size, hipStream_t stream) {
    static int grid = 0;
    if (grid == 0) {
        if (n_in != 25 || ws_size < WS_END) { fprintf(stderr, "kernel_launch: unexpected n_in %d / ws %zu\n", n_in, ws_size); grid = -1; return; }
        int dev = 0, cus = 0, per_cu = 0;
        hipGetDevice(&dev);
        hipDeviceGetAttribute(&cus, hipDeviceAttributeMultiprocessorCount, dev);
        hipFuncSetAttribute((const void*)mega, hipFuncAttributeMaxDynamicSharedMemorySize, LDS_BYTES);
        hipOccupancyMaxActiveBlocksPerMultiprocessor(&per_cu, (const void*)mega, NTHREADS, LDS_BYTES);
        if (per_cu < 1) { fprintf(stderr, "kernel_launch: occupancy query says %d blocks/CU\n", per_cu); per_cu = 1; }
        (void)hipGetLastError();
        grid = cus;
    }
    if (grid < 0) return;
    hipMemsetAsync((char*)d_ws + WS_CTL, 0, CTL_BYTES, stream);
    Args a{};
    for (int i = 0; i < 25; ++i) a.in[i] = (const float*)d_in[i];
    a.out = (float*)d_out; a.ws = (unsigned char*)d_ws;
    void* args[] = {&a};
    hipError_t e = hipLaunchCooperativeKernel((const void*)mega, dim3(grid), dim3(NTHREADS), args, LDS_BYTES, stream);
    if (e != hipSuccess) fprintf(stderr, "cooperative launch failed: %s (grid %d)\n", hipGetErrorString(e), grid);
}
```

```cpp
#include <hip/hip_runtime.h>
#include <hip/hip_cooperative_groups.h>
#include <cstdio>
#include <cstdint>
namespace cg = cooperative_groups;

constexpr int D = 1024, BATCH = 16, SEQ = 4096, M = BATCH * SEQ;
constexpr int EVP = 3352, EVPP = 3584, ODP = 1280;
constexpr int NEXP = 32, FF = 512;
constexpr int NTHREADS = 512, NWAVES = 8;
constexpr int MAXTILES = 544;
constexpr int NSLOTS = MAXTILES * 256;
constexpr float EPS = 1e-6f;

typedef unsigned short bf16_t;
typedef unsigned int u32;

constexpr size_t MiB = 1u << 20;
constexpr size_t WS_CTL = 0;
constexpr size_t CTL_BYTES = 64 * 1024;
constexpr size_t WS_LB = 1 * MiB;
constexpr size_t WS_CBIAS = WS_LB + 4096;
constexpr size_t WS_ROPE = WS_LB + 8192;
constexpr size_t WS_KCB = 2 * MiB;
constexpr size_t WS_VCB = 3 * MiB;
constexpr size_t WS_TE = 4 * MiB;
constexpr size_t WS_TR = 4 * MiB + 512 * 1024;
constexpr size_t WS_TW = 5 * MiB;
constexpr size_t WS_TSLOT = 5 * MiB + 512 * 1024;
constexpr size_t WS_ROWTOK = 6 * MiB;
constexpr size_t WS_ROWW = 7 * MiB;
constexpr size_t WS_TILEE = 8 * MiB;
constexpr size_t WS_W0T = 16 * MiB;
constexpr size_t WS_WO0T = 23 * MiB;
constexpr size_t WS_W1T = 25 * MiB;
constexpr size_t WS_WO1T = 28 * MiB;
constexpr size_t WS_CW1T = 30 * MiB;
constexpr size_t WS_CW2T = 32 * MiB;
constexpr size_t WS_RW = 33 * MiB;
constexpr size_t WS_WGU = 40 * MiB;
constexpr size_t WS_WD = 168 * MiB;
constexpr size_t WS_H = 232 * MiB;
constexpr size_t WS_PROJ = 360 * MiB;
constexpr size_t WS_HID = WS_PROJ;
constexpr size_t WS_YS = WS_PROJ + 136 * MiB;
constexpr size_t WS_LOGF = 808 * MiB;
constexpr size_t WS_XB = WS_LOGF;
constexpr size_t WS_LIST = 936 * MiB;
constexpr size_t WS_RSL = 944 * MiB;
constexpr size_t WS_RSTD = 952 * MiB;
constexpr size_t WS_END = 953 * MiB;

constexpr int LDS_BYTES = 160 * 1024;
constexpr int LDS_BARST = LDS_BYTES - 16;
constexpr size_t CTL_BAR = 16 * 1024;
constexpr int CTL_QUEUE = 1024;

__device__ __forceinline__ float bf2f(bf16_t v) { return __uint_as_float(((u32)v) << 16); }
typedef float f32x2_t __attribute__((ext_vector_type(2))); typedef __bf16 bf16x2_t __attribute__((ext_vector_type(2)));
__device__ __forceinline__ u32 pk2(float lo, float hi) { f32x2_t v = {lo, hi}; bf16x2_t b = __builtin_convertvector(v, bf16x2_t); return __builtin_bit_cast(u32, b); }
__device__ __forceinline__ bf16_t f2bf(float f) { return (bf16_t)(pk2(f, 0.f) & 0xffffu); }
__device__ __forceinline__ float wsum(float v) {
#pragma unroll
    for (int o = 32; o; o >>= 1) v += __shfl_xor(v, o);
    return v;
}
__device__ __forceinline__ float wmax(float v) {
#pragma unroll
    for (int o = 32; o; o >>= 1) v = fmaxf(v, __shfl_xor(v, o));
    return v;
}
__device__ __forceinline__ void unpack8(const uint4& w, float* f) {
    f[0] = __uint_as_float(w.x << 16); f[1] = __uint_as_float(w.x & 0xffff0000u);
    f[2] = __uint_as_float(w.y << 16); f[3] = __uint_as_float(w.y & 0xffff0000u);
    f[4] = __uint_as_float(w.z << 16); f[5] = __uint_as_float(w.z & 0xffff0000u);
    f[6] = __uint_as_float(w.w << 16); f[7] = __uint_as_float(w.w & 0xffff0000u);
}
#define LDS_FENCE() asm volatile("s_waitcnt lgkmcnt(0)" ::: "memory")

#define XB_TMO      128
#define XB_XCNT(j)  (256  + 64 * (j))
#define XB_XSUB(j)  (1280 + 64 * (j))
#define XB_XGEN(j)  (2304 + 64 * (j))
#define XB_TOP      3328
#define XB_TOPGEN   3392
#define XCD_BAR_WORDS 3456
#define XB_SPIN_CAP (1u << 18)
#define XLAS __attribute__((address_space(3)))
__device__ __forceinline__ unsigned xb_ld(unsigned* p)              { return __hip_atomic_load(p, __ATOMIC_RELAXED, __HIP_MEMORY_SCOPE_AGENT); }
__device__ __forceinline__ unsigned xb_add(unsigned* p, unsigned v) { return __hip_atomic_fetch_add(p, v, __ATOMIC_RELAXED, __HIP_MEMORY_SCOPE_AGENT); }
__device__ __forceinline__ unsigned xb_xcc_id() { return (unsigned)__builtin_amdgcn_s_getreg((3 << 11) | 20) & 0xFu; }
#define XB_SPIN(cond, bar) do { unsigned _sp = 0; while (cond) { __builtin_amdgcn_s_sleep(1); \
    if ((++_sp & 255u) == 0u) { if (xb_ld(&(bar)[XB_TMO])) break; if (_sp > XB_SPIN_CAP) { atomicAdd(&(bar)[XB_TMO], 1u); break; } } } } while (0)
struct XcdBarrier { unsigned* bar; unsigned x; volatile XLAS unsigned* st; };
__device__ __forceinline__ XcdBarrier xcd_barrier_post(unsigned* bar, volatile XLAS unsigned* st) {
    XcdBarrier b; b.bar = bar; b.x = xb_xcc_id(); b.st = st;
    if (threadIdx.x == 0) (void)xb_add(&bar[XB_XCNT(b.x)], 1u);
    return b;
}
__device__ __forceinline__ void xcd_barrier_complete(unsigned* bar, unsigned x, unsigned& nloc, unsigned& nx) {
    const unsigned G = gridDim.x * gridDim.y * gridDim.z;
    unsigned sum, cnt, mine, sp = 0u;
    for (;;) {
        sum = 0u; cnt = 0u; mine = 0u;
#pragma unroll
        for (unsigned j = 0; j < 16; ++j) { const unsigned c = xb_ld(&bar[XB_XCNT(j)]); sum += c; cnt += (c > 0u) ? 1u : 0u; mine = (j == x) ? c : mine; }
        if (sum == G) break;
        __builtin_amdgcn_s_sleep(1);
        if ((++sp & 255u) == 0u) { if (xb_ld(&bar[XB_TMO])) break; if (sp > XB_SPIN_CAP) { atomicAdd(&bar[XB_TMO], 1u); break; } }
    }
    nloc = mine > 0u ? mine : 1u; nx = cnt > 0u ? cnt : 1u;
}
__device__ __forceinline__ void xcd_barrier(const XcdBarrier& b) {
    asm volatile("s_waitcnt vmcnt(0)" ::: "memory");
    __syncthreads();
    if (threadIdx.x == 0) {
        unsigned* bar = b.bar;
        __builtin_amdgcn_s_waitcnt(0);
        unsigned nloc = b.st[0], nx = b.st[1];
        if (nloc == 0u) { xcd_barrier_complete(bar, b.x, nloc, nx); b.st[0] = nloc; b.st[1] = nx; }
        const unsigned old = xb_add(&bar[XB_XSUB(b.x)], 1u);
        const unsigned gen = old / nloc;
        if (old + 1u == (gen + 1u) * nloc) {
            __builtin_amdgcn_fence(__ATOMIC_RELEASE, "agent");
            asm volatile("s_waitcnt vmcnt(0)" ::: "memory");
            const unsigned og = xb_add(&bar[XB_TOP], 1u);
            const unsigned tg = og / nx;
            if (og + 1u == (tg + 1u) * nx) xb_add(&bar[XB_TOPGEN], 1u);
            else XB_SPIN(xb_ld(&bar[XB_TOPGEN]) == tg, bar);
            __builtin_amdgcn_fence(__ATOMIC_ACQUIRE, "agent");
            xb_add(&bar[XB_XGEN(b.x)], 1u);
            asm volatile("s_waitcnt vmcnt(0)" ::: "memory");
        } else {
            XB_SPIN(xb_ld(&bar[XB_XGEN(b.x)]) == gen, bar);
            __builtin_amdgcn_fence(__ATOMIC_ACQUIRE, "agent");
            asm volatile("s_waitcnt vmcnt(0)" ::: "memory");
        }
    }
    __syncthreads();
}

struct Args {
    const float* in[25];
    float* out;
    unsigned char* ws;
};

struct Ctx {
    const float *x, *ev_norm, *ev_w_in, *hg_lb, *hg_gain, *nsa_qg, *nsa_kg, *cmp_pe, *cmp_w1, *cmp_w2, *ev_w_out;
    const float *od_norm, *od_w_in, *swa_qg, *swa_kg, *swa_sinks, *od_w_out;
    const float *moe_norm, *moe_w_grp, *moe_b_grp, *moe_w_exp, *moe_b_exp, *moe_w_gate, *moe_w_up, *moe_w_down;
    float* xr;
    unsigned char* ws;
    int tid, lane, wave, gw, ngw;
};

typedef const __attribute__((address_space(4))) Args CArgs;
__device__ __forceinline__ void make_ctx(Ctx& c, CArgs& a, int tid_) {
    c.x = a.in[0]; c.ev_norm = a.in[1]; c.ev_w_in = a.in[2]; c.hg_lb = a.in[3]; c.hg_gain = a.in[4]; c.nsa_qg = a.in[5]; c.nsa_kg = a.in[6]; c.cmp_pe = a.in[7];
    c.cmp_w1 = a.in[8]; c.cmp_w2 = a.in[9]; c.ev_w_out = a.in[10]; c.od_norm = a.in[11]; c.od_w_in = a.in[12]; c.swa_qg = a.in[13]; c.swa_kg = a.in[14]; c.swa_sinks = a.in[15];
    c.od_w_out = a.in[16]; c.moe_norm = a.in[17]; c.moe_w_grp = a.in[18]; c.moe_b_grp = a.in[19]; c.moe_w_exp = a.in[20]; c.moe_b_exp = a.in[21];
    c.moe_w_gate = a.in[22]; c.moe_w_up = a.in[23]; c.moe_w_down = a.in[24];
    c.xr = a.out; c.ws = a.ws;
    c.tid = tid_; c.lane = c.tid & 63; c.wave = c.tid >> 6; c.gw = blockIdx.x * NWAVES + c.wave; c.ngw = gridDim.x * NWAVES;
}

__device__ __forceinline__ void transpose_item(const float* W, int K, int Nsrc, bf16_t* WT, int drow0, int k0, int n0, float* scr, int lane, const float* gain = nullptr) {
    const int rk = lane >> 3, c4 = 4 * (lane & 7);
    float4 v[8];
#pragma unroll
    for (int i = 0; i < 8; ++i) v[i] = (n0 + c4 < Nsrc) ? *(const float4*)(W + (size_t)(k0 + 8 * i + rk) * Nsrc + n0 + c4) : make_float4(0.f, 0.f, 0.f, 0.f);
#pragma unroll
    for (int i = 0; i < 8; ++i) { float* d = scr + (8 * i + rk) * 33 + c4; d[0] = v[i].x; d[1] = v[i].y; d[2] = v[i].z; d[3] = v[i].w; }
    LDS_FENCE();
    const int c = lane & 7;
#pragma unroll
    for (int j = 0; j < 4; ++j) {
        const int n = (lane >> 3) + 8 * j;
        const float* s = scr + (8 * c) * 33 + n;
        uint4 o;
        float4 ga = make_float4(1.f, 1.f, 1.f, 1.f), gb = ga;
        if (gain) { ga = *(const float4*)(gain + k0 + 8 * c); gb = *(const float4*)(gain + k0 + 8 * c + 4); }
        o.x = pk2(s[0 * 33] * ga.x, s[1 * 33] * ga.y); o.y = pk2(s[2 * 33] * ga.z, s[3 * 33] * ga.w); o.z = pk2(s[4 * 33] * gb.x, s[5 * 33] * gb.y); o.w = pk2(s[6 * 33] * gb.z, s[7 * 33] * gb.w);
        *(uint4*)(WT + (size_t)(drow0 + n0 + n) * K + k0 + 8 * c) = o;
    }
    LDS_FENCE();
}

struct MoeItem { const float* W; bf16_t* WT; const float* gain; int K, N, drow0, k0, n0; };
constexpr int MOE_ITEMS = 3 * 64 * 512;
__device__ __forceinline__ void moe_item_decode(const Ctx& c, int r, MoeItem& it) {
    constexpr int IG = 64 * 512;
    bf16_t* WGU = (bf16_t*)(c.ws + WS_WGU); bf16_t* WDt = (bf16_t*)(c.ws + WS_WD);
    if (r < 2 * IG) {
        const bool up = r >= IG; if (up) r -= IG;
        const int le = r >> 9, q = r & 511, kb = q >> 4, nb = q & 15, n0 = 32 * nb;
        it.W = (up ? c.moe_w_up : c.moe_w_gate) + (size_t)le * 1024 * 512; it.WT = WGU + (size_t)le * 1024 * 1024; it.K = 1024; it.N = 512; it.gain = c.moe_norm + (le >> 5) * D;
        it.drow0 = (n0 >> 7) * 256 + (up ? 128 : 0) + (n0 & 127) - n0; it.k0 = 32 * kb; it.n0 = n0;
    } else {
        r -= 2 * IG; const int le = r >> 9, q = r & 511;
        it.W = c.moe_w_down + (size_t)le * 512 * 1024; it.WT = WDt + (size_t)le * 1024 * 512; it.K = 512; it.N = 1024; it.drow0 = 0; it.k0 = 32 * (q >> 5); it.n0 = 32 * (q & 31); it.gain = nullptr;
    }
}
struct MoeRegs { float4 a, b, c, d; };
__device__ __forceinline__ void moe_item_issue(const MoeItem& it, MoeRegs& v, int lane) {
    const float* p = it.W + (size_t)(it.k0 + 4 * (lane >> 3)) * it.N + it.n0 + 4 * (lane & 7); const size_t N = it.N;
    v.a = *(const float4*)(p); v.b = *(const float4*)(p + N); v.c = *(const float4*)(p + 2 * N); v.d = *(const float4*)(p + 3 * N);
}
__device__ __forceinline__ void moe_item_finish(const MoeItem& it, const MoeRegs& v, int lane) {
    bf16_t* o = it.WT + (size_t)(it.drow0 + it.n0 + 4 * (lane & 7)) * it.K + it.k0 + 4 * (lane >> 3);
    uint2 w;
    w.x = pk2(v.a.x, v.b.x); w.y = pk2(v.c.x, v.d.x); *(uint2*)(o) = w;
    w.x = pk2(v.a.y, v.b.y); w.y = pk2(v.c.y, v.d.y); *(uint2*)(o + it.K) = w;
    w.x = pk2(v.a.z, v.b.z); w.y = pk2(v.c.z, v.d.z); *(uint2*)(o + 2 * (size_t)it.K) = w;
    w.x = pk2(v.a.w, v.b.w); w.y = pk2(v.c.w, v.d.w); *(uint2*)(o + 3 * (size_t)it.K) = w;
}

__device__ __forceinline__ void phase_prologue(const Ctx& c, float* lds) {
    float* scr = lds + c.wave * (64 * 33);
    unsigned char* ws = c.ws;
    bf16_t* W0T = (bf16_t*)(ws + WS_W0T); bf16_t* WO0T = (bf16_t*)(ws + WS_WO0T); bf16_t* W1T = (bf16_t*)(ws + WS_W1T); bf16_t* WO1T = (bf16_t*)(ws + WS_WO1T);
    bf16_t* CW1T = (bf16_t*)(ws + WS_CW1T); bf16_t* CW2T = (bf16_t*)(ws + WS_CW2T);
    constexpr int I0 = 16 * 112, I1 = 16 * 32, I2 = 16 * 40, I3 = 16 * 32, I4 = 2 * 32 * 8, I5 = 2 * 4 * 2;
    constexpr int NITEMS = I0 + I1 + I2 + I3 + I4 + I5;
    for (int it = c.gw; it < NITEMS; it += c.ngw) {
        int r = it;
        if (r < I0) { transpose_item(c.ev_w_in, 1024, EVP, W0T, 0, 64 * (r / 112), 32 * (r % 112), scr, c.lane); continue; } r -= I0;
        if (r < I1) { transpose_item(c.ev_w_out, 1024, 1024, WO0T, 0, 64 * (r / 32), 32 * (r % 32), scr, c.lane); continue; } r -= I1;
        if (r < I2) { transpose_item(c.od_w_in, 1024, ODP, W1T, 0, 64 * (r / 40), 32 * (r % 40), scr, c.lane, c.od_norm); continue; } r -= I2;
        if (r < I3) { transpose_item(c.od_w_out, 1024, 1024, WO1T, 0, 64 * (r / 32), 32 * (r % 32), scr, c.lane); continue; } r -= I3;
        if (r < I4) { const int kind = r / 256, q = r % 256; transpose_item(c.cmp_w1 + (size_t)kind * 2048 * 256, 2048, 256, CW1T + (size_t)kind * 256 * 2048, 0, 64 * (q / 8), 32 * (q % 8), scr, c.lane); continue; } r -= I4;
        if (r < I5) { const int kind = r / 8, q = r % 8; transpose_item(c.cmp_w2 + (size_t)kind * 256 * 64, 256, 64, CW2T + (size_t)kind * 64 * 256, 0, 64 * (q / 2), 32 * (q % 2), scr, c.lane); continue; }
    }
    const int gt = blockIdx.x * NTHREADS + c.tid, ngt = gridDim.x * NTHREADS;
    float* LB = (float*)(ws + WS_LB);
    for (int i = gt; i < 512; i += ngt) { const float l0 = c.hg_lb[i], l1 = c.hg_lb[512 + i]; LB[i] = 1.f / (1.f + expf(l1 - l0)); }
    float* CB = (float*)(ws + WS_CBIAS);
    for (int i = c.gw; i < 512; i += c.ngw) {
        const int kind = i >> 8, cc = i & 255; float sacc = 0.f;
        for (int k = c.lane; k < 2048; k += 64) sacc += c.cmp_pe[kind * 2048 + k] * c.cmp_w1[((size_t)kind * 2048 + k) * 256 + cc];
        sacc = wsum(sacc);
        if (c.lane == 0) CB[i] = sacc;
    }
    bf16_t* RW = (bf16_t*)(ws + WS_RW);
    for (int i = gt; i < 2 * 48 * 1024; i += ngt) {
        const int k = i & 1023, o = (i >> 10) % 48, layer = i / (48 * 1024);
        float wv = 0.f;
        if (o < 36) wv = c.moe_norm[layer * D + k] * (o < 4 ? c.moe_w_grp[(size_t)layer * 1024 * 4 + k * 4 + o] : c.moe_w_exp[(size_t)layer * 1024 * 32 + k * 32 + (o - 4)]);
        const bf16_t hi = f2bf(wv); const bf16_t lo = f2bf(wv - bf2f(hi));
        RW[((size_t)layer * 48 + o) * 2048 + k] = hi; RW[((size_t)layer * 48 + o) * 2048 + 1024 + k] = lo;
    }
    float2* RT = (float2*)(ws + WS_ROPE);
    for (int i = gt; i < 4096 * 8; i += ngt) {
        const int pos = i >> 3, f = i & 7;
        const double inv = exp(-(double)f * 0.125 * 13.122363377404328);
        const double a = (double)pos * inv;
        const double r = a - 6.283185307179586476925 * rint(a / 6.283185307179586476925);
        const float rf = (float)r;
        RT[i] = make_float2(cosf(rf), sinf(rf));
    }
}

__device__ __forceinline__ void phase_norm_x(const Ctx& c, const float* src, const float* gain, bf16_t* H) {
    for (int m0 = 2 * c.gw; m0 < M; m0 += 2 * c.ngw) {
        float4 v[2][4];
#pragma unroll
        for (int u = 0; u < 2; ++u) { const float4* xr = (const float4*)(src + (size_t)(m0 + u) * D) + c.lane;
#pragma unroll
            for (int j = 0; j < 4; ++j) v[u][j] = xr[64 * j]; }
#pragma unroll
        for (int u = 0; u < 2; ++u) {
            float s = 0.f;
#pragma unroll
            for (int j = 0; j < 4; ++j) s += v[u][j].x * v[u][j].x + v[u][j].y * v[u][j].y + v[u][j].z * v[u][j].z + v[u][j].w * v[u][j].w;
            const float rstd = rsqrtf(wsum(s) * (1.f / D) + EPS);
            uint2* o = (uint2*)(H + (size_t)(m0 + u) * D) + c.lane;
#pragma unroll
            for (int j = 0; j < 4; ++j) {
                const float4 g = ((const float4*)gain)[c.lane + 64 * j];
                uint2 w; w.x = pk2(v[u][j].x * rstd * g.x, v[u][j].y * rstd * g.y); w.y = pk2(v[u][j].z * rstd * g.z, v[u][j].w * rstd * g.w);
                o[64 * j] = w;
            }
        }
    }
}
template <bool FINAL>
__device__ __forceinline__ void phase_combine(const Ctx& c, bf16_t* XB, float* out, const float* gain, bf16_t* H, const bf16_t* YS, int layer) {
    const float* TWp = (const float*)(c.ws + WS_TW); const int* TEp = (const int*)(c.ws + WS_TE); const int* TRp = (const int*)(c.ws + WS_TR);
    int psrow;
    { const int cnt = ((const int*)(c.ws + WS_CTL))[layer * 32 + (c.lane & 31)]; const int pc = (cnt + 255) & ~255; int incl = pc;
#pragma unroll
      for (int o = 1; o < 32; o <<= 1) { const int t_ = __shfl_up(incl, o, 32); if ((c.lane & 31) >= o) incl += t_; }
      psrow = incl - pc; }
    for (int m0 = 2 * c.gw; m0 < M; m0 += 2 * c.ngw) {
        uint2 xw[2][4], ya[2][4], yb[2][4]; float wa[2], wb[2];
#pragma unroll
        for (int u = 0; u < 2; ++u) {
            const int m = m0 + u; const int s0 = __shfl(psrow, TEp[2 * m]) + TRp[2 * m], s1 = __shfl(psrow, TEp[2 * m + 1]) + TRp[2 * m + 1]; wa[u] = TWp[2 * m]; wb[u] = TWp[2 * m + 1];
            const uint2* xr = (const uint2*)(XB + (size_t)m * D) + c.lane; const uint2* y0 = (const uint2*)(YS + (size_t)s0 * D) + c.lane; const uint2* y1 = (const uint2*)(YS + (size_t)s1 * D) + c.lane;
#pragma unroll
            for (int j = 0; j < 4; ++j) { xw[u][j] = xr[64 * j]; ya[u][j] = y0[64 * j]; yb[u][j] = y1[64 * j]; }
        }
#pragma unroll
        for (int u = 0; u < 2; ++u) {
            const int m = m0 + u;
            float4 v[4]; float s = 0.f;
#pragma unroll
            for (int j = 0; j < 4; ++j) {
                v[j].x = __uint_as_float(xw[u][j].x << 16) + wa[u] * __uint_as_float(ya[u][j].x << 16) + wb[u] * __uint_as_float(yb[u][j].x << 16);
                v[j].y = __uint_as_float(xw[u][j].x & 0xffff0000u) + wa[u] * __uint_as_float(ya[u][j].x & 0xffff0000u) + wb[u] * __uint_as_float(yb[u][j].x & 0xffff0000u);
                v[j].z = __uint_as_float(xw[u][j].y << 16) + wa[u] * __uint_as_float(ya[u][j].y << 16) + wb[u] * __uint_as_float(yb[u][j].y << 16);
                v[j].w = __uint_as_float(xw[u][j].y & 0xffff0000u) + wa[u] * __uint_as_float(ya[u][j].y & 0xffff0000u) + wb[u] * __uint_as_float(yb[u][j].y & 0xffff0000u);
                s += v[j].x * v[j].x + v[j].y * v[j].y + v[j].z * v[j].z + v[j].w * v[j].w;
            }
            if (FINAL) {
                float4* xo = (float4*)(out + (size_t)m * D) + c.lane;
#pragma unroll
                for (int j = 0; j < 4; ++j) xo[64 * j] = v[j];
            } else {
                uint2* xo = (uint2*)(XB + (size_t)m * D) + c.lane;
#pragma unroll
                for (int j = 0; j < 4; ++j) { uint2 w; w.x = pk2(v[j].x, v[j].y); w.y = pk2(v[j].z, v[j].w); xo[64 * j] = w; }
                float s2 = 0.f;
#pragma unroll
                for (int j = 0; j < 4; ++j) { const float a0 = bf2f(f2bf(v[j].x)), a1 = bf2f(f2bf(v[j].y)), a2 = bf2f(f2bf(v[j].z)), a3 = bf2f(f2bf(v[j].w)); s2 += a0 * a0 + a1 * a1 + a2 * a2 + a3 * a3; }
                const float rstd = rsqrtf(wsum(s2) * (1.f / D) + EPS);
                if (c.lane == 0) ((float*)(c.ws + WS_RSTD))[m] = rstd;
            }
        }
    }
}

namespace pg8 {
#define PG8_LAS __attribute__((address_space(3)))
typedef short bf16x8 __attribute__((ext_vector_type(8)));
typedef float f32x4 __attribute__((ext_vector_type(4)));
typedef unsigned u32x4 __attribute__((ext_vector_type(4)));
constexpr int BM = 256, BK = 64, HALF = 128, HTB = HALF * BK * 2, STAGE_BYTES = 8 * HTB, NXCD = 8, WGM = 8;
__device__ __forceinline__ int lds_byte(int r, int c) { const int st = (r >> 4) * 2 + (c >> 5), rr = r & 15, cc = c & 31, ob = rr * 64 + cc * 2; return st * 1024 + (ob ^ (((ob >> 9) & 1) << 5)); }
__device__ __forceinline__ void stage_rc(int b, int& R, int& C) { const int st = b / 1024, sb = b % 1024, swz = sb ^ (((sb >> 9) & 1) << 5); R = (st >> 1) * 16 + swz / 64; C = (st & 1) * 32 + (swz % 64) / 2; }
__device__ __forceinline__ int perm32(int rho) { const int n = rho >> 4, i = rho & 15; return 8 * (i >> 2) + 4 * n + (i & 3); }
struct Unit { int pm, pn, e, nvalid, gbase; };
struct Gemm { const bf16_t* A; const bf16_t* Bt; int K; const int* gather; size_t bstride; };
struct StaticOrder {
    int nM, nN, nwg, G, c;
    __device__ __forceinline__ void init(int Mr, int N, int G_, int c_) { nM = Mr / BM; nN = N / BM; nwg = nM * nN; G = G_; c = c_; }
    __device__ __forceinline__ bool next(int i, Unit& u) const {
        const long L = (long)i * G + c; if (L >= nwg) return false;
        int wgid = (int)L; { const int q = nwg / NXCD, r = nwg % NXCD, xcd = wgid % NXCD, off = wgid / NXCD; wgid = (xcd < r ? xcd * (q + 1) : r * (q + 1) + (xcd - r) * q) + off; }
        const int nig = WGM * nN, gid = wgid / nig, fm = gid * WGM, gsz = (nM - fm) < WGM ? (nM - fm) : WGM;
        u.pm = fm + ((wgid % nig) % gsz); u.pn = (wgid % nig) / gsz; u.e = 0; u.nvalid = BM; u.gbase = 0; return true;
    }
};
struct MoeOrder {
    const int* te; const int* tv; const int* tg; int nwg, G, c;
    __device__ __forceinline__ bool next(int i, Unit& u) const {
        const long L = (long)i * G + c; if (L >= nwg) return false;
        int wgid = (int)L; { const int q = nwg / NXCD, r = nwg % NXCD, xcd = wgid % NXCD, off = wgid / NXCD; wgid = (xcd < r ? xcd * (q + 1) : r * (q + 1) + (xcd - r) * q) + off; }
        u.pm = wgid >> 2; u.pn = wgid & 3; u.e = te[u.pm]; u.nvalid = tv[u.pm]; u.gbase = tg[u.pm]; return true;
    }
};
__device__ __forceinline__ unsigned cvt_pk_bf16(float lo, float hi) { unsigned r; asm volatile("v_cvt_pk_bf16_f32 %0, %1, %2" : "=v"(r) : "v"(lo), "v"(hi)); return r; }

struct EpiRawScaleT { static constexpr bool PERM = true; bf16_t* O; int ldc; const float* RS;
    __device__ __forceinline__ void operator()(const f32x4 (&acc)[2][2][4][2], const Unit& u, int wr, int wc, int fr, int fq) const {
        const int row0 = u.pm * BM + wr * 64 + fr, col0 = u.pn * BM + wc * 32 + 8 * fq;
#pragma unroll
        for (int ai = 0; ai < 2; ++ai)
#pragma unroll
            for (int m = 0; m < 4; ++m) { const int r = row0 + ai * HALF + m * 16; const float sc = RS[r]; bf16_t* rowp = O + (size_t)r * ldc + col0;
#pragma unroll
                for (int bj = 0; bj < 2; ++bj) { const f32x4 v0 = acc[ai][bj][m][0] * sc, v1 = acc[ai][bj][m][1] * sc; u32x4 w;
                    w.x = cvt_pk_bf16(v0[0], v0[1]); w.y = cvt_pk_bf16(v0[2], v0[3]); w.z = cvt_pk_bf16(v1[0], v1[1]); w.w = cvt_pk_bf16(v1[2], v1[3]);
                    *(u32x4*)(rowp + bj * HALF) = w; } }
    } };
struct EpiProj0T { static constexpr bool PERM = true; bf16_t* O; float* LOGF; const float* LB;
    __device__ __forceinline__ void operator()(const f32x4 (&acc)[2][2][4][2], const Unit& u, int wr, int wc, int fr, int fq) const {
        const int row0 = u.pm * BM + wr * 64 + fr, col0 = u.pn * BM + wc * 32 + 8 * fq;
        const bool isf = (u.pn == 2 || u.pn == 3);
#pragma unroll
        for (int ai = 0; ai < 2; ++ai)
#pragma unroll
            for (int m = 0; m < 4; ++m) { const size_t r = (size_t)(row0 + ai * HALF + m * 16); bf16_t* rowp = O + r * EVPP + col0;
#pragma unroll
                for (int bj = 0; bj < 2; ++bj) { f32x4 v0 = acc[ai][bj][m][0], v1 = acc[ai][bj][m][1];
                    if (isf) {
                        const int cc = col0 + bj * HALF - 512; const f32x4 lb0 = *(const f32x4*)(LB + cc), lb1 = *(const f32x4*)(LB + cc + 4);
                        f32x4 lf0, lf1;
#pragma unroll
                        for (int j = 0; j < 4; ++j) {
                            { const float z = v0[j], lb = lb0[j], sg = 1.f / (1.f + __expf(-z)), sn = 1.f / (1.f + __expf(z)); lf0[j] = __logf(lb + (1.f - lb) * sg); v0[j] = (1.f - lb) * sn; }
                            { const float z = v1[j], lb = lb1[j], sg = 1.f / (1.f + __expf(-z)), sn = 1.f / (1.f + __expf(z)); lf1[j] = __logf(lb + (1.f - lb) * sg); v1[j] = (1.f - lb) * sn; }
                        }
                        *(f32x4*)(LOGF + r * 512 + cc) = lf0; *(f32x4*)(LOGF + r * 512 + cc + 4) = lf1;
                    }
                    u32x4 w; w.x = cvt_pk_bf16(v0[0], v0[1]); w.y = cvt_pk_bf16(v0[2], v0[3]); w.z = cvt_pk_bf16(v1[0], v1[1]); w.w = cvt_pk_bf16(v1[2], v1[3]);
                    *(u32x4*)(rowp + bj * HALF) = w; } }
    } };
struct EpiResidF2B { static constexpr bool PERM = true; const float* X; bf16_t* O;
    __device__ __forceinline__ void operator()(const f32x4 (&acc)[2][2][4][2], const Unit& u, int wr, int wc, int fr, int fq) const {
        const int row0 = u.pm * BM + wr * 64 + fr, col0 = u.pn * BM + wc * 32 + 8 * fq;
#pragma unroll
        for (int ai = 0; ai < 2; ++ai)
#pragma unroll
            for (int m = 0; m < 4; ++m) { const size_t off = (size_t)(row0 + ai * HALF + m * 16) * D + col0;
#pragma unroll
                for (int bj = 0; bj < 2; ++bj) { const f32x4 x0 = *(const f32x4*)(X + off + bj * HALF), x1 = *(const f32x4*)(X + off + bj * HALF + 4);
                    const f32x4 v0 = x0 + acc[ai][bj][m][0], v1 = x1 + acc[ai][bj][m][1]; u32x4 w;
                    w.x = cvt_pk_bf16(v0[0], v0[1]); w.y = cvt_pk_bf16(v0[2], v0[3]); w.z = cvt_pk_bf16(v1[0], v1[1]); w.w = cvt_pk_bf16(v1[2], v1[3]);
                    *(u32x4*)(O + off + bj * HALF) = w; } }
    } };
struct EpiResidB2B { static constexpr bool PERM = true; bf16_t* XO;
    __device__ __forceinline__ void operator()(const f32x4 (&acc)[2][2][4][2], const Unit& u, int wr, int wc, int fr, int fq) const {
        const int row0 = u.pm * BM + wr * 64 + fr, col0 = u.pn * BM + wc * 32 + 8 * fq;
#pragma unroll
        for (int ai = 0; ai < 2; ++ai)
#pragma unroll
            for (int m = 0; m < 4; ++m) { const size_t off = (size_t)(row0 + ai * HALF + m * 16) * D + col0;
#pragma unroll
                for (int bj = 0; bj < 2; ++bj) { const u32x4 xw = *(const u32x4*)(XO + off + bj * HALF);
                    const f32x4 a0 = acc[ai][bj][m][0], a1 = acc[ai][bj][m][1]; u32x4 w;
                    w.x = cvt_pk_bf16(__uint_as_float(xw.x << 16) + a0[0], __uint_as_float(xw.x & 0xffff0000u) + a0[1]); w.y = cvt_pk_bf16(__uint_as_float(xw.y << 16) + a0[2], __uint_as_float(xw.y & 0xffff0000u) + a0[3]);
                    w.z = cvt_pk_bf16(__uint_as_float(xw.z << 16) + a1[0], __uint_as_float(xw.z & 0xffff0000u) + a1[1]); w.w = cvt_pk_bf16(__uint_as_float(xw.w << 16) + a1[2], __uint_as_float(xw.w & 0xffff0000u) + a1[3]);
                    *(u32x4*)(XO + off + bj * HALF) = w; } }
    } };
struct EpiGUT { static constexpr bool PERM = true; bf16_t* HID; const float* RSL;
    __device__ __forceinline__ void operator()(const f32x4 (&acc)[2][2][4][2], const Unit& u, int wr, int wc, int fr, int fq) const {
        const int lr0 = wr * 64 + fr, row0 = u.pm * BM + lr0, col0 = u.pn * HALF + wc * 32 + 8 * fq;
        float rs[2][4];
#pragma unroll
        for (int ai = 0; ai < 2; ++ai)
#pragma unroll
            for (int m = 0; m < 4; ++m) { const int lr = lr0 + ai * HALF + m * 16; rs[ai][m] = RSL[u.gbase + (lr < u.nvalid ? lr : 0)]; }
#pragma unroll
        for (int ai = 0; ai < 2; ++ai)
#pragma unroll
            for (int m = 0; m < 4; ++m) { bf16_t* rowp = HID + (size_t)(row0 + ai * HALF + m * 16) * FF + col0; float h[8]; const float r_ = rs[ai][m];
#pragma unroll
                for (int n = 0; n < 2; ++n)
#pragma unroll
                    for (int j = 0; j < 4; ++j) { const float g = acc[ai][0][m][n][j] * r_, uu = acc[ai][1][m][n][j] * r_; h[4 * n + j] = g / (1.f + __expf(-g)) * uu; }
                u32x4 w; w.x = cvt_pk_bf16(h[0], h[1]); w.y = cvt_pk_bf16(h[2], h[3]); w.z = cvt_pk_bf16(h[4], h[5]); w.w = cvt_pk_bf16(h[6], h[7]);
                *(u32x4*)rowp = w; }
    } };
struct EpiDownT { static constexpr bool PERM = true; bf16_t* YS;
    __device__ __forceinline__ void operator()(const f32x4 (&acc)[2][2][4][2], const Unit& u, int wr, int wc, int fr, int fq) const {
        const int row0 = u.pm * BM + wr * 64 + fr, col0 = u.pn * BM + wc * 32 + 8 * fq;
#pragma unroll
        for (int ai = 0; ai < 2; ++ai)
#pragma unroll
            for (int m = 0; m < 4; ++m) { bf16_t* rowp = YS + (size_t)(row0 + ai * HALF + m * 16) * D + col0;
#pragma unroll
                for (int bj = 0; bj < 2; ++bj) { const f32x4 v0 = acc[ai][bj][m][0], v1 = acc[ai][bj][m][1]; u32x4 w;
                    w.x = cvt_pk_bf16(v0[0], v0[1]); w.y = cvt_pk_bf16(v0[2], v0[3]); w.z = cvt_pk_bf16(v1[0], v1[1]); w.w = cvt_pk_bf16(v1[2], v1[3]);
                    *(u32x4*)(rowp + bj * HALF) = w; } }
    } };

template <class Epi, class Sched, bool GATHER>
__device__ __forceinline__ void gemm_phase(PG8_LAS unsigned char* lds, const Gemm g, const Sched& S, const Epi& E) {
    int tid_o = threadIdx.x; asm volatile("" : "+v"(tid_o));
    const int tid = tid_o, wid = __builtin_amdgcn_readfirstlane(tid >> 6), lane = tid & 63, wr = wid >> 2, wc = wid & 3, fr = lane & 15, fq = lane >> 4;
    const int K = g.K, nt = K / BK;
    int stR[2], stC[2]; unsigned voffB[2];
#pragma unroll
    for (int i = 0; i < 2; ++i) { int R, C; stage_rc(tid * 16 + i * 8192, R, C); const int Rb = Epi::PERM ? ((R & ~31) + perm32(R & 31)) : R; stR[i] = R; stC[i] = C; voffB[i] = (unsigned)(Rb * K + C) * 2u; }
    const size_t kstep = (size_t)(BK * 2);
    const size_t hstep = (size_t)HALF * K * 2;
    const size_t tstep = 2 * hstep;
    const unsigned ldsw = (unsigned)wid * 1024u;
    const int aoff = lds_byte(wr * 64 + fr, fq * 8), boff = lds_byte(wc * 32 + fr, fq * 8);
#define PG8_SA(b, h) (((b) * 2 + (h)) * HTB)
#define PG8_SB(b, h) ((4 + (b) * 2 + (h)) * HTB)
#define PG8_STAGE(bufoff, gbase, voff) do { _Pragma("unroll") for (int _i = 0; _i < 2; ++_i) \
        __builtin_amdgcn_global_load_lds((const unsigned*)((const char*)(gbase) + (voff)[_i]), (PG8_LAS unsigned*)(lds + (bufoff) + ldsw + _i * 8192), 16, 0, 0); } while (0)
#define PG8_LDA(dst, b, h) do { _Pragma("unroll") for (int m = 0; m < 4; ++m) _Pragma("unroll") for (int k = 0; k < 2; ++k) dst[m][k] = *(const PG8_LAS bf16x8*)(lds + PG8_SA(b, h) + aoff + m * 2048 + k * 1024); } while (0)
#define PG8_LDB(dst, b, h) do { _Pragma("unroll") for (int n = 0; n < 2; ++n) _Pragma("unroll") for (int k = 0; k < 2; ++k) dst[n][k] = *(const PG8_LAS bf16x8*)(lds + PG8_SB(b, h) + boff + n * 2048 + k * 1024); } while (0)
#define PG8_MMA(ai, bj, At, Bt) do { __builtin_amdgcn_s_setprio(1); _Pragma("unroll") for (int m = 0; m < 4; ++m) _Pragma("unroll") for (int n = 0; n < 2; ++n) _Pragma("unroll") for (int k = 0; k < 2; ++k) \
        acc[ai][bj][m][n] = __builtin_amdgcn_mfma_f32_16x16x32_bf16(Bt[n][k], At[m][k], acc[ai][bj][m][n], 0, 0, 0); __builtin_amdgcn_s_setprio(0); } while (0)
#define PG8_WAIT_V(n) asm volatile("s_waitcnt vmcnt(" #n ")" ::: "memory")
#define PG8_WAIT_L(n) asm volatile("s_waitcnt lgkmcnt(" #n ")" ::: "memory")
#define PG8_BAR __builtin_amdgcn_s_barrier()
#define PG8_SCHED __builtin_amdgcn_sched_barrier(0)
#define PG8_OFFS(dst, u) do { _Pragma("unroll") for (int _h = 0; _h < 2; ++_h) _Pragma("unroll") for (int _i = 0; _i < 2; ++_i) { \
        int _row = (u).pm * BM + _h * HALF + stR[_i]; if (GATHER) { const int _lr = _h * HALF + stR[_i]; _row = _lr < (u).nvalid ? g.gather[(u).gbase + _lr] : 0; } dst[_h][_i] = (unsigned)(_row * K + stC[_i]) * 2u; } } while (0)
    Unit cur, nxt; int ui = 0;
    if (!S.next(0, cur)) return;
    f32x4 acc[2][2][4][2];
#pragma unroll
    for (int a = 0; a < 2; ++a)
#pragma unroll
        for (int b = 0; b < 2; ++b)
#pragma unroll
            for (int m = 0; m < 4; ++m)
#pragma unroll
                for (int n = 0; n < 2; ++n) acc[a][b][m][n] = (f32x4){0.f, 0.f, 0.f, 0.f};
    bf16x8 At[4][2], B0[2][2], B1[2][2];
    unsigned offC[2][2], offN[2][2];
    PG8_OFFS(offC, cur);
    const char* const A0 = (const char*)g.A;
    const char* cB = (const char*)g.Bt + ((size_t)cur.e * g.bstride) * 2 + (size_t)cur.pn * tstep;
    PG8_STAGE(PG8_SB(0, 0), cB, voffB); PG8_STAGE(PG8_SB(0, 1), cB + hstep, voffB); PG8_STAGE(PG8_SA(0, 0), A0, offC[0]); PG8_STAGE(PG8_SA(0, 1), A0, offC[1]);
    if (wr == 1) PG8_BAR;
    PG8_WAIT_V(2); PG8_BAR;
    PG8_STAGE(PG8_SB(1, 0), cB + kstep, voffB); PG8_STAGE(PG8_SA(1, 0), A0 + kstep, offC[0]); PG8_STAGE(PG8_SB(1, 1), cB + hstep + kstep, voffB);
    PG8_WAIT_V(6); PG8_BAR;
    for (;;) {
        const bool has_next = S.next(ui + 1, nxt);
        const char* nB = cB;
        if (has_next) { PG8_OFFS(offN, nxt); nB = (const char*)g.Bt + ((size_t)nxt.e * g.bstride) * 2 + (size_t)nxt.pn * tstep; }
        else {
#pragma unroll
            for (int _h = 0; _h < 2; ++_h)
#pragma unroll
                for (int _i = 0; _i < 2; ++_i) offN[_h][_i] = offC[_h][_i];
        }
        for (int t = 0; t < nt; t += 2) {
            const bool last = (t == nt - 2);
            const char* a1 = A0 + (size_t)(t + 1) * kstep;
            const char* a2 = A0 + (last ? (size_t)0 : (size_t)(t + 2) * kstep); const char* b2 = last ? nB : cB + (size_t)(t + 2) * kstep;
            const char* a3 = a2 + kstep; const char* b3 = b2 + kstep;
            unsigned off2[2][2];
            if (last) {
#pragma unroll
                for (int _h = 0; _h < 2; ++_h)
#pragma unroll
                    for (int _i = 0; _i < 2; ++_i) off2[_h][_i] = offN[_h][_i];
            } else {
#pragma unroll
                for (int _h = 0; _h < 2; ++_h)
#pragma unroll
                    for (int _i = 0; _i < 2; ++_i) off2[_h][_i] = offC[_h][_i];
            }
            PG8_LDB(B0, 0, 0); PG8_LDB(B1, 0, 1); PG8_SCHED; PG8_LDA(At, 0, 0); PG8_STAGE(PG8_SA(1, 1), a1, offC[1]);
            PG8_WAIT_V(8); PG8_WAIT_L(0); PG8_BAR; PG8_MMA(0, 0, At, B0); PG8_MMA(0, 1, At, B1); PG8_BAR; PG8_SCHED;
            PG8_LDA(At, 0, 1); PG8_STAGE(PG8_SB(0, 0), b2, voffB); PG8_STAGE(PG8_SB(0, 1), b2 + hstep, voffB); PG8_STAGE(PG8_SA(0, 0), a2, off2[0]);
            PG8_WAIT_V(8); PG8_WAIT_L(0); PG8_BAR; PG8_MMA(1, 0, At, B0); PG8_MMA(1, 1, At, B1); PG8_BAR; PG8_SCHED;
            PG8_LDB(B0, 1, 0); PG8_LDB(B1, 1, 1); PG8_SCHED; PG8_LDA(At, 1, 0); PG8_STAGE(PG8_SA(0, 1), a2, off2[1]);
            PG8_WAIT_V(8); PG8_WAIT_L(0); PG8_BAR; PG8_MMA(0, 0, At, B0); PG8_MMA(0, 1, At, B1); PG8_BAR; PG8_SCHED;
            PG8_LDA(At, 1, 1); PG8_STAGE(PG8_SB(1, 0), b3, voffB); PG8_STAGE(PG8_SB(1, 1), b3 + hstep, voffB); PG8_STAGE(PG8_SA(1, 0), a3, off2[0]);
            PG8_WAIT_V(8); PG8_WAIT_L(0); PG8_BAR; PG8_MMA(1, 0, At, B0); PG8_MMA(1, 1, At, B1); PG8_BAR; PG8_SCHED;
        }
        if (wr == 0) PG8_BAR;
        E(acc, cur, wr, wc, fr, fq);
        if (!has_next) break;
#pragma unroll
        for (int a = 0; a < 2; ++a)
#pragma unroll
            for (int b = 0; b < 2; ++b)
#pragma unroll
                for (int m = 0; m < 4; ++m)
#pragma unroll
                    for (int n = 0; n < 2; ++n) acc[a][b][m][n] = (f32x4){0.f, 0.f, 0.f, 0.f};
        cur = nxt; cB = nB; ++ui;
#pragma unroll
        for (int _h = 0; _h < 2; ++_h)
#pragma unroll
            for (int _i = 0; _i < 2; ++_i) offC[_h][_i] = offN[_h][_i];
        if (wr == 1) PG8_BAR;
    }
    PG8_WAIT_V(0);
    PG8_BAR;
#undef PG8_SA
#undef PG8_SB
#undef PG8_STAGE
#undef PG8_LDA
#undef PG8_LDB
#undef PG8_MMA
#undef PG8_WAIT_V
#undef PG8_WAIT_L
#undef PG8_BAR
#undef PG8_SCHED
#undef PG8_OFFS
}
}

__device__ __forceinline__ void normrope64(bf16_t* p, const float* gain, const float2* rt  ) {
    uint4 w[8]; float f[64];
#pragma unroll
    for (int i = 0; i < 8; ++i) { w[i] = ((const uint4*)p)[i]; unpack8(w[i], f + 8 * i); }
    float s = 0.f;
#pragma unroll
    for (int i = 0; i < 64; ++i) s += f[i] * f[i];
    const float rstd = rsqrtf(s * (1.f / 64.f) + EPS);
#pragma unroll
    for (int i = 0; i < 64; ++i) f[i] = f[i] * rstd * gain[i];
#pragma unroll
    for (int i = 0; i < 8; ++i) { const float2 cs = rt[i]; const float x1 = f[i], x2 = f[8 + i]; f[i] = x1 * cs.x - x2 * cs.y; f[8 + i] = x2 * cs.x + x1 * cs.y; }
#pragma unroll
    for (int i = 0; i < 8; ++i) { uint4 o; o.x = pk2(f[8 * i], f[8 * i + 1]); o.y = pk2(f[8 * i + 2], f[8 * i + 3]); o.z = pk2(f[8 * i + 4], f[8 * i + 5]); o.w = pk2(f[8 * i + 6], f[8 * i + 7]); ((uint4*)p)[i] = o; }
}

__device__ __forceinline__ void post_even(const Ctx& c, int vb, int nvb) {
    bf16_t* P = (bf16_t*)(c.ws + WS_PROJ); const float2* RT = (const float2*)(c.ws + WS_ROPE);
    const long total = (long)M * 4;
    for (long it = (long)vb * NTHREADS + c.tid; it < total; it += (long)nvb * NTHREADS) {
        const int m = (int)(it >> 2), s = (int)(it & 3); const int pos = m & (SEQ - 1);
        int col; const float* gain;
        if (s < 2) { col = 2816 + 64 * s; gain = c.nsa_kg + 64; }
        else { col = 3072 + 64 * (s - 2); gain = c.nsa_kg + 128; }
        normrope64(P + (size_t)m * EVPP + col, gain, RT + pos * 8);
    }
}
__device__ __forceinline__ float gelu_tanh(float x) { const float u = 0.7978845608028654f * (x + 0.044715f * x * x * x); return 0.5f * x * (1.f + tanhf(u)); }

__device__ __forceinline__ void compress_mfma(const Ctx& c, unsigned char* lds, int unit) {
    typedef short bf16x8 __attribute__((ext_vector_type(8)));
    typedef float f32x4 __attribute__((ext_vector_type(4)));
    const int kind = unit >> 7, b = (unit >> 3) & 15, g = (unit >> 2) & 1, n0 = (unit & 3) * 64;
    const bf16_t* P = (const bf16_t*)(c.ws + WS_PROJ);
    const bf16_t* W1 = (const bf16_t*)(c.ws + WS_CW1T) + (size_t)kind * 256 * 2048; const bf16_t* W2 = (const bf16_t*)(c.ws + WS_CW2T) + (size_t)kind * 64 * 256;
    const float* CB = (const float*)(c.ws + WS_CBIAS) + kind * 256; const float2* RT = (const float2*)(c.ws + WS_ROPE);
    bf16_t* OUTB = (bf16_t*)(c.ws + (kind == 0 ? WS_KCB : WS_VCB)) + (size_t)((b * 2 + g) * 256) * 64;
    const int tid = c.tid, lane = c.lane, w = c.wave, l15 = lane & 15, g4 = lane >> 4;
    constexpr int HP = 264;
    bf16_t* HS = (bf16_t*)lds; float* OS = (float*)(lds + 64 * HP * 2);
    constexpr int NTOK = 1040;
    static_assert(NTOK * 128 <= 160 * 1024 - 16, "compress input image");
    __syncthreads();
    {
        const bf16_t* src0 = P + ((size_t)b * SEQ) * EVPP + 2560 + kind * 128 + g * 64;
        const int tok0 = 16 * n0;
        uint4 stg[17];
#pragma unroll
        for (int x = 0; x < 17; ++x) { int idx = tid + 512 * x; if (idx > NTOK * 8 - 1) idx = NTOK * 8 - 1;
            int tk = tok0 + (idx >> 3); if (tk > SEQ - 1) tk = SEQ - 1; stg[x] = *(const uint4*)(src0 + (size_t)tk * EVPP + 8 * (idx & 7)); }
#pragma unroll
        for (int x = 0; x < 17; ++x) { int idx = tid + 512 * x; if (idx > NTOK * 8 - 1) idx = NTOK * 8 - 1; const int t = idx >> 3, cch = idx & 7; *(uint4*)(lds + t * 128 + ((cch ^ ((t >> 4) & 7)) << 4)) = stg[x]; }
    }
    __syncthreads();
    f32x4 acc[4][2];
#pragma unroll
    for (int mt = 0; mt < 4; ++mt) { acc[mt][0] = (f32x4){0.f, 0.f, 0.f, 0.f}; acc[mt][1] = (f32x4){0.f, 0.f, 0.f, 0.f}; }
    const bf16_t* wb0 = W1 + (size_t)(32 * w + l15) * 2048 + 8 * g4; const bf16_t* wb1 = wb0 + (size_t)16 * 2048;
#pragma unroll 8
    for (int ks = 0; ks < 64; ++ks) {
        const int tt = ks >> 1, cch = 4 * (ks & 1) + g4;
        const bf16x8 b0 = *(const bf16x8*)(wb0 + 32 * ks), b1 = *(const bf16x8*)(wb1 + 32 * ks);
#pragma unroll
        for (int mt = 0; mt < 4; ++mt) {
            const int t = 16 * (16 * mt + l15) + tt;
            const bf16x8 af = *(const bf16x8*)(lds + t * 128 + ((cch ^ ((t >> 4) & 7)) << 4));
            acc[mt][0] = __builtin_amdgcn_mfma_f32_16x16x32_bf16(af, b0, acc[mt][0], 0, 0, 0);
            acc[mt][1] = __builtin_amdgcn_mfma_f32_16x16x32_bf16(af, b1, acc[mt][1], 0, 0, 0);
        }
    }
    __syncthreads();
#pragma unroll
    for (int mt = 0; mt < 4; ++mt)
#pragma unroll
        for (int nt = 0; nt < 2; ++nt) { const int cc = 32 * w + 16 * nt + l15; const float bias = CB[cc];
#pragma unroll
            for (int r = 0; r < 4; ++r) HS[(16 * mt + 4 * g4 + r) * HP + cc] = f2bf(gelu_tanh(acc[mt][nt][r] + bias)); }
    __syncthreads();
    {
        const int mt = w >> 1, nt0 = 2 * (w & 1);
        f32x4 o0 = {0.f, 0.f, 0.f, 0.f}, o1 = {0.f, 0.f, 0.f, 0.f};
        const bf16_t* ar = HS + (16 * mt + l15) * HP + 8 * g4;
        const bf16_t* br0 = W2 + (size_t)(16 * nt0 + l15) * 256 + 8 * g4; const bf16_t* br1 = br0 + 16 * 256;
#pragma unroll
        for (int ks = 0; ks < 8; ++ks) {
            const bf16x8 af = *(const bf16x8*)(ar + 32 * ks);
            o0 = __builtin_amdgcn_mfma_f32_16x16x32_bf16(af, *(const bf16x8*)(br0 + 32 * ks), o0, 0, 0, 0);
            o1 = __builtin_amdgcn_mfma_f32_16x16x32_bf16(af, *(const bf16x8*)(br1 + 32 * ks), o1, 0, 0, 0);
        }
#pragma unroll
        for (int r = 0; r < 4; ++r) { OS[(16 * mt + 4 * g4 + r) * 68 + 16 * nt0 + l15] = o0[r]; OS[(16 * mt + 4 * g4 + r) * 68 + 16 * nt0 + 16 + l15] = o1[r]; }
    }
    __syncthreads();
    {
        const int row = tid >> 3, sub = tid & 7, n = n0 + row;
        float v[8];
#pragma unroll
        for (int j = 0; j < 8; ++j) v[j] = OS[row * 68 + 8 * sub + j];
        if (kind == 0) {
            float sq = 0.f;
#pragma unroll
            for (int j = 0; j < 8; ++j) sq += v[j] * v[j];
            sq += __shfl_xor(sq, 1); sq += __shfl_xor(sq, 2); sq += __shfl_xor(sq, 4);
            const float rstd = rsqrtf(sq * (1.f / 64.f) + EPS);
#pragma unroll
            for (int j = 0; j < 8; ++j) v[j] = v[j] * rstd * c.nsa_kg[8 * sub + j];
            const int pos = (16 * n + 31) & (SEQ - 1);
#pragma unroll
            for (int j = 0; j < 8; ++j) {
                const float other = __shfl_xor(v[j], 1);
                const float2 cs = RT[pos * 8 + j];
                if (sub == 0) v[j] = v[j] * cs.x - other * cs.y; else if (sub == 1) v[j] = v[j] * cs.x + other * cs.y;
            }
        }
        uint4 o; o.x = pk2(v[0], v[1]); o.y = pk2(v[2], v[3]); o.z = pk2(v[4], v[5]); o.w = pk2(v[6], v[7]);
        if (n > 254) { o.x = 0u; o.y = 0u; o.z = 0u; o.w = 0u; }
        *(uint4*)(OUTB + (size_t)n * 64 + 8 * sub) = o;
    }
}

namespace hg {
typedef short bf16x8 __attribute__((ext_vector_type(8)));
typedef float f32x4 __attribute__((ext_vector_type(4)));
constexpr int PQ = 136, PS = 72;
constexpr int O_QS = 0, O_QD = O_QS + 64 * PQ * 2, O_KD = O_QD + 64 * PQ * 2, O_KK = O_KD + 64 * PQ * 2, O_QO = O_KK + 48 * PQ * 2, O_KST = O_QO + 96 * PQ * 2,
              O_VT = O_KST + 128 * PS * 2, O_STT = O_VT + 32 * PS * 2, O_TSH = O_STT + 32 * PQ * 2, O_END = O_TSH + 4 * 128 * 4;
static_assert(O_END <= 160 * 1024, "hgrn2 LDS");
__device__ __forceinline__ bf16x8 pack8(float a0, float a1, float a2, float a3, float a4, float a5, float a6, float a7) {
    uint4 w; w.x = pk2(a0, a1); w.y = pk2(a2, a3); w.z = pk2(a4, a5); w.w = pk2(a6, a7); return __builtin_bit_cast(bf16x8, w); }
__device__ __forceinline__ float cexp(float x) { return __expf(fminf(fmaxf(x, -80.f), 80.f)); }
}
namespace hg {
constexpr int A_VT = O_KST + 128 * PS * 2, A_TSH = A_VT + 128 * PS * 2, A_END = A_TSH + 4 * 128 * 4;
static_assert(A_END <= 160 * 1024 - 16, "hgrn2 pass A LDS");
constexpr int S_QS = 0, S_STT = 2 * 64 * PQ * 2, S_OS = S_STT + 2 * 128 * PQ * 2, OSP = 132, S_END = S_OS + 64 * OSP * 4;
static_assert(S_END <= 160 * 1024 - 16, "hgrn2 sequential pass LDS");
constexpr size_t HG_U = 0, HG_QG = (size_t)128 << 20, HG_OI = (size_t)192 << 20;
}
__device__ __forceinline__ void hgrn2_passA(const Ctx& c, unsigned char* lds_raw, int su) {
    using namespace hg;
    const int cq = su & 3, h = (su >> 2) & 3, b = su >> 4;
    const bf16_t* P = (const bf16_t*)(c.ws + WS_PROJ); const float* LOGF = (const float*)(c.ws + WS_LOGF);
    unsigned char* scr = (unsigned char*)c.xr; float* GD = (float*)(c.ws + WS_LIST);
    bf16_t* QS = (bf16_t*)(lds_raw + O_QS); bf16_t* QD = (bf16_t*)(lds_raw + O_QD); bf16_t* KD = (bf16_t*)(lds_raw + O_KD); bf16_t* KK = (bf16_t*)(lds_raw + O_KK);
    bf16_t* QO = (bf16_t*)(lds_raw + O_QO); bf16_t* KST = (bf16_t*)(lds_raw + O_KST); bf16_t* VT = (bf16_t*)(lds_raw + A_VT);
    float* TSH = (float*)(lds_raw + A_TSH);
    const int tid = c.tid, lane = c.lane, w = c.wave;
    const int i = w >> 1, hf = w & 1, d = 2 * lane;
    const int tt = w >> 1, vh = w & 1, g4 = lane >> 4, l15 = lane & 15;
    const size_t rowbase = (size_t)b * SEQ + (size_t)cq * 1024;
    const bf16_t* qp = P + (rowbase + 16 * i + 8 * hf) * EVPP + h * 128 + d;
    const float* lp = LOGF + (rowbase + 16 * i + 8 * hf) * 512 + h * 128 + d;
    const int vrow = tid >> 3, vc = (tid & 7) * 16;
    const bf16_t* vp = P + (rowbase + vrow) * EVPP + 1024 + h * 128 + vc;
    u32 qraw[8], kraw[8]; float2 lfr[8], pre[8]; uint4 vr0, vr1;
#pragma unroll
    for (int r = 0; r < 8; ++r) { qraw[r] = *(const u32*)(qp + (size_t)r * EVPP); kraw[r] = *(const u32*)(qp + (size_t)r * EVPP + 512); lfr[r] = *(const float2*)(lp + (size_t)r * 512);
        pre[r] = *(const float2*)(lp + (size_t)r * 512 - (size_t)(8 * hf) * 512); }
    vr0 = *(const uint4*)vp; vr1 = *(const uint4*)(vp + 8);
    __syncthreads();
    for (int k = 0; k < 16; ++k) {
        const int u = ((b * 4 + h) * 64) + cq * 16 + k;
        float2 lb[8]; float2 run = make_float2(0.f, 0.f);
#pragma unroll
        for (int r = 0; r < 8; ++r) { run.x += pre[r].x; run.y += pre[r].y; }
        run.x *= (float)hf; run.y *= (float)hf;
        const float2 rmid = run;
#pragma unroll
        for (int r = 0; r < 8; ++r) { run.x += lfr[r].x; run.y += lfr[r].y; lb[r] = run; }
        if (hf) *(float2*)(TSH + i * 128 + d) = lb[7];
        if (k < 15) {
            const size_t adv = (size_t)(k + 1) * 64;
#pragma unroll
            for (int r = 0; r < 8; ++r) { lfr[r] = *(const float2*)(lp + (adv + r) * 512); pre[r] = *(const float2*)(lp + (adv + r) * 512 - (size_t)(8 * hf) * 512); }
        }
        __syncthreads();
        {
            const float2 T0 = *(const float2*)(TSH + d), T1 = *(const float2*)(TSH + 128 + d), T2 = *(const float2*)(TSH + 256 + d), T3 = *(const float2*)(TSH + 384 + d);
            const float2 Ti = i == 0 ? T0 : (i == 1 ? T1 : (i == 2 ? T2 : T3));
            const float2 rm = hf ? rmid : lb[7];
            float cQS[2], cQD[2], cKD[2], cKK[2], cKS[2], cQ0[2], cQ1[2], cQ2[2];
#pragma unroll
            for (int x = 0; x < 2; ++x) {
                const float t0x = x ? T0.y : T0.x, t1x = x ? T1.y : T1.x, t2x = x ? T2.y : T2.x, t3x = x ? T3.y : T3.x, tix = x ? Ti.y : Ti.x, rmx = x ? rm.y : rm.x;
                const float Bi = (i > 0 ? t0x : 0.f) + (i > 1 ? t1x : 0.f) + (i > 2 ? t2x : 0.f), B4 = (t0x + t1x) + (t2x + t3x);
                cQS[x] = cexp(Bi); cQD[x] = cexp(-rmx); cKD[x] = cexp(rmx); cKK[x] = cexp(tix); cKS[x] = cKK[x] * cexp(B4 - (Bi + tix));
                cQ0[x] = cexp(Bi - t0x); cQ1[x] = cexp(Bi - (t0x + t1x)); cQ2[x] = cexp(Bi - (t0x + t1x + t2x));
            }
            if (tid < 128) GD[(size_t)u * 128 + tid] = cexp((TSH[tid] + TSH[128 + tid]) + (TSH[256 + tid] + TSH[384 + tid]));
            float ks0[8], ks1[8];
#pragma unroll
            for (int r = 0; r < 8; ++r) {
                const int t = 16 * i + 8 * hf + r;
                const float q0 = __uint_as_float(qraw[r] << 16), q1 = __uint_as_float(qraw[r] & 0xffff0000u), k0 = __uint_as_float(kraw[r] << 16), k1 = __uint_as_float(kraw[r] & 0xffff0000u);
                const float e0 = __expf(fmaxf(lb[r].x, -80.f)), e1 = __expf(fmaxf(lb[r].y, -80.f));
                const float qe0 = q0 * e0, qe1 = q1 * e1, ke0 = k0 * __builtin_amdgcn_rcpf(e0), ke1 = k1 * __builtin_amdgcn_rcpf(e1);
                *(u32*)(QS + t * PQ + d) = pk2(qe0 * cQS[0], qe1 * cQS[1]);
                *(u32*)(QD + t * PQ + d) = pk2(qe0 * cQD[0], qe1 * cQD[1]); *(u32*)(KD + t * PQ + d) = pk2(ke0 * cKD[0], ke1 * cKD[1]);
                if (i < 3) *(u32*)(KK + t * PQ + d) = pk2(ke0 * cKK[0], ke1 * cKK[1]);
                ks0[r] = ke0 * cKS[0]; ks1[r] = ke1 * cKS[1];
                if (i >= 1) *(u32*)(QO + (t - 16) * PQ + d) = pk2(qe0 * cQ0[0], qe1 * cQ0[1]);
                if (i >= 2) *(u32*)(QO + (48 + t - 32) * PQ + d) = pk2(qe0 * cQ1[0], qe1 * cQ1[1]);
                if (i >= 3) *(u32*)(QO + (80 + t - 48) * PQ + d) = pk2(qe0 * cQ2[0], qe1 * cQ2[1]);
            }
            uint4 w0, w1;
            w0.x = pk2(ks0[0], ks0[1]); w0.y = pk2(ks0[2], ks0[3]); w0.z = pk2(ks0[4], ks0[5]); w0.w = pk2(ks0[6], ks0[7]);
            w1.x = pk2(ks1[0], ks1[1]); w1.y = pk2(ks1[2], ks1[3]); w1.z = pk2(ks1[4], ks1[5]); w1.w = pk2(ks1[6], ks1[7]);
            *(uint4*)(KST + d * PS + 16 * i + 8 * hf) = w0; *(uint4*)(KST + (d + 1) * PS + 16 * i + 8 * hf) = w1;
        }
        {
            const u32 vw[8] = {vr0.x, vr0.y, vr0.z, vr0.w, vr1.x, vr1.y, vr1.z, vr1.w};
#pragma unroll
            for (int j = 0; j < 8; ++j) { VT[(vc + 2 * j) * PS + vrow] = (bf16_t)(vw[j] & 0xffffu); VT[(vc + 2 * j + 1) * PS + vrow] = (bf16_t)(vw[j] >> 16); }
        }
        if (k < 15) {
            const size_t adv = (size_t)(k + 1) * 64;
#pragma unroll
            for (int r = 0; r < 8; ++r) { qraw[r] = *(const u32*)(qp + (adv + r) * EVPP); kraw[r] = *(const u32*)(qp + (adv + r) * EVPP + 512); }
            vr0 = *(const uint4*)(vp + adv * EVPP); vr1 = *(const uint4*)(vp + adv * EVPP + 8);
        }
        __syncthreads();
        {
            f32x4 Pj[4];
#pragma unroll
            for (int j = 0; j < 4; ++j) {
                Pj[j] = (f32x4){0.f, 0.f, 0.f, 0.f};
                if (j <= tt) {
                    const bf16_t* Ar; const bf16_t* Br;
                    if (j < tt) { Ar = KK + (16 * j + l15) * PQ; Br = QO + ((j == 0 ? 0 : (j == 1 ? 48 : 80)) + 16 * (tt - j - 1) + l15) * PQ; }
                    else { Ar = KD + (16 * tt + l15) * PQ; Br = QD + (16 * tt + l15) * PQ; }
                    f32x4 acc = {0.f, 0.f, 0.f, 0.f};
#pragma unroll
                    for (int ks = 0; ks < 4; ++ks) acc = __builtin_amdgcn_mfma_f32_16x16x32_bf16(*(const bf16x8*)(Ar + 32 * ks + 8 * g4), *(const bf16x8*)(Br + 32 * ks + 8 * g4), acc, 0, 0, 0);
                    __builtin_amdgcn_sched_group_barrier(0x100, 8, 0); __builtin_amdgcn_sched_group_barrier(0x008, 4, 0);
                    if (j == tt) {
#pragma unroll
                        for (int r = 0; r < 4; ++r) if (4 * g4 + r > l15) acc[r] = 0.f;
                    }
                    Pj[j] = acc;
                }
            }
            const bf16x8 af0 = pack8(Pj[0][0], Pj[0][1], Pj[0][2], Pj[0][3], Pj[1][0], Pj[1][1], Pj[1][2], Pj[1][3]);
            const bf16x8 af1 = pack8(Pj[2][0], Pj[2][1], Pj[2][2], Pj[2][3], Pj[3][0], Pj[3][1], Pj[3][2], Pj[3][3]);
            uint2* OI = (uint2*)(scr + HG_OI) + ((size_t)u * 32 + tt * 8) * 64 + lane;
#pragma unroll
            for (int q = 0; q < 4; ++q) {
                const int vt = 4 * vh + q;
                const bf16_t* vrw = VT + (16 * vt + l15) * PS;
                f32x4 o = {0.f, 0.f, 0.f, 0.f};
                { const uint2 lo = *(const uint2*)(vrw + 4 * g4), hi = *(const uint2*)(vrw + 16 + 4 * g4); uint4 bw; bw.x = lo.x; bw.y = lo.y; bw.z = hi.x; bw.w = hi.y;
                  o = __builtin_amdgcn_mfma_f32_16x16x32_bf16(af0, __builtin_bit_cast(bf16x8, bw), o, 0, 0, 0); }
                if (tt >= 2) { const uint2 lo = *(const uint2*)(vrw + 32 + 4 * g4), hi = *(const uint2*)(vrw + 48 + 4 * g4); uint4 bw; bw.x = lo.x; bw.y = lo.y; bw.z = hi.x; bw.w = hi.y;
                  o = __builtin_amdgcn_mfma_f32_16x16x32_bf16(af1, __builtin_bit_cast(bf16x8, bw), o, 0, 0, 0); }
                uint2 ow; ow.x = pk2(o[0], o[1]); ow.y = pk2(o[2], o[3]);
                OI[(size_t)vt * 64] = ow;
            }
            {
                uint2* U = (uint2*)(scr + HG_U) + ((size_t)u * 64 + w * 8) * 64 + lane;
                const bf16_t* vrw = VT + (16 * w + l15) * PS;
                const bf16x8 av0 = *(const bf16x8*)(vrw + 8 * g4), av1 = *(const bf16x8*)(vrw + 32 + 8 * g4);
#pragma unroll
                for (int dt = 0; dt < 8; ++dt) {
                    const bf16_t* kr = KST + (16 * dt + l15) * PS + 8 * g4;
                    f32x4 a = {0.f, 0.f, 0.f, 0.f};
                    a = __builtin_amdgcn_mfma_f32_16x16x32_bf16(av0, *(const bf16x8*)(kr), a, 0, 0, 0);
                    a = __builtin_amdgcn_mfma_f32_16x16x32_bf16(av1, *(const bf16x8*)(kr + 32), a, 0, 0, 0);
                    uint2 uw; uw.x = pk2(a[0], a[1]); uw.y = pk2(a[2], a[3]);
                    U[(size_t)dt * 64] = uw;
                }
            }
            {
                const int row = tid >> 3, ch16 = (tid & 7) * 16;
                const uint4 a0 = *(const uint4*)(QS + row * PQ + ch16), a1 = *(const uint4*)(QS + row * PQ + ch16 + 8);
                uint4* QG = (uint4*)(scr + HG_QG + ((size_t)u * 64 + row) * 256 + ch16 * 2);
                QG[0] = a0; QG[1] = a1;
            }
        }
        __syncthreads();
    }
}

static_assert(MOE_ITEMS == 2048 * 8 * 4 + 64 * 64 * 8, "four MoE conversion items per (NSA unit, wave) + one per (scan chunk, unit, wave)");
#define MB_DECL(SET) float4 SET##a, SET##b, SET##c, SET##d, SET##g; bf16_t* SET##o; size_t SET##k;
#define MB_ISSUE(SET, CM, MS) { MoeItem mi_; moe_item_decode(CM, (MS), mi_); \
          const float* p_ = mi_.W + (size_t)(mi_.k0 + 4 * (lane >> 3)) * mi_.N + mi_.n0 + 4 * (lane & 7); const size_t N_ = mi_.N; \
          SET##a = *(const float4*)(p_); SET##b = *(const float4*)(p_ + N_); SET##c = *(const float4*)(p_ + 2 * N_); SET##d = *(const float4*)(p_ + 3 * N_); \
          SET##g = mi_.gain ? *(const float4*)(mi_.gain + mi_.k0 + 4 * (lane >> 3)) : make_float4(1.f, 1.f, 1.f, 1.f); \
          SET##o = mi_.WT + (size_t)(mi_.drow0 + mi_.n0 + 4 * (lane & 7)) * mi_.K + mi_.k0 + 4 * (lane >> 3); SET##k = mi_.K; }
#define MB_FINISH(SET) { uint2 w_; \
          w_.x = pk2(SET##a.x * SET##g.x, SET##b.x * SET##g.y); w_.y = pk2(SET##c.x * SET##g.z, SET##d.x * SET##g.w); *(uint2*)(SET##o) = w_; \
          w_.x = pk2(SET##a.y * SET##g.x, SET##b.y * SET##g.y); w_.y = pk2(SET##c.y * SET##g.z, SET##d.y * SET##g.w); *(uint2*)(SET##o + SET##k) = w_; \
          w_.x = pk2(SET##a.z * SET##g.x, SET##b.z * SET##g.y); w_.y = pk2(SET##c.z * SET##g.z, SET##d.z * SET##g.w); *(uint2*)(SET##o + 2 * SET##k) = w_; \
          w_.x = pk2(SET##a.w * SET##g.x, SET##b.w * SET##g.y); w_.y = pk2(SET##c.w * SET##g.z, SET##d.w * SET##g.w); *(uint2*)(SET##o + 3 * SET##k) = w_; }
#define MB_CTX() Ctx cm_; { CArgs* ap_ = (CArgs*)__builtin_amdgcn_kernarg_segment_ptr(); asm volatile("" : "+s"(ap_)); int tid_ = threadIdx.x; asm volatile("" : "+v"(tid_)); make_ctx(cm_, *ap_, tid_); } \
          const int ms_ = (((63 - i) * 32 + b * 2 + g) * 8 + w) * 4
#define MB_ISSUE_A() if (!DRY) { MB_CTX();  }
#define MB_FINISH_A() if (!DRY) {  }
#define MB_ISSUE_B() if (!DRY) { MB_CTX() + 0; MB_ISSUE(m0, cm_, ms_ + 0) MB_ISSUE(m1, cm_, ms_ + 1) MB_ISSUE(m2, cm_, ms_ + 2) MB_ISSUE(m3, cm_, ms_ + 3) }
#define MB_FINISH_B() if (!DRY) { MB_FINISH(m0) MB_FINISH(m1) MB_FINISH(m2) MB_FINISH(m3) }
__device__ __forceinline__ void hgrn2_seq_full(const Ctx& c, unsigned char* lds_raw, int unit) {
    using namespace hg;
    const int h = unit & 3, b = unit >> 2;
    const bf16_t* P = (const bf16_t*)(c.ws + WS_PROJ); bf16_t* MIX = (bf16_t*)(c.ws + WS_H);
    const unsigned char* scr = (const unsigned char*)c.xr; const float* GD = (const float*)(c.ws + WS_LIST);
    const int tid = c.tid, lane = c.lane, w = c.wave;
    const int tt = w >> 1, vh = w & 1, g4 = lane >> 4, l15 = lane & 15;
    const size_t rowbase = (size_t)b * SEQ;
    const int u0 = unit * 64;
    f32x4 st[8];
#pragma unroll
    for (int dt = 0; dt < 8; ++dt) st[dt] = (f32x4){0.f, 0.f, 0.f, 0.f};
    const int qrow = tid >> 3, qc16 = (tid & 7) * 16;
    float* OS = (float*)(lds_raw + S_OS);
    uint4 q0, q1, gt0, gt1; uint2 uu[8], oi[4]; float gg[8]; MB_DECL(mx)
#define HGF_LDQ(CH) do { const uint4* qg_ = (const uint4*)(scr + HG_QG + (((size_t)(u0 + (CH))) * 64 + qrow) * 256 + qc16 * 2); q0 = qg_[0]; q1 = qg_[1]; } while (0)
#define HGF_LDOI(CH) do { const uint2* op_ = (const uint2*)(scr + HG_OI) + (((size_t)(u0 + (CH))) * 32 + tt * 8 + 4 * vh) * 64 + lane; \
        _Pragma("unroll") for (int q = 0; q < 4; ++q) oi[q] = op_[(size_t)q * 64]; } while (0)
#define HGF_LDU(CH) do { const uint2* up_ = (const uint2*)(scr + HG_U) + (((size_t)(u0 + (CH))) * 64 + w * 8) * 64 + lane; const float* gp_ = GD + ((size_t)(u0 + (CH))) * 128 + l15; \
        _Pragma("unroll") for (int dt = 0; dt < 8; ++dt) { uu[dt] = up_[(size_t)dt * 64]; gg[dt] = gp_[16 * dt]; } } while (0)
#define HGF_LDG(CH) do { const uint4* gp_ = (const uint4*)(P + (rowbase + (size_t)(CH) * 64 + qrow) * EVPP + 1536 + h * 128 + qc16); gt0 = gp_[0]; gt1 = gp_[1]; } while (0)
    HGF_LDQ(0); HGF_LDOI(0); HGF_LDU(0); HGF_LDG(0);
    __syncthreads();
    for (int ch = 0; ch < 64; ++ch) {
        bf16_t* QSL = (bf16_t*)(lds_raw + S_QS) + (ch & 1) * 64 * PQ; bf16_t* STT = (bf16_t*)(lds_raw + S_STT) + (ch & 1) * 128 * PQ;
        MB_ISSUE(mx, c, 2048 * 8 * 4 + (ch * 64 + unit) * 8 + w)
        *(uint4*)(QSL + qrow * PQ + qc16) = q0; *(uint4*)(QSL + qrow * PQ + qc16 + 8) = q1;
#pragma unroll
        for (int dt = 0; dt < 8; ++dt)
#pragma unroll
            for (int r = 0; r < 4; ++r) STT[(16 * w + 4 * g4 + r) * PQ + 16 * dt + l15] = f2bf(st[dt][r]);
        if (ch + 1 < 64) HGF_LDQ(ch + 1);
        __syncthreads();
#pragma unroll
        for (int q = 0; q < 4; ++q) {
            const int vt = 4 * vh + q;
            f32x4 o = {__uint_as_float(oi[q].x << 16), __uint_as_float(oi[q].x & 0xffff0000u), __uint_as_float(oi[q].y << 16), __uint_as_float(oi[q].y & 0xffff0000u)};
            const bf16_t* Ar = QSL + (16 * tt + l15) * PQ; const bf16_t* Br = STT + (16 * vt + l15) * PQ;
#pragma unroll
            for (int ks = 0; ks < 4; ++ks) o = __builtin_amdgcn_mfma_f32_16x16x32_bf16(*(const bf16x8*)(Ar + 32 * ks + 8 * g4), *(const bf16x8*)(Br + 32 * ks + 8 * g4), o, 0, 0, 0);
#pragma unroll
            for (int r = 0; r < 4; ++r) OS[(16 * tt + 4 * g4 + r) * OSP + 16 * vt + l15] = o[r];
        }
        if (ch + 1 < 64) HGF_LDOI(ch + 1);
#pragma unroll
        for (int dt = 0; dt < 8; ++dt) {
            st[dt][0] = st[dt][0] * gg[dt] + __uint_as_float(uu[dt].x << 16); st[dt][1] = st[dt][1] * gg[dt] + __uint_as_float(uu[dt].x & 0xffff0000u);
            st[dt][2] = st[dt][2] * gg[dt] + __uint_as_float(uu[dt].y << 16); st[dt][3] = st[dt][3] * gg[dt] + __uint_as_float(uu[dt].y & 0xffff0000u);
        }
        if (ch + 1 < 64) HGF_LDU(ch + 1);
        __syncthreads();
        MB_FINISH(mx)
        {
            const float* orow = OS + qrow * OSP + qc16;
            const float4 o0 = *(const float4*)(orow), o1 = *(const float4*)(orow + 4), o2 = *(const float4*)(orow + 8), o3 = *(const float4*)(orow + 12);
            float sq = (o0.x * o0.x + o0.y * o0.y) + (o0.z * o0.z + o0.w * o0.w) + (o1.x * o1.x + o1.y * o1.y) + (o1.z * o1.z + o1.w * o1.w)
                     + (o2.x * o2.x + o2.y * o2.y) + (o2.z * o2.z + o2.w * o2.w) + (o3.x * o3.x + o3.y * o3.y) + (o3.z * o3.z + o3.w * o3.w);
            sq += __shfl_xor(sq, 1); sq += __shfl_xor(sq, 2); sq += __shfl_xor(sq, 4);
            const float rstd = rsqrtf(sq * (1.f / 128.f) + EPS);
            const float4 n0 = *(const float4*)(c.hg_gain + qc16), n1 = *(const float4*)(c.hg_gain + qc16 + 4), n2 = *(const float4*)(c.hg_gain + qc16 + 8), n3 = *(const float4*)(c.hg_gain + qc16 + 12);
            float ga[8], gb[8]; unpack8(gt0, ga); unpack8(gt1, gb);
#define HGF_SG(G) ((G) / (1.f + __expf(-(G))))
            uint4 w0, w1;
            w0.x = pk2(o0.x * rstd * n0.x * HGF_SG(ga[0]), o0.y * rstd * n0.y * HGF_SG(ga[1])); w0.y = pk2(o0.z * rstd * n0.z * HGF_SG(ga[2]), o0.w * rstd * n0.w * HGF_SG(ga[3]));
            w0.z = pk2(o1.x * rstd * n1.x * HGF_SG(ga[4]), o1.y * rstd * n1.y * HGF_SG(ga[5])); w0.w = pk2(o1.z * rstd * n1.z * HGF_SG(ga[6]), o1.w * rstd * n1.w * HGF_SG(ga[7]));
            w1.x = pk2(o2.x * rstd * n2.x * HGF_SG(gb[0]), o2.y * rstd * n2.y * HGF_SG(gb[1])); w1.y = pk2(o2.z * rstd * n2.z * HGF_SG(gb[2]), o2.w * rstd * n2.w * HGF_SG(gb[3]));
            w1.z = pk2(o3.x * rstd * n3.x * HGF_SG(gb[4]), o3.y * rstd * n3.y * HGF_SG(gb[5])); w1.w = pk2(o3.z * rstd * n3.z * HGF_SG(gb[6]), o3.w * rstd * n3.w * HGF_SG(gb[7]));
#undef HGF_SG
            uint4* mp = (uint4*)(MIX + (rowbase + (size_t)ch * 64 + qrow) * D + h * 128 + qc16);
            mp[0] = w0; mp[1] = w1;
        }
        if (ch + 1 < 64) HGF_LDG(ch + 1);
    }
#undef HGF_LDQ
#undef HGF_LDOI
#undef HGF_LDU
#undef HGF_LDG
    __syncthreads();
}

namespace fa {
typedef short bf16x8 __attribute__((ext_vector_type(8)));
typedef short s16x4 __attribute__((ext_vector_type(4)));
typedef float f32x16 __attribute__((ext_vector_type(16)));
#define FA_LAS __attribute__((address_space(3)))
constexpr int RPK = 144, RPV = 192;
constexpr int KTB = 64 * RPK, VTB = 64 * RPV;
constexpr int O_KT = 0, O_VT = 2 * KTB, O_IMP = O_VT + 2 * VTB, O_SELM = O_IMP + 64 * 64 * 4, O_JL = O_SELM + 512, O_UM = O_JL + 64 * 4, O_STG = 0  , STG_P = 144, STG_W = 32 * STG_P,
              O_RES = O_UM + 32, RES_P = 68, RES_W = 32 * RES_P * 4, O_END = O_RES + 8 * RES_W;
static_assert(O_END + 16 <= LDS_BARST && (O_STG % 16) == 0 && (O_RES % 16) == 0 && 8 * STG_W <= 2 * KTB + 2 * VTB, "attention LDS");
constexpr float SC2 = 0.125f * 1.4426950408889634f;
constexpr float THR = 8.f;
__device__ __forceinline__ int crow(int r, int hi) { return (r & 3) + 8 * (r >> 2) + 4 * hi; }
struct RangeMask { int lo, hi; __device__ __forceinline__ bool operator()(int kl) const { return kl >= lo && kl <= hi; } };
__device__ __forceinline__ s16x4 vtr(const unsigned char* p) {
    typedef short v4i16_t __attribute__((ext_vector_type(4)));
    return __builtin_bit_cast(s16x4, __builtin_amdgcn_ds_read_tr16_b64_v4i16((FA_LAS v4i16_t*)(p))); }
struct State { f32x16 o[2]; float m, l; };
__device__ __forceinline__ void init(State& st, float m0, float l0) {
#pragma unroll
    for (int t = 0; t < 2; ++t)
#pragma unroll
        for (int r = 0; r < 16; ++r) st.o[t][r] = 0.f;
    st.m = m0; st.l = l0; }
__device__ __forceinline__ void qnorm_rope(bf16x8 (&qf)[4], const float* gain, const float2* rt  , int hi) {
    float f[4][8]; float ss = 0.f;
#pragma unroll
    for (int sp = 0; sp < 4; ++sp) { unpack8(__builtin_bit_cast(uint4, qf[sp]), f[sp]);
#pragma unroll
        for (int j = 0; j < 8; ++j) ss += f[sp][j] * f[sp][j]; }
    ss += __shfl_xor(ss, 32);
    const float rstd = rsqrtf(ss * (1.f / 64.f) + EPS);
#pragma unroll
    for (int sp = 0; sp < 4; ++sp) { const float4 g0 = *(const float4*)(gain + 16 * sp + 8 * hi), g1 = *(const float4*)(gain + 16 * sp + 8 * hi + 4);
        f[sp][0] *= rstd * g0.x; f[sp][1] *= rstd * g0.y; f[sp][2] *= rstd * g0.z; f[sp][3] *= rstd * g0.w; f[sp][4] *= rstd * g1.x; f[sp][5] *= rstd * g1.y; f[sp][6] *= rstd * g1.z; f[sp][7] *= rstd * g1.w; }
#pragma unroll
    for (int j = 0; j < 8; ++j) { const float other = __shfl_xor(f[0][j], 32); const float2 cs = rt[j];
        f[0][j] = hi ? (f[0][j] * cs.x + other * cs.y) : (f[0][j] * cs.x - other * cs.y); }
#pragma unroll
    for (int sp = 0; sp < 4; ++sp) { uint4 o; o.x = pk2(f[sp][0] * SC2, f[sp][1] * SC2); o.y = pk2(f[sp][2] * SC2, f[sp][3] * SC2); o.z = pk2(f[sp][4] * SC2, f[sp][5] * SC2); o.w = pk2(f[sp][6] * SC2, f[sp][7] * SC2);
        qf[sp] = __builtin_bit_cast(bf16x8, o); }
}
__device__ __forceinline__ uint4 knorm_rope(const uint4 kv, const float* gain, const float2* rt  , int chunk) {
    float f[8]; unpack8(kv, f); float ss = 0.f;
#pragma unroll
    for (int j = 0; j < 8; ++j) ss += f[j] * f[j];
    ss += __shfl_xor(ss, 1); ss += __shfl_xor(ss, 2); ss += __shfl_xor(ss, 4);
    const float rstd = rsqrtf(ss * (1.f / 64.f) + EPS);
    const float4 g0 = *(const float4*)(gain + 8 * chunk), g1 = *(const float4*)(gain + 8 * chunk + 4);
    f[0] *= rstd * g0.x; f[1] *= rstd * g0.y; f[2] *= rstd * g0.z; f[3] *= rstd * g0.w; f[4] *= rstd * g1.x; f[5] *= rstd * g1.y; f[6] *= rstd * g1.z; f[7] *= rstd * g1.w;
#pragma unroll
    for (int j = 0; j < 8; ++j) { const float other = __shfl_xor(f[j], 1);
        if (chunk < 2) { const float2 cs = rt[j]; f[j] = chunk ? (f[j] * cs.x + other * cs.y) : (f[j] * cs.x - other * cs.y); } }
    uint4 o; o.x = pk2(f[0], f[1]); o.y = pk2(f[2], f[3]); o.z = pk2(f[4], f[5]); o.w = pk2(f[6], f[7]); return o;
}
template <int ABL = 0, bool FAST = false, bool ROWM = true, bool IMPC = false>
__device__ __forceinline__ void tile(State& st, const unsigned char* lds, int koff, int voff, const bf16x8 (&qf)[4], float cbias, bool emask, const RangeMask mk, int lane, float* impr = nullptr, float* carry = nullptr) {
    const int r32 = lane & 31, hi = lane >> 5;
    const float negm = FAST ? (ROWM ? cbias : 0.f) : cbias - st.m;
    f32x16 p0, p1;
#pragma unroll
    for (int r = 0; r < 16; ++r) { p0[r] = negm; p1[r] = negm; }
    const unsigned char* kb = lds + koff + r32 * RPK + hi * 16;
#pragma unroll
    for (int sp = 0; sp < 4; ++sp) {
        const bf16x8 a0 = *(const bf16x8*)(kb + 32 * sp), a1 = *(const bf16x8*)(kb + 32 * RPK + 32 * sp);
        p0 = __builtin_amdgcn_mfma_f32_32x32x16_bf16(a0, qf[sp], p0, 0, 0, 0);
        p1 = __builtin_amdgcn_mfma_f32_32x32x16_bf16(a1, qf[sp], p1, 0, 0, 0);
    }
    __builtin_amdgcn_sched_group_barrier(0x100, 8, 0);
    __builtin_amdgcn_sched_group_barrier(0x008, 8, 0);
    if (emask) {
#pragma unroll
        for (int r = 0; r < 16; ++r) { const int kl = crow(r, hi); if (!mk(kl)) p0[r] = -INFINITY; if (!mk(kl + 32)) p1[r] = -INFINITY; }
    }
    if (ABL == 1) {
#pragma unroll
        for (int r = 0; r < 16; ++r) { p0[r] *= 0.001f; p1[r] *= 0.001f; }
        st.l += p0[0];
    } else if (FAST) {
        float sa = 0.f, sb = 0.f, sc = 0.f, sd = 0.f;
#pragma unroll
        for (int r = 0; r < 16; r += 4) {
            p0[r] = __builtin_amdgcn_exp2f(p0[r]); p1[r] = __builtin_amdgcn_exp2f(p1[r]); p0[r + 1] = __builtin_amdgcn_exp2f(p0[r + 1]); p1[r + 1] = __builtin_amdgcn_exp2f(p1[r + 1]);
            p0[r + 2] = __builtin_amdgcn_exp2f(p0[r + 2]); p1[r + 2] = __builtin_amdgcn_exp2f(p1[r + 2]); p0[r + 3] = __builtin_amdgcn_exp2f(p0[r + 3]); p1[r + 3] = __builtin_amdgcn_exp2f(p1[r + 3]);
            sa += p0[r] + p1[r]; sb += p0[r + 1] + p1[r + 1]; sc += p0[r + 2] + p1[r + 2]; sd += p0[r + 3] + p1[r + 3];
        }
        st.l += (sa + sb) + (sc + sd);
        if (IMPC) {
            float x0[4], x1[4];
#pragma unroll
            for (int q = 0; q < 4; ++q) { x0[q] = __shfl_xor(p0[4 * q + 3], 32); x1[q] = __shfl_xor(p1[4 * q + 3], 32); }
#pragma unroll
            for (int q = 0; q < 4; ++q) {
                const float g0 = (p0[4 * q] + p0[4 * q + 1]) + (p0[4 * q + 2] + p0[4 * q + 3]), g1 = (p1[4 * q] + p1[4 * q + 1]) + (p1[4 * q + 2] + p1[4 * q + 3]);
                const float e0 = hi ? x0[q] : (q ? x0[q ? q - 1 : 0] : *carry), e1 = hi ? x1[q] : (q ? x1[q ? q - 1 : 0] : x0[3]);
                impr[2 * q + hi] = g0 + e0; impr[8 + 2 * q + hi] = g1 + e1;
            }
            *carry = x1[3];
        }
    } else {
        float mxa = fmaxf(p0[0], p1[0]), mxb = fmaxf(p0[1], p1[1]), mxc = fmaxf(p0[2], p1[2]), mxd = fmaxf(p0[3], p1[3]);
#pragma unroll
        for (int r = 4; r < 16; r += 4) { mxa = fmaxf(mxa, fmaxf(p0[r], p1[r])); mxb = fmaxf(mxb, fmaxf(p0[r + 1], p1[r + 1])); mxc = fmaxf(mxc, fmaxf(p0[r + 2], p1[r + 2])); mxd = fmaxf(mxd, fmaxf(p0[r + 3], p1[r + 3])); }
        float mx = fmaxf(fmaxf(mxa, mxb), fmaxf(mxc, mxd));
        mx = fmaxf(mx, __shfl_xor(mx, 32));
        if (!__all(mx <= THR)) {
            const float delta = fmaxf(mx, 0.f), alpha = __builtin_amdgcn_exp2f(-delta);
            st.m += delta; st.l *= alpha;
#pragma unroll
            for (int r = 0; r < 16; ++r) { p0[r] -= delta; p1[r] -= delta; st.o[0][r] *= alpha; st.o[1][r] *= alpha; }
        }
        float sa = 0.f, sb = 0.f, sc = 0.f, sd = 0.f;
#pragma unroll
        for (int r = 0; r < 16; r += 4) {
            p0[r] = __builtin_amdgcn_exp2f(p0[r]); p1[r] = __builtin_amdgcn_exp2f(p1[r]); p0[r + 1] = __builtin_amdgcn_exp2f(p0[r + 1]); p1[r + 1] = __builtin_amdgcn_exp2f(p1[r + 1]);
            p0[r + 2] = __builtin_amdgcn_exp2f(p0[r + 2]); p1[r + 2] = __builtin_amdgcn_exp2f(p1[r + 2]); p0[r + 3] = __builtin_amdgcn_exp2f(p0[r + 3]); p1[r + 3] = __builtin_amdgcn_exp2f(p1[r + 3]);
            sa += p0[r] + p1[r]; sb += p0[r + 1] + p1[r + 1]; sc += p0[r + 2] + p1[r + 2]; sd += p0[r + 3] + p1[r + 3];
        }
        st.l += (sa + sb) + (sc + sd);
    }
    if (ABL == 2) { st.o[0][0] += p0[0] + p0[5] + p1[3] + p1[9]; return; }
    const int vbase = voff + (4 * hi + ((lane & 15) >> 2)) * RPV + ((lane >> 4) & 1) * 32 + (lane & 3) * 8;
#pragma unroll
    for (int sub = 0; sub < 2; ++sub)
#pragma unroll
        for (int ks = 0; ks < 2; ++ks) {
            uint4 pw;
            if (sub == 0) { pw.x = pk2(p0[8 * ks], p0[8 * ks + 1]); pw.y = pk2(p0[8 * ks + 2], p0[8 * ks + 3]); pw.z = pk2(p0[8 * ks + 4], p0[8 * ks + 5]); pw.w = pk2(p0[8 * ks + 6], p0[8 * ks + 7]); }
            else { pw.x = pk2(p1[8 * ks], p1[8 * ks + 1]); pw.y = pk2(p1[8 * ks + 2], p1[8 * ks + 3]); pw.z = pk2(p1[8 * ks + 4], p1[8 * ks + 5]); pw.w = pk2(p1[8 * ks + 6], p1[8 * ks + 7]); }
            const bf16x8 pf = __builtin_bit_cast(bf16x8, pw);
#pragma unroll
            for (int dt = 0; dt < 2; ++dt) {
                const unsigned char* vp = lds + vbase + (32 * sub + 16 * ks) * RPV + dt * 64;
                const s16x4 lo = vtr(vp), hi4 = vtr(vp + 8 * RPV);
                const bf16x8 vf = {lo[0], lo[1], lo[2], lo[3], hi4[0], hi4[1], hi4[2], hi4[3]};
                st.o[dt] = __builtin_amdgcn_mfma_f32_32x32x16_bf16(vf, pf, st.o[dt], 0, 0, 0);
            }
        }
}
__device__ __forceinline__ uint4 ldg_tile(const bf16_t* base, long row, int ld, int tid) { return *(const uint4*)(base + row * ld + (tid & 7) * 8); }
__device__ __forceinline__ void sts_k(unsigned char* lds, int buf, const uint4& v, int tid) { *(uint4*)(lds + O_KT + buf * KTB + (tid >> 3) * RPK + (tid & 7) * 16) = v; }
__device__ __forceinline__ void sts_v(unsigned char* lds, int buf, const uint4& v, int tid) { *(uint4*)(lds + O_VT + buf * VTB + (tid >> 3) * RPV + (tid & 7) * 16) = v; }
}

template <int ABL = 0, bool DRY = false, bool FAST = false>
__device__ __forceinline__ void nsa_unit(const Ctx& c, unsigned char* lds, int b, int i, int g) {
    using namespace fa;
    const bf16_t* P = (const bf16_t*)(c.ws + WS_PROJ);
    const bf16_t* KCB = (const bf16_t*)(c.ws + WS_KCB) + (size_t)((b * 2 + g) * 256) * 64; const bf16_t* VCB = (const bf16_t*)(c.ws + WS_VCB) + (size_t)((b * 2 + g) * 256) * 64;
    const int tid = c.tid, lane = c.lane, w = c.wave, r32 = lane & 31, hi = lane >> 5;
    const int tl = 8 * w + (r32 >> 2), hh = r32 & 3, t = 64 * i + tl, head = 4 * g + hh;
    const int key = tid >> 3;
    const size_t m = (size_t)b * SEQ + t;
    const bf16_t* prow = P + m * EVPP;
    const int nt = ((4 * i + 2) >> 6) + 1, nA = FAST ? nt : 2 * nt;
    uint4 kreg = ldg_tile(KCB, key, 64, tid), vreg = ldg_tile(VCB, key, 64, tid);
    bf16x8 qf[4];
#pragma unroll
    for (int sp = 0; sp < 4; ++sp) qf[sp] = *(const bf16x8*)(prow + 2048 + head * 64 + 16 * sp + 8 * hi);
    MB_DECL(m0) MB_DECL(m1) MB_DECL(m2) MB_DECL(m3)
    MB_ISSUE_A()
    qnorm_rope(qf, c.nsa_qg, (const float2*)(c.ws + WS_ROPE) + (size_t)t * 8, hi);
    float* IMP = (float*)(lds + O_IMP); unsigned long long* SELM = (unsigned long long*)(lds + O_SELM); u32* UM = (u32*)(lds + O_UM); int* JL = (int*)(lds + O_JL);
    float* RES = (float*)(lds + O_RES + w * RES_W) + r32 * RES_P;
#define NSA_GATE(k) (1.f / (1.f + __expf(-bf2f(P[((size_t)b * SEQ + t) * EVPP + 3328 + head * 3 + (k)]))))
    const int nmaxq = (t >= 31) ? ((t - 31) >> 4) : -1;
    State st; init(st, 0.f, 0.f);
    float inv = 0.f;
#define NSA_LOAD_A(IDX) do { const int idx_ = (IDX); const int kt_ = idx_ >= nt ? idx_ - nt : idx_; kreg = ldg_tile(KCB, 64 * kt_ + key, 64, tid); \
        if (idx_ < nt) vreg = ldg_tile(VCB, 64 * kt_ + key, 64, tid); \
        else { const int nn = 64 * kt_ + key, j0 = (tid & 7) * 8; u32 wv[4];     \
            _Pragma("unroll") for (int q = 0; q < 4; ++q) { const int ja = j0 + 2 * q, jb = ja + 1; \
                wv[q] = ((nn >= 4 * ja - 1 && nn <= 4 * ja + 3) ? 0x3f80u : 0u) | ((nn >= 4 * jb - 1 && nn <= 4 * jb + 3) ? 0x3f800000u : 0u); } \
            vreg.x = wv[0]; vreg.y = wv[1]; vreg.z = wv[2]; vreg.w = wv[3]; } } while (0)
    __syncthreads();
    sts_k(lds, 0, kreg, tid); sts_v(lds, 0, vreg, tid);
    NSA_LOAD_A(1);
    __syncthreads();
    MB_FINISH_A()
    float carry = 0.f;
    for (int idx = 0; idx < nA; ++idx) {
        if (!FAST && idx == nt) {
            const float lt = st.l + __shfl_xor(st.l, 32);
            inv = lt > 0.f ? 1.f / lt : 0.f;
            const float gci = NSA_GATE(0) * inv;
#pragma unroll
            for (int dt = 0; dt < 2; ++dt)
#pragma unroll
                for (int r = 0; r < 16; ++r) RES[32 * dt + crow(r, hi)] = gci * st.o[dt][r];
            const float mfin = st.m; init(st, mfin, 0.f);
        }
        const int kt = idx >= nt ? idx - nt : idx, cur = idx & 1;
        if (FAST) tile<ABL, true, false, true>(st, lds, O_KT + cur * KTB, O_VT + cur * VTB, qf, 0.f, true, RangeMask{0, nmaxq - 64 * kt}, lane, RES + 16 * kt, &carry);
        else tile<ABL, false, false>(st, lds, O_KT + cur * KTB, O_VT + cur * VTB, qf, 0.f, true, RangeMask{0, nmaxq - 64 * kt}, lane);
        if (idx + 1 < nA) { sts_k(lds, cur ^ 1, kreg, tid); sts_v(lds, cur ^ 1, vreg, tid); if (idx + 2 < nA) NSA_LOAD_A(idx + 2); }
        __syncthreads();
    }
#undef NSA_LOAD_A
    if (FAST) {
        const float lt = st.l + __shfl_xor(st.l, 32);
        inv = lt > 0.f ? 1.f / lt : 0.f;
        for (int jj = 0; jj < 8 * nt; ++jj) {
            float v = RES[2 * jj + hi] * inv; v += __shfl_xor(v, 1); v += __shfl_xor(v, 2);
            if (hh == 0) IMP[tl * 64 + 2 * jj + hi] = v;
        }
        const float gci = NSA_GATE(0) * inv;
#pragma unroll
        for (int dt = 0; dt < 2; ++dt)
#pragma unroll
            for (int r = 0; r < 16; ++r) RES[32 * dt + crow(r, hi)] = gci * st.o[dt][r];
    } else {
#pragma unroll
        for (int dt = 0; dt < 2; ++dt)
#pragma unroll
            for (int r = 0; r < 16; ++r) {
                float v = st.o[dt][r] * inv; v += __shfl_xor(v, 1); v += __shfl_xor(v, 2);
                if (hh == 0) IMP[tl * 64 + 32 * dt + crow(r, hi)] = v;
            }
    }
    const bf16_t* PB = P + (size_t)b * SEQ * EVPP + g * 64;
#define KW (PB + 3072)
#define VW (PB + 3200)
#define KS (PB + 2816)
#define VS (PB + 2944)
    const int k0 = (i - 8 > 0) ? i - 8 : 0, nW = i - k0 + 1;
    kreg = ldg_tile(KW, 64 * k0 + key, EVPP, tid); vreg = ldg_tile(VW, 64 * k0 + key, EVPP, tid);
    if (tid < 2) UM[tid] = 0u;
    MB_ISSUE_B()
    __syncthreads();
    {
        const int tk = tid >> 3, sub = tid & 7;
        float cand[8];
#pragma unroll
        for (int q = 0; q < 8; ++q) { const int j = 8 * sub + q; const bool allowed = j <= i, forced = (j == 0) || (j == i) || (j == i - 1);
            cand[q] = allowed ? IMP[tk * 64 + j] + (forced ? 1e4f : 0.f) : -INFINITY; }
        unsigned long long msk = 0ull;
#pragma unroll 1
        for (int rnd = 0; rnd < 8; ++rnd) {
            float bv = cand[0]; int bi = 0;
#pragma unroll
            for (int q = 1; q < 8; ++q) if (cand[q] > bv) { bv = cand[q]; bi = q; }
            bi += 8 * sub;
#pragma unroll
            for (int o = 1; o < 8; o <<= 1) { const float ov = __shfl_xor(bv, o); const int oi = __shfl_xor(bi, o); if (ov > bv || (ov == bv && oi < bi)) { bv = ov; bi = oi; } }
            if (bv > -INFINITY) {
                msk |= 1ull << bi;
#pragma unroll
                for (int q = 0; q < 8; ++q) if (8 * sub + q == bi) cand[q] = -INFINITY;
            }
        }
        if (sub == 0) { SELM[tk] = msk; atomicOr(&UM[0], (u32)msk); atomicOr(&UM[1], (u32)(msk >> 32)); }
    }
    __syncthreads();
    int nsel;
    {
        const unsigned long long um = (unsigned long long)UM[0] | ((unsigned long long)UM[1] << 32);
        nsel = __popcll(um);
        if (tid < 64 && ((um >> tid) & 1ull)) JL[__popcll(um & ((1ull << tid) - 1ull))] = tid;
    }
    sts_k(lds, 0, kreg, tid); sts_v(lds, 0, vreg, tid);
    __syncthreads();
    MB_FINISH_B()
    const int nB = nW + nsel;
    const unsigned long long mysel = SELM[tl];
#define NSA_LOAD_B(IDX) do { const int lidx_ = (IDX); if (lidx_ < nW) { const long row_ = 64 * (k0 + lidx_) + key; kreg = ldg_tile(KW, row_, EVPP, tid); vreg = ldg_tile(VW, row_, EVPP, tid); } \
        else { const long row_ = 64 * JL[lidx_ - nW] + key; kreg = ldg_tile(KS, row_, EVPP, tid); vreg = ldg_tile(VS, row_, EVPP, tid); } } while (0)
    NSA_LOAD_B(1);
    init(st, 0.f, 0.f);
#define NSA_STAGE_B(IDX) do { const int idx_ = (IDX); if (idx_ + 1 < nB) { sts_k(lds, (idx_ & 1) ^ 1, kreg, tid); sts_v(lds, (idx_ & 1) ^ 1, vreg, tid); if (idx_ + 2 < nB) NSA_LOAD_B(idx_ + 2); } __syncthreads(); } while (0)
    for (int idx = 0; idx < nW; ++idx) {
        const int cur = idx & 1, kt = k0 + idx; RangeMask mk{0, 63}; if (kt == i) mk.hi = tl; if (kt == i - 8) mk.lo = tl + 1;
        tile<ABL, FAST, false>(st, lds, O_KT + cur * KTB, O_VT + cur * VTB, qf, 0.f, (kt == i) || (kt == i - 8), mk, lane);
        NSA_STAGE_B(idx);
    }
    {
        const float lt = st.l + __shfl_xor(st.l, 32);
        const float sc = NSA_GATE(2) * (lt > 0.f ? 1.f / lt : 0.f);
#pragma unroll
        for (int dt = 0; dt < 2; ++dt)
#pragma unroll
            for (int r = 0; r < 16; ++r) RES[32 * dt + crow(r, hi)] += sc * st.o[dt][r];
        init(st, 0.f, 0.f);
    }
    for (int idx = nW; idx < nB; ++idx) {
        const int cur = idx & 1, j = JL[idx - nW]; const bool mine = ((mysel >> j) & 1ull) != 0ull;
        if (__any((int)mine)) tile<ABL, FAST, true>(st, lds, O_KT + cur * KTB, O_VT + cur * VTB, qf, mine ? 0.f : -INFINITY, j == i, RangeMask{0, tl}, lane);
        NSA_STAGE_B(idx);
    }
#undef NSA_STAGE_B
#undef NSA_LOAD_B
    {
        const float lt = st.l + __shfl_xor(st.l, 32);
        const float sc = NSA_GATE(1) * (lt > 0.f ? 1.f / lt : 0.f);
        unsigned char* stg = lds + O_STG + w * STG_W;
#pragma unroll
        for (int dt = 0; dt < 2; ++dt)
#pragma unroll
            for (int r = 0; r < 16; ++r) *(bf16_t*)(stg + r32 * STG_P + (32 * dt + crow(r, hi)) * 2) = f2bf(RES[32 * dt + crow(r, hi)] + sc * st.o[dt][r]);
        LDS_FENCE();
#pragma unroll
        for (int it = 0; it < 4; ++it) {
            const int row = it * 8 + (lane >> 3), ch = lane & 7;
            const uint4 v = *(const uint4*)(stg + row * STG_P + ch * 16);
            const size_t mm = (size_t)b * SEQ + 64 * i + 8 * w + (row >> 2);
            if (!DRY) *(uint4*)((bf16_t*)(c.ws + WS_H) + mm * D + 512 + (4 * g + (row & 3)) * 64 + ch * 8) = v;
            else if (v.x == 0x12345678u && v.y == 0x9abcdef0u) *(uint4*)((bf16_t*)(c.ws + WS_H) + mm * D + 512 + (4 * g + (row & 3)) * 64 + ch * 8) = v;
        }
        LDS_FENCE();
    }
#undef KW
#undef VW
#undef KS
#undef VS
#undef NSA_GATE
}
__device__ __forceinline__ float score_bound(const float* gq, const float* gk, int nk, int lane) {
    float a = fabsf(gq[lane]), b = 0.f;
    for (int x = 0; x < nk; ++x) b = fmaxf(b, fabsf(gk[64 * x + lane]));
    return fa::SC2 * 64.f * wmax(a) * wmax(b);
}
template <int ABL = 0, bool DRY = false>
__device__ __forceinline__ void nsa_mfma(const Ctx& c, unsigned char* lds) {
    const bool fast = score_bound(c.nsa_qg, c.nsa_kg, 3, c.lane) < 60.f;
    int* qc = (int*)(c.ws + WS_CTL) + CTL_QUEUE + (DRY ? 1 : 0);
    volatile int* slot = (volatile int*)(lds + fa::O_END);
    __syncthreads();
    if (c.tid == 0) *slot = atomicAdd(qc, 1);
    __syncthreads();
    int u = __builtin_amdgcn_readfirstlane(*slot);
    while (u < 2048) {
        __syncthreads();
        if (c.tid == 0) *slot = atomicAdd(qc, 1);
        const int rank = u >> 5, bg = u & 31;
        if (fast) nsa_unit<ABL, DRY, true>(c, lds, bg >> 1, 63 - rank, bg & 1); else nsa_unit<ABL, DRY, false>(c, lds, bg >> 1, 63 - rank, bg & 1);
        __syncthreads();
        u = __builtin_amdgcn_readfirstlane(*slot);
    }
}

__device__ __forceinline__ void swa_load(const Ctx& c, int b, int i, int g, uint4 (&kr)[3], uint4 (&vr)[3], int tid) {
    using namespace fa;
    const bf16_t* P = (const bf16_t*)(c.ws + WS_PROJ);
    const int k0 = (i - 2 > 0) ? i - 2 : 0, n = i - k0 + 1;
    const bf16_t* Kb = P + (size_t)b * SEQ * ODP + 1024 + g * 64; const bf16_t* Vb = P + (size_t)b * SEQ * ODP + 1152 + g * 64;
#pragma unroll
    for (int x = 0; x < 3; ++x) if (x < n) { const long row = 64 * (k0 + x) + (tid >> 3); kr[x] = ldg_tile(Kb, row, ODP, tid); vr[x] = ldg_tile(Vb, row, ODP, tid); }
}
template <bool FAST>
__device__ __forceinline__ void swa_unit(const Ctx& c, unsigned char* lds, int b, int i, int g, uint4 (&kr)[3], uint4 (&vr)[3], bool has_next, int nb, int ni, int ng) {
    using namespace fa;
    constexpr int SW_K = 0, SW_V = 3 * KTB, SW_STG = 3 * KTB + 3 * VTB;
    static_assert(SW_STG + 8 * STG_W <= LDS_BARST, "swa LDS");
    const bf16_t* P = (const bf16_t*)(c.ws + WS_PROJ); bf16_t* ATT = (bf16_t*)(c.ws + WS_H);
    const int tid = c.tid, lane = c.lane, w = c.wave, r32 = lane & 31, hi = lane >> 5;
    const int tl = 8 * w + (r32 >> 2), hh = r32 & 3, t = 64 * i + tl;
    const size_t m = (size_t)b * SEQ + t;
    const int k0 = (i - 2 > 0) ? i - 2 : 0, n = i - k0 + 1;
#pragma unroll
    for (int x = 0; x < 3; ++x) if (x < n) kr[x] = knorm_rope(kr[x], c.swa_kg, (const float2*)(c.ws + WS_ROPE) + (size_t)(64 * (k0 + x) + (tid >> 3)) * 8, tid & 7);
    __syncthreads();
#pragma unroll
    for (int x = 0; x < 3; ++x) if (x < n) { *(uint4*)(lds + SW_K + x * KTB + (tid >> 3) * RPK + (tid & 7) * 16) = kr[x]; *(uint4*)(lds + SW_V + x * VTB + (tid >> 3) * RPV + (tid & 7) * 16) = vr[x]; }
    __syncthreads();
    if (has_next) swa_load(c, nb, ni, ng, kr, vr, tid);
#pragma unroll 1
    for (int hq = 0; hq < 2; ++hq) {
        const int head = 8 * g + 4 * hq + hh;
        bf16x8 qf[4];
#pragma unroll
        for (int sp = 0; sp < 4; ++sp) qf[sp] = *(const bf16x8*)(P + m * ODP + head * 64 + 16 * sp + 8 * hi);
        qnorm_rope(qf, c.swa_qg, (const float2*)(c.ws + WS_ROPE) + (size_t)t * 8, hi);
        State st; const float sink2 = c.swa_sinks[head] * 1.4426950408889634f;
        if (FAST) init(st, 0.f, hi == 0 ? __builtin_amdgcn_exp2f(sink2) : 0.f); else init(st, sink2, hi == 0 ? 1.f : 0.f);
#pragma unroll 1
        for (int x = 0; x < n; ++x) {
            const int kt = k0 + x;
            RangeMask mk{0, 63}; if (kt == i) mk.hi = tl; if (kt == i - 2) mk.lo = tl + 1;
            tile<0, FAST, false>(st, lds, SW_K + x * KTB, SW_V + x * VTB, qf, 0.f, (kt == i) || (kt == i - 2), mk, lane);
        }
        unsigned char* stg = lds + SW_STG + w * STG_W;
        const float lt = st.l + __shfl_xor(st.l, 32);
        const float sc = 1.f / lt;
#pragma unroll
        for (int dt = 0; dt < 2; ++dt)
#pragma unroll
            for (int r = 0; r < 16; ++r) *(bf16_t*)(stg + r32 * STG_P + (32 * dt + crow(r, hi)) * 2) = f2bf(sc * st.o[dt][r]);
        LDS_FENCE();
#pragma unroll
        for (int it = 0; it < 4; ++it) {
            const int row = it * 8 + (lane >> 3), ch = lane & 7;
            const uint4 v = *(const uint4*)(stg + row * STG_P + ch * 16);
            const size_t mm = (size_t)b * SEQ + 64 * i + 8 * w + (row >> 2);
            *(uint4*)(ATT + mm * D + (8 * g + 4 * hq + (row & 3)) * 64 + ch * 8) = v;
        }
        LDS_FENCE();
    }
}
__device__ __forceinline__ void swa_mfma(const Ctx& c, unsigned char* lds) {
    const bool fast = score_bound(c.swa_qg, c.swa_kg, 1, c.lane) < 60.f && wmax(fabsf(c.swa_sinks[c.lane & 15])) < 40.f;
    uint4 kr[3], vr[3];
    if ((int)blockIdx.x < 2048) swa_load(c, blockIdx.x >> 7, (blockIdx.x >> 1) & 63, blockIdx.x & 1, kr, vr, c.tid);
    for (int u = blockIdx.x; u < 2048; u += gridDim.x) {
        const int g = u & 1, i = (u >> 1) & 63, b = u >> 7, un = u + gridDim.x;
        if (fast) swa_unit<true>(c, lds, b, i, g, kr, vr, un < 2048, un >> 7, (un >> 1) & 63, un & 1); else swa_unit<false>(c, lds, b, i, g, kr, vr, un < 2048, un >> 7, (un >> 1) & 63, un & 1);
    }
}

__device__ __forceinline__ void phase_router2(const Ctx& c, unsigned char* lds_raw, int layer) {
    typedef short bf16x8 __attribute__((ext_vector_type(8)));
    typedef float f32x4 __attribute__((ext_vector_type(4)));
    const int tid = c.tid, lane = c.lane, w = c.wave, l15 = lane & 15, g4 = lane >> 4;
    float* LG = (float*)(lds_raw + w * 5632);
    float* RS = LG + 32 * 40;
    int* lcnt = (int*)(lds_raw + 8 * 5632);
    int* lbase = lcnt + 32;
    int* tinfo = lbase + 32;
    float* twt = (float*)(tinfo + 1024);
    const bf16_t* XB = (const bf16_t*)(c.ws + WS_XB); const bf16_t* RW = (const bf16_t*)(c.ws + WS_RW) + (size_t)layer * 48 * 2048;
    const float* bg = c.moe_b_grp + layer * 4; const float* be = c.moe_b_exp + layer * 32; const float* gain = c.moe_norm + layer * D;
    int* gcnt = (int*)(c.ws + WS_CTL) + layer * 32;
    bf16_t* H = (bf16_t*)(c.ws + WS_H);
    int* TE = (int*)(c.ws + WS_TE); int* TR = (int*)(c.ws + WS_TR); float* TW = (float*)(c.ws + WS_TW);
    __syncthreads();
    if (tid < 32) lcnt[tid] = 0;
    __syncthreads();
    for (int blk = blockIdx.x; blk < M / 256; blk += gridDim.x) {
        const int tok0 = blk * 256 + w * 32;
        f32x4 acc[2][3];
#pragma unroll
        for (int mt = 0; mt < 2; ++mt)
#pragma unroll
            for (int nt = 0; nt < 3; ++nt) acc[mt][nt] = (f32x4){0.f, 0.f, 0.f, 0.f};
        float sq0 = 0.f, sq1 = 0.f;
        const bf16_t* a0 = XB + (size_t)(tok0 + l15) * D + 8 * g4; const bf16_t* a1 = a0 + (size_t)16 * D;
        const bf16_t* b0 = RW + (size_t)l15 * 2048 + 8 * g4;
#pragma unroll 2
        for (int ks = 0; ks < 32; ++ks) {
            const bf16x8 A0 = *(const bf16x8*)(a0 + 32 * ks), A1 = *(const bf16x8*)(a1 + 32 * ks);
            { float f[8]; unpack8(__builtin_bit_cast(uint4, A0), f);
#pragma unroll
              for (int j = 0; j < 8; ++j) sq0 += f[j] * f[j];
              unpack8(__builtin_bit_cast(uint4, A1), f);
#pragma unroll
              for (int j = 0; j < 8; ++j) sq1 += f[j] * f[j]; }
#pragma unroll
            for (int nt = 0; nt < 3; ++nt) {
                const bf16x8 Bh = *(const bf16x8*)(b0 + (size_t)nt * 16 * 2048 + 32 * ks), Bl = *(const bf16x8*)(b0 + (size_t)nt * 16 * 2048 + 1024 + 32 * ks);
                acc[0][nt] = __builtin_amdgcn_mfma_f32_16x16x32_bf16(A0, Bh, acc[0][nt], 0, 0, 0); acc[0][nt] = __builtin_amdgcn_mfma_f32_16x16x32_bf16(A0, Bl, acc[0][nt], 0, 0, 0);
                acc[1][nt] = __builtin_amdgcn_mfma_f32_16x16x32_bf16(A1, Bh, acc[1][nt], 0, 0, 0); acc[1][nt] = __builtin_amdgcn_mfma_f32_16x16x32_bf16(A1, Bl, acc[1][nt], 0, 0, 0);
            }
        }
        sq0 += __shfl_xor(sq0, 16); sq0 += __shfl_xor(sq0, 32); sq1 += __shfl_xor(sq1, 16); sq1 += __shfl_xor(sq1, 32);
        if (g4 == 0) { RS[l15] = rsqrtf(sq0 * (1.f / D) + EPS); RS[16 + l15] = rsqrtf(sq1 * (1.f / D) + EPS); }
        LDS_FENCE();
#pragma unroll
        for (int nt = 0; nt < 3; ++nt) {
            const int o = 16 * nt + l15;
            if (o < 36) {
                const float bias = o < 4 ? bg[o] : be[o - 4];
#pragma unroll
                for (int mt = 0; mt < 2; ++mt)
#pragma unroll
                    for (int r = 0; r < 4; ++r) { const int tk = 16 * mt + 4 * g4 + r; LG[tk * 40 + o] = acc[mt][nt][r] * RS[tk] + bias; }
            }
        }
        LDS_FENCE();
        if (lane < 32) {
            const float* lg = LG + lane * 40;
            int gi = 0; float gm = lg[0];
#pragma unroll
            for (int q = 1; q < 4; ++q) if (lg[q] > gm) { gm = lg[q]; gi = q; }
            float gs = 0.f;
#pragma unroll
            for (int q = 0; q < 4; ++q) gs += expf(lg[q] - gm);
            const float gwt = 1.f / gs;
            float w8[8];
#pragma unroll
            for (int j = 0; j < 8; ++j) w8[j] = lg[4 + gi * 8 + j];
            int j0 = 0; float l0 = w8[0];
#pragma unroll
            for (int j = 1; j < 8; ++j) if (w8[j] > l0) { l0 = w8[j]; j0 = j; }
            int j1 = -1; float l1 = -INFINITY;
#pragma unroll
            for (int j = 0; j < 8; ++j) if (j != j0 && w8[j] > l1) { l1 = w8[j]; j1 = j; }
            const float e1 = expf(l1 - l0); const float w0 = gwt / (1.f + e1), w1 = gwt * e1 / (1.f + e1);
            const int tl = w * 32 + lane, ea = gi * 8 + j0, eb = gi * 8 + j1;
            const int ra = atomicAdd(&lcnt[ea], 1), rb = atomicAdd(&lcnt[eb], 1);
            tinfo[tl * 4 + 0] = ea; tinfo[tl * 4 + 1] = eb; tinfo[tl * 4 + 2] = ra; tinfo[tl * 4 + 3] = rb; twt[tl * 2] = w0; twt[tl * 2 + 1] = w1;
        }
        __syncthreads();
        if (tid < 32) { lbase[tid] = atomicAdd(&gcnt[tid], lcnt[tid]); lcnt[tid] = 0; }
        __syncthreads();
        if (tid < 256) {
            const int m = blk * 256 + tid; const int ea = tinfo[tid * 4], eb = tinfo[tid * 4 + 1];
            TE[2 * m] = ea; TE[2 * m + 1] = eb; TR[2 * m] = lbase[ea] + tinfo[tid * 4 + 2]; TR[2 * m + 1] = lbase[eb] + tinfo[tid * 4 + 3];
            TW[2 * m] = twt[tid * 2]; TW[2 * m + 1] = twt[tid * 2 + 1];
            int* LIST = (int*)(c.ws + WS_LIST);
            LIST[(size_t)ea * 65536 + lbase[ea] + tinfo[tid * 4 + 2]] = m; LIST[(size_t)eb * 65536 + lbase[eb] + tinfo[tid * 4 + 3]] = m;
            float* RSL = (float*)(c.ws + WS_RSL); const float rsv = ((const float*)(lds_raw + (tid >> 5) * 5632))[32 * 40 + (tid & 31)];
            RSL[(size_t)ea * 65536 + lbase[ea] + tinfo[tid * 4 + 2]] = rsv; RSL[(size_t)eb * 65536 + lbase[eb] + tinfo[tid * 4 + 3]] = rsv;
        }
        __syncthreads();
    }
}

__device__ __forceinline__ int build_tile_table(const Ctx& c, unsigned char* lds_raw, int layer) {
    const int* gcnt = (const int*)(c.ws + WS_CTL) + layer * 32;
    int* pst = (int*)(lds_raw + pg8::STAGE_BYTES); int* te = pst + 64; int* tv = te + MAXTILES; int* tg = tv + MAXTILES;
    __syncthreads();
    if (c.tid == 0) { int a = 0; for (int e = 0; e < 32; ++e) { pst[e] = a; a += (gcnt[e] + 255) >> 8; } pst[32] = a; }
    __syncthreads();
    for (int st = c.tid; st < MAXTILES; st += NTHREADS) {
        int e = 31;
        for (int q = 0; q < 32; ++q) if (st >= pst[q] && st < pst[q + 1]) e = q;
        const int ti = st - pst[e], rem = gcnt[e] - 256 * ti;
        te[st] = e; tv[st] = rem < 256 ? (rem > 0 ? rem : 0) : 256; tg[st] = e * 65536 + 256 * ti;
    }
    __syncthreads();
    return pst[32];
}
__device__ __forceinline__ void phase_moe1_mfma(const Ctx& c, unsigned char* lds_raw, int layer) {
    const int nt = build_tile_table(c, lds_raw, layer);
    const int* te = (const int*)(lds_raw + pg8::STAGE_BYTES) + 64;
    pg8::Gemm g{(const bf16_t*)(c.ws + WS_XB), (const bf16_t*)(c.ws + WS_WGU) + (size_t)layer * 32 * 1024 * 1024, D, (const int*)(c.ws + WS_LIST), (size_t)1024 * 1024};
    pg8::MoeOrder S{te, te + MAXTILES, te + 2 * MAXTILES, nt * 4, (int)gridDim.x, (int)blockIdx.x};
    pg8::EpiGUT E{(bf16_t*)(c.ws + WS_HID), (const float*)(c.ws + WS_RSL)};
    pg8::gemm_phase<pg8::EpiGUT, pg8::MoeOrder, true>((PG8_LAS unsigned char*)lds_raw, g, S, E);
}
__device__ __forceinline__ void phase_moe2_mfma(const Ctx& c, unsigned char* lds_raw, int layer) {
    const int nt = build_tile_table(c, lds_raw, layer);
    const int* te = (const int*)(lds_raw + pg8::STAGE_BYTES) + 64;
    pg8::Gemm g{(const bf16_t*)(c.ws + WS_HID), (const bf16_t*)(c.ws + WS_WD) + (size_t)layer * 32 * 1024 * 512, FF, nullptr, (size_t)1024 * 512};
    pg8::MoeOrder S{te, te + MAXTILES, te + 2 * MAXTILES, nt * 4, (int)gridDim.x, (int)blockIdx.x};
    pg8::EpiDownT E{(bf16_t*)(c.ws + WS_YS)};
    pg8::gemm_phase<pg8::EpiDownT, pg8::MoeOrder, false>((PG8_LAS unsigned char*)lds_raw, g, S, E);
}
template <class Epi>
__device__ __forceinline__ void phase_gemm_mfma(unsigned char* lds_raw, const bf16_t* A, const bf16_t* Bt, int Npad, int K, const Epi& E) {
    pg8::Gemm g{A, Bt, K, nullptr, 0}; pg8::StaticOrder S; S.init(M, Npad, (int)gridDim.x, (int)blockIdx.x);
    pg8::gemm_phase<Epi, pg8::StaticOrder, false>((PG8_LAS unsigned char*)lds_raw, g, S, E);
}

#ifndef PSTAMP
#define PSTAMP(k) do {} while (0)
#endif
#define PHASE_BEGIN() Ctx c; { CArgs* ap_ = (CArgs*)__builtin_amdgcn_kernarg_segment_ptr(); asm volatile("" : "+s"(ap_)); int tid_ = threadIdx.x; asm volatile("" : "+v"(tid_)); make_ctx(c, *ap_, tid_); } \
    unsigned char* ws = c.ws; bf16_t* H = (bf16_t*)(ws + WS_H); bf16_t* PROJ = (bf16_t*)(ws + WS_PROJ); (void)H; (void)PROJ;
__global__ void __launch_bounds__(NTHREADS, 2) mega(Args a) {
    extern __shared__ __attribute__((aligned(16))) unsigned char lds_raw[];
    float* lds = (float*)lds_raw;
    if (threadIdx.x < 4) ((volatile XLAS unsigned*)(XLAS unsigned char*)lds_raw)[(LDS_BARST >> 2) + threadIdx.x] = 0u;
    __syncthreads();
    const XcdBarrier xbar = xcd_barrier_post((unsigned*)(a.ws + WS_CTL + CTL_BAR), (volatile XLAS unsigned*)((XLAS unsigned char*)lds_raw + LDS_BARST));
    PSTAMP(0); { PHASE_BEGIN(); phase_prologue(c, lds); PSTAMP(23); phase_norm_x(c, c.x, c.ev_norm, H); }
    xcd_barrier(xbar);
    PSTAMP(1); { PHASE_BEGIN(); pg8::EpiProj0T epi{PROJ, (float*)(ws + WS_LOGF), (const float*)(ws + WS_LB)}; phase_gemm_mfma(lds_raw, H, (const bf16_t*)(ws + WS_W0T), EVPP, D, epi); }
    xcd_barrier(xbar);
    PSTAMP(2); { PHASE_BEGIN();
      post_even(c, blockIdx.x, gridDim.x); PSTAMP(20);
      for (int u = blockIdx.x; u < 256; u += gridDim.x) compress_mfma(c, lds_raw, u);
      PSTAMP(21);
      for (int su = blockIdx.x; su < 256; su += gridDim.x) hgrn2_passA(c, lds_raw, su); }
    xcd_barrier(xbar);
    PSTAMP(24); { PHASE_BEGIN();
      for (int u = blockIdx.x; u < 64; u += gridDim.x) hgrn2_seq_full(c, lds_raw, u);
      PSTAMP(3); nsa_mfma(c, lds_raw); PSTAMP(22);
#ifdef PROBE_NSA_ABL
      nsa_mfma<PROBE_NSA_ABL, true>(c, lds_raw);
#endif
    }
    xcd_barrier(xbar);
    PSTAMP(4); { PHASE_BEGIN(); pg8::EpiResidF2B epi{c.x, (bf16_t*)(ws + WS_XB)}; phase_gemm_mfma(lds_raw, H, (const bf16_t*)(ws + WS_WO0T), D, D, epi); }
    xcd_barrier(xbar);
    PSTAMP(5); { PHASE_BEGIN(); phase_router2(c, lds_raw, 0); }
    xcd_barrier(xbar);
    PSTAMP(7); { PHASE_BEGIN(); phase_moe1_mfma(c, lds_raw, 0); }
    xcd_barrier(xbar);
    PSTAMP(8); { PHASE_BEGIN(); phase_moe2_mfma(c, lds_raw, 0); }
    xcd_barrier(xbar);
    PSTAMP(9); { PHASE_BEGIN(); phase_combine<false>(c, (bf16_t*)(ws + WS_XB), nullptr, c.od_norm, H, (const bf16_t*)(ws + WS_YS), 0); }
    xcd_barrier(xbar);
    PSTAMP(10); { PHASE_BEGIN(); pg8::EpiRawScaleT epi{PROJ, ODP, (const float*)(ws + WS_RSTD)}; phase_gemm_mfma(lds_raw, (const bf16_t*)(ws + WS_XB), (const bf16_t*)(ws + WS_W1T), ODP, D, epi); }
    xcd_barrier(xbar);
    PSTAMP(12); { PHASE_BEGIN(); swa_mfma(c, lds_raw); }
    xcd_barrier(xbar);
    PSTAMP(13); { PHASE_BEGIN(); pg8::EpiResidB2B epi{(bf16_t*)(ws + WS_XB)}; phase_gemm_mfma(lds_raw, H, (const bf16_t*)(ws + WS_WO1T), D, D, epi); }
    xcd_barrier(xbar);
    PSTAMP(14); { PHASE_BEGIN(); phase_router2(c, lds_raw, 1); }
    xcd_barrier(xbar);
    PSTAMP(16); { PHASE_BEGIN(); phase_moe1_mfma(c, lds_raw, 1); }
    xcd_barrier(xbar);
    PSTAMP(17); { PHASE_BEGIN(); phase_moe2_mfma(c, lds_raw, 1); }
    xcd_barrier(xbar);
    PSTAMP(18); { PHASE_BEGIN(); phase_combine<true>(c, (bf16_t*)(ws + WS_XB), c.xr, nullptr, nullptr, (const bf16_t*)(ws + WS_YS), 1); }
    PSTAMP(19);
#ifdef PROBE_TAIL
    PROBE_TAIL
#endif
}

extern "C" void kernel_launch(void* const* d_in, const int* in_sizes, int n_in, void* d_out, int out_size, void* d_ws, size_t ws_size, hipStream_t stream) {
    static int grid = 0;
    if (grid == 0) {
        if (n_in != 25 || ws_size < WS_END) { fprintf(stderr, "kernel_launch: unexpected n_in %d / ws %zu\n", n_in, ws_size); grid = -1; return; }
        int dev = 0, cus = 0, per_cu = 0;
        hipGetDevice(&dev);
        hipDeviceGetAttribute(&cus, hipDeviceAttributeMultiprocessorCount, dev);
        hipFuncSetAttribute((const void*)mega, hipFuncAttributeMaxDynamicSharedMemorySize, LDS_BYTES);
        hipOccupancyMaxActiveBlocksPerMultiprocessor(&per_cu, (const void*)mega, NTHREADS, LDS_BYTES);
        if (per_cu < 1) { fprintf(stderr, "kernel_launch: occupancy query says %d blocks/CU\n", per_cu); per_cu = 1; }
        (void)hipGetLastError();
        grid = cus;
    }
    if (grid < 0) return;
    hipMemsetAsync((char*)d_ws + WS_CTL, 0, CTL_BYTES, stream);
    Args a{};
    for (int i = 0; i < 25; ++i) a.in[i] = (const float*)d_in[i];
    a.out = (float*)d_out; a.ws = (unsigned char*)d_ws;
    void* args[] = {&a};
    hipError_t e = hipLaunchCooperativeKernel((const void*)mega, dim3(grid), dim3(NTHREADS), args, LDS_BYTES, stream);
    if (e != hipSuccess) fprintf(stderr, "cooperative launch failed: %s (grid %d)\n", hipGetErrorString(e), grid);
}
```

```cpp
#include <hip/hip_runtime.h>
#include <hip/hip_cooperative_groups.h>
#include <cstdio>
#include <cstdint>
namespace cg = cooperative_groups;

constexpr int D = 1024, BATCH = 16, SEQ = 4096, M = BATCH * SEQ;
constexpr int EVP = 3352, EVPP = 3584, ODP = 1280;
constexpr int NEXP = 32, FF = 512;
constexpr int NTHREADS = 512, NWAVES = 8;
constexpr int MAXTILES = 544;
constexpr int NSLOTS = MAXTILES * 256;
constexpr float EPS = 1e-6f;

typedef unsigned short bf16_t;
typedef unsigned int u32;

constexpr size_t MiB = 1u << 20;
constexpr size_t WS_CTL = 0;
constexpr size_t CTL_BYTES = 64 * 1024;
constexpr size_t WS_LB = 1 * MiB;
constexpr size_t WS_CBIAS = WS_LB + 4096;
constexpr size_t WS_ROPE = WS_LB + 8192;
constexpr size_t WS_KCB = 2 * MiB;
constexpr size_t WS_VCB = 3 * MiB;
constexpr size_t WS_TE = 4 * MiB;
constexpr size_t WS_TR = 4 * MiB + 512 * 1024;
constexpr size_t WS_TW = 5 * MiB;
constexpr size_t WS_TSLOT = 5 * MiB + 512 * 1024;
constexpr size_t WS_ROWTOK = 6 * MiB;
constexpr size_t WS_ROWW = 7 * MiB;
constexpr size_t WS_TILEE = 8 * MiB;
constexpr size_t WS_W0T = 16 * MiB;
constexpr size_t WS_WO0T = 23 * MiB;
constexpr size_t WS_W1T = 25 * MiB;
constexpr size_t WS_WO1T = 28 * MiB;
constexpr size_t WS_CW1T = 30 * MiB;
constexpr size_t WS_CW2T = 32 * MiB;
constexpr size_t WS_RW = 33 * MiB;
constexpr size_t WS_WGU = 40 * MiB;
constexpr size_t WS_WD = 168 * MiB;
constexpr size_t WS_H = 232 * MiB;
constexpr size_t WS_PROJ = 360 * MiB;
constexpr size_t WS_HID = WS_PROJ;
constexpr size_t WS_YS = WS_PROJ + 136 * MiB;
constexpr size_t WS_LOGF = 808 * MiB;
constexpr size_t WS_XB = WS_LOGF;
constexpr size_t WS_LIST = 936 * MiB;
constexpr size_t WS_RSL = 944 * MiB;
constexpr size_t WS_RSTD = 952 * MiB;
constexpr size_t WS_END = 953 * MiB;

constexpr int LDS_BYTES = 160 * 1024;
constexpr int LDS_BARST = LDS_BYTES - 16;
constexpr size_t CTL_BAR = 16 * 1024;
constexpr int CTL_QUEUE = 1024;

__device__ __forceinline__ float bf2f(bf16_t v) { return __uint_as_float(((u32)v) << 16); }
typedef float f32x2_t __attribute__((ext_vector_type(2))); typedef __bf16 bf16x2_t __attribute__((ext_vector_type(2)));
__device__ __forceinline__ u32 pk2(float lo, float hi) { f32x2_t v = {lo, hi}; bf16x2_t b = __builtin_convertvector(v, bf16x2_t); return __builtin_bit_cast(u32, b); }
__device__ __forceinline__ bf16_t f2bf(float f) { return (bf16_t)(pk2(f, 0.f) & 0xffffu); }
__device__ __forceinline__ float wsum(float v) {
#pragma unroll
    for (int o = 32; o; o >>= 1) v += __shfl_xor(v, o);
    return v;
}
__device__ __forceinline__ float wmax(float v) {
#pragma unroll
    for (int o = 32; o; o >>= 1) v = fmaxf(v, __shfl_xor(v, o));
    return v;
}
__device__ __forceinline__ void unpack8(const uint4& w, float* f) {
    f[0] = __uint_as_float(w.x << 16); f[1] = __uint_as_float(w.x & 0xffff0000u);
    f[2] = __uint_as_float(w.y << 16); f[3] = __uint_as_float(w.y & 0xffff0000u);
    f[4] = __uint_as_float(w.z << 16); f[5] = __uint_as_float(w.z & 0xffff0000u);
    f[6] = __uint_as_float(w.w << 16); f[7] = __uint_as_float(w.w & 0xffff0000u);
}
#define LDS_FENCE() asm volatile("s_waitcnt lgkmcnt(0)" ::: "memory")
typedef unsigned hs_u32x4 __attribute__((ext_vector_type(4)));
typedef unsigned hs_u32x2 __attribute__((ext_vector_type(2)));
__device__ __forceinline__ void st_hidden(void* p, uint4 v) { hs_u32x4 d = {v.x, v.y, v.z, v.w}; asm volatile("global_store_dwordx4 %0, %1, off\n\ts_nop 1" : : "v"(p), "v"(d) : "memory"); }
__device__ __forceinline__ void st_hidden(void* p, uint2 v) { hs_u32x2 d = {v.x, v.y}; asm volatile("global_store_dwordx2 %0, %1, off\n\ts_nop 1" : : "v"(p), "v"(d) : "memory"); }
__device__ __forceinline__ void st_hidden(void* p, float v) { asm volatile("global_store_dword %0, %1, off\n\ts_nop 1" : : "v"(p), "v"(v) : "memory"); }
#define HS_DRAIN() asm volatile("s_waitcnt vmcnt(0)" ::: "memory")

#define XB_TMO      128
#define XB_XCNT(j)  (256  + 64 * (j))
#define XB_XSUB(j)  (1280 + 64 * (j))
#define XB_XGEN(j)  (2304 + 64 * (j))
#define XB_TOP      3328
#define XB_TOPGEN   3392
#define XCD_BAR_WORDS 3456
#define XB_SPIN_CAP (1u << 18)
#define XLAS __attribute__((address_space(3)))
__device__ __forceinline__ unsigned xb_ld(unsigned* p)              { return __hip_atomic_load(p, __ATOMIC_RELAXED, __HIP_MEMORY_SCOPE_AGENT); }
__device__ __forceinline__ unsigned xb_add(unsigned* p, unsigned v) { return __hip_atomic_fetch_add(p, v, __ATOMIC_RELAXED, __HIP_MEMORY_SCOPE_AGENT); }
__device__ __forceinline__ unsigned xb_xcc_id() { return (unsigned)__builtin_amdgcn_s_getreg((3 << 11) | 20) & 0xFu; }
#define XB_SPIN(cond, bar) do { unsigned _sp = 0; while (cond) { __builtin_amdgcn_s_sleep(1); \
    if ((++_sp & 255u) == 0u) { if (xb_ld(&(bar)[XB_TMO])) break; if (_sp > XB_SPIN_CAP) { atomicAdd(&(bar)[XB_TMO], 1u); break; } } } } while (0)
struct XcdBarrier { unsigned* bar; unsigned x; volatile XLAS unsigned* st; };
__device__ __forceinline__ XcdBarrier xcd_barrier_post(unsigned* bar, volatile XLAS unsigned* st) {
    XcdBarrier b; b.bar = bar; b.x = xb_xcc_id(); b.st = st;
    if (threadIdx.x == 0) (void)xb_add(&bar[XB_XCNT(b.x)], 1u);
    return b;
}
__device__ __forceinline__ void xcd_barrier_complete(unsigned* bar, unsigned x, unsigned& nloc, unsigned& nx) {
    const unsigned G = gridDim.x * gridDim.y * gridDim.z;
    unsigned sum, cnt, mine, sp = 0u;
    for (;;) {
        sum = 0u; cnt = 0u; mine = 0u;
#pragma unroll
        for (unsigned j = 0; j < 16; ++j) { const unsigned c = xb_ld(&bar[XB_XCNT(j)]); sum += c; cnt += (c > 0u) ? 1u : 0u; mine = (j == x) ? c : mine; }
        if (sum == G) break;
        __builtin_amdgcn_s_sleep(1);
        if ((++sp & 255u) == 0u) { if (xb_ld(&bar[XB_TMO])) break; if (sp > XB_SPIN_CAP) { atomicAdd(&bar[XB_TMO], 1u); break; } }
    }
    nloc = mine > 0u ? mine : 1u; nx = cnt > 0u ? cnt : 1u;
}
__device__ __forceinline__ void xcd_barrier(const XcdBarrier& b) {
    asm volatile("s_waitcnt vmcnt(0)" ::: "memory");
    __syncthreads();
    if (threadIdx.x == 0) {
        unsigned* bar = b.bar;
        __builtin_amdgcn_s_waitcnt(0);
        unsigned nloc = b.st[0], nx = b.st[1];
        if (nloc == 0u) { xcd_barrier_complete(bar, b.x, nloc, nx); b.st[0] = nloc; b.st[1] = nx; }
        const unsigned old = xb_add(&bar[XB_XSUB(b.x)], 1u);
        const unsigned gen = old / nloc;
        if (old + 1u == (gen + 1u) * nloc) {
            __builtin_amdgcn_fence(__ATOMIC_RELEASE, "agent");
            asm volatile("s_waitcnt vmcnt(0)" ::: "memory");
            const unsigned og = xb_add(&bar[XB_TOP], 1u);
            const unsigned tg = og / nx;
            if (og + 1u == (tg + 1u) * nx) xb_add(&bar[XB_TOPGEN], 1u);
            else XB_SPIN(xb_ld(&bar[XB_TOPGEN]) == tg, bar);
            __builtin_amdgcn_fence(__ATOMIC_ACQUIRE, "agent");
            xb_add(&bar[XB_XGEN(b.x)], 1u);
            asm volatile("s_waitcnt vmcnt(0)" ::: "memory");
        } else {
            XB_SPIN(xb_ld(&bar[XB_XGEN(b.x)]) == gen, bar);
            __builtin_amdgcn_fence(__ATOMIC_ACQUIRE, "agent");
            asm volatile("s_waitcnt vmcnt(0)" ::: "memory");
        }
    }
    __syncthreads();
}

struct Args {
    const float* in[25];
    float* out;
    unsigned char* ws;
};

struct Ctx {
    const float *x, *ev_norm, *ev_w_in, *hg_lb, *hg_gain, *nsa_qg, *nsa_kg, *cmp_pe, *cmp_w1, *cmp_w2, *ev_w_out;
    const float *od_norm, *od_w_in, *swa_qg, *swa_kg, *swa_sinks, *od_w_out;
    const float *moe_norm, *moe_w_grp, *moe_b_grp, *moe_w_exp, *moe_b_exp, *moe_w_gate, *moe_w_up, *moe_w_down;
    float* xr;
    unsigned char* ws;
    int tid, lane, wave, gw, ngw;
};

typedef const __attribute__((address_space(4))) Args CArgs;
__device__ __forceinline__ void make_ctx(Ctx& c, CArgs& a, int tid_) {
    c.x = a.in[0]; c.ev_norm = a.in[1]; c.ev_w_in = a.in[2]; c.hg_lb = a.in[3]; c.hg_gain = a.in[4]; c.nsa_qg = a.in[5]; c.nsa_kg = a.in[6]; c.cmp_pe = a.in[7];
    c.cmp_w1 = a.in[8]; c.cmp_w2 = a.in[9]; c.ev_w_out = a.in[10]; c.od_norm = a.in[11]; c.od_w_in = a.in[12]; c.swa_qg = a.in[13]; c.swa_kg = a.in[14]; c.swa_sinks = a.in[15];
    c.od_w_out = a.in[16]; c.moe_norm = a.in[17]; c.moe_w_grp = a.in[18]; c.moe_b_grp = a.in[19]; c.moe_w_exp = a.in[20]; c.moe_b_exp = a.in[21];
    c.moe_w_gate = a.in[22]; c.moe_w_up = a.in[23]; c.moe_w_down = a.in[24];
    c.xr = a.out; c.ws = a.ws;
    c.tid = tid_; c.lane = c.tid & 63; c.wave = c.tid >> 6; c.gw = blockIdx.x * NWAVES + c.wave; c.ngw = gridDim.x * NWAVES;
}

__device__ __forceinline__ void transpose_item(const float* W, int K, int Nsrc, bf16_t* WT, int drow0, int k0, int n0, float* scr, int lane, const float* gain = nullptr) {
    const int rk = lane >> 3, c4 = 4 * (lane & 7);
    float4 v[8];
#pragma unroll
    for (int i = 0; i < 8; ++i) v[i] = (n0 + c4 < Nsrc) ? *(const float4*)(W + (size_t)(k0 + 8 * i + rk) * Nsrc + n0 + c4) : make_float4(0.f, 0.f, 0.f, 0.f);
#pragma unroll
    for (int i = 0; i < 8; ++i) { float* d = scr + (8 * i + rk) * 33 + c4; d[0] = v[i].x; d[1] = v[i].y; d[2] = v[i].z; d[3] = v[i].w; }
    LDS_FENCE();
    const int c = lane & 7;
#pragma unroll
    for (int j = 0; j < 4; ++j) {
        const int n = (lane >> 3) + 8 * j;
        const float* s = scr + (8 * c) * 33 + n;
        uint4 o;
        float4 ga = make_float4(1.f, 1.f, 1.f, 1.f), gb = ga;
        if (gain) { ga = *(const float4*)(gain + k0 + 8 * c); gb = *(const float4*)(gain + k0 + 8 * c + 4); }
        o.x = pk2(s[0 * 33] * ga.x, s[1 * 33] * ga.y); o.y = pk2(s[2 * 33] * ga.z, s[3 * 33] * ga.w); o.z = pk2(s[4 * 33] * gb.x, s[5 * 33] * gb.y); o.w = pk2(s[6 * 33] * gb.z, s[7 * 33] * gb.w);
        *(uint4*)(WT + (size_t)(drow0 + n0 + n) * K + k0 + 8 * c) = o;
    }
    LDS_FENCE();
}

struct MoeItem { const float* W; bf16_t* WT; const float* gain; int K, N, drow0, k0, n0; };
constexpr int MOE_ITEMS = 3 * 64 * 512;
__device__ __forceinline__ void moe_item_decode(const Ctx& c, int r, MoeItem& it) {
    constexpr int IG = 64 * 512;
    bf16_t* WGU = (bf16_t*)(c.ws + WS_WGU); bf16_t* WDt = (bf16_t*)(c.ws + WS_WD);
    if (r < 2 * IG) {
        const bool up = r >= IG; if (up) r -= IG;
        const int le = r >> 9, q = r & 511, kb = q >> 4, nb = q & 15, n0 = 32 * nb;
        it.W = (up ? c.moe_w_up : c.moe_w_gate) + (size_t)le * 1024 * 512; it.WT = WGU + (size_t)le * 1024 * 1024; it.K = 1024; it.N = 512; it.gain = c.moe_norm + (le >> 5) * D;
        it.drow0 = (n0 >> 7) * 256 + (up ? 128 : 0) + (n0 & 127) - n0; it.k0 = 32 * kb; it.n0 = n0;
    } else {
        r -= 2 * IG; const int le = r >> 9, q = r & 511;
        it.W = c.moe_w_down + (size_t)le * 512 * 1024; it.WT = WDt + (size_t)le * 1024 * 512; it.K = 512; it.N = 1024; it.drow0 = 0; it.k0 = 32 * (q >> 5); it.n0 = 32 * (q & 31); it.gain = nullptr;
    }
}
struct MoeRegs { float4 a, b, c, d; };
__device__ __forceinline__ void moe_item_issue(const MoeItem& it, MoeRegs& v, int lane) {
    const float* p = it.W + (size_t)(it.k0 + 4 * (lane >> 3)) * it.N + it.n0 + 4 * (lane & 7); const size_t N = it.N;
    v.a = *(const float4*)(p); v.b = *(const float4*)(p + N); v.c = *(const float4*)(p + 2 * N); v.d = *(const float4*)(p + 3 * N);
}
__device__ __forceinline__ void moe_item_finish(const MoeItem& it, const MoeRegs& v, int lane) {
    bf16_t* o = it.WT + (size_t)(it.drow0 + it.n0 + 4 * (lane & 7)) * it.K + it.k0 + 4 * (lane >> 3);
    uint2 w;
    w.x = pk2(v.a.x, v.b.x); w.y = pk2(v.c.x, v.d.x); *(uint2*)(o) = w;
    w.x = pk2(v.a.y, v.b.y); w.y = pk2(v.c.y, v.d.y); *(uint2*)(o + it.K) = w;
    w.x = pk2(v.a.z, v.b.z); w.y = pk2(v.c.z, v.d.z); *(uint2*)(o + 2 * (size_t)it.K) = w;
    w.x = pk2(v.a.w, v.b.w); w.y = pk2(v.c.w, v.d.w); *(uint2*)(o + 3 * (size_t)it.K) = w;
}

__device__ __forceinline__ void phase_prologue(const Ctx& c, float* lds) {
    float* scr = lds + c.wave * (64 * 33);
    unsigned char* ws = c.ws;
    bf16_t* W0T = (bf16_t*)(ws + WS_W0T); bf16_t* WO0T = (bf16_t*)(ws + WS_WO0T); bf16_t* W1T = (bf16_t*)(ws + WS_W1T); bf16_t* WO1T = (bf16_t*)(ws + WS_WO1T);
    bf16_t* CW1T = (bf16_t*)(ws + WS_CW1T); bf16_t* CW2T = (bf16_t*)(ws + WS_CW2T);
    constexpr int I0 = 16 * 112, I1 = 16 * 32, I2 = 16 * 40, I3 = 16 * 32, I4 = 2 * 32 * 8, I5 = 2 * 4 * 2;
    constexpr int NITEMS = I0 + I1 + I2 + I3 + I4 + I5;
    for (int it = c.gw; it < NITEMS; it += c.ngw) {
        int r = it;
        if (r < I0) { transpose_item(c.ev_w_in, 1024, EVP, W0T, 0, 64 * (r / 112), 32 * (r % 112), scr, c.lane); continue; } r -= I0;
        if (r < I1) { transpose_item(c.ev_w_out, 1024, 1024, WO0T, 0, 64 * (r / 32), 32 * (r % 32), scr, c.lane); continue; } r -= I1;
        if (r < I2) { transpose_item(c.od_w_in, 1024, ODP, W1T, 0, 64 * (r / 40), 32 * (r % 40), scr, c.lane, c.od_norm); continue; } r -= I2;
        if (r < I3) { transpose_item(c.od_w_out, 1024, 1024, WO1T, 0, 64 * (r / 32), 32 * (r % 32), scr, c.lane); continue; } r -= I3;
        if (r < I4) { const int kind = r / 256, q = r % 256; transpose_item(c.cmp_w1 + (size_t)kind * 2048 * 256, 2048, 256, CW1T + (size_t)kind * 256 * 2048, 0, 64 * (q / 8), 32 * (q % 8), scr, c.lane); continue; } r -= I4;
        if (r < I5) { const int kind = r / 8, q = r % 8; transpose_item(c.cmp_w2 + (size_t)kind * 256 * 64, 256, 64, CW2T + (size_t)kind * 64 * 256, 0, 64 * (q / 2), 32 * (q % 2), scr, c.lane); continue; }
    }
    const int gt = blockIdx.x * NTHREADS + c.tid, ngt = gridDim.x * NTHREADS;
    float* LB = (float*)(ws + WS_LB);
    for (int i = gt; i < 512; i += ngt) { const float l0 = c.hg_lb[i], l1 = c.hg_lb[512 + i]; LB[i] = 1.f / (1.f + expf(l1 - l0)); }
    float* CBP = (float*)(ws + WS_TSLOT);
    for (int j = c.gw; j < 2048; j += c.ngw) {
        const int i = j & 511, qk = j >> 9, kind = i >> 8, cc = i & 255; float sacc = 0.f;
#pragma unroll
        for (int it = 0; it < 8; ++it) { const int k = 512 * qk + 64 * it + c.lane; sacc += c.cmp_pe[kind * 2048 + k] * c.cmp_w1[((size_t)kind * 2048 + k) * 256 + cc]; }
        sacc = wsum(sacc);
        if (c.lane == 0) CBP[qk * 512 + i] = sacc;
    }
    bf16_t* RW = (bf16_t*)(ws + WS_RW);
    for (int i = gt; i < 2 * 48 * 1024; i += ngt) {
        const int k = i & 1023, o = (i >> 10) % 48, layer = i / (48 * 1024);
        float wv = 0.f;
        if (o < 36) wv = c.moe_norm[layer * D + k] * (o < 4 ? c.moe_w_grp[(size_t)layer * 1024 * 4 + k * 4 + o] : c.moe_w_exp[(size_t)layer * 1024 * 32 + k * 32 + (o - 4)]);
        const bf16_t hi = f2bf(wv); const bf16_t lo = f2bf(wv - bf2f(hi));
        RW[((size_t)layer * 48 + o) * 2048 + k] = hi; RW[((size_t)layer * 48 + o) * 2048 + 1024 + k] = lo;
    }
    float2* RT = (float2*)(ws + WS_ROPE);
    for (int i = (gt + ngt - 192 * NTHREADS) % ngt; i < 4096 * 8; i += ngt) {
        const int pos = i >> 3, f = i & 7;
        const double inv = f == 0 ? 1.0 : f == 1 ? 0.1939227447486858 : f == 2 ? 0.03760603093086394 : f == 3 ? 0.007292664737217109 : f == 4 ? 0.0014142135623730955 : f == 5 ? 0.00027424817567620724 : f == 6 ? 5.318295896944988e-05 : 1.0313385377212461e-05;
        const double a = (double)pos * inv;
        const double r = a - 6.283185307179586476925 * rint(a / 6.283185307179586476925);
        const float rf = (float)r;
        RT[i] = make_float2(cosf(rf), sinf(rf));
    }
}

__device__ __forceinline__ void phase_norm_x(const Ctx& c, const float* src, const float* gain, bf16_t* H) {
    for (int m0 = 2 * c.gw; m0 < M; m0 += 2 * c.ngw) {
        float4 v[2][4];
#pragma unroll
        for (int u = 0; u < 2; ++u) { const float4* xr = (const float4*)(src + (size_t)(m0 + u) * D) + c.lane;
#pragma unroll
            for (int j = 0; j < 4; ++j) v[u][j] = xr[64 * j]; }
#pragma unroll
        for (int u = 0; u < 2; ++u) {
            float s = 0.f;
#pragma unroll
            for (int j = 0; j < 4; ++j) s += v[u][j].x * v[u][j].x + v[u][j].y * v[u][j].y + v[u][j].z * v[u][j].z + v[u][j].w * v[u][j].w;
            const float rstd = rsqrtf(wsum(s) * (1.f / D) + EPS);
            uint2* o = (uint2*)(H + (size_t)(m0 + u) * D) + c.lane;
#pragma unroll
            for (int j = 0; j < 4; ++j) {
                const float4 g = ((const float4*)gain)[c.lane + 64 * j];
                uint2 w; w.x = pk2(v[u][j].x * rstd * g.x, v[u][j].y * rstd * g.y); w.y = pk2(v[u][j].z * rstd * g.z, v[u][j].w * rstd * g.w);
                o[64 * j] = w;
            }
        }
    }
}
template <bool FINAL>
__device__ __forceinline__ void phase_combine(const Ctx& c, bf16_t* XB, float* out, const float* gain, bf16_t* H, const bf16_t* YS, int layer) {
    const float* TWp = (const float*)(c.ws + WS_TW); const int* TEp = (const int*)(c.ws + WS_TE); const int* TRp = (const int*)(c.ws + WS_TR);
    int psrow;
    { const int cnt = ((const int*)(c.ws + WS_CTL))[layer * 32 + (c.lane & 31)]; const int pc = (cnt + 255) & ~255; int incl = pc;
#pragma unroll
      for (int o = 1; o < 32; o <<= 1) { const int t_ = __shfl_up(incl, o, 32); if ((c.lane & 31) >= o) incl += t_; }
      psrow = incl - pc; }
    for (int m0 = 2 * c.gw; m0 < M; m0 += 2 * c.ngw) {
        uint2 xw[2][4], ya[2][4], yb[2][4]; float wa[2], wb[2];
#pragma unroll
        for (int u = 0; u < 2; ++u) {
            const int m = m0 + u; const int s0 = __shfl(psrow, TEp[2 * m]) + TRp[2 * m], s1 = __shfl(psrow, TEp[2 * m + 1]) + TRp[2 * m + 1]; wa[u] = TWp[2 * m]; wb[u] = TWp[2 * m + 1];
            const uint2* xr = (const uint2*)(XB + (size_t)m * D) + c.lane; const uint2* y0 = (const uint2*)(YS + (size_t)s0 * D) + c.lane; const uint2* y1 = (const uint2*)(YS + (size_t)s1 * D) + c.lane;
#pragma unroll
            for (int j = 0; j < 4; ++j) { xw[u][j] = xr[64 * j]; ya[u][j] = y0[64 * j]; yb[u][j] = y1[64 * j]; }
        }
#pragma unroll
        for (int u = 0; u < 2; ++u) {
            const int m = m0 + u;
            float4 v[4]; float s = 0.f;
#pragma unroll
            for (int j = 0; j < 4; ++j) {
                v[j].x = __uint_as_float(xw[u][j].x << 16) + wa[u] * __uint_as_float(ya[u][j].x << 16) + wb[u] * __uint_as_float(yb[u][j].x << 16);
                v[j].y = __uint_as_float(xw[u][j].x & 0xffff0000u) + wa[u] * __uint_as_float(ya[u][j].x & 0xffff0000u) + wb[u] * __uint_as_float(yb[u][j].x & 0xffff0000u);
                v[j].z = __uint_as_float(xw[u][j].y << 16) + wa[u] * __uint_as_float(ya[u][j].y << 16) + wb[u] * __uint_as_float(yb[u][j].y << 16);
                v[j].w = __uint_as_float(xw[u][j].y & 0xffff0000u) + wa[u] * __uint_as_float(ya[u][j].y & 0xffff0000u) + wb[u] * __uint_as_float(yb[u][j].y & 0xffff0000u);
                s += v[j].x * v[j].x + v[j].y * v[j].y + v[j].z * v[j].z + v[j].w * v[j].w;
            }
            if (FINAL) {
                float4* xo = (float4*)(out + (size_t)m * D) + c.lane;
#pragma unroll
                for (int j = 0; j < 4; ++j) xo[64 * j] = v[j];
            } else {
                uint2* xo = (uint2*)(XB + (size_t)m * D) + c.lane;
#pragma unroll
                for (int j = 0; j < 4; ++j) { uint2 w; w.x = pk2(v[j].x, v[j].y); w.y = pk2(v[j].z, v[j].w); xo[64 * j] = w; }
                float s2 = 0.f;
#pragma unroll
                for (int j = 0; j < 4; ++j) { const float a0 = bf2f(f2bf(v[j].x)), a1 = bf2f(f2bf(v[j].y)), a2 = bf2f(f2bf(v[j].z)), a3 = bf2f(f2bf(v[j].w)); s2 += a0 * a0 + a1 * a1 + a2 * a2 + a3 * a3; }
                const float rstd = rsqrtf(wsum(s2) * (1.f / D) + EPS);
                if (c.lane == 0) ((float*)(c.ws + WS_RSTD))[m] = rstd;
            }
        }
    }
}

namespace pg8 {
#define PG8_LAS __attribute__((address_space(3)))
typedef short bf16x8 __attribute__((ext_vector_type(8)));
typedef float f32x4 __attribute__((ext_vector_type(4)));
typedef unsigned u32x4 __attribute__((ext_vector_type(4)));
constexpr int BM = 256, BK = 64, HALF = 128, HTB = HALF * BK * 2, STAGE_BYTES = 8 * HTB, NXCD = 8, WGM = 8;
__device__ __forceinline__ int lds_byte(int r, int c) { const int st = (r >> 4) * 2 + (c >> 5), rr = r & 15, cc = c & 31, ob = rr * 64 + cc * 2; return st * 1024 + (ob ^ (((ob >> 9) & 1) << 5)); }
__device__ __forceinline__ void stage_rc(int b, int& R, int& C) { const int st = b / 1024, sb = b % 1024, swz = sb ^ (((sb >> 9) & 1) << 5); R = (st >> 1) * 16 + swz / 64; C = (st & 1) * 32 + (swz % 64) / 2; }
__device__ __forceinline__ int perm32(int rho) { const int n = rho >> 4, i = rho & 15; return 8 * (i >> 2) + 4 * n + (i & 3); }
struct Unit { int pm, pn, e, nvalid, gbase; };
struct Gemm { const bf16_t* A; const bf16_t* Bt; int K; const int* gather; size_t bstride; };
struct StaticOrder {
    int nM, nN, nwg, G, c;
    __device__ __forceinline__ void init(int Mr, int N, int G_, int c_) { nM = Mr / BM; nN = N / BM; nwg = nM * nN; G = G_; c = c_; }
    __device__ __forceinline__ bool next(int i, Unit& u) const {
        const long L = (long)i * G + c; if (L >= nwg) return false;
        int wgid = (int)L; { const int q = nwg / NXCD, r = nwg % NXCD, xcd = wgid % NXCD, off = wgid / NXCD; wgid = (xcd < r ? xcd * (q + 1) : r * (q + 1) + (xcd - r) * q) + off; }
        const int nig = WGM * nN, gid = wgid / nig, fm = gid * WGM, gsz = (nM - fm) < WGM ? (nM - fm) : WGM;
        u.pm = fm + ((wgid % nig) % gsz); u.pn = (wgid % nig) / gsz; u.e = 0; u.nvalid = BM; u.gbase = 0; return true;
    }
};
struct MoeOrder {
    const int* te; const int* tv; const int* tg; int nwg, G, c;
    __device__ __forceinline__ bool next(int i, Unit& u) const {
        const long L = (long)i * G + c; if (L >= nwg) return false;
        int wgid = (int)L; { const int q = nwg / NXCD, r = nwg % NXCD, xcd = wgid % NXCD, off = wgid / NXCD; wgid = (xcd < r ? xcd * (q + 1) : r * (q + 1) + (xcd - r) * q) + off; }
        u.pm = wgid >> 2; u.pn = wgid & 3; u.e = te[u.pm]; u.nvalid = tv[u.pm]; u.gbase = tg[u.pm]; return true;
    }
};
__device__ __forceinline__ unsigned cvt_pk_bf16(float lo, float hi) { unsigned r; asm volatile("v_cvt_pk_bf16_f32 %0, %1, %2" : "=v"(r) : "v"(lo), "v"(hi)); return r; }

struct EpiRawScaleT { static constexpr bool PERM = true; bf16_t* O; int ldc; const float* RS;
    __device__ __forceinline__ void operator()(const f32x4 (&acc)[2][2][4][2], const Unit& u, int wr, int wc, int fr, int fq) const {
        const int row0 = u.pm * BM + wr * 64 + fr, col0 = u.pn * BM + wc * 32 + 8 * fq;
#pragma unroll
        for (int ai = 0; ai < 2; ++ai)
#pragma unroll
            for (int m = 0; m < 4; ++m) { const int r = row0 + ai * HALF + m * 16; const float sc = RS[r]; bf16_t* rowp = O + (size_t)r * ldc + col0;
#pragma unroll
                for (int bj = 0; bj < 2; ++bj) { const f32x4 v0 = acc[ai][bj][m][0] * sc, v1 = acc[ai][bj][m][1] * sc; u32x4 w;
                    w.x = cvt_pk_bf16(v0[0], v0[1]); w.y = cvt_pk_bf16(v0[2], v0[3]); w.z = cvt_pk_bf16(v1[0], v1[1]); w.w = cvt_pk_bf16(v1[2], v1[3]);
                    *(u32x4*)(rowp + bj * HALF) = w; } }
    } };
struct EpiProj0T { static constexpr bool PERM = true; bf16_t* O; float* LOGF; const float* LB;
    __device__ __forceinline__ void operator()(const f32x4 (&acc)[2][2][4][2], const Unit& u, int wr, int wc, int fr, int fq) const {
        const int row0 = u.pm * BM + wr * 64 + fr, col0 = u.pn * BM + wc * 32 + 8 * fq;
        const bool isf = (u.pn == 2 || u.pn == 3);
#pragma unroll
        for (int ai = 0; ai < 2; ++ai)
#pragma unroll
            for (int m = 0; m < 4; ++m) { const size_t r = (size_t)(row0 + ai * HALF + m * 16); bf16_t* rowp = O + r * EVPP + col0;
#pragma unroll
                for (int bj = 0; bj < 2; ++bj) { f32x4 v0 = acc[ai][bj][m][0], v1 = acc[ai][bj][m][1];
                    if (isf) {
                        const int cc = col0 + bj * HALF - 512; const f32x4 lb0 = *(const f32x4*)(LB + cc), lb1 = *(const f32x4*)(LB + cc + 4);
                        f32x4 lf0, lf1;
#pragma unroll
                        for (int j = 0; j < 4; ++j) {
                            { const float z = v0[j], lb = lb0[j], sg = 1.f / (1.f + __expf(-z)), sn = 1.f - sg; lf0[j] = __logf(lb + (1.f - lb) * sg); v0[j] = (1.f - lb) * sn; }
                            { const float z = v1[j], lb = lb1[j], sg = 1.f / (1.f + __expf(-z)), sn = 1.f - sg; lf1[j] = __logf(lb + (1.f - lb) * sg); v1[j] = (1.f - lb) * sn; }
                        }
                        *(f32x4*)(LOGF + r * 512 + cc) = lf0; *(f32x4*)(LOGF + r * 512 + cc + 4) = lf1;
                    }
                    u32x4 w; w.x = cvt_pk_bf16(v0[0], v0[1]); w.y = cvt_pk_bf16(v0[2], v0[3]); w.z = cvt_pk_bf16(v1[0], v1[1]); w.w = cvt_pk_bf16(v1[2], v1[3]);
                    *(u32x4*)(rowp + bj * HALF) = w; } }
    } };
struct EpiResidF2B { static constexpr bool PERM = true; const float* X; bf16_t* O;
    __device__ __forceinline__ void operator()(const f32x4 (&acc)[2][2][4][2], const Unit& u, int wr, int wc, int fr, int fq) const {
        const int row0 = u.pm * BM + wr * 64 + fr, col0 = u.pn * BM + wc * 32 + 8 * fq;
#pragma unroll
        for (int ai = 0; ai < 2; ++ai)
#pragma unroll
            for (int m = 0; m < 4; ++m) { const size_t off = (size_t)(row0 + ai * HALF + m * 16) * D + col0;
#pragma unroll
                for (int bj = 0; bj < 2; ++bj) { const f32x4 x0 = *(const f32x4*)(X + off + bj * HALF), x1 = *(const f32x4*)(X + off + bj * HALF + 4);
                    const f32x4 v0 = x0 + acc[ai][bj][m][0], v1 = x1 + acc[ai][bj][m][1]; u32x4 w;
                    w.x = cvt_pk_bf16(v0[0], v0[1]); w.y = cvt_pk_bf16(v0[2], v0[3]); w.z = cvt_pk_bf16(v1[0], v1[1]); w.w = cvt_pk_bf16(v1[2], v1[3]);
                    *(u32x4*)(O + off + bj * HALF) = w; } }
    } };
struct EpiResidB2B { static constexpr bool PERM = true; bf16_t* XO;
    __device__ __forceinline__ void operator()(const f32x4 (&acc)[2][2][4][2], const Unit& u, int wr, int wc, int fr, int fq) const {
        const int row0 = u.pm * BM + wr * 64 + fr, col0 = u.pn * BM + wc * 32 + 8 * fq;
#pragma unroll
        for (int ai = 0; ai < 2; ++ai)
#pragma unroll
            for (int m = 0; m < 4; ++m) { const size_t off = (size_t)(row0 + ai * HALF + m * 16) * D + col0;
#pragma unroll
                for (int bj = 0; bj < 2; ++bj) { const u32x4 xw = *(const u32x4*)(XO + off + bj * HALF);
                    const f32x4 a0 = acc[ai][bj][m][0], a1 = acc[ai][bj][m][1]; u32x4 w;
                    w.x = cvt_pk_bf16(__uint_as_float(xw.x << 16) + a0[0], __uint_as_float(xw.x & 0xffff0000u) + a0[1]); w.y = cvt_pk_bf16(__uint_as_float(xw.y << 16) + a0[2], __uint_as_float(xw.y & 0xffff0000u) + a0[3]);
                    w.z = cvt_pk_bf16(__uint_as_float(xw.z << 16) + a1[0], __uint_as_float(xw.z & 0xffff0000u) + a1[1]); w.w = cvt_pk_bf16(__uint_as_float(xw.w << 16) + a1[2], __uint_as_float(xw.w & 0xffff0000u) + a1[3]);
                    *(u32x4*)(XO + off + bj * HALF) = w; } }
    } };
struct EpiGUT { static constexpr bool PERM = true; bf16_t* HID; const float* RSL;
    __device__ __forceinline__ void operator()(const f32x4 (&acc)[2][2][4][2], const Unit& u, int wr, int wc, int fr, int fq) const {
        const int lr0 = wr * 64 + fr, row0 = u.pm * BM + lr0, col0 = u.pn * HALF + wc * 32 + 8 * fq;
        float rs[2][4];
#pragma unroll
        for (int ai = 0; ai < 2; ++ai)
#pragma unroll
            for (int m = 0; m < 4; ++m) { const int lr = lr0 + ai * HALF + m * 16; rs[ai][m] = RSL[u.gbase + (lr < u.nvalid ? lr : 0)]; }
#pragma unroll
        for (int ai = 0; ai < 2; ++ai)
#pragma unroll
            for (int m = 0; m < 4; ++m) { bf16_t* rowp = HID + (size_t)(row0 + ai * HALF + m * 16) * FF + col0; float h[8]; const float r_ = rs[ai][m];
#pragma unroll
                for (int n = 0; n < 2; ++n)
#pragma unroll
                    for (int j = 0; j < 4; ++j) { const float g = acc[ai][0][m][n][j] * r_, uu = acc[ai][1][m][n][j] * r_; h[4 * n + j] = g / (1.f + __expf(-g)) * uu; }
                u32x4 w; w.x = cvt_pk_bf16(h[0], h[1]); w.y = cvt_pk_bf16(h[2], h[3]); w.z = cvt_pk_bf16(h[4], h[5]); w.w = cvt_pk_bf16(h[6], h[7]);
                *(u32x4*)rowp = w; }
    } };
struct EpiDownT { static constexpr bool PERM = true; bf16_t* YS;
    __device__ __forceinline__ void operator()(const f32x4 (&acc)[2][2][4][2], const Unit& u, int wr, int wc, int fr, int fq) const {
        const int row0 = u.pm * BM + wr * 64 + fr, col0 = u.pn * BM + wc * 32 + 8 * fq;
#pragma unroll
        for (int ai = 0; ai < 2; ++ai)
#pragma unroll
            for (int m = 0; m < 4; ++m) { bf16_t* rowp = YS + (size_t)(row0 + ai * HALF + m * 16) * D + col0;
#pragma unroll
                for (int bj = 0; bj < 2; ++bj) { const f32x4 v0 = acc[ai][bj][m][0], v1 = acc[ai][bj][m][1]; u32x4 w;
                    w.x = cvt_pk_bf16(v0[0], v0[1]); w.y = cvt_pk_bf16(v0[2], v0[3]); w.z = cvt_pk_bf16(v1[0], v1[1]); w.w = cvt_pk_bf16(v1[2], v1[3]);
                    *(u32x4*)(rowp + bj * HALF) = w; } }
    } };

template <class Epi, class Sched, bool GATHER>
__device__ __forceinline__ void gemm_phase(PG8_LAS unsigned char* lds, const Gemm g, const Sched& S, const Epi& E) {
    int tid_o = threadIdx.x; asm volatile("" : "+v"(tid_o));
    const int tid = tid_o, wid = __builtin_amdgcn_readfirstlane(tid >> 6), lane = tid & 63, wr = wid >> 2, wc = wid & 3, fr = lane & 15, fq = lane >> 4;
    const int K = g.K, nt = K / BK;
    int stR[2], stC[2]; unsigned voffB[2];
#pragma unroll
    for (int i = 0; i < 2; ++i) { int R, C; stage_rc(tid * 16 + i * 8192, R, C); const int Rb = Epi::PERM ? ((R & ~31) + perm32(R & 31)) : R; stR[i] = R; stC[i] = C; voffB[i] = (unsigned)(Rb * K + C) * 2u; }
    const size_t kstep = (size_t)(BK * 2);
    const size_t hstep = (size_t)HALF * K * 2;
    const size_t tstep = 2 * hstep;
    const unsigned ldsw = (unsigned)wid * 1024u;
    const int aoff = lds_byte(wr * 64 + fr, fq * 8), boff = lds_byte(wc * 32 + fr, fq * 8);
#define PG8_SA(b, h) (((b) * 2 + (h)) * HTB)
#define PG8_SB(b, h) ((4 + (b) * 2 + (h)) * HTB)
#define PG8_STAGE(bufoff, gbase, voff) do { _Pragma("unroll") for (int _i = 0; _i < 2; ++_i) \
        __builtin_amdgcn_global_load_lds((const unsigned*)((const char*)(gbase) + (voff)[_i]), (PG8_LAS unsigned*)(lds + (bufoff) + ldsw + _i * 8192), 16, 0, 0); } while (0)
#define PG8_LDA(dst, b, h) do { _Pragma("unroll") for (int m = 0; m < 4; ++m) _Pragma("unroll") for (int k = 0; k < 2; ++k) dst[m][k] = *(const PG8_LAS bf16x8*)(lds + PG8_SA(b, h) + aoff + m * 2048 + k * 1024); } while (0)
#define PG8_LDB(dst, b, h) do { _Pragma("unroll") for (int n = 0; n < 2; ++n) _Pragma("unroll") for (int k = 0; k < 2; ++k) dst[n][k] = *(const PG8_LAS bf16x8*)(lds + PG8_SB(b, h) + boff + n * 2048 + k * 1024); } while (0)
#define PG8_MMA(ai, bj, At, Bt) do { __builtin_amdgcn_s_setprio(1); _Pragma("unroll") for (int m = 0; m < 4; ++m) _Pragma("unroll") for (int n = 0; n < 2; ++n) _Pragma("unroll") for (int k = 0; k < 2; ++k) \
        acc[ai][bj][m][n] = __builtin_amdgcn_mfma_f32_16x16x32_bf16(Bt[n][k], At[m][k], acc[ai][bj][m][n], 0, 0, 0); __builtin_amdgcn_s_setprio(0); } while (0)
#define PG8_WAIT_V(n) asm volatile("s_waitcnt vmcnt(" #n ")" ::: "memory")
#define PG8_WAIT_L(n) asm volatile("s_waitcnt lgkmcnt(" #n ")" ::: "memory")
#define PG8_BAR __builtin_amdgcn_s_barrier()
#define PG8_SCHED __builtin_amdgcn_sched_barrier(0)
#define PG8_OFFS(dst, u) do { _Pragma("unroll") for (int _h = 0; _h < 2; ++_h) _Pragma("unroll") for (int _i = 0; _i < 2; ++_i) { \
        int _row = (u).pm * BM + _h * HALF + stR[_i]; if (GATHER) { const int _lr = _h * HALF + stR[_i]; _row = _lr < (u).nvalid ? g.gather[(u).gbase + _lr] : 0; } dst[_h][_i] = (unsigned)(_row * K + stC[_i]) * 2u; } } while (0)
    Unit cur, nxt; int ui = 0;
    if (!S.next(0, cur)) return;
    f32x4 acc[2][2][4][2];
#pragma unroll
    for (int a = 0; a < 2; ++a)
#pragma unroll
        for (int b = 0; b < 2; ++b)
#pragma unroll
            for (int m = 0; m < 4; ++m)
#pragma unroll
                for (int n = 0; n < 2; ++n) acc[a][b][m][n] = (f32x4){0.f, 0.f, 0.f, 0.f};
    bf16x8 At[4][2], B0[2][2], B1[2][2];
    unsigned offC[2][2], offN[2][2];
    PG8_OFFS(offC, cur);
    const char* const A0 = (const char*)g.A;
    const char* cB = (const char*)g.Bt + ((size_t)cur.e * g.bstride) * 2 + (size_t)cur.pn * tstep;
    PG8_STAGE(PG8_SB(0, 0), cB, voffB); PG8_STAGE(PG8_SB(0, 1), cB + hstep, voffB); PG8_STAGE(PG8_SA(0, 0), A0, offC[0]); PG8_STAGE(PG8_SA(0, 1), A0, offC[1]);
    if (wr == 1) PG8_BAR;
    PG8_WAIT_V(2); PG8_BAR;
    PG8_STAGE(PG8_SB(1, 0), cB + kstep, voffB); PG8_STAGE(PG8_SA(1, 0), A0 + kstep, offC[0]); PG8_STAGE(PG8_SB(1, 1), cB + hstep + kstep, voffB);
    PG8_WAIT_V(6); PG8_BAR;
    for (;;) {
        const bool has_next = S.next(ui + 1, nxt);
        const char* nB = cB;
        if (has_next) { PG8_OFFS(offN, nxt); nB = (const char*)g.Bt + ((size_t)nxt.e * g.bstride) * 2 + (size_t)nxt.pn * tstep; }
        else {
#pragma unroll
            for (int _h = 0; _h < 2; ++_h)
#pragma unroll
                for (int _i = 0; _i < 2; ++_i) offN[_h][_i] = offC[_h][_i];
        }
        for (int t = 0; t < nt; t += 2) {
            const bool last = (t == nt - 2);
            const char* a1 = A0 + (size_t)(t + 1) * kstep;
            const char* a2 = A0 + (last ? (size_t)0 : (size_t)(t + 2) * kstep); const char* b2 = last ? nB : cB + (size_t)(t + 2) * kstep;
            const char* a3 = a2 + kstep; const char* b3 = b2 + kstep;
            unsigned off2[2][2];
            if (last) {
#pragma unroll
                for (int _h = 0; _h < 2; ++_h)
#pragma unroll
                    for (int _i = 0; _i < 2; ++_i) off2[_h][_i] = offN[_h][_i];
            } else {
#pragma unroll
                for (int _h = 0; _h < 2; ++_h)
#pragma unroll
                    for (int _i = 0; _i < 2; ++_i) off2[_h][_i] = offC[_h][_i];
            }
            PG8_LDB(B0, 0, 0); PG8_LDB(B1, 0, 1); PG8_SCHED; PG8_LDA(At, 0, 0); PG8_STAGE(PG8_SA(1, 1), a1, offC[1]);
            PG8_WAIT_V(8); PG8_WAIT_L(0); PG8_BAR; PG8_MMA(0, 0, At, B0); PG8_MMA(0, 1, At, B1); PG8_BAR; PG8_SCHED;
            PG8_LDA(At, 0, 1); PG8_STAGE(PG8_SB(0, 0), b2, voffB); PG8_STAGE(PG8_SB(0, 1), b2 + hstep, voffB); PG8_STAGE(PG8_SA(0, 0), a2, off2[0]);
            PG8_WAIT_V(8); PG8_WAIT_L(0); PG8_BAR; PG8_MMA(1, 0, At, B0); PG8_MMA(1, 1, At, B1); PG8_BAR; PG8_SCHED;
            PG8_LDB(B0, 1, 0); PG8_LDB(B1, 1, 1); PG8_SCHED; PG8_LDA(At, 1, 0); PG8_STAGE(PG8_SA(0, 1), a2, off2[1]);
            PG8_WAIT_V(8); PG8_WAIT_L(0); PG8_BAR; PG8_MMA(0, 0, At, B0); PG8_MMA(0, 1, At, B1); PG8_BAR; PG8_SCHED;
            PG8_LDA(At, 1, 1); PG8_STAGE(PG8_SB(1, 0), b3, voffB); PG8_STAGE(PG8_SB(1, 1), b3 + hstep, voffB); PG8_STAGE(PG8_SA(1, 0), a3, off2[0]);
            PG8_WAIT_V(8); PG8_WAIT_L(0); PG8_BAR; PG8_MMA(1, 0, At, B0); PG8_MMA(1, 1, At, B1); PG8_BAR; PG8_SCHED;
        }
        if (wr == 0) PG8_BAR;
        E(acc, cur, wr, wc, fr, fq);
        if (!has_next) break;
#pragma unroll
        for (int a = 0; a < 2; ++a)
#pragma unroll
            for (int b = 0; b < 2; ++b)
#pragma unroll
                for (int m = 0; m < 4; ++m)
#pragma unroll
                    for (int n = 0; n < 2; ++n) acc[a][b][m][n] = (f32x4){0.f, 0.f, 0.f, 0.f};
        cur = nxt; cB = nB; ++ui;
#pragma unroll
        for (int _h = 0; _h < 2; ++_h)
#pragma unroll
            for (int _i = 0; _i < 2; ++_i) offC[_h][_i] = offN[_h][_i];
        if (wr == 1) PG8_BAR;
    }
    PG8_WAIT_V(0);
    PG8_BAR;
#undef PG8_SA
#undef PG8_SB
#undef PG8_STAGE
#undef PG8_LDA
#undef PG8_LDB
#undef PG8_MMA
#undef PG8_WAIT_V
#undef PG8_WAIT_L
#undef PG8_BAR
#undef PG8_SCHED
#undef PG8_OFFS
}
}

__device__ __forceinline__ void normrope64(bf16_t* p, const float* gain, const float2* rt  ) {
    uint4 w[8]; float f[64];
#pragma unroll
    for (int i = 0; i < 8; ++i) { w[i] = ((const uint4*)p)[i]; unpack8(w[i], f + 8 * i); }
    float s = 0.f;
#pragma unroll
    for (int i = 0; i < 64; ++i) s += f[i] * f[i];
    const float rstd = rsqrtf(s * (1.f / 64.f) + EPS);
#pragma unroll
    for (int i = 0; i < 64; ++i) f[i] = f[i] * rstd * gain[i];
#pragma unroll
    for (int i = 0; i < 8; ++i) { const float2 cs = rt[i]; const float x1 = f[i], x2 = f[8 + i]; f[i] = x1 * cs.x - x2 * cs.y; f[8 + i] = x2 * cs.x + x1 * cs.y; }
#pragma unroll
    for (int i = 0; i < 8; ++i) { uint4 o; o.x = pk2(f[8 * i], f[8 * i + 1]); o.y = pk2(f[8 * i + 2], f[8 * i + 3]); o.z = pk2(f[8 * i + 4], f[8 * i + 5]); o.w = pk2(f[8 * i + 6], f[8 * i + 7]); ((uint4*)p)[i] = o; }
}

__device__ __forceinline__ void post_even(const Ctx& c, int vb, int nvb) {
    bf16_t* P = (bf16_t*)(c.ws + WS_PROJ); const float2* RT = (const float2*)(c.ws + WS_ROPE);
    const long total = (long)M * 4;
    for (long it = (long)vb * NTHREADS + c.tid; it < total; it += (long)nvb * NTHREADS) {
        const int m = (int)(it >> 2), s = (int)(it & 3); const int pos = m & (SEQ - 1);
        int col; const float* gain;
        if (s < 2) { col = 2816 + 64 * s; gain = c.nsa_kg + 64; }
        else { col = 3072 + 64 * (s - 2); gain = c.nsa_kg + 128; }
        normrope64(P + (size_t)m * EVPP + col, gain, RT + pos * 8);
    }
}
__device__ __forceinline__ float gelu_tanh(float x) { const float u = 0.7978845608028654f * (x + 0.044715f * x * x * x); return 0.5f * x * (1.f + tanhf(u)); }

namespace fa { __device__ __forceinline__ float2 rope_cs(int pos, int j); }
using fa::rope_cs;
__device__ __forceinline__ void compress_mfma(const Ctx& c, unsigned char* lds, int unit) {
    typedef short bf16x8 __attribute__((ext_vector_type(8)));
    typedef float f32x4 __attribute__((ext_vector_type(4)));
    const int kind = unit >> 7, b = (unit >> 3) & 15, g = (unit >> 2) & 1, n0 = (unit & 3) * 64;
    const bf16_t* P = (const bf16_t*)(c.ws + WS_PROJ);
    const bf16_t* W1 = (const bf16_t*)(c.ws + WS_CW1T) + (size_t)kind * 256 * 2048; const bf16_t* W2 = (const bf16_t*)(c.ws + WS_CW2T) + (size_t)kind * 64 * 256;
    const float* CB = (const float*)(c.ws + WS_TSLOT) + kind * 256; const float2* RT = (const float2*)(c.ws + WS_ROPE);
    bf16_t* OUTB = (bf16_t*)(c.ws + (kind == 0 ? WS_KCB : WS_VCB)) + (size_t)((b * 2 + g) * 256) * 64;
    const int tid = c.tid, lane = c.lane, w = c.wave, l15 = lane & 15, g4 = lane >> 4;
    constexpr int HP = 264;
    bf16_t* HS = (bf16_t*)lds; float* OS = (float*)(lds + 64 * HP * 2);
    constexpr int NTOK = 1040;
    static_assert(NTOK * 128 <= 160 * 1024 - 16, "compress input image");
    __syncthreads();
    {
        const bf16_t* src0 = P + ((size_t)b * SEQ) * EVPP + 2560 + kind * 128 + g * 64;
        const int tok0 = 16 * n0;
        uint4 stg[17];
#pragma unroll
        for (int x = 0; x < 17; ++x) { int idx = tid + 512 * x; if (idx > NTOK * 8 - 1) idx = NTOK * 8 - 1;
            int tk = tok0 + (idx >> 3); if (tk > SEQ - 1) tk = SEQ - 1; stg[x] = *(const uint4*)(src0 + (size_t)tk * EVPP + 8 * (idx & 7)); }
#pragma unroll
        for (int x = 0; x < 17; ++x) { int idx = tid + 512 * x; if (idx > NTOK * 8 - 1) idx = NTOK * 8 - 1; const int t = idx >> 3, cch = idx & 7; *(uint4*)(lds + t * 128 + ((cch ^ ((t >> 4) & 7)) << 4)) = stg[x]; }
    }
    __syncthreads();
    f32x4 acc[4][2];
#pragma unroll
    for (int mt = 0; mt < 4; ++mt) { acc[mt][0] = (f32x4){0.f, 0.f, 0.f, 0.f}; acc[mt][1] = (f32x4){0.f, 0.f, 0.f, 0.f}; }
    const bf16_t* wb0 = W1 + (size_t)(32 * w + l15) * 2048 + 8 * g4; const bf16_t* wb1 = wb0 + (size_t)16 * 2048;
#define CM_LD(S, KS0) do { S##0 = *(const bf16x8*)(wb0 + 32 * (KS0)); S##1 = *(const bf16x8*)(wb1 + 32 * (KS0)); S##2 = *(const bf16x8*)(wb0 + 32 * ((KS0) + 1)); S##3 = *(const bf16x8*)(wb1 + 32 * ((KS0) + 1)); \
        S##4 = *(const bf16x8*)(wb0 + 32 * ((KS0) + 2)); S##5 = *(const bf16x8*)(wb1 + 32 * ((KS0) + 2)); S##6 = *(const bf16x8*)(wb0 + 32 * ((KS0) + 3)); S##7 = *(const bf16x8*)(wb1 + 32 * ((KS0) + 3)); } while (0)
#define CM_STEP(B0, B1, KS) do { const int ks = (KS); const int tt = ks >> 1, cch = 4 * (ks & 1) + g4; \
        _Pragma("unroll") for (int mt = 0; mt < 4; ++mt) { \
            const int t = 16 * (16 * mt + l15) + tt; \
            const bf16x8 af = *(const bf16x8*)(lds + t * 128 + ((cch ^ ((t >> 4) & 7)) << 4)); \
            acc[mt][0] = __builtin_amdgcn_mfma_f32_16x16x32_bf16(af, B0, acc[mt][0], 0, 0, 0); \
            acc[mt][1] = __builtin_amdgcn_mfma_f32_16x16x32_bf16(af, B1, acc[mt][1], 0, 0, 0); \
        } } while (0)
#define CM_CHUNK(S, KS0) do { CM_STEP(S##0, S##1, (KS0)); CM_STEP(S##2, S##3, (KS0) + 1); CM_STEP(S##4, S##5, (KS0) + 2); CM_STEP(S##6, S##7, (KS0) + 3); } while (0)
    {
        bf16x8 U0, U1, U2, U3, U4, U5, U6, U7, V0, V1, V2, V3, V4, V5, V6, V7;
        const int rot = (unit & 7) * 8;
        CM_LD(U, rot);
#pragma unroll 1
        for (int kc = 0; kc < 64; kc += 8) {
            CM_LD(V, (kc + 4 + rot) & 63);
            CM_CHUNK(U, (kc + rot) & 63);
            if (kc + 8 < 64) CM_LD(U, (kc + 8 + rot) & 63);
            CM_CHUNK(V, (kc + 4 + rot) & 63);
        }
    }
#undef CM_LD
#undef CM_STEP
#undef CM_CHUNK
    __syncthreads();
#pragma unroll
    for (int mt = 0; mt < 4; ++mt)
#pragma unroll
        for (int nt = 0; nt < 2; ++nt) { const int cc = 32 * w + 16 * nt + l15; const float bias = ((CB[cc] + CB[512 + cc]) + CB[1024 + cc]) + CB[1536 + cc];
#pragma unroll
            for (int r = 0; r < 4; ++r) HS[(16 * mt + 4 * g4 + r) * HP + cc] = f2bf(gelu_tanh(acc[mt][nt][r] + bias)); }
    __syncthreads();
    {
        const int mt = w >> 1, nt0 = 2 * (w & 1);
        f32x4 o0 = {0.f, 0.f, 0.f, 0.f}, o1 = {0.f, 0.f, 0.f, 0.f};
        const bf16_t* ar = HS + (16 * mt + l15) * HP + 8 * g4;
        const bf16_t* br0 = W2 + (size_t)(16 * nt0 + l15) * 256 + 8 * g4; const bf16_t* br1 = br0 + 16 * 256;
#pragma unroll
        for (int ks = 0; ks < 8; ++ks) {
            const bf16x8 af = *(const bf16x8*)(ar + 32 * ks);
            o0 = __builtin_amdgcn_mfma_f32_16x16x32_bf16(af, *(const bf16x8*)(br0 + 32 * ks), o0, 0, 0, 0);
            o1 = __builtin_amdgcn_mfma_f32_16x16x32_bf16(af, *(const bf16x8*)(br1 + 32 * ks), o1, 0, 0, 0);
        }
#pragma unroll
        for (int r = 0; r < 4; ++r) { OS[(16 * mt + 4 * g4 + r) * 68 + 16 * nt0 + l15] = o0[r]; OS[(16 * mt + 4 * g4 + r) * 68 + 16 * nt0 + 16 + l15] = o1[r]; }
    }
    __syncthreads();
    {
        const int row = tid >> 3, sub = tid & 7, n = n0 + row;
        float v[8];
#pragma unroll
        for (int j = 0; j < 8; ++j) v[j] = OS[row * 68 + 8 * sub + j];
        if (kind == 0) {
            float sq = 0.f;
#pragma unroll
            for (int j = 0; j < 8; ++j) sq += v[j] * v[j];
            sq += __shfl_xor(sq, 1); sq += __shfl_xor(sq, 2); sq += __shfl_xor(sq, 4);
            const float rstd = rsqrtf(sq * (1.f / 64.f) + EPS);
#pragma unroll
            for (int j = 0; j < 8; ++j) v[j] = v[j] * rstd * c.nsa_kg[8 * sub + j];
            const int pos = (16 * n + 31) & (SEQ - 1);
#pragma unroll
            for (int j = 0; j < 8; ++j) {
                const float other = __shfl_xor(v[j], 1);
                const float2 cs = rope_cs(pos, j);
                if (sub == 0) v[j] = v[j] * cs.x - other * cs.y; else if (sub == 1) v[j] = v[j] * cs.x + other * cs.y;
            }
        }
        uint4 o; o.x = pk2(v[0], v[1]); o.y = pk2(v[2], v[3]); o.z = pk2(v[4], v[5]); o.w = pk2(v[6], v[7]);
        if (n > 254) { o.x = 0u; o.y = 0u; o.z = 0u; o.w = 0u; }
        *(uint4*)(OUTB + (size_t)n * 64 + 8 * sub) = o;
    }
}

namespace hg {
typedef short bf16x8 __attribute__((ext_vector_type(8)));
typedef float f32x4 __attribute__((ext_vector_type(4)));
constexpr int PQ = 136, PS = 72;
constexpr int O_QS = 0, O_QD = O_QS + 64 * PQ * 2, O_KD = O_QD + 64 * PQ * 2, O_KK = O_KD + 64 * PQ * 2, O_QO = O_KK + 48 * PQ * 2, O_KST = O_QO + 96 * PQ * 2,
              O_VT = O_KST + 128 * PS * 2, O_STT = O_VT + 32 * PS * 2, O_TSH = O_STT + 32 * PQ * 2, O_END = O_TSH + 4 * 128 * 4;
static_assert(O_END <= 160 * 1024, "hgrn2 LDS");
__device__ __forceinline__ bf16x8 pack8(float a0, float a1, float a2, float a3, float a4, float a5, float a6, float a7) {
    uint4 w; w.x = pk2(a0, a1); w.y = pk2(a2, a3); w.z = pk2(a4, a5); w.w = pk2(a6, a7); return __builtin_bit_cast(bf16x8, w); }
__device__ __forceinline__ float cexp(float x) { return __expf(fminf(fmaxf(x, -80.f), 80.f)); }
}
namespace hg {
constexpr int A_VT = O_KST + 128 * PS * 2, A_TSH = A_VT + 128 * PS * 2, A_END = A_TSH + 4 * 128 * 4;
static_assert(A_END <= 160 * 1024 - 16, "hgrn2 pass A LDS");
constexpr int S_QS = 0, S_STT = 2 * 64 * PQ * 2, S_OS = S_STT + 2 * 128 * PQ * 2, OSP = 132, S_END = S_OS + 64 * OSP * 4;
static_assert(S_END <= 160 * 1024 - 16, "hgrn2 sequential pass LDS");
constexpr size_t HG_U = 0, HG_QG = (size_t)128 << 20, HG_OI = (size_t)192 << 20;
}
__device__ __forceinline__ void hgrn2_passA(const Ctx& c, unsigned char* lds_raw, int su) {
    using namespace hg;
    const int cq = su & 3, h = (su >> 2) & 3, b = su >> 4;
    const bf16_t* P = (const bf16_t*)(c.ws + WS_PROJ); const float* LOGF = (const float*)(c.ws + WS_LOGF);
    unsigned char* scr = (unsigned char*)c.xr; float* GD = (float*)(c.ws + WS_LIST);
    bf16_t* QS = (bf16_t*)(lds_raw + O_QS); bf16_t* QD = (bf16_t*)(lds_raw + O_QD); bf16_t* KD = (bf16_t*)(lds_raw + O_KD); bf16_t* KK = (bf16_t*)(lds_raw + O_KK);
    bf16_t* QO = (bf16_t*)(lds_raw + O_QO); bf16_t* KST = (bf16_t*)(lds_raw + O_KST); bf16_t* VT = (bf16_t*)(lds_raw + A_VT);
    float* TSH = (float*)(lds_raw + A_TSH);
    const int tid = c.tid, lane = c.lane, w = c.wave;
    const int i = w >> 1, hf = w & 1, d = 2 * lane;
    const int tt = w >> 1, vh = w & 1, g4 = lane >> 4, l15 = lane & 15;
    const size_t rowbase = (size_t)b * SEQ + (size_t)cq * 1024;
    const bf16_t* qp = P + (rowbase + 16 * i + 8 * hf) * EVPP + h * 128 + d;
    const float* lp = LOGF + (rowbase + 16 * i + 8 * hf) * 512 + h * 128 + d;
    const int vrow = tid >> 3, vc = (tid & 7) * 16;
    const bf16_t* vp = P + (rowbase + vrow) * EVPP + 1024 + h * 128 + vc;
    u32 qraw[8], kraw[8]; float2 lfr[8], pre[8]; uint4 vr0, vr1;
#pragma unroll
    for (int r = 0; r < 8; ++r) { qraw[r] = *(const u32*)(qp + (size_t)r * EVPP); kraw[r] = *(const u32*)(qp + (size_t)r * EVPP + 512); lfr[r] = *(const float2*)(lp + (size_t)r * 512);
        pre[r] = *(const float2*)(lp + (size_t)r * 512 - (size_t)(8 * hf) * 512); }
    vr0 = *(const uint4*)vp; vr1 = *(const uint4*)(vp + 8);
    __syncthreads();
    for (int k = 0; k < 16; ++k) {
        const int u = ((b * 4 + h) * 64) + cq * 16 + k;
        float2 lb[8]; float2 run = make_float2(0.f, 0.f);
#pragma unroll
        for (int r = 0; r < 8; ++r) { run.x += pre[r].x; run.y += pre[r].y; }
        run.x *= (float)hf; run.y *= (float)hf;
        const float2 rmid = run;
#pragma unroll
        for (int r = 0; r < 8; ++r) { run.x += lfr[r].x; run.y += lfr[r].y; lb[r] = run; }
        if (hf) *(float2*)(TSH + i * 128 + d) = lb[7];
        if (k < 15) {
            const size_t adv = (size_t)(k + 1) * 64;
#pragma unroll
            for (int r = 0; r < 8; ++r) { lfr[r] = *(const float2*)(lp + (adv + r) * 512); pre[r] = *(const float2*)(lp + (adv + r) * 512 - (size_t)(8 * hf) * 512); }
        }
        __syncthreads();
        {
            const float2 T0 = *(const float2*)(TSH + d), T1 = *(const float2*)(TSH + 128 + d), T2 = *(const float2*)(TSH + 256 + d), T3 = *(const float2*)(TSH + 384 + d);
            const float2 Ti = i == 0 ? T0 : (i == 1 ? T1 : (i == 2 ? T2 : T3));
            const float2 rm = hf ? rmid : lb[7];
            float cQS[2], cQD[2], cKD[2], cKK[2], cKS[2], cQ0[2], cQ1[2], cQ2[2];
#pragma unroll
            for (int x = 0; x < 2; ++x) {
                const float t0x = x ? T0.y : T0.x, t1x = x ? T1.y : T1.x, t2x = x ? T2.y : T2.x, t3x = x ? T3.y : T3.x, tix = x ? Ti.y : Ti.x, rmx = x ? rm.y : rm.x;
                const float Bi = (i > 0 ? t0x : 0.f) + (i > 1 ? t1x : 0.f) + (i > 2 ? t2x : 0.f), B4 = (t0x + t1x) + (t2x + t3x);
                cQS[x] = cexp(Bi); cQD[x] = cexp(-rmx); cKD[x] = cexp(rmx); cKK[x] = cexp(tix); cKS[x] = cKK[x] * cexp(B4 - (Bi + tix));
                cQ0[x] = cexp(Bi - t0x); cQ1[x] = cexp(Bi - (t0x + t1x)); cQ2[x] = cexp(Bi - (t0x + t1x + t2x));
            }
            if (tid < 128) st_hidden(GD + (size_t)u * 128 + tid, cexp((TSH[tid] + TSH[128 + tid]) + (TSH[256 + tid] + TSH[384 + tid])));
            float ks0[8], ks1[8];
#pragma unroll
            for (int r = 0; r < 8; ++r) {
                const int t = 16 * i + 8 * hf + r;
                const float q0 = __uint_as_float(qraw[r] << 16), q1 = __uint_as_float(qraw[r] & 0xffff0000u), k0 = __uint_as_float(kraw[r] << 16), k1 = __uint_as_float(kraw[r] & 0xffff0000u);
                const float e0 = __expf(fmaxf(lb[r].x, -80.f)), e1 = __expf(fmaxf(lb[r].y, -80.f));
                const float qe0 = q0 * e0, qe1 = q1 * e1, ke0 = k0 * __builtin_amdgcn_rcpf(e0), ke1 = k1 * __builtin_amdgcn_rcpf(e1);
                *(u32*)(QS + t * PQ + d) = pk2(qe0 * cQS[0], qe1 * cQS[1]);
                *(u32*)(QD + t * PQ + d) = pk2(qe0 * cQD[0], qe1 * cQD[1]); *(u32*)(KD + t * PQ + d) = pk2(ke0 * cKD[0], ke1 * cKD[1]);
                if (i < 3) *(u32*)(KK + t * PQ + d) = pk2(ke0 * cKK[0], ke1 * cKK[1]);
                ks0[r] = ke0 * cKS[0]; ks1[r] = ke1 * cKS[1];
                if (i >= 1) *(u32*)(QO + (t - 16) * PQ + d) = pk2(qe0 * cQ0[0], qe1 * cQ0[1]);
                if (i >= 2) *(u32*)(QO + (48 + t - 32) * PQ + d) = pk2(qe0 * cQ1[0], qe1 * cQ1[1]);
                if (i >= 3) *(u32*)(QO + (80 + t - 48) * PQ + d) = pk2(qe0 * cQ2[0], qe1 * cQ2[1]);
            }
            uint4 w0, w1;
            w0.x = pk2(ks0[0], ks0[1]); w0.y = pk2(ks0[2], ks0[3]); w0.z = pk2(ks0[4], ks0[5]); w0.w = pk2(ks0[6], ks0[7]);
            w1.x = pk2(ks1[0], ks1[1]); w1.y = pk2(ks1[2], ks1[3]); w1.z = pk2(ks1[4], ks1[5]); w1.w = pk2(ks1[6], ks1[7]);
            *(uint4*)(KST + d * PS + 16 * i + 8 * hf) = w0; *(uint4*)(KST + (d + 1) * PS + 16 * i + 8 * hf) = w1;
        }
        {
            const u32 vw[8] = {vr0.x, vr0.y, vr0.z, vr0.w, vr1.x, vr1.y, vr1.z, vr1.w};
#pragma unroll
            for (int j = 0; j < 8; ++j) { VT[(vc + 2 * j) * PS + vrow] = (bf16_t)(vw[j] & 0xffffu); VT[(vc + 2 * j + 1) * PS + vrow] = (bf16_t)(vw[j] >> 16); }
        }
        if (k < 15) {
            const size_t adv = (size_t)(k + 1) * 64;
#pragma unroll
            for (int r = 0; r < 8; ++r) { qraw[r] = *(const u32*)(qp + (adv + r) * EVPP); kraw[r] = *(const u32*)(qp + (adv + r) * EVPP + 512); }
            vr0 = *(const uint4*)(vp + adv * EVPP); vr1 = *(const uint4*)(vp + adv * EVPP + 8);
        }
        __syncthreads();
        {
            f32x4 Pj[4];
#pragma unroll
            for (int j = 0; j < 4; ++j) {
                Pj[j] = (f32x4){0.f, 0.f, 0.f, 0.f};
                if (j <= tt) {
                    const bf16_t* Ar; const bf16_t* Br;
                    if (j < tt) { Ar = KK + (16 * j + l15) * PQ; Br = QO + ((j == 0 ? 0 : (j == 1 ? 48 : 80)) + 16 * (tt - j - 1) + l15) * PQ; }
                    else { Ar = KD + (16 * tt + l15) * PQ; Br = QD + (16 * tt + l15) * PQ; }
                    f32x4 acc = {0.f, 0.f, 0.f, 0.f};
#pragma unroll
                    for (int ks = 0; ks < 4; ++ks) acc = __builtin_amdgcn_mfma_f32_16x16x32_bf16(*(const bf16x8*)(Ar + 32 * ks + 8 * g4), *(const bf16x8*)(Br + 32 * ks + 8 * g4), acc, 0, 0, 0);
                    __builtin_amdgcn_sched_group_barrier(0x100, 8, 0); __builtin_amdgcn_sched_group_barrier(0x008, 4, 0);
                    if (j == tt) {
#pragma unroll
                        for (int r = 0; r < 4; ++r) if (4 * g4 + r > l15) acc[r] = 0.f;
                    }
                    Pj[j] = acc;
                }
            }
            const bf16x8 af0 = pack8(Pj[0][0], Pj[0][1], Pj[0][2], Pj[0][3], Pj[1][0], Pj[1][1], Pj[1][2], Pj[1][3]);
            const bf16x8 af1 = pack8(Pj[2][0], Pj[2][1], Pj[2][2], Pj[2][3], Pj[3][0], Pj[3][1], Pj[3][2], Pj[3][3]);
            uint2* OI = (uint2*)(scr + HG_OI) + ((size_t)u * 32 + tt * 8) * 64 + lane;
#pragma unroll
            for (int q = 0; q < 4; ++q) {
                const int vt = 4 * vh + q;
                const bf16_t* vrw = VT + (16 * vt + l15) * PS;
                f32x4 o = {0.f, 0.f, 0.f, 0.f};
                { const uint2 lo = *(const uint2*)(vrw + 4 * g4), hi = *(const uint2*)(vrw + 16 + 4 * g4); uint4 bw; bw.x = lo.x; bw.y = lo.y; bw.z = hi.x; bw.w = hi.y;
                  o = __builtin_amdgcn_mfma_f32_16x16x32_bf16(af0, __builtin_bit_cast(bf16x8, bw), o, 0, 0, 0); }
                if (tt >= 2) { const uint2 lo = *(const uint2*)(vrw + 32 + 4 * g4), hi = *(const uint2*)(vrw + 48 + 4 * g4); uint4 bw; bw.x = lo.x; bw.y = lo.y; bw.z = hi.x; bw.w = hi.y;
                  o = __builtin_amdgcn_mfma_f32_16x16x32_bf16(af1, __builtin_bit_cast(bf16x8, bw), o, 0, 0, 0); }
                uint2 ow; ow.x = pk2(o[0], o[1]); ow.y = pk2(o[2], o[3]);
                st_hidden(OI + (size_t)vt * 64, ow);
            }
            {
                uint2* U = (uint2*)(scr + HG_U) + ((size_t)u * 64 + w * 8) * 64 + lane;
                const bf16_t* vrw = VT + (16 * w + l15) * PS;
                const bf16x8 av0 = *(const bf16x8*)(vrw + 8 * g4), av1 = *(const bf16x8*)(vrw + 32 + 8 * g4);
#pragma unroll
                for (int dt = 0; dt < 8; ++dt) {
                    const bf16_t* kr = KST + (16 * dt + l15) * PS + 8 * g4;
                    f32x4 a = {0.f, 0.f, 0.f, 0.f};
                    a = __builtin_amdgcn_mfma_f32_16x16x32_bf16(av0, *(const bf16x8*)(kr), a, 0, 0, 0);
                    a = __builtin_amdgcn_mfma_f32_16x16x32_bf16(av1, *(const bf16x8*)(kr + 32), a, 0, 0, 0);
                    uint2 uw; uw.x = pk2(a[0], a[1]); uw.y = pk2(a[2], a[3]);
                    st_hidden(U + (size_t)dt * 64, uw);
                }
            }
            {
                const int row = tid >> 3, ch16 = (tid & 7) * 16;
                const uint4 a0 = *(const uint4*)(QS + row * PQ + ch16), a1 = *(const uint4*)(QS + row * PQ + ch16 + 8);
                uint4* QG = (uint4*)(scr + HG_QG + ((size_t)u * 64 + row) * 256 + ch16 * 2);
                st_hidden(QG, a0); st_hidden(QG + 1, a1);
            }
        }
        __syncthreads();
    }
    HS_DRAIN();
}

static_assert(MOE_ITEMS == 2048 * 8 * 4 + 64 * 64 * 8, "four MoE conversion items per (NSA unit, wave) + one per (scan chunk, unit, wave)");
#define MB_DECL(SET) float4 SET##a, SET##b, SET##c, SET##d, SET##g; bf16_t* SET##o; size_t SET##k;
#define MB_ISSUE(SET, CM, MS) { MoeItem mi_; moe_item_decode(CM, (MS), mi_); \
          const float* p_ = mi_.W + (size_t)(mi_.k0 + 4 * (lane >> 3)) * mi_.N + mi_.n0 + 4 * (lane & 7); const size_t N_ = mi_.N; \
          SET##a = *(const float4*)(p_); SET##b = *(const float4*)(p_ + N_); SET##c = *(const float4*)(p_ + 2 * N_); SET##d = *(const float4*)(p_ + 3 * N_); \
          SET##g = mi_.gain ? *(const float4*)(mi_.gain + mi_.k0 + 4 * (lane >> 3)) : make_float4(1.f, 1.f, 1.f, 1.f); \
          SET##o = mi_.WT + (size_t)(mi_.drow0 + mi_.n0 + 4 * (lane & 7)) * mi_.K + mi_.k0 + 4 * (lane >> 3); SET##k = mi_.K; }
#define MB_FINISH(SET) { uint2 w_; \
          w_.x = pk2(SET##a.x * SET##g.x, SET##b.x * SET##g.y); w_.y = pk2(SET##c.x * SET##g.z, SET##d.x * SET##g.w); *(uint2*)(SET##o) = w_; \
          w_.x = pk2(SET##a.y * SET##g.x, SET##b.y * SET##g.y); w_.y = pk2(SET##c.y * SET##g.z, SET##d.y * SET##g.w); *(uint2*)(SET##o + SET##k) = w_; \
          w_.x = pk2(SET##a.z * SET##g.x, SET##b.z * SET##g.y); w_.y = pk2(SET##c.z * SET##g.z, SET##d.z * SET##g.w); *(uint2*)(SET##o + 2 * SET##k) = w_; \
          w_.x = pk2(SET##a.w * SET##g.x, SET##b.w * SET##g.y); w_.y = pk2(SET##c.w * SET##g.z, SET##d.w * SET##g.w); *(uint2*)(SET##o + 3 * SET##k) = w_; }
#define MB_CTX() Ctx cm_; { CArgs* ap_ = (CArgs*)__builtin_amdgcn_kernarg_segment_ptr(); asm volatile("" : "+s"(ap_)); int tid_ = threadIdx.x; asm volatile("" : "+v"(tid_)); make_ctx(cm_, *ap_, tid_); } \
          const int ms_ = (((63 - i) * 32 + b * 2 + g) * 8 + w) * 4
#define MB_ISSUE_A() if (!DRY) { MB_CTX();  }
#define MB_FINISH_A() if (!DRY) {  }
#define MB_ISSUE_B() if (!DRY) { MB_CTX() + 0; MB_ISSUE(m0, cm_, ms_ + 0) MB_ISSUE(m1, cm_, ms_ + 1) MB_ISSUE(m2, cm_, ms_ + 2) MB_ISSUE(m3, cm_, ms_ + 3) }
#define MB_FINISH_B() if (!DRY) { MB_FINISH(m0) MB_FINISH(m1) MB_FINISH(m2) MB_FINISH(m3) }
__device__ __forceinline__ void hgrn2_seq_full(const Ctx& c, unsigned char* lds_raw, int unit) {
    using namespace hg;
    const int h = unit & 3, b = unit >> 2;
    const bf16_t* P = (const bf16_t*)(c.ws + WS_PROJ); bf16_t* MIX = (bf16_t*)(c.ws + WS_H);
    const unsigned char* scr = (const unsigned char*)c.xr; const float* GD = (const float*)(c.ws + WS_LIST);
    const int tid = c.tid, lane = c.lane, w = c.wave;
    const int tt = w >> 1, vh = w & 1, g4 = lane >> 4, l15 = lane & 15;
    const size_t rowbase = (size_t)b * SEQ;
    const int u0 = unit * 64;
    f32x4 st[8];
#pragma unroll
    for (int dt = 0; dt < 8; ++dt) st[dt] = (f32x4){0.f, 0.f, 0.f, 0.f};
    const int qrow = tid >> 3, qc16 = (tid & 7) * 16;
    float* OS = (float*)(lds_raw + S_OS);
    uint4 q0, q1, gt0, gt1; uint2 uu[8], oi[4]; float gg[8]; MB_DECL(mx)
#define HGF_LDQ(CH) do { const uint4* qg_ = (const uint4*)(scr + HG_QG + (((size_t)(u0 + (CH))) * 64 + qrow) * 256 + qc16 * 2); q0 = qg_[0]; q1 = qg_[1]; } while (0)
#define HGF_LDOI(CH) do { const uint2* op_ = (const uint2*)(scr + HG_OI) + (((size_t)(u0 + (CH))) * 32 + tt * 8 + 4 * vh) * 64 + lane; \
        _Pragma("unroll") for (int q = 0; q < 4; ++q) oi[q] = op_[(size_t)q * 64]; } while (0)
#define HGF_LDU(CH) do { const uint2* up_ = (const uint2*)(scr + HG_U) + (((size_t)(u0 + (CH))) * 64 + w * 8) * 64 + lane; const float* gp_ = GD + ((size_t)(u0 + (CH))) * 128 + l15; \
        _Pragma("unroll") for (int dt = 0; dt < 8; ++dt) { uu[dt] = up_[(size_t)dt * 64]; gg[dt] = gp_[16 * dt]; } } while (0)
#define HGF_LDG(CH) do { const uint4* gp_ = (const uint4*)(P + (rowbase + (size_t)(CH) * 64 + qrow) * EVPP + 1536 + h * 128 + qc16); gt0 = gp_[0]; gt1 = gp_[1]; } while (0)
    HGF_LDQ(0); HGF_LDOI(0); HGF_LDU(0); HGF_LDG(0);
    __syncthreads();
    for (int ch = 0; ch < 64; ++ch) {
        bf16_t* QSL = (bf16_t*)(lds_raw + S_QS) + (ch & 1) * 64 * PQ; bf16_t* STT = (bf16_t*)(lds_raw + S_STT) + (ch & 1) * 128 * PQ;
        MB_ISSUE(mx, c, 2048 * 8 * 4 + (ch * 64 + unit) * 8 + w)
        *(uint4*)(QSL + qrow * PQ + qc16) = q0; *(uint4*)(QSL + qrow * PQ + qc16 + 8) = q1;
#pragma unroll
        for (int dt = 0; dt < 8; ++dt)
#pragma unroll
            for (int r = 0; r < 4; ++r) STT[(16 * w + 4 * g4 + r) * PQ + 16 * dt + l15] = f2bf(st[dt][r]);
        if (ch + 1 < 64) HGF_LDQ(ch + 1);
        __syncthreads();
#pragma unroll
        for (int q = 0; q < 4; ++q) {
            const int vt = 4 * vh + q;
            f32x4 o = {__uint_as_float(oi[q].x << 16), __uint_as_float(oi[q].x & 0xffff0000u), __uint_as_float(oi[q].y << 16), __uint_as_float(oi[q].y & 0xffff0000u)};
            const bf16_t* Ar = QSL + (16 * tt + l15) * PQ; const bf16_t* Br = STT + (16 * vt + l15) * PQ;
#pragma unroll
            for (int ks = 0; ks < 4; ++ks) o = __builtin_amdgcn_mfma_f32_16x16x32_bf16(*(const bf16x8*)(Ar + 32 * ks + 8 * g4), *(const bf16x8*)(Br + 32 * ks + 8 * g4), o, 0, 0, 0);
#pragma unroll
            for (int r = 0; r < 4; ++r) OS[(16 * tt + 4 * g4 + r) * OSP + 16 * vt + l15] = o[r];
        }
        if (ch + 1 < 64) HGF_LDOI(ch + 1);
#pragma unroll
        for (int dt = 0; dt < 8; ++dt) {
            st[dt][0] = st[dt][0] * gg[dt] + __uint_as_float(uu[dt].x << 16); st[dt][1] = st[dt][1] * gg[dt] + __uint_as_float(uu[dt].x & 0xffff0000u);
            st[dt][2] = st[dt][2] * gg[dt] + __uint_as_float(uu[dt].y << 16); st[dt][3] = st[dt][3] * gg[dt] + __uint_as_float(uu[dt].y & 0xffff0000u);
        }
        if (ch + 1 < 64) HGF_LDU(ch + 1);
        __syncthreads();
        MB_FINISH(mx)
        {
            const float* orow = OS + qrow * OSP + qc16;
            const float4 o0 = *(const float4*)(orow), o1 = *(const float4*)(orow + 4), o2 = *(const float4*)(orow + 8), o3 = *(const float4*)(orow + 12);
            float sq = (o0.x * o0.x + o0.y * o0.y) + (o0.z * o0.z + o0.w * o0.w) + (o1.x * o1.x + o1.y * o1.y) + (o1.z * o1.z + o1.w * o1.w)
                     + (o2.x * o2.x + o2.y * o2.y) + (o2.z * o2.z + o2.w * o2.w) + (o3.x * o3.x + o3.y * o3.y) + (o3.z * o3.z + o3.w * o3.w);
            sq += __shfl_xor(sq, 1); sq += __shfl_xor(sq, 2); sq += __shfl_xor(sq, 4);
            const float rstd = rsqrtf(sq * (1.f / 128.f) + EPS);
            const float4 n0 = *(const float4*)(c.hg_gain + qc16), n1 = *(const float4*)(c.hg_gain + qc16 + 4), n2 = *(const float4*)(c.hg_gain + qc16 + 8), n3 = *(const float4*)(c.hg_gain + qc16 + 12);
            float ga[8], gb[8]; unpack8(gt0, ga); unpack8(gt1, gb);
#define HGF_SG(G) ((G) / (1.f + __expf(-(G))))
            uint4 w0, w1;
            w0.x = pk2(o0.x * rstd * n0.x * HGF_SG(ga[0]), o0.y * rstd * n0.y * HGF_SG(ga[1])); w0.y = pk2(o0.z * rstd * n0.z * HGF_SG(ga[2]), o0.w * rstd * n0.w * HGF_SG(ga[3]));
            w0.z = pk2(o1.x * rstd * n1.x * HGF_SG(ga[4]), o1.y * rstd * n1.y * HGF_SG(ga[5])); w0.w = pk2(o1.z * rstd * n1.z * HGF_SG(ga[6]), o1.w * rstd * n1.w * HGF_SG(ga[7]));
            w1.x = pk2(o2.x * rstd * n2.x * HGF_SG(gb[0]), o2.y * rstd * n2.y * HGF_SG(gb[1])); w1.y = pk2(o2.z * rstd * n2.z * HGF_SG(gb[2]), o2.w * rstd * n2.w * HGF_SG(gb[3]));
            w1.z = pk2(o3.x * rstd * n3.x * HGF_SG(gb[4]), o3.y * rstd * n3.y * HGF_SG(gb[5])); w1.w = pk2(o3.z * rstd * n3.z * HGF_SG(gb[6]), o3.w * rstd * n3.w * HGF_SG(gb[7]));
#undef HGF_SG
            uint4* mp = (uint4*)(MIX + (rowbase + (size_t)ch * 64 + qrow) * D + h * 128 + qc16);
            mp[0] = w0; mp[1] = w1;
        }
        if (ch + 1 < 64) HGF_LDG(ch + 1);
    }
#undef HGF_LDQ
#undef HGF_LDOI
#undef HGF_LDU
#undef HGF_LDG
    __syncthreads();
}

namespace fa {
typedef short bf16x8 __attribute__((ext_vector_type(8)));
typedef short s16x4 __attribute__((ext_vector_type(4)));
typedef float f32x16 __attribute__((ext_vector_type(16)));
#define FA_LAS __attribute__((address_space(3)))
constexpr int RPK = 144, RPV = 192;
constexpr int KTB = 64 * RPK, VTB = 64 * RPV;
constexpr int O_KT = 0, O_VT = 2 * KTB, O_IMP = O_VT + 2 * VTB, O_SELM = O_IMP + 64 * 64 * 4, O_JL = O_SELM + 512, O_UM = O_JL + 64 * 4, O_STG = 0  , STG_P = 144, STG_W = 32 * STG_P,
              O_RES = O_UM + 32, RES_P = 68, RES_W = 32 * RES_P * 4, O_END = O_RES + 8 * RES_W;
static_assert(O_END + 16 <= LDS_BARST && (O_STG % 16) == 0 && (O_RES % 16) == 0 && 8 * STG_W <= 2 * KTB + 2 * VTB, "attention LDS");
constexpr float SC2 = 0.125f * 1.4426950408889634f;
constexpr float THR = 8.f;
__device__ __forceinline__ int crow(int r, int hi) { return (r & 3) + 8 * (r >> 2) + 4 * hi; }
struct RangeMask { int lo, hi; __device__ __forceinline__ bool operator()(int kl) const { return kl >= lo && kl <= hi; } };
__device__ __forceinline__ s16x4 vtr(const unsigned char* p) {
    typedef short v4i16_t __attribute__((ext_vector_type(4)));
    return __builtin_bit_cast(s16x4, __builtin_amdgcn_ds_read_tr16_b64_v4i16((FA_LAS v4i16_t*)(p))); }
struct State { f32x16 o[2]; float m, l; };
__device__ __forceinline__ void init(State& st, float m0, float l0) {
#pragma unroll
    for (int t = 0; t < 2; ++t)
#pragma unroll
        for (int r = 0; r < 16; ++r) st.o[t][r] = 0.f;
    st.m = m0; st.l = l0; }
__device__ __forceinline__ void qnorm_rope(bf16x8 (&qf)[4], const float* gain, const float2* rt  , int hi) {
    float f[4][8]; float ss = 0.f;
#pragma unroll
    for (int sp = 0; sp < 4; ++sp) { unpack8(__builtin_bit_cast(uint4, qf[sp]), f[sp]);
#pragma unroll
        for (int j = 0; j < 8; ++j) ss += f[sp][j] * f[sp][j]; }
    ss += __shfl_xor(ss, 32);
    const float rstd = rsqrtf(ss * (1.f / 64.f) + EPS);
#pragma unroll
    for (int sp = 0; sp < 4; ++sp) { const float4 g0 = *(const float4*)(gain + 16 * sp + 8 * hi), g1 = *(const float4*)(gain + 16 * sp + 8 * hi + 4);
        f[sp][0] *= rstd * g0.x; f[sp][1] *= rstd * g0.y; f[sp][2] *= rstd * g0.z; f[sp][3] *= rstd * g0.w; f[sp][4] *= rstd * g1.x; f[sp][5] *= rstd * g1.y; f[sp][6] *= rstd * g1.z; f[sp][7] *= rstd * g1.w; }
#pragma unroll
    for (int j = 0; j < 8; ++j) { const float other = __shfl_xor(f[0][j], 32); const float2 cs = rt[j];
        f[0][j] = hi ? (f[0][j] * cs.x + other * cs.y) : (f[0][j] * cs.x - other * cs.y); }
#pragma unroll
    for (int sp = 0; sp < 4; ++sp) { uint4 o; o.x = pk2(f[sp][0] * SC2, f[sp][1] * SC2); o.y = pk2(f[sp][2] * SC2, f[sp][3] * SC2); o.z = pk2(f[sp][4] * SC2, f[sp][5] * SC2); o.w = pk2(f[sp][6] * SC2, f[sp][7] * SC2);
        qf[sp] = __builtin_bit_cast(bf16x8, o); }
}
__device__ __forceinline__ uint4 knorm_rope(const uint4 kv, const float* gain, const float2* rt  , int chunk) {
    float f[8]; unpack8(kv, f); float ss = 0.f;
#pragma unroll
    for (int j = 0; j < 8; ++j) ss += f[j] * f[j];
    ss += __shfl_xor(ss, 1); ss += __shfl_xor(ss, 2); ss += __shfl_xor(ss, 4);
    const float rstd = rsqrtf(ss * (1.f / 64.f) + EPS);
    const float4 g0 = *(const float4*)(gain + 8 * chunk), g1 = *(const float4*)(gain + 8 * chunk + 4);
    f[0] *= rstd * g0.x; f[1] *= rstd * g0.y; f[2] *= rstd * g0.z; f[3] *= rstd * g0.w; f[4] *= rstd * g1.x; f[5] *= rstd * g1.y; f[6] *= rstd * g1.z; f[7] *= rstd * g1.w;
#pragma unroll
    for (int j = 0; j < 8; ++j) { const float other = __shfl_xor(f[j], 1);
        if (chunk < 2) { const float2 cs = rt[j]; f[j] = chunk ? (f[j] * cs.x + other * cs.y) : (f[j] * cs.x - other * cs.y); } }
    uint4 o; o.x = pk2(f[0], f[1]); o.y = pk2(f[2], f[3]); o.z = pk2(f[4], f[5]); o.w = pk2(f[6], f[7]); return o;
}
__device__ __forceinline__ float2 rope_cs(int pos, int j) {
    const float chi = j == 0 ? 0.15911865234375f : j == 1 ? 0.03086090087890625f : j == 2 ? 0.0059833526611328125f : j == 3 ? 0.0011606216430664062f : j == 4 ? 0.000225067138671875f : j == 5 ? 4.3645501136779785e-05f : j == 6 ? 8.463859558105469e-06f : 1.6409903764724731e-06f;
    const float clo = j == 0 ? 3.629074853961356e-05f : j == 1 ? 2.8625258892134298e-06f : j == 2 ? 1.8330515558773186e-06f : j == 3 ? 4.1998173827551e-08f : j == 4 ? 1.1940367805607366e-08f : j == 5 ? 2.451655989332835e-09f : j == 6 ? 4.712501500137023e-10f : 4.3588632703261965e-10f;
    const float fp = (float)pos;
    const float fr = __builtin_amdgcn_fractf(fp * chi) + fp * clo;
    return make_float2(__builtin_amdgcn_cosf(fr), __builtin_amdgcn_sinf(fr));
}
__device__ __forceinline__ void qnorm_rope(bf16x8 (&qf)[4], const float* gain, int pos, int hi) {
    float f[4][8]; float ss = 0.f;
#pragma unroll
    for (int sp = 0; sp < 4; ++sp) { unpack8(__builtin_bit_cast(uint4, qf[sp]), f[sp]);
#pragma unroll
        for (int j = 0; j < 8; ++j) ss += f[sp][j] * f[sp][j]; }
    ss += __shfl_xor(ss, 32);
    const float rstd = rsqrtf(ss * (1.f / 64.f) + EPS);
#pragma unroll
    for (int sp = 0; sp < 4; ++sp) { const float4 g0 = *(const float4*)(gain + 16 * sp + 8 * hi), g1 = *(const float4*)(gain + 16 * sp + 8 * hi + 4);
        f[sp][0] *= rstd * g0.x; f[sp][1] *= rstd * g0.y; f[sp][2] *= rstd * g0.z; f[sp][3] *= rstd * g0.w; f[sp][4] *= rstd * g1.x; f[sp][5] *= rstd * g1.y; f[sp][6] *= rstd * g1.z; f[sp][7] *= rstd * g1.w; }
#pragma unroll
    for (int j = 0; j < 8; ++j) { const float other = __shfl_xor(f[0][j], 32); const float2 cs = rope_cs(pos, j);
        f[0][j] = hi ? (f[0][j] * cs.x + other * cs.y) : (f[0][j] * cs.x - other * cs.y); }
#pragma unroll
    for (int sp = 0; sp < 4; ++sp) { uint4 o; o.x = pk2(f[sp][0] * SC2, f[sp][1] * SC2); o.y = pk2(f[sp][2] * SC2, f[sp][3] * SC2); o.z = pk2(f[sp][4] * SC2, f[sp][5] * SC2); o.w = pk2(f[sp][6] * SC2, f[sp][7] * SC2);
        qf[sp] = __builtin_bit_cast(bf16x8, o); }
}
__device__ __forceinline__ uint4 knorm_rope(const uint4 kv, const float* gain, int pos, int chunk) {
    float f[8]; unpack8(kv, f); float ss = 0.f;
#pragma unroll
    for (int j = 0; j < 8; ++j) ss += f[j] * f[j];
    ss += __shfl_xor(ss, 1); ss += __shfl_xor(ss, 2); ss += __shfl_xor(ss, 4);
    const float rstd = rsqrtf(ss * (1.f / 64.f) + EPS);
    const float4 g0 = *(const float4*)(gain + 8 * chunk), g1 = *(const float4*)(gain + 8 * chunk + 4);
    f[0] *= rstd * g0.x; f[1] *= rstd * g0.y; f[2] *= rstd * g0.z; f[3] *= rstd * g0.w; f[4] *= rstd * g1.x; f[5] *= rstd * g1.y; f[6] *= rstd * g1.z; f[7] *= rstd * g1.w;
#pragma unroll
    for (int j = 0; j < 8; ++j) { const float other = __shfl_xor(f[j], 1);
        if (chunk < 2) { const float2 cs = rope_cs(pos, j); f[j] = chunk ? (f[j] * cs.x + other * cs.y) : (f[j] * cs.x - other * cs.y); } }
    uint4 o; o.x = pk2(f[0], f[1]); o.y = pk2(f[2], f[3]); o.z = pk2(f[4], f[5]); o.w = pk2(f[6], f[7]); return o;
}
template <int ABL = 0, bool FAST = false, bool ROWM = true, bool IMPC = false>
__device__ __forceinline__ void tile(State& st, const unsigned char* lds, int koff, int voff, const bf16x8 (&qf)[4], float cbias, bool emask, const RangeMask mk, int lane, float* impr = nullptr, float* carry = nullptr) {
    const int r32 = lane & 31, hi = lane >> 5;
    const float negm = FAST ? (ROWM ? cbias : 0.f) : cbias - st.m;
    f32x16 p0, p1;
#pragma unroll
    for (int r = 0; r < 16; ++r) { p0[r] = negm; p1[r] = negm; }
    const unsigned char* kb = lds + koff + r32 * RPK + hi * 16;
#pragma unroll
    for (int sp = 0; sp < 4; ++sp) {
        const bf16x8 a0 = *(const bf16x8*)(kb + 32 * sp), a1 = *(const bf16x8*)(kb + 32 * RPK + 32 * sp);
        p0 = __builtin_amdgcn_mfma_f32_32x32x16_bf16(a0, qf[sp], p0, 0, 0, 0);
        p1 = __builtin_amdgcn_mfma_f32_32x32x16_bf16(a1, qf[sp], p1, 0, 0, 0);
    }
    __builtin_amdgcn_sched_group_barrier(0x100, 8, 0);
    __builtin_amdgcn_sched_group_barrier(0x008, 8, 0);
    if (emask) {
#pragma unroll
        for (int r = 0; r < 16; ++r) { const int kl = crow(r, hi); if (!mk(kl)) p0[r] = -INFINITY; if (!mk(kl + 32)) p1[r] = -INFINITY; }
    }
    if (ABL == 1) {
#pragma unroll
        for (int r = 0; r < 16; ++r) { p0[r] *= 0.001f; p1[r] *= 0.001f; }
        st.l += p0[0];
    } else if (FAST) {
        float sa = 0.f, sb = 0.f, sc = 0.f, sd = 0.f;
#pragma unroll
        for (int r = 0; r < 16; r += 4) {
            p0[r] = __builtin_amdgcn_exp2f(p0[r]); p1[r] = __builtin_amdgcn_exp2f(p1[r]); p0[r + 1] = __builtin_amdgcn_exp2f(p0[r + 1]); p1[r + 1] = __builtin_amdgcn_exp2f(p1[r + 1]);
            p0[r + 2] = __builtin_amdgcn_exp2f(p0[r + 2]); p1[r + 2] = __builtin_amdgcn_exp2f(p1[r + 2]); p0[r + 3] = __builtin_amdgcn_exp2f(p0[r + 3]); p1[r + 3] = __builtin_amdgcn_exp2f(p1[r + 3]);
            sa += p0[r] + p1[r]; sb += p0[r + 1] + p1[r + 1]; sc += p0[r + 2] + p1[r + 2]; sd += p0[r + 3] + p1[r + 3];
        }
        st.l += (sa + sb) + (sc + sd);
        if (IMPC) {
            float x0[4], x1[4];
#pragma unroll
            for (int q = 0; q < 4; ++q) { x0[q] = __shfl_xor(p0[4 * q + 3], 32); x1[q] = __shfl_xor(p1[4 * q + 3], 32); }
#pragma unroll
            for (int q = 0; q < 4; ++q) {
                const float g0 = (p0[4 * q] + p0[4 * q + 1]) + (p0[4 * q + 2] + p0[4 * q + 3]), g1 = (p1[4 * q] + p1[4 * q + 1]) + (p1[4 * q + 2] + p1[4 * q + 3]);
                const float e0 = hi ? x0[q] : (q ? x0[q ? q - 1 : 0] : *carry), e1 = hi ? x1[q] : (q ? x1[q ? q - 1 : 0] : x0[3]);
                impr[2 * q + hi] = g0 + e0; impr[8 + 2 * q + hi] = g1 + e1;
            }
            *carry = x1[3];
        }
    } else {
        float mxa = fmaxf(p0[0], p1[0]), mxb = fmaxf(p0[1], p1[1]), mxc = fmaxf(p0[2], p1[2]), mxd = fmaxf(p0[3], p1[3]);
#pragma unroll
        for (int r = 4; r < 16; r += 4) { mxa = fmaxf(mxa, fmaxf(p0[r], p1[r])); mxb = fmaxf(mxb, fmaxf(p0[r + 1], p1[r + 1])); mxc = fmaxf(mxc, fmaxf(p0[r + 2], p1[r + 2])); mxd = fmaxf(mxd, fmaxf(p0[r + 3], p1[r + 3])); }
        float mx = fmaxf(fmaxf(mxa, mxb), fmaxf(mxc, mxd));
        mx = fmaxf(mx, __shfl_xor(mx, 32));
        if (!__all(mx <= THR)) {
            const float delta = fmaxf(mx, 0.f), alpha = __builtin_amdgcn_exp2f(-delta);
            st.m += delta; st.l *= alpha;
#pragma unroll
            for (int r = 0; r < 16; ++r) { p0[r] -= delta; p1[r] -= delta; st.o[0][r] *= alpha; st.o[1][r] *= alpha; }
        }
        float sa = 0.f, sb = 0.f, sc = 0.f, sd = 0.f;
#pragma unroll
        for (int r = 0; r < 16; r += 4) {
            p0[r] = __builtin_amdgcn_exp2f(p0[r]); p1[r] = __builtin_amdgcn_exp2f(p1[r]); p0[r + 1] = __builtin_amdgcn_exp2f(p0[r + 1]); p1[r + 1] = __builtin_amdgcn_exp2f(p1[r + 1]);
            p0[r + 2] = __builtin_amdgcn_exp2f(p0[r + 2]); p1[r + 2] = __builtin_amdgcn_exp2f(p1[r + 2]); p0[r + 3] = __builtin_amdgcn_exp2f(p0[r + 3]); p1[r + 3] = __builtin_amdgcn_exp2f(p1[r + 3]);
            sa += p0[r] + p1[r]; sb += p0[r + 1] + p1[r + 1]; sc += p0[r + 2] + p1[r + 2]; sd += p0[r + 3] + p1[r + 3];
        }
        st.l += (sa + sb) + (sc + sd);
    }
    if (ABL == 2) { st.o[0][0] += p0[0] + p0[5] + p1[3] + p1[9]; return; }
    const int vbase = voff + (4 * hi + ((lane & 15) >> 2)) * RPV + ((lane >> 4) & 1) * 32 + (lane & 3) * 8;
#pragma unroll
    for (int sub = 0; sub < 2; ++sub)
#pragma unroll
        for (int ks = 0; ks < 2; ++ks) {
            uint4 pw;
            if (sub == 0) { pw.x = pk2(p0[8 * ks], p0[8 * ks + 1]); pw.y = pk2(p0[8 * ks + 2], p0[8 * ks + 3]); pw.z = pk2(p0[8 * ks + 4], p0[8 * ks + 5]); pw.w = pk2(p0[8 * ks + 6], p0[8 * ks + 7]); }
            else { pw.x = pk2(p1[8 * ks], p1[8 * ks + 1]); pw.y = pk2(p1[8 * ks + 2], p1[8 * ks + 3]); pw.z = pk2(p1[8 * ks + 4], p1[8 * ks + 5]); pw.w = pk2(p1[8 * ks + 6], p1[8 * ks + 7]); }
            const bf16x8 pf = __builtin_bit_cast(bf16x8, pw);
#pragma unroll
            for (int dt = 0; dt < 2; ++dt) {
                const unsigned char* vp = lds + vbase + (32 * sub + 16 * ks) * RPV + dt * 64;
                const s16x4 lo = vtr(vp), hi4 = vtr(vp + 8 * RPV);
                const bf16x8 vf = {lo[0], lo[1], lo[2], lo[3], hi4[0], hi4[1], hi4[2], hi4[3]};
                st.o[dt] = __builtin_amdgcn_mfma_f32_32x32x16_bf16(vf, pf, st.o[dt], 0, 0, 0);
            }
        }
}
__device__ __forceinline__ uint4 ldg_tile(const bf16_t* base, long row, int ld, int tid) { return *(const uint4*)(base + row * ld + (tid & 7) * 8); }
__device__ __forceinline__ void sts_k(unsigned char* lds, int buf, const uint4& v, int tid) { *(uint4*)(lds + O_KT + buf * KTB + (tid >> 3) * RPK + (tid & 7) * 16) = v; }
__device__ __forceinline__ void sts_v(unsigned char* lds, int buf, const uint4& v, int tid) { *(uint4*)(lds + O_VT + buf * VTB + (tid >> 3) * RPV + (tid & 7) * 16) = v; }
}

template <int ABL = 0, bool DRY = false, bool FAST = false>
__device__ __forceinline__ void nsa_unit(const Ctx& c, unsigned char* lds, int b, int i, int g) {
    using namespace fa;
    const bf16_t* P = (const bf16_t*)(c.ws + WS_PROJ);
    const bf16_t* KCB = (const bf16_t*)(c.ws + WS_KCB) + (size_t)((b * 2 + g) * 256) * 64; const bf16_t* VCB = (const bf16_t*)(c.ws + WS_VCB) + (size_t)((b * 2 + g) * 256) * 64;
    const int tid = c.tid, lane = c.lane, w = c.wave, r32 = lane & 31, hi = lane >> 5;
    const int tl = 8 * w + (r32 >> 2), hh = r32 & 3, t = 64 * i + tl, head = 4 * g + hh;
    const int key = tid >> 3;
    const size_t m = (size_t)b * SEQ + t;
    const bf16_t* prow = P + m * EVPP;
    const int nt = ((4 * i + 2) >> 6) + 1, nA = FAST ? nt : 2 * nt;
    uint4 kreg = ldg_tile(KCB, key, 64, tid), vreg = ldg_tile(VCB, key, 64, tid);
    bf16x8 qf[4];
#pragma unroll
    for (int sp = 0; sp < 4; ++sp) qf[sp] = *(const bf16x8*)(prow + 2048 + head * 64 + 16 * sp + 8 * hi);
    MB_DECL(m0) MB_DECL(m1) MB_DECL(m2) MB_DECL(m3)
    MB_ISSUE_A()
    qnorm_rope(qf, c.nsa_qg, (const float2*)(c.ws + WS_ROPE) + (size_t)t * 8, hi);
    float* IMP = (float*)(lds + O_IMP); unsigned long long* SELM = (unsigned long long*)(lds + O_SELM); u32* UM = (u32*)(lds + O_UM); int* JL = (int*)(lds + O_JL);
    float* RES = (float*)(lds + O_RES + w * RES_W) + r32 * RES_P;
#define NSA_GATE(k) (1.f / (1.f + __expf(-bf2f(P[((size_t)b * SEQ + t) * EVPP + 3328 + head * 3 + (k)]))))
    const int nmaxq = (t >= 31) ? ((t - 31) >> 4) : -1;
    State st; init(st, 0.f, 0.f);
    float inv = 0.f;
#define NSA_LOAD_A(IDX) do { const int idx_ = (IDX); const int kt_ = idx_ >= nt ? idx_ - nt : idx_; kreg = ldg_tile(KCB, 64 * kt_ + key, 64, tid); \
        if (idx_ < nt) vreg = ldg_tile(VCB, 64 * kt_ + key, 64, tid); \
        else { const int nn = 64 * kt_ + key, j0 = (tid & 7) * 8; u32 wv[4];     \
            _Pragma("unroll") for (int q = 0; q < 4; ++q) { const int ja = j0 + 2 * q, jb = ja + 1; \
                wv[q] = ((nn >= 4 * ja - 1 && nn <= 4 * ja + 3) ? 0x3f80u : 0u) | ((nn >= 4 * jb - 1 && nn <= 4 * jb + 3) ? 0x3f800000u : 0u); } \
            vreg.x = wv[0]; vreg.y = wv[1]; vreg.z = wv[2]; vreg.w = wv[3]; } } while (0)
    __syncthreads();
    sts_k(lds, 0, kreg, tid); sts_v(lds, 0, vreg, tid);
    NSA_LOAD_A(1);
    __syncthreads();
    MB_FINISH_A()
    float carry = 0.f;
    for (int idx = 0; idx < nA; ++idx) {
        if (!FAST && idx == nt) {
            const float lt = st.l + __shfl_xor(st.l, 32);
            inv = lt > 0.f ? 1.f / lt : 0.f;
            const float gci = NSA_GATE(0) * inv;
#pragma unroll
            for (int dt = 0; dt < 2; ++dt)
#pragma unroll
                for (int r = 0; r < 16; ++r) RES[32 * dt + crow(r, hi)] = gci * st.o[dt][r];
            const float mfin = st.m; init(st, mfin, 0.f);
        }
        const int kt = idx >= nt ? idx - nt : idx, cur = idx & 1;
        if (FAST) tile<ABL, true, false, true>(st, lds, O_KT + cur * KTB, O_VT + cur * VTB, qf, 0.f, true, RangeMask{0, nmaxq - 64 * kt}, lane, RES + 16 * kt, &carry);
        else tile<ABL, false, false>(st, lds, O_KT + cur * KTB, O_VT + cur * VTB, qf, 0.f, true, RangeMask{0, nmaxq - 64 * kt}, lane);
        if (idx + 1 < nA) { sts_k(lds, cur ^ 1, kreg, tid); sts_v(lds, cur ^ 1, vreg, tid); if (idx + 2 < nA) NSA_LOAD_A(idx + 2); }
        __syncthreads();
    }
#undef NSA_LOAD_A
    if (FAST) {
        const float lt = st.l + __shfl_xor(st.l, 32);
        inv = lt > 0.f ? 1.f / lt : 0.f;
        for (int jj = 0; jj < 8 * nt; ++jj) {
            float v = RES[2 * jj + hi] * inv; v += __shfl_xor(v, 1); v += __shfl_xor(v, 2);
            if (hh == 0) IMP[tl * 64 + 2 * jj + hi] = v;
        }
        const float gci = NSA_GATE(0) * inv;
#pragma unroll
        for (int dt = 0; dt < 2; ++dt)
#pragma unroll
            for (int r = 0; r < 16; ++r) RES[32 * dt + crow(r, hi)] = gci * st.o[dt][r];
    } else {
#pragma unroll
        for (int dt = 0; dt < 2; ++dt)
#pragma unroll
            for (int r = 0; r < 16; ++r) {
                float v = st.o[dt][r] * inv; v += __shfl_xor(v, 1); v += __shfl_xor(v, 2);
                if (hh == 0) IMP[tl * 64 + 32 * dt + crow(r, hi)] = v;
            }
    }
    const bf16_t* PB = P + (size_t)b * SEQ * EVPP + g * 64;
#define KW (PB + 3072)
#define VW (PB + 3200)
#define KS (PB + 2816)
#define VS (PB + 2944)
    const int k0 = (i - 8 > 0) ? i - 8 : 0, nW = i - k0 + 1;
    kreg = ldg_tile(KW, 64 * k0 + key, EVPP, tid); vreg = ldg_tile(VW, 64 * k0 + key, EVPP, tid);
    if (tid < 2) UM[tid] = 0u;
    MB_ISSUE_B()
    __syncthreads();
    {
        const int tk = tid >> 3, sub = tid & 7;
        float cand[8];
#pragma unroll
        for (int q = 0; q < 8; ++q) { const int j = 8 * sub + q; const bool allowed = j <= i, forced = (j == 0) || (j == i) || (j == i - 1);
            cand[q] = allowed ? IMP[tk * 64 + j] + (forced ? 1e4f : 0.f) : -INFINITY; }
        unsigned long long msk = 0ull;
#pragma unroll 1
        for (int rnd = 0; rnd < 8; ++rnd) {
            float bv = cand[0]; int bi = 0;
#pragma unroll
            for (int q = 1; q < 8; ++q) if (cand[q] > bv) { bv = cand[q]; bi = q; }
            bi += 8 * sub;
#pragma unroll
            for (int o = 1; o < 8; o <<= 1) { const float ov = __shfl_xor(bv, o); const int oi = __shfl_xor(bi, o); if (ov > bv || (ov == bv && oi < bi)) { bv = ov; bi = oi; } }
            if (bv > -INFINITY) {
                msk |= 1ull << bi;
#pragma unroll
                for (int q = 0; q < 8; ++q) if (8 * sub + q == bi) cand[q] = -INFINITY;
            }
        }
        if (sub == 0) { SELM[tk] = msk; atomicOr(&UM[0], (u32)msk); atomicOr(&UM[1], (u32)(msk >> 32)); }
    }
    __syncthreads();
    int nsel;
    {
        const unsigned long long um = (unsigned long long)UM[0] | ((unsigned long long)UM[1] << 32);
        nsel = __popcll(um);
        if (tid < 64 && ((um >> tid) & 1ull)) JL[__popcll(um & ((1ull << tid) - 1ull))] = tid;
    }
    sts_k(lds, 0, kreg, tid); sts_v(lds, 0, vreg, tid);
    __syncthreads();
    MB_FINISH_B()
    const int nB = nW + nsel;
    const unsigned long long mysel = SELM[tl];
#define NSA_LOAD_B(IDX) do { const int lidx_ = (IDX); if (lidx_ < nW) { const long row_ = 64 * (k0 + lidx_) + key; kreg = ldg_tile(KW, row_, EVPP, tid); vreg = ldg_tile(VW, row_, EVPP, tid); } \
        else { const long row_ = 64 * JL[lidx_ - nW] + key; kreg = ldg_tile(KS, row_, EVPP, tid); vreg = ldg_tile(VS, row_, EVPP, tid); } } while (0)
    NSA_LOAD_B(1);
    init(st, 0.f, 0.f);
#define NSA_STAGE_B(IDX) do { const int idx_ = (IDX); if (idx_ + 1 < nB) { sts_k(lds, (idx_ & 1) ^ 1, kreg, tid); sts_v(lds, (idx_ & 1) ^ 1, vreg, tid); if (idx_ + 2 < nB) NSA_LOAD_B(idx_ + 2); } __syncthreads(); } while (0)
    for (int idx = 0; idx < nW; ++idx) {
        const int cur = idx & 1, kt = k0 + idx; RangeMask mk{0, 63}; if (kt == i) mk.hi = tl; if (kt == i - 8) mk.lo = tl + 1;
        tile<ABL, FAST, false>(st, lds, O_KT + cur * KTB, O_VT + cur * VTB, qf, 0.f, (kt == i) || (kt == i - 8), mk, lane);
        NSA_STAGE_B(idx);
    }
    {
        const float lt = st.l + __shfl_xor(st.l, 32);
        const float sc = NSA_GATE(2) * (lt > 0.f ? 1.f / lt : 0.f);
#pragma unroll
        for (int dt = 0; dt < 2; ++dt)
#pragma unroll
            for (int r = 0; r < 16; ++r) RES[32 * dt + crow(r, hi)] += sc * st.o[dt][r];
        init(st, 0.f, 0.f);
    }
    for (int idx = nW; idx < nB; ++idx) {
        const int cur = idx & 1, j = JL[idx - nW]; const bool mine = ((mysel >> j) & 1ull) != 0ull;
        if (__any((int)mine)) tile<ABL, FAST, true>(st, lds, O_KT + cur * KTB, O_VT + cur * VTB, qf, mine ? 0.f : -INFINITY, j == i, RangeMask{0, tl}, lane);
        NSA_STAGE_B(idx);
    }
#undef NSA_STAGE_B
#undef NSA_LOAD_B
    {
        const float lt = st.l + __shfl_xor(st.l, 32);
        const float sc = NSA_GATE(1) * (lt > 0.f ? 1.f / lt : 0.f);
        unsigned char* stg = lds + O_STG + w * STG_W;
#pragma unroll
        for (int dt = 0; dt < 2; ++dt)
#pragma unroll
            for (int r = 0; r < 16; ++r) *(bf16_t*)(stg + r32 * STG_P + (32 * dt + crow(r, hi)) * 2) = f2bf(RES[32 * dt + crow(r, hi)] + sc * st.o[dt][r]);
        LDS_FENCE();
#pragma unroll
        for (int it = 0; it < 4; ++it) {
            const int row = it * 8 + (lane >> 3), ch = lane & 7;
            const uint4 v = *(const uint4*)(stg + row * STG_P + ch * 16);
            const size_t mm = (size_t)b * SEQ + 64 * i + 8 * w + (row >> 2);
            if (!DRY) *(uint4*)((bf16_t*)(c.ws + WS_H) + mm * D + 512 + (4 * g + (row & 3)) * 64 + ch * 8) = v;
            else if (v.x == 0x12345678u && v.y == 0x9abcdef0u) *(uint4*)((bf16_t*)(c.ws + WS_H) + mm * D + 512 + (4 * g + (row & 3)) * 64 + ch * 8) = v;
        }
        LDS_FENCE();
    }
#undef KW
#undef VW
#undef KS
#undef VS
#undef NSA_GATE
}
__device__ __forceinline__ float score_bound(const float* gq, const float* gk, int nk, int lane) {
    float a = fabsf(gq[lane]), b = 0.f;
    for (int x = 0; x < nk; ++x) b = fmaxf(b, fabsf(gk[64 * x + lane]));
    return fa::SC2 * 64.f * wmax(a) * wmax(b);
}
template <int ABL = 0, bool DRY = false>
__device__ __forceinline__ void nsa_mfma(const Ctx& c, unsigned char* lds) {
    const bool fast = score_bound(c.nsa_qg, c.nsa_kg, 3, c.lane) < 60.f;
    int* qc = (int*)(c.ws + WS_CTL) + CTL_QUEUE + (DRY ? 1 : 0);
    volatile int* slot = (volatile int*)(lds + fa::O_END);
    __syncthreads();
    if (c.tid == 0) *slot = atomicAdd(qc, 1);
    __syncthreads();
    int u = __builtin_amdgcn_readfirstlane(*slot);
    while (u < 2048) {
        __syncthreads();
        if (c.tid == 0) *slot = atomicAdd(qc, 1);
        const int rank = u >> 5, bg = u & 31;
        if (fast) nsa_unit<ABL, DRY, true>(c, lds, bg >> 1, 63 - rank, bg & 1); else nsa_unit<ABL, DRY, false>(c, lds, bg >> 1, 63 - rank, bg & 1);
        __syncthreads();
        u = __builtin_amdgcn_readfirstlane(*slot);
    }
}

__device__ __forceinline__ void swa_load(const Ctx& c, int b, int i, int g, uint4 (&kr)[3], uint4 (&vr)[3], int tid) {
    using namespace fa;
    const bf16_t* P = (const bf16_t*)(c.ws + WS_PROJ);
    const int k0 = (i - 2 > 0) ? i - 2 : 0, n = i - k0 + 1;
    const bf16_t* Kb = P + (size_t)b * SEQ * ODP + 1024 + g * 64; const bf16_t* Vb = P + (size_t)b * SEQ * ODP + 1152 + g * 64;
#pragma unroll
    for (int x = 0; x < 3; ++x) if (x < n) { const long row = 64 * (k0 + x) + (tid >> 3); kr[x] = ldg_tile(Kb, row, ODP, tid); vr[x] = ldg_tile(Vb, row, ODP, tid); }
}
template <bool FAST>
__device__ __forceinline__ void swa_unit(const Ctx& c, unsigned char* lds, int b, int i, int g, uint4 (&kr)[3], uint4 (&vr)[3], bool has_next, int nb, int ni, int ng) {
    using namespace fa;
    constexpr int SW_K = 0, SW_V = 3 * KTB, SW_STG = 3 * KTB + 3 * VTB;
    static_assert(SW_STG + 8 * STG_W <= LDS_BARST, "swa LDS");
    const bf16_t* P = (const bf16_t*)(c.ws + WS_PROJ); bf16_t* ATT = (bf16_t*)(c.ws + WS_H);
    const int tid = c.tid, lane = c.lane, w = c.wave, r32 = lane & 31, hi = lane >> 5;
    const int tl = 8 * w + (r32 >> 2), hh = r32 & 3, t = 64 * i + tl;
    const size_t m = (size_t)b * SEQ + t;
    const int k0 = (i - 2 > 0) ? i - 2 : 0, n = i - k0 + 1;
    bf16x8 qa0, qa1, qa2, qa3, qb0, qb1, qb2, qb3;
    { const bf16_t* qp_ = P + m * ODP + (8 * g + hh) * 64 + 8 * hi; qa0 = *(const bf16x8*)(qp_); qa1 = *(const bf16x8*)(qp_ + 16); qa2 = *(const bf16x8*)(qp_ + 32); qa3 = *(const bf16x8*)(qp_ + 48);
      qb0 = *(const bf16x8*)(qp_ + 256); qb1 = *(const bf16x8*)(qp_ + 272); qb2 = *(const bf16x8*)(qp_ + 288); qb3 = *(const bf16x8*)(qp_ + 304); }
#pragma unroll
    for (int x = 0; x < 3; ++x) if (x < n) kr[x] = knorm_rope(kr[x], c.swa_kg, 64 * (k0 + x) + (tid >> 3), tid & 7);
    __syncthreads();
#pragma unroll
    for (int x = 0; x < 3; ++x) if (x < n) { *(uint4*)(lds + SW_K + x * KTB + (tid >> 3) * RPK + (tid & 7) * 16) = kr[x]; *(uint4*)(lds + SW_V + x * VTB + (tid >> 3) * RPV + (tid & 7) * 16) = vr[x]; }
    __syncthreads();
    if (has_next) swa_load(c, nb, ni, ng, kr, vr, tid);
#pragma unroll 1
    for (int hq = 0; hq < 2; ++hq) {
        const int head = 8 * g + 4 * hq + hh;
        bf16x8 qf[4];
        qf[0] = hq ? qb0 : qa0; qf[1] = hq ? qb1 : qa1; qf[2] = hq ? qb2 : qa2; qf[3] = hq ? qb3 : qa3;
        qnorm_rope(qf, c.swa_qg, (const float2*)(c.ws + WS_ROPE) + (size_t)t * 8, hi);
        State st; const float sink2 = c.swa_sinks[head] * 1.4426950408889634f;
        if (FAST) init(st, 0.f, hi == 0 ? __builtin_amdgcn_exp2f(sink2) : 0.f); else init(st, sink2, hi == 0 ? 1.f : 0.f);
#pragma unroll 1
        for (int x = 0; x < n; ++x) {
            const int kt = k0 + x;
            RangeMask mk{0, 63}; if (kt == i) mk.hi = tl; if (kt == i - 2) mk.lo = tl + 1;
            tile<0, FAST, false>(st, lds, SW_K + x * KTB, SW_V + x * VTB, qf, 0.f, (kt == i) || (kt == i - 2), mk, lane);
        }
        unsigned char* stg = lds + SW_STG + w * STG_W;
        const float lt = st.l + __shfl_xor(st.l, 32);
        const float sc = 1.f / lt;
#pragma unroll
        for (int dt = 0; dt < 2; ++dt)
#pragma unroll
            for (int r = 0; r < 16; ++r) *(bf16_t*)(stg + r32 * STG_P + (32 * dt + crow(r, hi)) * 2) = f2bf(sc * st.o[dt][r]);
        LDS_FENCE();
#pragma unroll
        for (int it = 0; it < 4; ++it) {
            const int row = it * 8 + (lane >> 3), ch = lane & 7;
            const uint4 v = *(const uint4*)(stg + row * STG_P + ch * 16);
            const size_t mm = (size_t)b * SEQ + 64 * i + 8 * w + (row >> 2);
            *(uint4*)(ATT + mm * D + (8 * g + 4 * hq + (row & 3)) * 64 + ch * 8) = v;
        }
        LDS_FENCE();
    }
}
__device__ __forceinline__ void swa_mfma(const Ctx& c, unsigned char* lds) {
    const bool fast = score_bound(c.swa_qg, c.swa_kg, 1, c.lane) < 60.f && wmax(fabsf(c.swa_sinks[c.lane & 15])) < 40.f;
    uint4 kr[3], vr[3];
    if ((int)blockIdx.x < 2048) swa_load(c, blockIdx.x >> 7, (blockIdx.x >> 1) & 63, blockIdx.x & 1, kr, vr, c.tid);
    for (int u = blockIdx.x; u < 2048; u += gridDim.x) {
        const int g = u & 1, i = (u >> 1) & 63, b = u >> 7, un = u + gridDim.x;
        if (fast) swa_unit<true>(c, lds, b, i, g, kr, vr, un < 2048, un >> 7, (un >> 1) & 63, un & 1); else swa_unit<false>(c, lds, b, i, g, kr, vr, un < 2048, un >> 7, (un >> 1) & 63, un & 1);
    }
}

__device__ __forceinline__ void phase_router2(const Ctx& c, unsigned char* lds_raw, int layer) {
    typedef short bf16x8 __attribute__((ext_vector_type(8)));
    typedef float f32x4 __attribute__((ext_vector_type(4)));
    const int tid = c.tid, lane = c.lane, w = c.wave, l15 = lane & 15, g4 = lane >> 4;
    float* LG = (float*)(lds_raw + w * 5632);
    float* RS = LG + 32 * 40;
    int* lcnt = (int*)(lds_raw + 8 * 5632);
    int* lbase = lcnt + 32;
    int* tinfo = lbase + 32;
    float* twt = (float*)(tinfo + 1024);
    const bf16_t* XB = (const bf16_t*)(c.ws + WS_XB); const bf16_t* RW = (const bf16_t*)(c.ws + WS_RW) + (size_t)layer * 48 * 2048;
    const float* bg = c.moe_b_grp + layer * 4; const float* be = c.moe_b_exp + layer * 32; const float* gain = c.moe_norm + layer * D;
    int* gcnt = (int*)(c.ws + WS_CTL) + layer * 32;
    bf16_t* H = (bf16_t*)(c.ws + WS_H);
    int* TE = (int*)(c.ws + WS_TE); int* TR = (int*)(c.ws + WS_TR); float* TW = (float*)(c.ws + WS_TW);
    __syncthreads();
    if (tid < 32) lcnt[tid] = 0;
    __syncthreads();
    for (int blk = blockIdx.x; blk < M / 256; blk += gridDim.x) {
        const int tok0 = blk * 256 + w * 32;
        f32x4 acc[2][3];
#pragma unroll
        for (int mt = 0; mt < 2; ++mt)
#pragma unroll
            for (int nt = 0; nt < 3; ++nt) acc[mt][nt] = (f32x4){0.f, 0.f, 0.f, 0.f};
        float sq0 = 0.f, sq1 = 0.f;
        const bf16_t* a0 = XB + (size_t)(tok0 + l15) * D + 8 * g4; const bf16_t* a1 = a0 + (size_t)16 * D;
        constexpr int RB_P = 528, RB_B = 48 * RB_P, RB_OFF = 65536;
        static_assert(RB_OFF + 2 * RB_B <= 160 * 1024 - 16 && RB_OFF >= 8 * 5632 + 8192, "router LDS");
        const int rs_row0 = tid >> 5, rs_part = tid & 31;
        const bf16_t* rsrc = RW + (size_t)rs_row0 * 2048 + (rs_part < 16 ? 0 : 1024) + (rs_part & 15) * 8;
        unsigned char* rdst = lds_raw + RB_OFF + rs_row0 * RB_P + rs_part * 16;
        const unsigned char* bfr = lds_raw + RB_OFF + l15 * RB_P + g4 * 16;
#define RT_LDW(KC) do { w0_ = *(const uint4*)(rsrc + 128 * (KC)); w1_ = *(const uint4*)(rsrc + (size_t)16 * 2048 + 128 * (KC)); w2_ = *(const uint4*)(rsrc + (size_t)32 * 2048 + 128 * (KC)); } while (0)
#define RT_STW(BUF) do { *(uint4*)(rdst + (BUF) * RB_B) = w0_; *(uint4*)(rdst + (BUF) * RB_B + 16 * RB_P) = w1_; *(uint4*)(rdst + (BUF) * RB_B + 32 * RB_P) = w2_; } while (0)
#define RT_LD(S, KS0) do { S##00 = *(const bf16x8*)(a0 + 32 * (KS0)); S##01 = *(const bf16x8*)(a0 + 32 * ((KS0) + 1)); S##02 = *(const bf16x8*)(a0 + 32 * ((KS0) + 2)); S##03 = *(const bf16x8*)(a0 + 32 * ((KS0) + 3)); \
        S##10 = *(const bf16x8*)(a1 + 32 * (KS0)); S##11 = *(const bf16x8*)(a1 + 32 * ((KS0) + 1)); S##12 = *(const bf16x8*)(a1 + 32 * ((KS0) + 2)); S##13 = *(const bf16x8*)(a1 + 32 * ((KS0) + 3)); } while (0)
#define RT_STEP(A0, A1, BUF, KL) do { \
        { float f[8]; unpack8(__builtin_bit_cast(uint4, A0), f); \
          _Pragma("unroll") for (int j = 0; j < 8; ++j) sq0 += f[j] * f[j]; \
          unpack8(__builtin_bit_cast(uint4, A1), f); \
          _Pragma("unroll") for (int j = 0; j < 8; ++j) sq1 += f[j] * f[j]; } \
        _Pragma("unroll") for (int nt = 0; nt < 3; ++nt) { \
            const bf16x8 Bh = *(const bf16x8*)(bfr + (BUF) * RB_B + nt * 16 * RB_P + (KL) * 64), Bl = *(const bf16x8*)(bfr + (BUF) * RB_B + nt * 16 * RB_P + 256 + (KL) * 64); \
            acc[0][nt] = __builtin_amdgcn_mfma_f32_16x16x32_bf16(A0, Bh, acc[0][nt], 0, 0, 0); acc[0][nt] = __builtin_amdgcn_mfma_f32_16x16x32_bf16(A0, Bl, acc[0][nt], 0, 0, 0); \
            acc[1][nt] = __builtin_amdgcn_mfma_f32_16x16x32_bf16(A1, Bh, acc[1][nt], 0, 0, 0); acc[1][nt] = __builtin_amdgcn_mfma_f32_16x16x32_bf16(A1, Bl, acc[1][nt], 0, 0, 0); \
        } } while (0)
#define RT_CHUNK(S, BUF) do { RT_STEP(S##00, S##10, BUF, 0); RT_STEP(S##01, S##11, BUF, 1); RT_STEP(S##02, S##12, BUF, 2); RT_STEP(S##03, S##13, BUF, 3); } while (0)
        bf16x8 P00, P01, P02, P03, P10, P11, P12, P13, Q00, Q01, Q02, Q03, Q10, Q11, Q12, Q13;
        uint4 w0_, w1_, w2_;
        const int rrot = blk & 7;
#define RT_KC(X) (((X) + rrot) & 7)
        RT_LDW(RT_KC(0)); RT_LD(P, 4 * RT_KC(0));
        __syncthreads();
        RT_STW(0);
        RT_LDW(RT_KC(1));
        __syncthreads();
#pragma unroll 1
        for (int kc = 0; kc < 8; kc += 2) {
            RT_LD(Q, 4 * RT_KC(kc + 1));
            RT_CHUNK(P, 0);
            RT_STW(1);
            if (kc + 2 < 8) RT_LDW(RT_KC(kc + 2));
            __syncthreads();
            if (kc + 2 < 8) RT_LD(P, 4 * RT_KC(kc + 2));
            RT_CHUNK(Q, 1);
            if (kc + 2 < 8) { RT_STW(0); if (kc + 3 < 8) RT_LDW(RT_KC(kc + 3)); }
            __syncthreads();
        }
#undef RT_KC
#undef RT_LDW
#undef RT_STW
#undef RT_LD
#undef RT_STEP
#undef RT_CHUNK
        sq0 += __shfl_xor(sq0, 16); sq0 += __shfl_xor(sq0, 32); sq1 += __shfl_xor(sq1, 16); sq1 += __shfl_xor(sq1, 32);
        if (g4 == 0) { RS[l15] = rsqrtf(sq0 * (1.f / D) + EPS); RS[16 + l15] = rsqrtf(sq1 * (1.f / D) + EPS); }
        LDS_FENCE();
#pragma unroll
        for (int nt = 0; nt < 3; ++nt) {
            const int o = 16 * nt + l15;
            if (o < 36) {
                const float bias = o < 4 ? bg[o] : be[o - 4];
#pragma unroll
                for (int mt = 0; mt < 2; ++mt)
#pragma unroll
                    for (int r = 0; r < 4; ++r) { const int tk = 16 * mt + 4 * g4 + r; LG[tk * 40 + o] = acc[mt][nt][r] * RS[tk] + bias; }
            }
        }
        LDS_FENCE();
        if (lane < 32) {
            const float* lg = LG + lane * 40;
            int gi = 0; float gm = lg[0];
#pragma unroll
            for (int q = 1; q < 4; ++q) if (lg[q] > gm) { gm = lg[q]; gi = q; }
            float gs = 0.f;
#pragma unroll
            for (int q = 0; q < 4; ++q) gs += __expf(lg[q] - gm);
            const float gwt = 1.f / gs;
            float w8[8];
#pragma unroll
            for (int j = 0; j < 8; ++j) w8[j] = lg[4 + gi * 8 + j];
            int j0 = 0; float l0 = w8[0];
#pragma unroll
            for (int j = 1; j < 8; ++j) if (w8[j] > l0) { l0 = w8[j]; j0 = j; }
            int j1 = -1; float l1 = -INFINITY;
#pragma unroll
            for (int j = 0; j < 8; ++j) if (j != j0 && w8[j] > l1) { l1 = w8[j]; j1 = j; }
            const float e1 = __expf(l1 - l0); const float w0 = gwt / (1.f + e1), w1 = gwt * e1 / (1.f + e1);
            const int tl = w * 32 + lane, ea = gi * 8 + j0, eb = gi * 8 + j1;
            const int ra = atomicAdd(&lcnt[ea], 1), rb = atomicAdd(&lcnt[eb], 1);
            tinfo[tl * 4 + 0] = ea; tinfo[tl * 4 + 1] = eb; tinfo[tl * 4 + 2] = ra; tinfo[tl * 4 + 3] = rb; twt[tl * 2] = w0; twt[tl * 2 + 1] = w1;
        }
        __syncthreads();
        if (tid < 32) { lbase[tid] = atomicAdd(&gcnt[tid], lcnt[tid]); lcnt[tid] = 0; }
        __syncthreads();
        if (tid < 256) {
            const int m = blk * 256 + tid; const int ea = tinfo[tid * 4], eb = tinfo[tid * 4 + 1];
            TE[2 * m] = ea; TE[2 * m + 1] = eb; TR[2 * m] = lbase[ea] + tinfo[tid * 4 + 2]; TR[2 * m + 1] = lbase[eb] + tinfo[tid * 4 + 3];
            TW[2 * m] = twt[tid * 2]; TW[2 * m + 1] = twt[tid * 2 + 1];
            int* LIST = (int*)(c.ws + WS_LIST);
            LIST[(size_t)ea * 65536 + lbase[ea] + tinfo[tid * 4 + 2]] = m; LIST[(size_t)eb * 65536 + lbase[eb] + tinfo[tid * 4 + 3]] = m;
            float* RSL = (float*)(c.ws + WS_RSL); const float rsv = ((const float*)(lds_raw + (tid >> 5) * 5632))[32 * 40 + (tid & 31)];
            RSL[(size_t)ea * 65536 + lbase[ea] + tinfo[tid * 4 + 2]] = rsv; RSL[(size_t)eb * 65536 + lbase[eb] + tinfo[tid * 4 + 3]] = rsv;
        }
        __syncthreads();
    }
}

__device__ __forceinline__ int build_tile_table(const Ctx& c, unsigned char* lds_raw, int layer) {
    const int* gcnt = (const int*)(c.ws + WS_CTL) + layer * 32;
    int* pst = (int*)(lds_raw + pg8::STAGE_BYTES); int* te = pst + 64; int* tv = te + MAXTILES; int* tg = tv + MAXTILES;
    __syncthreads();
    if (c.tid == 0) { int a = 0; for (int e = 0; e < 32; ++e) { pst[e] = a; a += (gcnt[e] + 255) >> 8; } pst[32] = a; }
    __syncthreads();
    for (int st = c.tid; st < MAXTILES; st += NTHREADS) {
        int e = 31;
        for (int q = 0; q < 32; ++q) if (st >= pst[q] && st < pst[q + 1]) e = q;
        const int ti = st - pst[e], rem = gcnt[e] - 256 * ti;
        te[st] = e; tv[st] = rem < 256 ? (rem > 0 ? rem : 0) : 256; tg[st] = e * 65536 + 256 * ti;
    }
    __syncthreads();
    return pst[32];
}
__device__ __forceinline__ void phase_moe1_mfma(const Ctx& c, unsigned char* lds_raw, int layer) {
    const int nt = build_tile_table(c, lds_raw, layer);
    const int* te = (const int*)(lds_raw + pg8::STAGE_BYTES) + 64;
    pg8::Gemm g{(const bf16_t*)(c.ws + WS_XB), (const bf16_t*)(c.ws + WS_WGU) + (size_t)layer * 32 * 1024 * 1024, D, (const int*)(c.ws + WS_LIST), (size_t)1024 * 1024};
    pg8::MoeOrder S{te, te + MAXTILES, te + 2 * MAXTILES, nt * 4, (int)gridDim.x, (int)blockIdx.x};
    pg8::EpiGUT E{(bf16_t*)(c.ws + WS_HID), (const float*)(c.ws + WS_RSL)};
    pg8::gemm_phase<pg8::EpiGUT, pg8::MoeOrder, true>((PG8_LAS unsigned char*)lds_raw, g, S, E);
}
__device__ __forceinline__ void phase_moe2_mfma(const Ctx& c, unsigned char* lds_raw, int layer) {
    __syncthreads();
    const int nt = ((const int*)(lds_raw + pg8::STAGE_BYTES))[32];
    const int* te = (const int*)(lds_raw + pg8::STAGE_BYTES) + 64;
    pg8::Gemm g{(const bf16_t*)(c.ws + WS_HID), (const bf16_t*)(c.ws + WS_WD) + (size_t)layer * 32 * 1024 * 512, FF, nullptr, (size_t)1024 * 512};
    pg8::MoeOrder S{te, te + MAXTILES, te + 2 * MAXTILES, nt * 4, (int)gridDim.x, (int)blockIdx.x};
    pg8::EpiDownT E{(bf16_t*)(c.ws + WS_YS)};
    pg8::gemm_phase<pg8::EpiDownT, pg8::MoeOrder, false>((PG8_LAS unsigned char*)lds_raw, g, S, E);
}
template <class Epi>
__device__ __forceinline__ void phase_gemm_mfma(unsigned char* lds_raw, const bf16_t* A, const bf16_t* Bt, int Npad, int K, const Epi& E) {
    pg8::Gemm g{A, Bt, K, nullptr, 0}; pg8::StaticOrder S; S.init(M, Npad, (int)gridDim.x, (int)blockIdx.x);
    pg8::gemm_phase<Epi, pg8::StaticOrder, false>((PG8_LAS unsigned char*)lds_raw, g, S, E);
}

#ifndef PSTAMP
#define PSTAMP(k) do {} while (0)
#endif
#define PHASE_BEGIN() Ctx c; { CArgs* ap_ = (CArgs*)__builtin_amdgcn_kernarg_segment_ptr(); asm volatile("" : "+s"(ap_)); int tid_ = threadIdx.x; asm volatile("" : "+v"(tid_)); make_ctx(c, *ap_, tid_); } \
    unsigned char* ws = c.ws; bf16_t* H = (bf16_t*)(ws + WS_H); bf16_t* PROJ = (bf16_t*)(ws + WS_PROJ); (void)H; (void)PROJ;
__global__ void __launch_bounds__(NTHREADS, 2) mega(Args a) {
    extern __shared__ __attribute__((aligned(16))) unsigned char lds_raw[];
    float* lds = (float*)lds_raw;
    if (threadIdx.x < 4) ((volatile XLAS unsigned*)(XLAS unsigned char*)lds_raw)[(LDS_BARST >> 2) + threadIdx.x] = 0u;
    __syncthreads();
    const XcdBarrier xbar = xcd_barrier_post((unsigned*)(a.ws + WS_CTL + CTL_BAR), (volatile XLAS unsigned*)((XLAS unsigned char*)lds_raw + LDS_BARST));
    PSTAMP(0); { PHASE_BEGIN(); phase_prologue(c, lds); PSTAMP(23); phase_norm_x(c, c.x, c.ev_norm, H); }
    xcd_barrier(xbar);
    PSTAMP(1); { PHASE_BEGIN(); pg8::EpiProj0T epi{PROJ, (float*)(ws + WS_LOGF), (const float*)(ws + WS_LB)}; phase_gemm_mfma(lds_raw, H, (const bf16_t*)(ws + WS_W0T), EVPP, D, epi); }
    xcd_barrier(xbar);
    PSTAMP(2); { PHASE_BEGIN();
      post_even(c, blockIdx.x, gridDim.x); PSTAMP(20);
      for (int u = blockIdx.x; u < 256; u += gridDim.x) compress_mfma(c, lds_raw, u);
      PSTAMP(21);
      for (int su = blockIdx.x; su < 256; su += gridDim.x) hgrn2_passA(c, lds_raw, su); }
    xcd_barrier(xbar);
    PSTAMP(24); { PHASE_BEGIN();
      for (int u = blockIdx.x; u < 64; u += gridDim.x) hgrn2_seq_full(c, lds_raw, u);
      PSTAMP(3); nsa_mfma(c, lds_raw); PSTAMP(22);
#ifdef PROBE_NSA_ABL
      nsa_mfma<PROBE_NSA_ABL, true>(c, lds_raw);
#endif
    }
    xcd_barrier(xbar);
    PSTAMP(4); { PHASE_BEGIN(); pg8::EpiResidF2B epi{c.x, (bf16_t*)(ws + WS_XB)}; phase_gemm_mfma(lds_raw, H, (const bf16_t*)(ws + WS_WO0T), D, D, epi); }
    xcd_barrier(xbar);
    PSTAMP(5); { PHASE_BEGIN(); phase_router2(c, lds_raw, 0); }
    xcd_barrier(xbar);
    PSTAMP(7); { PHASE_BEGIN(); phase_moe1_mfma(c, lds_raw, 0); }
    xcd_barrier(xbar);
    PSTAMP(8); { PHASE_BEGIN(); phase_moe2_mfma(c, lds_raw, 0); }
    xcd_barrier(xbar);
    PSTAMP(9); { PHASE_BEGIN(); phase_combine<false>(c, (bf16_t*)(ws + WS_XB), nullptr, c.od_norm, H, (const bf16_t*)(ws + WS_YS), 0); }
    xcd_barrier(xbar);
    PSTAMP(10); { PHASE_BEGIN(); pg8::EpiRawScaleT epi{PROJ, ODP, (const float*)(ws + WS_RSTD)}; phase_gemm_mfma(lds_raw, (const bf16_t*)(ws + WS_XB), (const bf16_t*)(ws + WS_W1T), ODP, D, epi); }
    xcd_barrier(xbar);
    PSTAMP(12); { PHASE_BEGIN(); swa_mfma(c, lds_raw); }
    xcd_barrier(xbar);
    PSTAMP(13); { PHASE_BEGIN(); pg8::EpiResidB2B epi{(bf16_t*)(ws + WS_XB)}; phase_gemm_mfma(lds_raw, H, (const bf16_t*)(ws + WS_WO1T), D, D, epi); }
    xcd_barrier(xbar);
    PSTAMP(14); { PHASE_BEGIN(); phase_router2(c, lds_raw, 1); }
    xcd_barrier(xbar);
    PSTAMP(16); { PHASE_BEGIN(); phase_moe1_mfma(c, lds_raw, 1); }
    xcd_barrier(xbar);
    PSTAMP(17); { PHASE_BEGIN(); phase_moe2_mfma(c, lds_raw, 1); }
    xcd_barrier(xbar);
    PSTAMP(18); { PHASE_BEGIN(); phase_combine<true>(c, (bf16_t*)(ws + WS_XB), c.xr, nullptr, nullptr, (const bf16_t*)(ws + WS_YS), 1); }
    PSTAMP(19);
#ifdef PROBE_TAIL
    PROBE_TAIL
#endif
}

extern "C" void kernel_launch(void* const* d_in, const int* in_sizes, int n_in, void* d_out, int out_size, void* d_ws, size_t ws_size, hipStream_t stream) {
    static int grid = 0;
    if (grid == 0) {
        if (n_in != 25 || ws_size < WS_END) { fprintf(stderr, "kernel_launch: unexpected n_in %d / ws %zu\n", n_in, ws_size); grid = -1; return; }
        int dev = 0, cus = 0, per_cu = 0;
        hipGetDevice(&dev);
        hipDeviceGetAttribute(&cus, hipDeviceAttributeMultiprocessorCount, dev);
        hipFuncSetAttribute((const void*)mega, hipFuncAttributeMaxDynamicSharedMemorySize, LDS_BYTES);
        hipOccupancyMaxActiveBlocksPerMultiprocessor(&per_cu, (const void*)mega, NTHREADS, LDS_BYTES);
        if (per_cu < 1) { fprintf(stderr, "kernel_launch: occupancy query says %d blocks/CU\n", per_cu); per_cu = 1; }
        (void)hipGetLastError();
        grid = cus;
    }
    if (grid < 0) return;
    hipMemsetAsync((char*)d_ws + WS_CTL, 0, CTL_BYTES, stream);
    Args a{};
    for (int i = 0; i < 25; ++i) a.in[i] = (const float*)d_in[i];
    a.out = (float*)d_out; a.ws = (unsigned char*)d_ws;
    void* args[] = {&a};
    hipError_t e = hipLaunchCooperativeKernel((const void*)mega, dim3(grid), dim3(NTHREADS), args, LDS_BYTES, stream);
    if (e != hipSuccess) fprintf(stderr, "cooperative launch failed: %s (grid %d)\n", hipGetErrorString(e), grid);
}
```
